# Optimizing an MI355X kernel written in HIP

```python
import math
import jax, jax.numpy as jnp
from jax import lax
import numpy as np

D_MODEL = 1024
BATCH = 8
SEQ = 4096
DEPTH = 2

CHUNK = 64
D_MIX = D_MODEL
NORM_EPS = 1e-5
GLA_HEADS = 4
GLA_WIDTH = 3 * D_MIX // 8
GLA_DV = GLA_WIDTH // GLA_HEADS
GLA_DK = GLA_DV // 2
GLA_GATE_RANK = 16
GLA_GATE_TEMP = 16.0
RET_HEADS = 4
RET_WIDTH = 3 * D_MIX // 8
RET_DV = RET_WIDTH // RET_HEADS
RET_DK = RET_DV // 2
ROPE_BASE = 10000.0
S5_WIDTH = D_MIX - GLA_WIDTH - RET_WIDTH
S5_GROUP_DIM = 16
S5_GROUPS = S5_WIDTH // S5_GROUP_DIM
S5_STATE = 64
N_EXPERTS = 32
TOP_K = 4
D_FF = D_MODEL
SWIGLU_LIMIT = 7.0
SWIGLU_ALPHA = 1.702
EXPERT_BLOCK = 128
IN_SIZES = (GLA_HEADS * GLA_DK, GLA_HEADS * GLA_DK, GLA_WIDTH, GLA_WIDTH, GLA_GATE_RANK,
            RET_HEADS * RET_DK, RET_HEADS * RET_DK, RET_WIDTH, RET_WIDTH, S5_WIDTH)
IN_COLS = sum(IN_SIZES)

kernel_name = 'hybrid_gla_retnet_s5_moe_adaln'


def rms_norm(x, w):
    xf = x.astype(jnp.float32)
    y = xf * lax.rsqrt(jnp.mean(xf * xf, axis=-1, keepdims=True) + NORM_EPS)
    return (y * w.astype(jnp.float32)).astype(x.dtype)


def head_rms_norm(o, w):
    y = o * lax.rsqrt(jnp.mean(o * o, axis=-1, keepdims=True) + NORM_EPS)
    return y * w.astype(jnp.float32).reshape(o.shape[-2], o.shape[-1])


def head_group_norm(o, w):
    mu = jnp.mean(o, axis=-1, keepdims=True)
    oc = o - mu
    y = oc * lax.rsqrt(jnp.mean(oc * oc, axis=-1, keepdims=True) + NORM_EPS)
    return y * w.astype(jnp.float32).reshape(o.shape[-2], o.shape[-1])


def rotary(t, cos, sin):
    t1, t2 = jnp.split(t, 2, axis=-1)
    return jnp.concatenate([t1 * cos - t2 * sin, t1 * sin + t2 * cos], axis=-1)


def chunked_gated_linear_attention(q, k, v, log_a):
    b, l, h, dk = q.shape
    dv = v.shape[-1]
    n = l // CHUNK

    def chunks(t):
        return t.reshape(b, n, CHUNK, h, t.shape[-1]).transpose(0, 3, 1, 2, 4)

    q, k, v, log_a = chunks(q), chunks(k), chunks(v), chunks(log_a)
    cum = jnp.cumsum(log_a, axis=3)
    q_dec = q * jnp.exp(cum)
    k_inv = k * jnp.exp(-cum)
    causal = jnp.tril(jnp.ones((CHUNK, CHUNK), dtype=bool))
    scores = jnp.where(causal, jnp.einsum('bhnid,bhnjd->bhnij', q_dec, k_inv), 0.0)
    o_intra = jnp.einsum('bhnij,bhnjv->bhniv', scores, v)
    total = cum[:, :, :, -1]
    k_end = k * jnp.exp(total[:, :, :, None, :] - cum)
    d_state = jnp.einsum('bhncd,bhncv->nbhdv', k_end, v)
    decay = jnp.moveaxis(jnp.exp(total), 2, 0)

    def step(state, inp):
        ds, dec = inp
        return dec[..., None] * state + ds, state

    _, s_prev = lax.scan(step, jnp.zeros((b, h, dk, dv), q.dtype), (d_state, decay))
    o_inter = jnp.einsum('bhncd,nbhdv->bhncv', q_dec, s_prev)
    o = o_intra + o_inter
    return o.transpose(0, 2, 3, 1, 4).reshape(b, l, h, dv)


def s5_mixer(u, a_re, a_im, log_dt, b_re, b_im, c_re, c_im, d_skip, w_glu, b_glu):
    f32 = jnp.float32
    b, l, _ = u.shape
    uf = u.reshape(b, l, S5_GROUPS, S5_GROUP_DIM)
    lam = lax.complex(a_re.astype(f32), a_im.astype(f32))
    dt = jnp.exp(log_dt.astype(f32))[:, None]
    lam_bar = jnp.exp(lam * dt)
    b_mat = lax.complex(b_re.astype(f32), b_im.astype(f32))
    c_mat = lax.complex(c_re.astype(f32), c_im.astype(f32))
    b_bar = ((lam_bar - 1.0) / lam)[..., None] * b_mat
    bu = jnp.einsum('blgh,gph->blgp', uf.astype(jnp.complex64), b_bar)
    a_elems = jnp.broadcast_to(lam_bar, bu.shape)

    def combine(e1, e2):
        a1, x1 = e1
        a2, x2 = e2
        return a1 * a2, a2 * x1 + x2

    _, states = lax.associative_scan(combine, (a_elems, bu), axis=1)
    y = jnp.einsum('blgp,ghp->blgh', states, c_mat).real
    y = y + d_skip.astype(f32).reshape(S5_GROUPS, S5_GROUP_DIM) * uf
    y = jax.nn.gelu(y.reshape(b, l, S5_WIDTH))
    return y * jax.nn.sigmoid(y @ w_glu.astype(f32) + b_glu.astype(f32))


def token_mixer(h, w_in, gla_w_a2, gla_b_a, gla_norm_w, ret_norm_w, s5_a_re, s5_a_im,
                s5_log_dt, s5_b_re, s5_b_im, s5_c_re, s5_c_im, s5_d, s5_w_glu, s5_b_glu, w_out):
    f32 = jnp.float32
    b, l, _ = h.shape
    proj = (h @ w_in).astype(f32)
    points = np.cumsum(IN_SIZES)[:-1].tolist()
    gq, gk, gv, gg, ga, rq, rk, rv, rg, su = jnp.split(proj, points, axis=-1)

    log_a = jax.nn.log_sigmoid(ga @ gla_w_a2.astype(f32) + gla_b_a.astype(f32)) / GLA_GATE_TEMP
    o_gla = chunked_gated_linear_attention(
        gq.reshape(b, l, GLA_HEADS, GLA_DK) * GLA_DK ** -0.5,
        gk.reshape(b, l, GLA_HEADS, GLA_DK),
        gv.reshape(b, l, GLA_HEADS, GLA_DV),
        log_a.reshape(b, l, GLA_HEADS, GLA_DK))
    o_gla = head_rms_norm(o_gla, gla_norm_w).reshape(b, l, GLA_WIDTH) * jax.nn.silu(gg)

    pos = jnp.arange(l, dtype=f32)
    inv_freq = ROPE_BASE ** (-jnp.arange(0, RET_DK, 2, dtype=f32) / RET_DK)
    ang = pos[:, None] * inv_freq[None, :]
    cos, sin = jnp.cos(ang)[None, :, None, :], jnp.sin(ang)[None, :, None, :]
    q_r = rotary(rq.reshape(b, l, RET_HEADS, RET_DK), cos, sin)
    k_r = rotary(rk.reshape(b, l, RET_HEADS, RET_DK), cos, sin) * RET_DK ** -0.5
    log_gamma = jnp.log1p(-jnp.exp2(-5.0 - jnp.arange(RET_HEADS, dtype=f32)))
    log_decay = jnp.broadcast_to(log_gamma[None, None, :, None], (b, l, RET_HEADS, RET_DK))
    o_ret = chunked_gated_linear_attention(q_r, k_r, rv.reshape(b, l, RET_HEADS, RET_DV), log_decay)
    o_ret = head_group_norm(o_ret, ret_norm_w).reshape(b, l, RET_WIDTH) * jax.nn.silu(rg)

    o_s5 = s5_mixer(su, s5_a_re, s5_a_im, s5_log_dt, s5_b_re, s5_b_im, s5_c_re, s5_c_im,
                    s5_d, s5_w_glu, s5_b_glu)

    mixed = jnp.concatenate([o_gla, o_ret, o_s5], axis=-1).astype(h.dtype)
    return mixed @ w_out


def moe_ffn(h, router_w, router_b, w_up, b_up, w_down, b_down):
    b, l, d = h.shape
    t = b * l
    hf = h.reshape(t, d)
    logits = hf.astype(jnp.float32) @ router_w.astype(jnp.float32) + router_b.astype(jnp.float32)
    top_logits, top_idx = lax.top_k(logits, TOP_K)
    gates = jax.nn.softmax(top_logits, axis=-1)
    n_slots = t * TOP_K
    flat_e = top_idx.reshape(-1)
    order = jnp.argsort(flat_e)
    sorted_e = flat_e[order]
    counts = jnp.bincount(flat_e, length=N_EXPERTS)
    starts = jnp.cumsum(counts) - counts
    padded = (counts + EXPERT_BLOCK - 1) // EXPERT_BLOCK * EXPERT_BLOCK
    pad_ends = jnp.cumsum(padded)
    pad_starts = pad_ends - padded
    dest_sorted = pad_starts[sorted_e] + jnp.arange(n_slots) - starts[sorted_e]
    dest = jnp.zeros_like(dest_sorted).at[order].set(dest_sorted)
    n_blocks = n_slots // EXPERT_BLOCK + N_EXPERTS
    rows = jnp.zeros((n_blocks * EXPERT_BLOCK, d), h.dtype).at[dest].set(jnp.repeat(hf, TOP_K, axis=0))
    block_e = jnp.minimum(jnp.searchsorted(pad_ends, jnp.arange(n_blocks) * EXPERT_BLOCK, side='right'),
                          N_EXPERTS - 1)

    def expert_block(args):
        xb, e = args
        up = xb @ w_up[e] + b_up[e]
        x_glu, x_lin = jnp.split(up, 2, axis=-1)
        x_glu = jnp.minimum(x_glu, SWIGLU_LIMIT)
        x_lin = jnp.clip(x_lin, -SWIGLU_LIMIT, SWIGLU_LIMIT)
        act = x_glu * jax.nn.sigmoid(SWIGLU_ALPHA * x_glu) * (x_lin + 1.0)
        return act @ w_down[e] + b_down[e]

    out_rows = lax.map(expert_block, (rows.reshape(n_blocks, EXPERT_BLOCK, d), block_e)).reshape(-1, d)
    y = jnp.einsum('tkd,tk->td', out_rows[dest].reshape(t, TOP_K, d), gates.astype(h.dtype))
    return y.reshape(b, l, d)


def setup_inputs(seed: int = 0) -> dict:
    key = jax.random.key(seed)
    ks = iter(jax.random.split(key, 40))
    nrm = lambda shape, s: jax.random.normal(next(ks), shape, jnp.float32) * s
    gain = lambda shape: 1.0 + nrm(shape, 0.02)
    L = DEPTH
    d = D_MODEL
    a_im0 = jnp.pi * jnp.arange(S5_STATE, dtype=jnp.float32)
    return {
        'x': nrm((BATCH, SEQ, d), 1.0),
        'c': nrm((BATCH, d), 1.0),
        'norm1_w': gain((L, d)),
        'norm2_w': gain((L, d)),
        'w_mod': nrm((L, d, 6 * d), 0.5 * d ** -0.5),
        'b_mod': nrm((L, 6 * d), 0.02),
        'w_in': nrm((L, d, IN_COLS), d ** -0.5),
        'gla_w_a2': nrm((L, GLA_GATE_RANK, GLA_HEADS * GLA_DK), GLA_GATE_RANK ** -0.5),
        'gla_b_a': nrm((L, GLA_HEADS * GLA_DK), 0.1),
        'gla_norm_w': gain((L, GLA_WIDTH)),
        'ret_norm_w': gain((L, RET_WIDTH)),
        's5_a_re': -0.5 + nrm((L, S5_GROUPS, S5_STATE), 0.01),
        's5_a_im': a_im0 + nrm((L, S5_GROUPS, S5_STATE), 0.01),
        's5_log_dt': jax.random.uniform(next(ks), (L, S5_GROUPS), jnp.float32,
                                        math.log(1e-3), math.log(1e-1)),
        's5_b_re': nrm((L, S5_GROUPS, S5_STATE, S5_GROUP_DIM), (2.0 * S5_GROUP_DIM) ** -0.5),
        's5_b_im': nrm((L, S5_GROUPS, S5_STATE, S5_GROUP_DIM), (2.0 * S5_GROUP_DIM) ** -0.5),
        's5_c_re': nrm((L, S5_GROUPS, S5_GROUP_DIM, S5_STATE), S5_STATE ** -0.5),
        's5_c_im': nrm((L, S5_GROUPS, S5_GROUP_DIM, S5_STATE), S5_STATE ** -0.5),
        's5_d': nrm((L, S5_WIDTH), 1.0),
        's5_w_glu': nrm((L, S5_WIDTH, S5_WIDTH), S5_WIDTH ** -0.5),
        's5_b_glu': nrm((L, S5_WIDTH), 0.02),
        'w_out': nrm((L, D_MIX, d), D_MIX ** -0.5),
        'router_w': nrm((L, d, N_EXPERTS), d ** -0.5),
        'router_b': nrm((L, N_EXPERTS), 0.01),
        'w_up': nrm((L, N_EXPERTS, d, 2 * D_FF), d ** -0.5),
        'b_up': nrm((L, N_EXPERTS, 2 * D_FF), 0.02),
        'w_down': nrm((L, N_EXPERTS, D_FF, d), D_FF ** -0.5),
        'b_down': nrm((L, N_EXPERTS, d), 0.02),
        'final_norm_w': gain((d,)),
    }


def reference(x, c, norm1_w, norm2_w, w_mod, b_mod, w_in, gla_w_a2, gla_b_a, gla_norm_w,
              ret_norm_w, s5_a_re, s5_a_im, s5_log_dt, s5_b_re, s5_b_im, s5_c_re, s5_c_im,
              s5_d, s5_w_glu, s5_b_glu, w_out, router_w, router_b, w_up, b_up, w_down,
              b_down, final_norm_w):
    cond = jax.nn.silu(c)
    for i in range(DEPTH):
        mod = cond @ w_mod[i] + b_mod[i]
        sh1, sc1, g1, sh2, sc2, g2 = jnp.split(mod[:, None, :], 6, axis=-1)
        hdn = rms_norm(x, norm1_w[i]) * (1.0 + sc1) + sh1
        x = x + g1 * token_mixer(hdn, w_in[i], gla_w_a2[i], gla_b_a[i], gla_norm_w[i],
                                 ret_norm_w[i], s5_a_re[i], s5_a_im[i], s5_log_dt[i],
                                 s5_b_re[i], s5_b_im[i], s5_c_re[i], s5_c_im[i], s5_d[i],
                                 s5_w_glu[i], s5_b_glu[i], w_out[i])
        hdn = rms_norm(x, norm2_w[i]) * (1.0 + sc2) + sh2
        x = x + g2 * moe_ffn(hdn, router_w[i], router_b[i], w_up[i], b_up[i], w_down[i], b_down[i])
    return rms_norm(x, final_norm_w)
```

```cpp
#include <hip/hip_runtime.h>
#include <hip/hip_cooperative_groups.h>
#include <cstdio>
#include <cstdint>
#include <cmath>
namespace cg = cooperative_groups;

#define LAS __attribute__((address_space(3)))
typedef unsigned short bf16_t;
typedef short bf16x8 __attribute__((ext_vector_type(8)));
typedef float f32x4 __attribute__((ext_vector_type(4)));
typedef float f32x16 __attribute__((ext_vector_type(16)));
typedef unsigned u32x4 __attribute__((ext_vector_type(4)));
typedef unsigned u32x2 __attribute__((ext_vector_type(2)));

constexpr int T_TOK = 32768, DM = 1024, NBATCH = 8, SEQ = 4096, NLAYER = 2;
constexpr int NPROJ = 2576, NPROJP = 2816;
constexpr int NE = 32, CAP = 32768, NSLOT = T_TOK * 4;
constexpr int C_GQ = 0, C_GK = 192, C_GV = 384, C_GG = 768, C_GA = 1152, C_RQ = 1168, C_RK = 1360, C_RV = 1552, C_RG = 1936, C_SU = 2320;
constexpr float NORM_EPS = 1e-5f;
constexpr int NTHREADS = 512, NWAVES = 8;
constexpr int LDS_BYTES = 160 * 1024;
constexpr int MISC_OFF = 148 * 1024;

constexpr size_t al256(size_t x) { return (x + 255) & ~(size_t)255; }
constexpr size_t WS_CTL   = 0;
constexpr size_t WS_MOD   = 4096;
constexpr size_t WS_WIN   = al256(WS_MOD + (size_t)2 * 8 * 6144 * 4);
constexpr size_t WS_WOUT  = al256(WS_WIN + (size_t)2 * NPROJP * 1024 * 2);
constexpr size_t WS_WUP   = al256(WS_WOUT + (size_t)2 * 1024 * 1024 * 2);
constexpr size_t WS_WDN   = al256(WS_WUP + (size_t)2 * 32 * 2048 * 1024 * 2);
constexpr size_t WS_WGLU  = al256(WS_WDN + (size_t)2 * 32 * 1024 * 1024 * 2);
constexpr size_t WS_KTAB  = al256(WS_WGLU + (size_t)2 * 256 * 256 * 2);
constexpr size_t WS_BPOW  = al256(WS_KTAB + (size_t)2 * 16 * 65 * 256 * 2);
constexpr size_t WS_CPOW  = al256(WS_BPOW + (size_t)2 * 16 * 128 * 1024 * 2);
constexpr size_t WS_LAM64 = al256(WS_CPOW + (size_t)2 * 16 * 1024 * 128 * 2);
constexpr size_t WS_ROPE  = al256(WS_LAM64 + (size_t)2 * 16 * 64 * 2 * 4);
constexpr size_t WS_X     = al256(WS_ROPE + (size_t)4096 * 24 * 2 * 4);
constexpr size_t WS_HDN   = al256(WS_X + (size_t)T_TOK * 1024 * 4);
constexpr size_t WS_PROJ  = al256(WS_HDN + (size_t)T_TOK * 1024 * 2);
constexpr size_t WS_MIXED = al256(WS_PROJ + (size_t)T_TOK * NPROJP * 2);
constexpr size_t WS_YBUF  = al256(WS_MIXED + (size_t)T_TOK * 1024 * 2);
constexpr size_t WS_ACT   = al256(WS_YBUF + (size_t)T_TOK * 256 * 2);
constexpr size_t WS_OUTR  = al256(WS_ACT + (size_t)(NSLOT + 256) * 1024 * 2);
constexpr size_t WS_STOK  = al256(WS_OUTR + (size_t)NSLOT * 1024 * 2);
constexpr size_t WS_SGATE = al256(WS_STOK + (size_t)NE * CAP * 4);
constexpr size_t WS_END   = al256(WS_SGATE + (size_t)NE * CAP * 4);

struct Params {
    const float* x; const float* c; const float* norm1_w; const float* norm2_w; const float* w_mod; const float* b_mod;
    const float* w_in; const float* gla_w_a2; const float* gla_b_a; const float* gla_norm_w; const float* ret_norm_w;
    const float* s5_a_re; const float* s5_a_im; const float* s5_log_dt; const float* s5_b_re; const float* s5_b_im;
    const float* s5_c_re; const float* s5_c_im; const float* s5_d; const float* s5_w_glu; const float* s5_b_glu;
    const float* w_out; const float* router_w; const float* router_b; const float* w_up; const float* b_up;
    const float* w_down; const float* b_down; const float* final_norm_w;
    float* out; unsigned char* ws;
    double inv_freq_rev[24];
    float log_gamma[4]; float pad0[4];
};

__device__ __forceinline__ unsigned f2bf(float f) { unsigned u = __builtin_bit_cast(unsigned, f); return (u + 0x7fffu + ((u >> 16) & 1u)) >> 16; }
__device__ __forceinline__ unsigned pk2(float lo, float hi) { unsigned r; asm volatile("v_cvt_pk_bf16_f32 %0, %1, %2" : "=v"(r) : "v"(lo), "v"(hi)); return r; }
__device__ __forceinline__ float bflo(unsigned w) { return __builtin_bit_cast(float, w << 16); }
__device__ __forceinline__ float bfhi(unsigned w) { return __builtin_bit_cast(float, w & 0xffff0000u); }
__device__ __forceinline__ float bf2f(bf16_t b) { return __builtin_bit_cast(float, (unsigned)b << 16); }
__device__ __forceinline__ float lx_f(float v, int lane, int o) { return __builtin_bit_cast(float, __builtin_amdgcn_ds_bpermute((lane ^ o) << 2, __builtin_bit_cast(int, v))); }
__device__ __forceinline__ int lx_i(int v, int lane, int o) { return __builtin_amdgcn_ds_bpermute((lane ^ o) << 2, v); }
__device__ __forceinline__ float lidx_f(float v, int src) { return __builtin_bit_cast(float, __builtin_amdgcn_ds_bpermute(src << 2, __builtin_bit_cast(int, v))); }
__device__ __forceinline__ float wave_sum(float v, int lane) {
#pragma unroll
    for (int o = 1; o < 64; o <<= 1) v += lx_f(v, lane, o);
    return v;
}
__device__ __forceinline__ float siluf(float x) { return x / (1.0f + __expf(-x)); }
__device__ __forceinline__ float sigmoidf_(float x) { return 1.0f / (1.0f + __expf(-x)); }
#define LDS_WAIT() asm volatile("s_waitcnt lgkmcnt(0)" ::: "memory")
__device__ __forceinline__ unsigned char* opaque_ptr(unsigned char* p) { asm volatile("" : "+s"(p)); return p; }
__device__ __forceinline__ LAS unsigned char* opaque_lds(LAS unsigned char* p) { unsigned v = (unsigned)(size_t)p; asm volatile("" : "+s"(v)); return (LAS unsigned char*)(size_t)v; }
__device__ __forceinline__ int opaque_tid() { int t = threadIdx.x; asm volatile("" : "+v"(t)); return t; }

namespace gm {
constexpr int BM = 256, BK = 64, HALF = 128, HTB = HALF * BK * 2, STAGE_BYTES = 8 * HTB, NXCD = 8, WGM = 8;
__device__ __forceinline__ int lds_byte(int r, int c) { const int st = (r >> 4) * 2 + (c >> 5), rr = r & 15, cc = c & 31, ob = rr * 64 + cc * 2; return st * 1024 + (ob ^ (((ob >> 9) & 1) << 5)); }
__device__ __forceinline__ void stage_rc(int b, int& R, int& C) { const int st = b / 1024, sb = b % 1024, swz = sb ^ (((sb >> 9) & 1) << 5); R = (st >> 1) * 16 + swz / 64; C = (st & 1) * 32 + (swz % 64) / 2; }
__device__ __forceinline__ int perm32(int rho) { const int n = rho >> 4, i = rho & 15; return 8 * (i >> 2) + 4 * n + (i & 3); }

struct Unit { const char* B; int pm, pn, e, rows; };

template <class Epi, class Sched, bool GATHER>
__device__ __forceinline__ void gemm_phase(LAS unsigned char* lds, const int K_in, const Sched& S, const Epi& E) {
    int K = K_in; asm volatile("" : "+s"(K));
    const int tid = opaque_tid(), wid = __builtin_amdgcn_readfirstlane(tid >> 6), lane = tid & 63, wr = wid >> 2, wc = wid & 3, fr = lane & 15, fq = lane >> 4;
    const int nt = K / BK;
    int R0, C0; unsigned voffB;
    { stage_rc(tid * 16, R0, C0);
      const int Rb0 = Epi::PERM ? ((R0 & ~31) + perm32(R0 & 31)) : R0;
      voffB = (unsigned)(Rb0 * K + C0) * 2u; }
    const size_t kstep = (size_t)(BK * 2);
    const size_t hstep = (size_t)HALF * K * 2;
    const size_t qstep = (size_t)64 * K * 2;
    const unsigned ldsw = (unsigned)wid * 1024u;
    const int aoff = lds_byte(wr * 64 + fr, fq * 8), boff = lds_byte(wc * 32 + fr, fq * 8);
#define G_SA(b, h) (((b) * 2 + (h)) * gm::HTB)
#define G_SB(b, h) ((4 + (b) * 2 + (h)) * gm::HTB)
#define G_GLDS(gptr, ldsoff) __builtin_amdgcn_global_load_lds((const unsigned*)(gptr), (LAS unsigned*)(lds + (ldsoff)), 16, 0, 0)
#define G_STAGEB(bufoff, gbase) do { G_GLDS((const char*)(gbase) + voffB, (bufoff) + ldsw); G_GLDS((const char*)(gbase) + qstep + voffB, (bufoff) + ldsw + 8192); } while (0)
#define G_STAGEA(bufoff, ubase, h, o0, o1) do { if (GATHER) { G_GLDS((const char*)(ubase) + (o0), (bufoff) + ldsw); G_GLDS((const char*)(ubase) + (o1), (bufoff) + ldsw + 8192); } \
        else { G_GLDS((const char*)(ubase) + (h) * hstep + (o0), (bufoff) + ldsw); G_GLDS((const char*)(ubase) + (h) * hstep + qstep + (o0), (bufoff) + ldsw + 8192); } } while (0)
#define G_LDA(dst, b, h) do { _Pragma("unroll") for (int m = 0; m < 4; ++m) _Pragma("unroll") for (int k = 0; k < 2; ++k) dst[m][k] = *(const LAS bf16x8*)(lds + G_SA(b, h) + aoff + m * 2048 + k * 1024); } while (0)
#define G_LDB(dst, b, h) do { _Pragma("unroll") for (int n = 0; n < 2; ++n) _Pragma("unroll") for (int k = 0; k < 2; ++k) dst[n][k] = *(const LAS bf16x8*)(lds + G_SB(b, h) + boff + n * 2048 + k * 1024); } while (0)
#define G_MMA(ai, bj, At, Bt) do { __builtin_amdgcn_s_setprio(1); _Pragma("unroll") for (int m = 0; m < 4; ++m) _Pragma("unroll") for (int n = 0; n < 2; ++n) _Pragma("unroll") for (int k = 0; k < 2; ++k) \
        acc[ai][bj][m][n] = __builtin_amdgcn_mfma_f32_16x16x32_bf16(Bt[n][k], At[m][k], acc[ai][bj][m][n], 0, 0, 0); __builtin_amdgcn_s_setprio(0); } while (0)
#define G_WAIT_V(n) asm volatile("s_waitcnt vmcnt(" #n ")" ::: "memory")
#define G_WAIT_L(n) asm volatile("s_waitcnt lgkmcnt(" #n ")" ::: "memory")
#define G_BAR __builtin_amdgcn_s_barrier()
#define G_SCHED __builtin_amdgcn_sched_barrier(0)
    Unit cur, nxt; int ui = 0;
    if (!S.next(0, cur)) return;
    f32x4 acc[2][2][4][2];
#pragma unroll
    for (int a = 0; a < 2; ++a)
#pragma unroll
        for (int b = 0; b < 2; ++b)
#pragma unroll
            for (int m = 0; m < 4; ++m)
#pragma unroll
                for (int n = 0; n < 2; ++n) acc[a][b][m][n] = (f32x4){0.f, 0.f, 0.f, 0.f};
    bf16x8 At[4][2], B0[2][2], B1[2][2];
    unsigned c00, c01 = 0, c10 = 0, c11 = 0;
    c00 = S.a_off(0, R0, C0);
    if (GATHER) { c01 = S.a_off(0, R0 + 64, C0); c10 = S.a_off(0, R0 + 128, C0); c11 = S.a_off(0, R0 + 192, C0); }
    const char* cA = S.a_base(cur); const char* cB = cur.B;
    G_STAGEB(G_SB(0, 0), cB); G_STAGEB(G_SB(0, 1), cB + hstep); G_STAGEA(G_SA(0, 0), cA, 0, c00, c01); G_STAGEA(G_SA(0, 1), cA, 1, c10 + (GATHER ? 0u : c00), c11);
    if (wr == 1) G_BAR;
    G_WAIT_V(2); G_BAR;
    G_STAGEB(G_SB(1, 0), cB + kstep); G_STAGEA(G_SA(1, 0), cA + kstep, 0, c00, c01); G_STAGEB(G_SB(1, 1), cB + hstep + kstep);
    G_WAIT_V(6); G_BAR;
    for (;;) {
        const bool has_next = S.next(ui + 1, nxt);
        const char* nB = cB; const char* nA = cA;
        if (has_next) { nB = nxt.B; nA = S.a_base(nxt); }
        for (int t = 0; t < nt; t += 2) {
            const bool last = (t == nt - 2);
            const char* a1 = cA + (size_t)(t + 1) * kstep;
            const char* a2 = last ? nA : cA + (size_t)(t + 2) * kstep;
            const char* b2 = last ? nB : cB + (size_t)(t + 2) * kstep;
            G_LDB(B0, 0, 0); G_LDB(B1, 0, 1); G_SCHED; G_LDA(At, 0, 0); G_STAGEA(G_SA(1, 1), a1, 1, c10 + (GATHER ? 0u : c00), c11);
            G_WAIT_V(8); G_WAIT_L(0); G_BAR; G_MMA(0, 0, At, B0); G_MMA(0, 1, At, B1); G_BAR; G_SCHED;
            if (GATHER) { if (last && has_next) { c00 = S.a_off(ui + 1, R0, C0); c01 = S.a_off(ui + 1, R0 + 64, C0); c10 = S.a_off(ui + 1, R0 + 128, C0); c11 = S.a_off(ui + 1, R0 + 192, C0); } }
            G_LDA(At, 0, 1); G_STAGEB(G_SB(0, 0), b2); G_STAGEB(G_SB(0, 1), b2 + hstep); G_STAGEA(G_SA(0, 0), a2, 0, c00, c01);
            G_WAIT_V(8); G_WAIT_L(0); G_BAR; G_MMA(1, 0, At, B0); G_MMA(1, 1, At, B1); G_BAR; G_SCHED;
            G_LDB(B0, 1, 0); G_LDB(B1, 1, 1); G_SCHED; G_LDA(At, 1, 0); G_STAGEA(G_SA(0, 1), a2, 1, c10 + (GATHER ? 0u : c00), c11);
            G_WAIT_V(8); G_WAIT_L(0); G_BAR; G_MMA(0, 0, At, B0); G_MMA(0, 1, At, B1); G_BAR; G_SCHED;
            G_LDA(At, 1, 1); G_STAGEB(G_SB(1, 0), b2 + kstep); G_STAGEB(G_SB(1, 1), b2 + kstep + hstep); G_STAGEA(G_SA(1, 0), a2 + kstep, 0, c00, c01);
            G_WAIT_V(8); G_WAIT_L(0); G_BAR; G_MMA(1, 0, At, B0); G_MMA(1, 1, At, B1); G_BAR; G_SCHED;
        }
        if (wr == 0) G_BAR;
        E(acc, cur, wr, wc, fr, fq);
        if (!has_next) break;
#pragma unroll
        for (int a = 0; a < 2; ++a)
#pragma unroll
            for (int b = 0; b < 2; ++b)
#pragma unroll
                for (int m = 0; m < 4; ++m)
#pragma unroll
                    for (int n = 0; n < 2; ++n) acc[a][b][m][n] = (f32x4){0.f, 0.f, 0.f, 0.f};
        cur = nxt; cB = nB; cA = nA; ++ui;
        if (wr == 1) G_BAR;
    }
    G_WAIT_V(0);
    G_BAR;
}
}

struct DenseOrder {
    int nM, nN, nwg, G, c, K; const char* Bt;
    __device__ __forceinline__ void init(int M, int N, int K_, int G_, int c_, const void* A_, const void* Bt_) { nM = M / 256; nN = N / 256; nwg = nM * nN; G = G_; c = c_; K = K_; A = (const char*)A_; Bt = (const char*)Bt_; }
    __device__ __forceinline__ bool next(int i, gm::Unit& u) const {
        const long L = (long)i * G + c; if (L >= nwg) return false;
        int wgid = (int)L; { const int q = nwg / gm::NXCD, r = nwg % gm::NXCD, xcd = wgid % gm::NXCD, off = wgid / gm::NXCD; wgid = (xcd < r ? xcd * (q + 1) : r * (q + 1) + (xcd - r) * q) + off; }
        const int nig = gm::WGM * nN, gid = wgid / nig, fm = gid * gm::WGM, gsz = (nM - fm) < gm::WGM ? (nM - fm) : gm::WGM;
        u.pm = fm + ((wgid % nig) % gsz); u.pn = (wgid % nig) / gsz; u.e = 0; u.rows = 256;
        u.B = Bt + (size_t)u.pn * 256 * K * 2; return true;
    }
    const char* A;
    __device__ __forceinline__ const char* a_base(const gm::Unit& u) const { return A + (size_t)u.pm * 256 * K * 2; }
    __device__ __forceinline__ unsigned a_off(int, int r, int c) const { return (unsigned)(r * K + c) * 2u; }
};
constexpr int GT_MAX = 19, GT_OFF = 128 * 1024;
template <bool GATHER> struct MoeOrder {
    LAS const int* tab; int nN, G, vc; const char* Wt; size_t wstride; const int* stok;
    __device__ __forceinline__ bool next(int i, gm::Unit& u) const {
        const int L = i * G + vc; if (L >= tab[32]) return false;
        int e = 0;
#pragma unroll 1
        for (int k = 1; k < 32; ++k) e += (tab[k] <= L) ? 1 : 0;
        const int r = L - tab[e]; u.e = e; u.pm = r / nN; u.pn = r % nN;
        const int cnt = tab[128 + e]; u.rows = (cnt - u.pm * 256) < 256 ? (cnt - u.pm * 256) : 256;
        u.B = Wt + (size_t)e * wstride + (size_t)u.pn * 256 * 1024 * 2; return true;
    }
    const char* A;
    __device__ __forceinline__ const char* a_base(const gm::Unit& u) const { return GATHER ? A : A + (size_t)(tab[64 + u.e] + u.pm * 256) * 2048; }
    LAS const unsigned* gtab;
    __device__ __forceinline__ unsigned a_off(int ui, int r, int c) const {
        if (GATHER) return gtab[ui * 256 + r] + (unsigned)c * 2u;
        else return (unsigned)(r * 1024 + c) * 2u;
    }
    __device__ __forceinline__ void fill_gather(LAS unsigned* gt) const {
        const int tid = opaque_tid();
        if (tid < 256) { gm::Unit u;
            for (int i = 0; i < GT_MAX && next(i, u); ++i) { int tk = 0; if (tid < u.rows) tk = stok[u.e * CAP + u.pm * 256 + tid] >> 2; gt[i * 256 + tid] = (unsigned)tk * 2048u; } }
        __syncthreads();
    }
};
__device__ __forceinline__ void moe_tables(LAS unsigned char* lds, const int* gcount, int nN) {
    LAS int* tab = (LAS int*)(lds + MISC_OFF);
    if (opaque_tid() == 0) { int cu = 0, ro = 0;
#pragma unroll 1
        for (int e = 0; e < 32; ++e) { const int c = gcount[e]; tab[e] = cu; tab[64 + e] = ro; tab[128 + e] = c; cu += ((c + 255) >> 8) * nN; ro += c; }
        tab[32] = cu; tab[64 + 32] = ro; }
    __syncthreads();
}

struct EpiProj {
    static constexpr bool PERM = true;
    bf16_t* O; int ldc;
    __device__ __forceinline__ void operator()(const f32x4 (&acc)[2][2][4][2], const gm::Unit& u, int wr, int wc, int fr_, int fq_) const {
        int fr = fr_, fq = fq_; asm volatile("" : "+v"(fr), "+v"(fq));
        const int row0 = u.pm * 256 + wr * 64 + fr, col0 = u.pn * 256 + wc * 32 + 8 * fq;
#pragma unroll
        for (int ai = 0; ai < 2; ++ai)
#pragma unroll
            for (int m = 0; m < 4; ++m) { bf16_t* rowp = O + (size_t)(row0 + ai * 128 + m * 16) * ldc + col0;
#pragma unroll
                for (int bj = 0; bj < 2; ++bj) { const f32x4 v0 = acc[ai][bj][m][0], v1 = acc[ai][bj][m][1];
                    u32x4 w; w.x = pk2(v0[0], v0[1]); w.y = pk2(v0[2], v0[3]); w.z = pk2(v1[0], v1[1]); w.w = pk2(v1[2], v1[3]);
                    *(u32x4*)(rowp + bj * 128) = w; } }
    }
};
struct EpiOut {
    static constexpr bool PERM = false;
    const float* xin; float* xout; const float* gate;
    __device__ __forceinline__ void operator()(const f32x4 (&acc)[2][2][4][2], const gm::Unit& u, int wr, int wc, int fr_, int fq_) const {
        int fr = fr_, fq = fq_; asm volatile("" : "+v"(fr), "+v"(fq));
        const int row0 = u.pm * 256 + wr * 64 + fr, col0 = u.pn * 256 + wc * 32 + 4 * fq;
        const float* gp = gate + (size_t)(u.pm >> 4) * 6144 + col0;
        f32x4 gv[2][2];
#pragma unroll
        for (int bj = 0; bj < 2; ++bj)
#pragma unroll
            for (int n = 0; n < 2; ++n) gv[bj][n] = *(const f32x4*)(gp + bj * 128 + n * 16);
#pragma unroll
        for (int ai = 0; ai < 2; ++ai)
#pragma unroll
            for (int m = 0; m < 4; ++m) { const size_t ro = (size_t)(row0 + ai * 128 + m * 16) * 1024 + col0;
#pragma unroll
                for (int bj = 0; bj < 2; ++bj)
#pragma unroll
                    for (int n = 0; n < 2; ++n) { const f32x4 xi = *(const f32x4*)(xin + ro + bj * 128 + n * 16);
                        *(f32x4*)(xout + ro + bj * 128 + n * 16) = xi + gv[bj][n] * acc[ai][bj][m][n]; } }
    }
};
struct EpiGlu {
    static constexpr bool PERM = true;
    const bf16_t* y; bf16_t* mixed; const float* bias;
    __device__ __forceinline__ void operator()(const f32x4 (&acc)[2][2][4][2], const gm::Unit& u, int wr, int wc, int fr_, int fq_) const {
        int fr = fr_, fq = fq_; asm volatile("" : "+v"(fr), "+v"(fq));
        const int row0 = u.pm * 256 + wr * 64 + fr, col0 = wc * 32 + 8 * fq;
#pragma unroll
        for (int ai = 0; ai < 2; ++ai)
#pragma unroll
            for (int m = 0; m < 4; ++m) { const int row = row0 + ai * 128 + m * 16;
#pragma unroll
                for (int bj = 0; bj < 2; ++bj) { const int col = col0 + bj * 128;
                    const f32x4 b0 = *(const f32x4*)(bias + col), b1 = *(const f32x4*)(bias + col + 4);
                    const u32x4 yw = *(const u32x4*)(y + (size_t)row * 256 + col);
                    const f32x4 z0 = acc[ai][bj][m][0] + b0, z1 = acc[ai][bj][m][1] + b1;
                    u32x4 w;
                    w.x = pk2(bflo(yw.x) * sigmoidf_(z0[0]), bfhi(yw.x) * sigmoidf_(z0[1]));
                    w.y = pk2(bflo(yw.y) * sigmoidf_(z0[2]), bfhi(yw.y) * sigmoidf_(z0[3]));
                    w.z = pk2(bflo(yw.z) * sigmoidf_(z1[0]), bfhi(yw.z) * sigmoidf_(z1[1]));
                    w.w = pk2(bflo(yw.w) * sigmoidf_(z1[2]), bfhi(yw.w) * sigmoidf_(z1[3]));
                    *(u32x4*)(mixed + (size_t)row * 1024 + 768 + col) = w; }
                __builtin_amdgcn_sched_barrier(0); }
    }
};
__device__ __forceinline__ float swiglu1(float g, float l) {
    g = fminf(g, 7.0f); l = fminf(fmaxf(l, -7.0f), 7.0f);
    return g * sigmoidf_(1.702f * g) * (l + 1.0f);
}
struct EpiUp {
    static constexpr bool PERM = true;
    bf16_t* act; const float* bias; LAS const int* tab;
    __device__ __forceinline__ void operator()(const f32x4 (&acc)[2][2][4][2], const gm::Unit& u, int wr, int wc, int fr_, int fq_) const {
        int fr = fr_, fq = fq_; asm volatile("" : "+v"(fr), "+v"(fq));
        const int rl0 = wr * 64 + fr, col0 = u.pn * 128 + wc * 32 + 8 * fq;
        const float* bp = bias + (size_t)u.e * 2048 + col0;
        const size_t arow = (size_t)(tab[64 + u.e] + u.pm * 256);
#pragma unroll
        for (int ai = 0; ai < 2; ++ai)
#pragma unroll
            for (int m = 0; m < 4; ++m) { const int rl = rl0 + ai * 128 + m * 16;
                if (rl < u.rows) {
                    const f32x4 bg0 = *(const f32x4*)(bp), bg1 = *(const f32x4*)(bp + 4), bl0 = *(const f32x4*)(bp + 1024), bl1 = *(const f32x4*)(bp + 1028);
                    const f32x4 g0 = acc[ai][0][m][0] + bg0, g1 = acc[ai][0][m][1] + bg1, l0 = acc[ai][1][m][0] + bl0, l1 = acc[ai][1][m][1] + bl1;
                    u32x4 w;
                    w.x = pk2(swiglu1(g0[0], l0[0]), swiglu1(g0[1], l0[1])); w.y = pk2(swiglu1(g0[2], l0[2]), swiglu1(g0[3], l0[3]));
                    w.z = pk2(swiglu1(g1[0], l1[0]), swiglu1(g1[1], l1[1])); w.w = pk2(swiglu1(g1[2], l1[2]), swiglu1(g1[3], l1[3]));
                    *(u32x4*)(act + (arow + rl) * 1024 + col0) = w; }
                __builtin_amdgcn_sched_barrier(0); }
    }
};
struct EpiDown {
    static constexpr bool PERM = true;
    bf16_t* outr; const float* bias; const int* stok; const float* sgate;
    __device__ __forceinline__ void operator()(const f32x4 (&acc)[2][2][4][2], const gm::Unit& u, int wr, int wc, int fr_, int fq_) const {
        int fr = fr_, fq = fq_; asm volatile("" : "+v"(fr), "+v"(fq));
        const int rl0 = wr * 64 + fr, col0 = u.pn * 256 + wc * 32 + 8 * fq;
        const float* bp = bias + (size_t)u.e * 1024 + col0;
        f32x4 bv[2][2];
#pragma unroll
        for (int bj = 0; bj < 2; ++bj) { bv[bj][0] = *(const f32x4*)(bp + bj * 128); bv[bj][1] = *(const f32x4*)(bp + bj * 128 + 4); }
#pragma unroll
        for (int ai = 0; ai < 2; ++ai)
#pragma unroll
            for (int m = 0; m < 4; ++m) { const int rl = rl0 + ai * 128 + m * 16;
                if (rl < u.rows) {
                    const int si = u.e * CAP + u.pm * 256 + rl; const int st = stok[si]; const float gt = sgate[si];
                    bf16_t* rowp = outr + (size_t)st * 1024 + col0;
#pragma unroll
                    for (int bj = 0; bj < 2; ++bj) { const f32x4 v0 = (acc[ai][bj][m][0] + bv[bj][0]) * gt, v1 = (acc[ai][bj][m][1] + bv[bj][1]) * gt;
                        u32x4 w; w.x = pk2(v0[0], v0[1]); w.y = pk2(v0[2], v0[3]); w.z = pk2(v1[0], v1[1]); w.w = pk2(v1[2], v1[3]);
                        *(u32x4*)(rowp + bj * 128) = w; } }
                __builtin_amdgcn_sched_barrier(0); }
    }
};

__device__ __forceinline__ void transpose_item(const float* W, int K, int Nsrc, bf16_t* WT, int mode, LAS float* scr, int kb, int nb, int lane) {
    const int k0 = 64 * kb, n0 = 32 * nb;
    const int ncol = n0 + (lane & 31);
#pragma unroll 8
    for (int i = 0; i < 32; ++i) { const int kk = 2 * i + (lane >> 5); scr[kk * 33 + (lane & 31)] = (ncol < Nsrc) ? W[(size_t)(k0 + kk) * Nsrc + ncol] : 0.f; }
    LDS_WAIT(); asm volatile("" ::: "memory");
    const int c = lane & 7;
#pragma unroll
    for (int j = 0; j < 4; ++j) { const int n = (lane >> 3) + 8 * j; const LAS float* s = scr + (8 * c) * 33 + n;
        u32x4 o; o.x = pk2(s[0 * 33], s[1 * 33]); o.y = pk2(s[2 * 33], s[3 * 33]); o.z = pk2(s[4 * 33], s[5 * 33]); o.w = pk2(s[6 * 33], s[7 * 33]);
        int drow = n0 + n;
        if (mode == 1) { const int jj = drow & 1023, lin = drow >> 10; drow = (jj >> 7) * 256 + lin * 128 + (jj & 127); }
        *(u32x4*)(WT + (size_t)drow * K + k0 + 8 * c) = o; }
    LDS_WAIT(); asm volatile("" ::: "memory");
}
constexpr int TI_IN = 16 * 88, TI_OUT = 16 * 32, TI_UP = 16 * 64, TI_DN = 16 * 32, TI_GLU = 4 * 8;
constexpr int TI_R0 = 2 * TI_IN, TI_R1 = TI_R0 + 2 * TI_OUT, TI_R2 = TI_R1 + 64 * TI_UP, TI_R3 = TI_R2 + 64 * TI_DN, TI_R4 = TI_R3 + 2 * TI_GLU;
__device__ __forceinline__ void transpose_all(const Params& P, LAS unsigned char* lds, int gw, int ngw, int wave, int lane) {
    unsigned char* const wsp = opaque_ptr(P.ws);
    LAS float* scr = (LAS float*)(lds + wave * 8704);
    unsigned char* ws = wsp;
    for (int it = gw; it < TI_R4; it += ngw) {
        if (it < TI_R0) { const int l = it / TI_IN, r = it % TI_IN;
            transpose_item(P.w_in + (size_t)l * 1024 * NPROJ, 1024, NPROJ, (bf16_t*)(ws + WS_WIN) + (size_t)l * NPROJP * 1024, 0, scr, r / 88, r % 88, lane); }
        else if (it < TI_R1) { const int q = it - TI_R0, l = q / TI_OUT, r = q % TI_OUT;
            transpose_item(P.w_out + (size_t)l * 1024 * 1024, 1024, 1024, (bf16_t*)(ws + WS_WOUT) + (size_t)l * 1024 * 1024, 0, scr, r / 32, r % 32, lane); }
        else if (it < TI_R2) { const int q = it - TI_R1, le = q / TI_UP, r = q % TI_UP;
            transpose_item(P.w_up + (size_t)le * 1024 * 2048, 1024, 2048, (bf16_t*)(ws + WS_WUP) + (size_t)le * 2048 * 1024, 1, scr, r / 64, r % 64, lane); }
        else if (it < TI_R3) { const int q = it - TI_R2, le = q / TI_DN, r = q % TI_DN;
            transpose_item(P.w_down + (size_t)le * 1024 * 1024, 1024, 1024, (bf16_t*)(ws + WS_WDN) + (size_t)le * 1024 * 1024, 0, scr, r / 32, r % 32, lane); }
        else { const int q = it - TI_R3, l = q / TI_GLU, r = q % TI_GLU;
            transpose_item(P.s5_w_glu + (size_t)l * 256 * 256, 256, 256, (bf16_t*)(ws + WS_WGLU) + (size_t)l * 256 * 256, 0, scr, r / 8, r % 8, lane); }
    }
}
__device__ __forceinline__ void mod_item(const Params& P, LAS unsigned char* lds, int item) {
    unsigned char* const wsp = opaque_ptr(P.ws);
    const int tid = opaque_tid(), wave = tid >> 6, lane = tid & 63;
    LAS float* sc = (LAS float*)lds;
    LAS float* red = (LAS float*)(lds + 32768);
    const int l = item / 96, cb = item % 96;
    for (int i = tid; i < 8192; i += NTHREADS) sc[i] = siluf(P.c[i]);
    __syncthreads();
    const float* W = P.w_mod + (size_t)l * 1024 * 6144 + cb * 64 + lane;
    float a[8];
#pragma unroll
    for (int b = 0; b < 8; ++b) a[b] = 0.f;
    for (int k = wave; k < 1024; k += 8) { const float w = W[(size_t)k * 6144];
#pragma unroll
        for (int b = 0; b < 8; ++b) a[b] += sc[b * 1024 + k] * w; }
#pragma unroll
    for (int b = 0; b < 8; ++b) red[(wave * 8 + b) * 64 + lane] = a[b];
    __syncthreads();
    { const int b = tid >> 6; float s = 0.f;
#pragma unroll
      for (int w = 0; w < 8; ++w) s += red[(w * 8 + b) * 64 + lane];
      ((float*)(wsp + WS_MOD))[(size_t)(l * 8 + b) * 6144 + cb * 64 + lane] = s + P.b_mod[l * 6144 + cb * 64 + lane]; }
    __syncthreads();
}
__device__ __forceinline__ void dsincos(double x, double& s, double& c) {
    const double x2 = x * x; double ts = x, tc = 1.0; s = x; c = 1.0;
#pragma unroll 1
    for (int k = 1; k <= 14; ++k) { tc = -tc * x2 / (double)((2 * k - 1) * (2 * k)); ts = -ts * x2 / (double)((2 * k) * (2 * k + 1)); c += tc; s += ts; }
}
__device__ __forceinline__ double dexp_small(double z) {
    double t = 1.0, r = 1.0;
#pragma unroll 1
    for (int k = 1; k <= 18; ++k) { t = t * z / (double)k; r += t; }
    return r;
}
__device__ __forceinline__ void s5_tables_item(const Params& P, LAS unsigned char* lds, int item) {
    unsigned char* const wsp = opaque_ptr(P.ws);
    const int tid = opaque_tid(); const int l = item >> 4, g = item & 15, lg = l * 16 + g;
    LAS float* pwr = (LAS float*)lds;
    LAS float* pwi = pwr + 64 * 65;
    LAS float* bbr = pwi + 64 * 65;
    LAS float* bbi = bbr + 1024;
    LAS float* ccr = bbi + 1024;
    LAS float* cci = ccr + 1024;
    if (tid < 64) { const int p = tid;
        const double are = (double)P.s5_a_re[lg * 64 + p], aim = (double)P.s5_a_im[lg * 64 + p];
        const double dt = (double)expf(P.s5_log_dt[lg]);
        const double mag = dexp_small(are * dt);
        double ang = aim * dt; const double TWO_PI = 6.283185307179586476925;
        ang -= TWO_PI * rint(ang / TWO_PI);
        double sn, cs; dsincos(ang, sn, cs);
        const double lbr = mag * cs, lbi = mag * sn;
        const double nr = lbr - 1.0, ni = lbi, den = are * are + aim * aim;
        const double cfr = (nr * are + ni * aim) / den, cfi = (ni * are - nr * aim) / den;
        double pr = 1.0, pi_ = 0.0;
        for (int t = 0; t <= 64; ++t) { pwr[p * 65 + t] = (float)pr; pwi[p * 65 + t] = (float)pi_; const double nr2 = pr * lbr - pi_ * lbi, ni2 = pr * lbi + pi_ * lbr; pr = nr2; pi_ = ni2; }
        for (int h = 0; h < 16; ++h) { const double br = (double)P.s5_b_re[(lg * 64 + p) * 16 + h], bi = (double)P.s5_b_im[(lg * 64 + p) * 16 + h];
            bbr[p * 16 + h] = (float)(cfr * br - cfi * bi); bbi[p * 16 + h] = (float)(cfr * bi + cfi * br); }
        float* l64 = (float*)(wsp + WS_LAM64) + (size_t)(lg * 64 + p) * 2;
        l64[0] = pwr[p * 65 + 64]; l64[1] = pwi[p * 65 + 64];
    }
    for (int i = tid; i < 1024; i += NTHREADS) { ccr[i] = P.s5_c_re[lg * 1024 + i]; cci[i] = P.s5_c_im[lg * 1024 + i]; }
    __syncthreads();
    bf16_t* kt = (bf16_t*)(wsp + WS_KTAB) + (size_t)lg * 65 * 256;
    for (int i = tid; i < 65 * 256; i += NTHREADS) { const int tau = i >> 8, h = (i >> 4) & 15, h2 = i & 15; float s = 0.f;
        if (tau < 64) {
            for (int p = 0; p < 64; ++p) { const float pr = pwr[p * 65 + tau], pi_ = pwi[p * 65 + tau], br = bbr[p * 16 + h2], bi = bbi[p * 16 + h2];
                const float wr_ = pr * br - pi_ * bi, wi_ = pr * bi + pi_ * br; s += ccr[h * 64 + p] * wr_ - cci[h * 64 + p] * wi_; }
            if (tau == 0 && h == h2) s += P.s5_d[l * 256 + g * 16 + h]; }
        kt[i] = (bf16_t)f2bf(s); }
    bf16_t* bp = (bf16_t*)(wsp + WS_BPOW) + (size_t)lg * 128 * 1024;
    for (int i = tid; i < 128 * 1024; i += NTHREADS) { const int q = i >> 10, s = (i >> 4) & 63, h2 = i & 15, p = q & 63;
        const float pr = pwr[p * 65 + 63 - s], pi_ = pwi[p * 65 + 63 - s], br = bbr[p * 16 + h2], bi = bbi[p * 16 + h2];
        const float v = (q < 64) ? (pr * br - pi_ * bi) : (pr * bi + pi_ * br);
        bp[i] = (bf16_t)f2bf(v); }
    bf16_t* cp = (bf16_t*)(wsp + WS_CPOW) + (size_t)lg * 1024 * 128;
    for (int i = tid; i < 1024 * 128; i += NTHREADS) { const int q = i & 127, th = i >> 7, t = th >> 4, h = th & 15, p = q & 63;
        const float pr = pwr[p * 65 + t + 1], pi_ = pwi[p * 65 + t + 1], cr = ccr[h * 64 + p], ci = cci[h * 64 + p];
        const float v = (q < 64) ? (cr * pr - ci * pi_) : -(cr * pi_ + ci * pr);
        cp[i] = (bf16_t)f2bf(v); }
    __syncthreads();
}
__device__ __forceinline__ void rope_table(const Params& P, int gtid, int gthreads) {
    unsigned char* const wsp = opaque_ptr(P.ws);
    float* rp = (float*)(wsp + WS_ROPE);
    for (int i = gtid; i < 4096 * 24; i += gthreads) { const int pos = i / 24, f = i % 24;
        double rev = (double)pos * P.inv_freq_rev[f]; rev -= rint(rev);
        double sn, cs; dsincos(rev * 6.283185307179586476925, sn, cs);
        rp[2 * i] = (float)cs; rp[2 * i + 1] = (float)sn; }
}
__device__ __forceinline__ void norm_row_store(const f32x4 (&v)[4], const float* nw, const float* modrow_sh, const float* modrow_sc, bf16_t* orow, int lane) {
    float ss = 0.f;
#pragma unroll
    for (int j = 0; j < 4; ++j) ss += (v[j][0] * v[j][0] + v[j][1] * v[j][1]) + (v[j][2] * v[j][2] + v[j][3] * v[j][3]);
    const float rstd = 1.0f / sqrtf(wave_sum(ss, lane) * (1.0f / 1024.0f) + NORM_EPS);
#pragma unroll
    for (int hf = 0; hf < 2; ++hf) { const int col = hf * 512 + 8 * lane; float o[8];
#pragma unroll
        for (int q = 0; q < 2; ++q) { const f32x4 w = *(const f32x4*)(nw + col + 4 * q), sc = *(const f32x4*)(modrow_sc + col + 4 * q), sh = *(const f32x4*)(modrow_sh + col + 4 * q);
#pragma unroll
            for (int e = 0; e < 4; ++e) o[4 * q + e] = v[hf * 2 + q][e] * rstd * w[e] * (1.0f + sc[e]) + sh[e]; }
        u32x4 w4; w4.x = pk2(o[0], o[1]); w4.y = pk2(o[2], o[3]); w4.z = pk2(o[4], o[5]); w4.w = pk2(o[6], o[7]);
        *(u32x4*)(orow + col) = w4; }
}

template <int KS>
__device__ __forceinline__ f32x16 mma32(LAS const unsigned char* A, int lda, LAS const unsigned char* B, int ldb, f32x16 acc, int lane) {
    const int r = lane & 31, h = lane >> 5;
#pragma unroll
    for (int ks = 0; ks < KS; ++ks) {
        const bf16x8 a = *(const LAS bf16x8*)(A + r * lda + ks * 32 + h * 16);
        const bf16x8 b = *(const LAS bf16x8*)(B + r * ldb + ks * 32 + h * 16);
        acc = __builtin_amdgcn_mfma_f32_32x32x16_bf16(a, b, acc, 0, 0, 0);
    }
    return acc;
}
__device__ __forceinline__ int crow(int reg, int lane) { return (reg & 3) + 8 * (reg >> 2) + 4 * (lane >> 5); }

constexpr int MX_RQ = 0, MX_RK = 6144, MX_RV = 12288, MX_RG = 24576, MX_RGA = 36864, MX_QD = 38912, MX_KI = 46080, MX_KET = 53248, MX_VT = 62464,
              MX_SM = 76288, MX_SPT = 85504, MX_OB = 96256, MX_DEC = 121856, MX_WA = 122112;
__device__ __forceinline__ void mixer_head_item(const Params& P, LAS unsigned char* lds, int l, int item) {
    unsigned char* const wsp = opaque_ptr(P.ws);
    const int tid_k = opaque_tid(), w = __builtin_amdgcn_readfirstlane(tid_k >> 6), lane_k = tid_k & 63; const int tid = tid_k;
    const int type = item >> 5, b = (item >> 2) & 7, h = item & 3;
    const bf16_t* proj = (const bf16_t*)(wsp + WS_PROJ) + (size_t)b * SEQ * NPROJP;
    bf16_t* mixed = (bf16_t*)(wsp + WS_MIXED) + (size_t)b * SEQ * 1024 + type * 384 + h * 96;
    const int cq = (type ? C_RQ : C_GQ) + h * 48, ck = (type ? C_RK : C_GK) + h * 48, cv = (type ? C_RV : C_GV) + h * 96, cgt = (type ? C_RG : C_GG) + h * 96;
    const float* nw = (type ? P.ret_norm_w : P.gla_norm_w) + l * 384 + h * 96;
    const float* wa2 = P.gla_w_a2 + (size_t)l * 16 * 192 + h * 48;
    const float* ba = P.gla_b_a + l * 192 + h * 48;
    const float* rope = (const float*)(wsp + WS_ROPE);
    const float lgam = P.log_gamma[h];
    int goff[5], loff[5];
#pragma unroll
    for (int j = 0; j < 5; ++j) { const int pid = tid + NTHREADS * j; int row, c, col, lo;
        if (pid < 384)       { row = pid / 6; c = pid % 6; col = cq + c * 8; lo = MX_RQ + row * 96 + c * 16; }
        else if (pid < 768)  { const int p = pid - 384; row = p / 6; c = p % 6; col = ck + c * 8; lo = MX_RK + row * 96 + c * 16; }
        else if (pid < 1536) { const int p = pid - 768; row = p / 12; c = p % 12; col = cv + c * 8; lo = MX_RV + row * 192 + c * 16; }
        else if (pid < 2304) { const int p = pid - 1536; row = p / 12; c = p % 12; col = cgt + c * 8; lo = MX_RG + row * 192 + c * 16; }
        else if (pid < 2432 && type == 0) { const int p = pid - 2304; row = p / 2; c = p % 2; col = C_GA + c * 8; lo = MX_RGA + row * 32 + c * 16; }
        else { row = 0; col = 0; lo = -1; }
        goff[j] = row * NPROJP + col; loff[j] = lo; }
    for (int i = tid; i < 10752 / 4; i += NTHREADS) ((LAS unsigned*)(lds + MX_SPT))[i] = 0u;
    for (int i = tid; i < (16 * 144) / 4; i += NTHREADS) ((LAS unsigned*)(lds + MX_KET + 48 * 144))[i] = 0u;
    if (tid < 64) ((LAS float*)(lds + MX_DEC))[tid] = 1.0f;
    for (int i = tid; i < 17 * 48; i += NTHREADS) { const int r_ = i / 48, d_ = i % 48; ((LAS float*)(lds + MX_WA))[i] = (r_ < 16) ? wa2[r_ * 192 + d_] : ba[d_]; }
    f32x16 sacc;
#pragma unroll
    for (int i = 0; i < 16; ++i) sacc[i] = 0.f;
    u32x4 pf[5];
#pragma unroll
    for (int j = 0; j < 5; ++j) { pf[j] = (u32x4){0u, 0u, 0u, 0u}; if (loff[j] >= 0) pf[j] = *(const u32x4*)(proj + goff[j]); }
    __syncthreads();
#pragma unroll 1
    for (int n = 0; n < 64; ++n) {
#pragma unroll
        for (int j = 0; j < 5; ++j) if (loff[j] >= 0) *(LAS u32x4*)(lds + loff[j]) = pf[j];
        __syncthreads();
        int lane = lane_k, tid = tid_k; asm volatile("" : "+v"(lane), "+v"(tid));
        if (n + 1 < 64) {
            const bf16_t* pn = proj + (size_t)(n + 1) * 64 * NPROJP;
#pragma unroll
            for (int j = 0; j < 5; ++j) if (loff[j] >= 0) pf[j] = *(const u32x4*)(pn + goff[j]);
        }
        {
            const int t = lane;
            float cum[6], tot[6], qv[6], kv[6];
#pragma unroll
            for (int i = 0; i < 6; ++i) { const int d = w + 8 * i;
                qv[i] = bf2f(*(const LAS bf16_t*)(lds + MX_RQ + t * 96 + d * 2)); kv[i] = bf2f(*(const LAS bf16_t*)(lds + MX_RK + t * 96 + d * 2)); }
            if (type == 0) {
                float ga[16];
                { const u32x4 g0 = *(const LAS u32x4*)(lds + MX_RGA + t * 32), g1 = *(const LAS u32x4*)(lds + MX_RGA + t * 32 + 16);
                  ga[0] = bflo(g0.x); ga[1] = bfhi(g0.x); ga[2] = bflo(g0.y); ga[3] = bfhi(g0.y); ga[4] = bflo(g0.z); ga[5] = bfhi(g0.z); ga[6] = bflo(g0.w); ga[7] = bfhi(g0.w);
                  ga[8] = bflo(g1.x); ga[9] = bfhi(g1.x); ga[10] = bflo(g1.y); ga[11] = bfhi(g1.y); ga[12] = bflo(g1.z); ga[13] = bfhi(g1.z); ga[14] = bflo(g1.w); ga[15] = bfhi(g1.w); }
#pragma unroll
                for (int i = 0; i < 6; ++i) { const int d = w + 8 * i; const LAS float* wl = (const LAS float*)(lds + MX_WA) + d; float pre = wl[16 * 48];
#pragma unroll
                    for (int r = 0; r < 16; ++r) pre += ga[r] * wl[r * 48];
                    const float ls = fminf(pre, 0.f) - log1pf(expf(-fabsf(pre)));
                    cum[i] = ls * (1.0f / 16.0f); }
#pragma unroll
                for (int off = 1; off < 64; off <<= 1) {
#pragma unroll
                    for (int i = 0; i < 6; ++i) { const float o = lidx_f(cum[i], (lane - off) & 63); if (lane >= off) cum[i] += o; } }
#pragma unroll
                for (int i = 0; i < 6; ++i) { tot[i] = __builtin_bit_cast(float, __builtin_amdgcn_readlane(__builtin_bit_cast(int, cum[i]), 63)); qv[i] *= 0.14433756729740643f; }
            } else {
#pragma unroll
                for (int i = 0; i < 6; ++i) { cum[i] = (float)(t + 1) * lgam; tot[i] = 64.0f * lgam; }
                const float* rp = rope + (size_t)(n * 64 + t) * 48;
#pragma unroll
                for (int i = 0; i < 3; ++i) { const int d1 = w + 8 * i; const float cs = rp[2 * d1], sn = rp[2 * d1 + 1];
                    const float q1 = qv[i], q2 = qv[i + 3], k1 = kv[i], k2 = kv[i + 3];
                    qv[i] = q1 * cs - q2 * sn; qv[i + 3] = q1 * sn + q2 * cs;
                    kv[i] = (k1 * cs - k2 * sn) * 0.14433756729740643f; kv[i + 3] = (k1 * sn + k2 * cs) * 0.14433756729740643f; }
            }
#pragma unroll
            for (int i = 0; i < 6; ++i) { const int d = w + 8 * i;
                const float e1 = __expf(cum[i]), e2 = __expf(-cum[i]), e3 = __expf(tot[i] - cum[i]);
                *(LAS bf16_t*)(lds + MX_QD + t * 112 + d * 2) = (bf16_t)f2bf(qv[i] * e1);
                *(LAS bf16_t*)(lds + MX_KI + t * 112 + d * 2) = (bf16_t)f2bf(kv[i] * e2);
                *(LAS bf16_t*)(lds + MX_KET + d * 144 + t * 2) = (bf16_t)f2bf(kv[i] * e3);
                if (lane == 0) ((LAS float*)(lds + MX_DEC))[d] = __expf(tot[i]); }
#pragma unroll
            for (int i = 0; i < 12; ++i) { const int v = 12 * w + i;
                *(LAS bf16_t*)(lds + MX_VT + v * 144 + t * 2) = *(const LAS bf16_t*)(lds + MX_RV + t * 192 + v * 2); }
        }
        __syncthreads();
        f32x16 oacc;
#pragma unroll
        for (int i = 0; i < 16; ++i) oacc[i] = 0.f;
        const int mi = (w < 6) ? (w / 3) : 0, vi = (w < 6) ? (w % 3) : 0;
        if (w < 6) {
            oacc = mma32<3>(lds + MX_QD + mi * 32 * 112, 112, lds + MX_SPT + vi * 32 * 112, 112, oacc, lane);
        } else {
#pragma unroll
            for (int q = 0; q < 2; ++q) { const int smi = (w == 6) ? q : (1 - q), sni = (w == 6) ? 0 : 1;
                f32x16 s;
#pragma unroll
                for (int i = 0; i < 16; ++i) s[i] = 0.f;
                if (sni <= smi) s = mma32<3>(lds + MX_QD + smi * 32 * 112, 112, lds + MX_KI + sni * 32 * 112, 112, s, lane);
#pragma unroll
                for (int reg = 0; reg < 16; ++reg) { const int ii = smi * 32 + crow(reg, lane), jj = sni * 32 + (lane & 31);
                    const float val = (jj <= ii) ? s[reg] : 0.f;
                    *(LAS bf16_t*)(lds + MX_SM + ii * 144 + jj * 2) = (bf16_t)f2bf(val); } }
        }
        __syncthreads();
        if (w < 6) {
            oacc = mma32<4>(lds + MX_SM + mi * 32 * 144, 144, lds + MX_VT + vi * 32 * 144, 144, oacc, lane);
#pragma unroll
            for (int reg = 0; reg < 16; ++reg) ((LAS float*)(lds + MX_OB))[(mi * 32 + crow(reg, lane)) * 100 + vi * 32 + (lane & 31)] = oacc[reg];
#pragma unroll
            for (int reg = 0; reg < 16; ++reg) sacc[reg] *= ((const LAS float*)(lds + MX_DEC))[mi * 32 + crow(reg, lane)];
            sacc = mma32<4>(lds + MX_KET + mi * 32 * 144, 144, lds + MX_VT + vi * 32 * 144, 144, sacc, lane);
#pragma unroll
            for (int g4 = 0; g4 < 4; ++g4) { const int d0 = mi * 32 + 8 * g4 + 4 * (lane >> 5);
                if (d0 < 48) { u32x2 pk; pk.x = pk2(sacc[4 * g4], sacc[4 * g4 + 1]); pk.y = pk2(sacc[4 * g4 + 2], sacc[4 * g4 + 3]);
                    *(LAS u32x2*)(lds + MX_SPT + (vi * 32 + (lane & 31)) * 112 + d0 * 2) = pk; } }
        }
        __syncthreads();
        {
            const int i = tid >> 3, part = tid & 7, v0 = 12 * part;
            float xv[12], gv[12];
#pragma unroll
            for (int q = 0; q < 3; ++q) { const f32x4 o4 = *(const LAS f32x4*)(lds + MX_OB + (i * 100 + v0 + 4 * q) * 4);
                xv[4 * q] = o4[0]; xv[4 * q + 1] = o4[1]; xv[4 * q + 2] = o4[2]; xv[4 * q + 3] = o4[3];
                const u32x2 g2 = *(const LAS u32x2*)(lds + MX_RG + i * 192 + (v0 + 4 * q) * 2);
                gv[4 * q] = bflo(g2.x); gv[4 * q + 1] = bfhi(g2.x); gv[4 * q + 2] = bflo(g2.y); gv[4 * q + 3] = bfhi(g2.y); }
            float mean = 0.f;
            if (type == 1) { float s = 0.f;
#pragma unroll
                for (int q = 0; q < 12; ++q) s += xv[q];
                s += lx_f(s, lane, 1); s += lx_f(s, lane, 2); s += lx_f(s, lane, 4); mean = s * (1.0f / 96.0f); }
            float ss = 0.f;
#pragma unroll
            for (int q = 0; q < 12; ++q) { xv[q] -= mean; ss += xv[q] * xv[q]; }
            ss += lx_f(ss, lane, 1); ss += lx_f(ss, lane, 2); ss += lx_f(ss, lane, 4);
            const float rstd = 1.0f / sqrtf(ss * (1.0f / 96.0f) + NORM_EPS);
            bf16_t* op = mixed + (size_t)(n * 64 + i) * 1024 + v0;
#pragma unroll
            for (int q = 0; q < 3; ++q) { float o[4];
#pragma unroll
                for (int e = 0; e < 4; ++e) { const int k = 4 * q + e; o[e] = xv[k] * rstd * nw[v0 + k] * siluf(gv[k]); }
                u32x2 pk; pk.x = pk2(o[0], o[1]); pk.y = pk2(o[2], o[3]);
                *(u32x2*)(op + 4 * q) = pk; }
        }
        __syncthreads();
    }
}

constexpr int S5_KT = 0, S5_EB = 33280, S5_CY = 66048;
__device__ __forceinline__ float gelu_tanh(float x) { const float u = 0.7978845608028654f * (x + 0.044715f * x * x * x); const float e = __expf(2.0f * u); const float th = 1.0f - 2.0f / (e + 1.0f); return 0.5f * x * (1.0f + th); }
__device__ __forceinline__ void s5_item(const Params& P, LAS unsigned char* lds, int l, int item) {
    unsigned char* const wsp = opaque_ptr(P.ws);
    const int tid = opaque_tid(), w = __builtin_amdgcn_readfirstlane(tid >> 6), lane = tid & 63, r = lane & 31, hh = lane >> 5;
    const int half = item & 1, b = item >> 5, g = (item >> 1) & 15, lg = l * 16 + g;
    const bf16_t* ub = (const bf16_t*)(wsp + WS_PROJ) + (size_t)b * SEQ * NPROJP + C_SU + g * 16 + 8 * hh;
    const bf16_t* ktg = (const bf16_t*)(wsp + WS_KTAB) + (size_t)lg * 65 * 256;
    const bf16_t* bpw = (const bf16_t*)(wsp + WS_BPOW) + (size_t)lg * 128 * 1024 + (size_t)((w & 3) * 32 + r) * 1024 + 8 * hh;
    const bf16_t* cpw = (const bf16_t*)(wsp + WS_CPOW) + (size_t)lg * 1024 * 128;
    for (int p = tid; p < 2080; p += NTHREADS) *(LAS u32x4*)(lds + S5_KT + p * 16) = *(const u32x4*)(ktg + p * 8);
    __syncthreads();
    f32x16 acc[2][2], eacc;
    const int nt0 = half ? (w + 8) : w, nt1 = half ? (w + 16) : (w + 24);
#pragma unroll
    for (int j = 0; j < 2; ++j)
#pragma unroll
        for (int mt = 0; mt < 2; ++mt)
#pragma unroll
            for (int i = 0; i < 16; ++i) acc[j][mt][i] = 0.f;
#pragma unroll
    for (int i = 0; i < 16; ++i) eacc[i] = 0.f;
    const int emt = w >> 2;
    const size_t arow0 = (size_t)(r * 64) * NPROJP, arow1 = (size_t)((32 + r) * 64) * NPROJP;
#define S5_LOAD(A0, A1, BP, s) do { A0 = *(const bf16x8*)(ub + arow0 + (size_t)(s) * NPROJP); A1 = *(const bf16x8*)(ub + arow1 + (size_t)(s) * NPROJP); BP = *(const bf16x8*)(bpw + (s) * 16); } while (0)
#define S5_STEP(A0, A1, BP, s) do { \
        _Pragma("unroll") for (int j = 0; j < 2; ++j) { const int t0 = 2 * (j ? nt1 : nt0); \
            if (t0 + 1 >= (s)) { const int tt = t0 + (r >> 4); const int tau = tt - (s); const int slot = tau < 0 ? 64 : tau; \
                const bf16x8 kb = *(const LAS bf16x8*)(lds + S5_KT + slot * 512 + (lane & 15) * 32 + hh * 16); \
                acc[j][0] = __builtin_amdgcn_mfma_f32_32x32x16_bf16(A0, kb, acc[j][0], 0, 0, 0); \
                acc[j][1] = __builtin_amdgcn_mfma_f32_32x32x16_bf16(A1, kb, acc[j][1], 0, 0, 0); } } \
        eacc = __builtin_amdgcn_mfma_f32_32x32x16_bf16(emt ? A1 : A0, BP, eacc, 0, 0, 0); } while (0)
    bf16x8 xa0, xa1, xbp, ya0, ya1, ybp;
    S5_LOAD(xa0, xa1, xbp, 0); S5_LOAD(ya0, ya1, ybp, 1);
#pragma unroll 1
    for (int s = 0; s < 64; s += 2) {
        S5_STEP(xa0, xa1, xbp, s);
        if (s + 2 < 64) S5_LOAD(xa0, xa1, xbp, s + 2);
        S5_STEP(ya0, ya1, ybp, s + 1);
        if (s + 3 < 64) S5_LOAD(ya0, ya1, ybp, s + 3);
    }
#undef S5_LOAD
#undef S5_STEP
#pragma unroll
    for (int reg = 0; reg < 16; ++reg) ((LAS float*)(lds + S5_EB))[(emt * 32 + crow(reg, lane)) * 128 + (w & 3) * 32 + r] = eacc[reg];
    __syncthreads();
    if (tid < 64) { const int p = tid; const float* l64 = (const float*)(wsp + WS_LAM64) + (size_t)(lg * 64 + p) * 2; const float ar = l64[0], ai = l64[1];
        float cr = 0.f, ci = 0.f;
#pragma unroll 1
        for (int n = 0; n < 64; ++n) {
            *(LAS bf16_t*)(lds + S5_CY + n * 272 + p * 2) = (bf16_t)f2bf(cr); *(LAS bf16_t*)(lds + S5_CY + n * 272 + (64 + p) * 2) = (bf16_t)f2bf(ci);
            const float er = ((const LAS float*)(lds + S5_EB))[n * 128 + p], ei = ((const LAS float*)(lds + S5_EB))[n * 128 + 64 + p];
            const float nr = ar * cr - ai * ci + er, ni = ar * ci + ai * cr + ei; cr = nr; ci = ni; } }
    __syncthreads();
#pragma unroll
    for (int j = 0; j < 2; ++j) { const bf16_t* cpr = cpw + (size_t)((j ? nt1 : nt0) * 32 + r) * 128 + 8 * hh;
#pragma unroll
        for (int ks = 0; ks < 8; ++ks) { const bf16x8 cb = *(const bf16x8*)(cpr + ks * 16);
            const bf16x8 c0 = *(const LAS bf16x8*)(lds + S5_CY + r * 272 + ks * 32 + hh * 16), c1 = *(const LAS bf16x8*)(lds + S5_CY + (32 + r) * 272 + ks * 32 + hh * 16);
            acc[j][0] = __builtin_amdgcn_mfma_f32_32x32x16_bf16(c0, cb, acc[j][0], 0, 0, 0);
            acc[j][1] = __builtin_amdgcn_mfma_f32_32x32x16_bf16(c1, cb, acc[j][1], 0, 0, 0); } }
    bf16_t* yb = (bf16_t*)(wsp + WS_YBUF) + (size_t)b * SEQ * 256 + g * 16 + (lane & 15);
#pragma unroll
    for (int j = 0; j < 2; ++j) { const int tt = 2 * (j ? nt1 : nt0) + (r >> 4);
#pragma unroll
        for (int mt = 0; mt < 2; ++mt)
#pragma unroll
            for (int reg = 0; reg < 16; ++reg) { const int n = mt * 32 + crow(reg, lane);
                yb[(size_t)(n * 64 + tt) * 256] = (bf16_t)f2bf(gelu_tanh(acc[j][mt][reg])); } }
    __syncthreads();
}

constexpr int RT_W = 0, RT_CNT = MISC_OFF, RT_BASE = MISC_OFF + 128, RT_TE = MISC_OFF + 256, RT_TG = RT_TE + 2048, RT_TR = RT_TG + 2048;
__device__ __forceinline__ void router_phase(const Params& P, LAS unsigned char* lds, int l, int blk) {
    unsigned char* const wsp = opaque_ptr(P.ws);
    const int tid = opaque_tid(), w = tid >> 6, lane = tid & 63;
    const float* x = (const float*)(wsp + WS_X);
    bf16_t* hdn = (bf16_t*)(wsp + WS_HDN);
    const float* rw = P.router_w + (size_t)l * 1024 * 32;
    const int tok0 = blk * 128, b = tok0 >> 12;
    const float* mrow = (const float*)(wsp + WS_MOD) + (size_t)(l * 8 + b) * 6144;
    int* gcount = (int*)(wsp + WS_CTL) + l * 32;
    int* stok = (int*)(wsp + WS_STOK); float* sgate = (float*)(wsp + WS_SGATE);
    for (int i = tid; i < 8192; i += NTHREADS) { const int k = i >> 3, c4 = (i & 7) * 4; *(LAS f32x4*)(lds + RT_W + (k * 36 + c4) * 4) = *(const f32x4*)(rw + k * 32 + c4); }
    if (tid < 32) ((LAS int*)(lds + RT_CNT))[tid] = 0;
    float wsc[16], wsh[16];
#pragma unroll
    for (int i = 0; i < 16; ++i) { const int col = lane + 64 * i; wsc[i] = P.norm2_w[l * 1024 + col] * (1.0f + mrow[4096 + col]); wsh[i] = mrow[3072 + col]; }
    __syncthreads();
#pragma unroll 1
    for (int tt = 0; tt < 16; ++tt) {
        const int tl = w * 16 + tt, tok = tok0 + tl;
        float hv[16]; float ss = 0.f;
#pragma unroll
        for (int i = 0; i < 16; ++i) { hv[i] = x[(size_t)tok * 1024 + lane + 64 * i]; ss += hv[i] * hv[i]; }
        const float rstd = 1.0f / sqrtf(wave_sum(ss, lane) * (1.0f / 1024.0f) + NORM_EPS);
#pragma unroll
        for (int i = 0; i < 16; ++i) { hv[i] = hv[i] * rstd * wsc[i] + wsh[i]; hdn[(size_t)tok * 1024 + lane + 64 * i] = (bf16_t)f2bf(hv[i]); }
        float a[32];
#pragma unroll
        for (int e = 0; e < 32; ++e) a[e] = 0.f;
#pragma unroll
        for (int i = 0; i < 16; ++i) { const LAS float* wr_ = (const LAS float*)(lds + RT_W) + (lane + 64 * i) * 36;
#pragma unroll
            for (int q = 0; q < 8; ++q) { const f32x4 w4 = *(const LAS f32x4*)(wr_ + 4 * q);
                a[4 * q] += hv[i] * w4[0]; a[4 * q + 1] += hv[i] * w4[1]; a[4 * q + 2] += hv[i] * w4[2]; a[4 * q + 3] += hv[i] * w4[3]; } }
#pragma unroll
        for (int e = 0; e < 16; ++e) { const bool up = (lane & 32) != 0; const float keep = up ? a[e + 16] : a[e], send = up ? a[e] : a[e + 16]; a[e] = keep + lx_f(send, lane, 32); }
#pragma unroll
        for (int e = 0; e < 8; ++e) { const bool up = (lane & 16) != 0; const float keep = up ? a[e + 8] : a[e], send = up ? a[e] : a[e + 8]; a[e] = keep + lx_f(send, lane, 16); }
#pragma unroll
        for (int e = 0; e < 4; ++e) { const bool up = (lane & 8) != 0; const float keep = up ? a[e + 4] : a[e], send = up ? a[e] : a[e + 4]; a[e] = keep + lx_f(send, lane, 8); }
#pragma unroll
        for (int e = 0; e < 2; ++e) { const bool up = (lane & 4) != 0; const float keep = up ? a[e + 2] : a[e], send = up ? a[e] : a[e + 2]; a[e] = keep + lx_f(send, lane, 4); }
        { const bool up = (lane & 2) != 0; const float keep = up ? a[1] : a[0], send = up ? a[0] : a[1]; a[0] = keep + lx_f(send, lane, 2); }
        float logit = a[0] + lx_f(a[0], lane, 1);
        const int myE = lane >> 1;
        logit += P.router_b[l * 32 + myE];
        float tv[4]; int te[4]; float cur = logit;
#pragma unroll
        for (int k = 0; k < 4; ++k) { float bv = cur; int be = myE;
#pragma unroll
            for (int o = 1; o < 64; o <<= 1) { const float ov = lx_f(bv, lane, o); const int oe = lx_i(be, lane, o); if (ov > bv || (ov == bv && oe < be)) { bv = ov; be = oe; } }
            tv[k] = bv; te[k] = be; if (myE == be) cur = -3.0e38f; }
        const float e1 = __expf(tv[1] - tv[0]), e2 = __expf(tv[2] - tv[0]), e3 = __expf(tv[3] - tv[0]); const float inv = 1.0f / (1.0f + e1 + e2 + e3);
        if (lane < 4) { const int ek = (lane == 0) ? te[0] : (lane == 1) ? te[1] : (lane == 2) ? te[2] : te[3];
            const float gk = ((lane == 0) ? 1.0f : (lane == 1) ? e1 : (lane == 2) ? e2 : e3) * inv;
            const int rk = __hip_atomic_fetch_add((LAS int*)(lds + RT_CNT) + ek, 1, __ATOMIC_RELAXED, __HIP_MEMORY_SCOPE_WORKGROUP);
            ((LAS int*)(lds + RT_TE))[tl * 4 + lane] = ek; ((LAS float*)(lds + RT_TG))[tl * 4 + lane] = gk; ((LAS int*)(lds + RT_TR))[tl * 4 + lane] = rk; }
    }
    __syncthreads();
    if (tid < 32) ((LAS int*)(lds + RT_BASE))[tid] = atomicAdd(gcount + tid, ((LAS int*)(lds + RT_CNT))[tid]);
    __syncthreads();
    { const int e = ((LAS int*)(lds + RT_TE))[tid]; const int pos = ((LAS int*)(lds + RT_BASE))[e] + ((LAS int*)(lds + RT_TR))[tid];
      stok[e * CAP + pos] = (tok0 + (tid >> 2)) * 4 + (tid & 3); sgate[e * CAP + pos] = ((LAS float*)(lds + RT_TG))[tid]; }
    __syncthreads();
}

__device__ __forceinline__ void combine_phase(const Params& P, int l, int gw, int ngw, int lane_in) {
    unsigned char* const wsp = opaque_ptr(P.ws);
    int lane = lane_in; asm volatile("" : "+v"(lane));
    float* x = (float*)(wsp + WS_X);
    const bf16_t* outr = (const bf16_t*)(wsp + WS_OUTR);
    bf16_t* hdn = (bf16_t*)(wsp + WS_HDN);
    for (int tok = gw; tok < T_TOK; tok += ngw) {
        const int b = tok >> 12;
        const float* mrow = (const float*)(wsp + WS_MOD) + (size_t)(l * 8 + b) * 6144;
        f32x4 v[4];
#pragma unroll
        for (int hf = 0; hf < 2; ++hf) { const int col = hf * 512 + 8 * lane;
            float s[8];
#pragma unroll
            for (int e = 0; e < 8; ++e) s[e] = 0.f;
#pragma unroll
            for (int k = 0; k < 4; ++k) { const u32x4 r4 = *(const u32x4*)(outr + ((size_t)tok * 4 + k) * 1024 + col);
                s[0] += bflo(r4.x); s[1] += bfhi(r4.x); s[2] += bflo(r4.y); s[3] += bfhi(r4.y); s[4] += bflo(r4.z); s[5] += bfhi(r4.z); s[6] += bflo(r4.w); s[7] += bfhi(r4.w); }
#pragma unroll
            for (int q = 0; q < 2; ++q) { const f32x4 xv = *(const f32x4*)(x + (size_t)tok * 1024 + col + 4 * q), g2 = *(const f32x4*)(mrow + 5120 + col + 4 * q);
                f32x4 o; o[0] = xv[0] + g2[0] * s[4 * q]; o[1] = xv[1] + g2[1] * s[4 * q + 1]; o[2] = xv[2] + g2[2] * s[4 * q + 2]; o[3] = xv[3] + g2[3] * s[4 * q + 3];
                v[hf * 2 + q] = o; if (l + 1 < NLAYER) *(f32x4*)(x + (size_t)tok * 1024 + col + 4 * q) = o; } }
        if (l + 1 < NLAYER) {
            const float* mnext = (const float*)(wsp + WS_MOD) + (size_t)((l + 1) * 8 + b) * 6144;
            norm_row_store(v, P.norm1_w + (l + 1) * 1024, mnext, mnext + 1024, hdn + (size_t)tok * 1024, lane);
        } else {
            float ss = 0.f;
#pragma unroll
            for (int j = 0; j < 4; ++j) ss += (v[j][0] * v[j][0] + v[j][1] * v[j][1]) + (v[j][2] * v[j][2] + v[j][3] * v[j][3]);
            const float rstd = 1.0f / sqrtf(wave_sum(ss, lane) * (1.0f / 1024.0f) + NORM_EPS);
#pragma unroll
            for (int hf = 0; hf < 2; ++hf)
#pragma unroll
                for (int q = 0; q < 2; ++q) { const int col = hf * 512 + 8 * lane + 4 * q; const f32x4 fw = *(const f32x4*)(P.final_norm_w + col);
                    f32x4 o; o[0] = v[hf * 2 + q][0] * rstd * fw[0]; o[1] = v[hf * 2 + q][1] * rstd * fw[1]; o[2] = v[hf * 2 + q][2] * rstd * fw[2]; o[3] = v[hf * 2 + q][3] * rstd * fw[3];
                    *(f32x4*)(P.out + (size_t)tok * 1024 + col) = o; }
        }
    }
}

#ifndef PH
#define PH 0xFFFF
#endif
#define PHON(b) ((((PH) >> (b)) & 1) != 0)
__global__ void __launch_bounds__(NTHREADS, 2) fwd_megakernel(Params P) {
    extern __shared__ __attribute__((aligned(16))) unsigned char lds_raw[];
    LAS unsigned char* const lds0 = (LAS unsigned char*)lds_raw;
    cg::grid_group grid = cg::this_grid();
    const int G = gridDim.x, bid = blockIdx.x;
    const int vcu = (G % 8 == 0) ? (bid % 8) * (G / 8) + bid / 8 : bid;
    const int ngw = G * NWAVES;
#define KTID() const int tid = opaque_tid(), wave = __builtin_amdgcn_readfirstlane(tid >> 6), lane = tid & 63, gw = bid * NWAVES + wave; (void)lane; (void)gw

    { KTID(); unsigned char* const ws = opaque_ptr(P.ws); LAS unsigned char* const lds = opaque_lds(lds0); (void)lds;
    if (bid == 0 && tid < 64) ((int*)(ws + WS_CTL))[tid] = 0;
    if (PHON(0)) for (int it = bid; it < 192 + 32; it += G) { if (it < 192) mod_item(P, lds, it); else s5_tables_item(P, lds, it - 192); }
    rope_table(P, bid * NTHREADS + tid, G * NTHREADS);
    __syncthreads();
    if (PHON(1)) transpose_all(P, lds, gw, ngw, wave, lane); }
    grid.sync();
    { KTID(); unsigned char* const ws = opaque_ptr(P.ws); LAS unsigned char* const lds = opaque_lds(lds0); (void)lds;
    for (int tok = gw; tok < T_TOK; tok += ngw) {
        const float* mrow = (const float*)(ws + WS_MOD) + (size_t)(tok >> 12) * 6144;
        f32x4 v[4];
#pragma unroll
        for (int hf = 0; hf < 2; ++hf)
#pragma unroll
            for (int q = 0; q < 2; ++q) v[hf * 2 + q] = *(const f32x4*)(P.x + (size_t)tok * 1024 + hf * 512 + 8 * lane + 4 * q);
        norm_row_store(v, P.norm1_w, mrow, mrow + 1024, (bf16_t*)(ws + WS_HDN) + (size_t)tok * 1024, lane);
    } }
    grid.sync();
#pragma unroll 1
    for (int l = 0; l < NLAYER; ++l) {
        if (PHON(2)) { unsigned char* const ws = opaque_ptr(P.ws); LAS unsigned char* const lds = opaque_lds(lds0); (void)lds; DenseOrder S; S.init(T_TOK, NPROJP, 1024, G, bid, ws + WS_HDN, (const bf16_t*)(ws + WS_WIN) + (size_t)l * NPROJP * 1024);
          EpiProj E{(bf16_t*)(ws + WS_PROJ), NPROJP};
          gm::gemm_phase<EpiProj, DenseOrder, false>(lds, 1024, S, E); }
        grid.sync();
        { LAS unsigned char* const lds = opaque_lds(lds0);
        if (PHON(3) && bid < 64) mixer_head_item(P, lds, l, bid);
        if (PHON(4) && bid >= 64) for (int it = bid - 64; it < 256; it += G - 64) s5_item(P, lds, l, it); }
        grid.sync();
        if (PHON(5)) { unsigned char* const ws = opaque_ptr(P.ws); LAS unsigned char* const lds = opaque_lds(lds0); (void)lds; DenseOrder S; S.init(T_TOK, 256, 256, G, bid, ws + WS_YBUF, (const bf16_t*)(ws + WS_WGLU) + (size_t)l * 256 * 256);
          EpiGlu E{(const bf16_t*)(ws + WS_YBUF), (bf16_t*)(ws + WS_MIXED), P.s5_b_glu + l * 256};
          gm::gemm_phase<EpiGlu, DenseOrder, false>(lds, 256, S, E); }
        grid.sync();
        if (PHON(6)) { unsigned char* const ws = opaque_ptr(P.ws); LAS unsigned char* const lds = opaque_lds(lds0); (void)lds; const float* modl = (const float*)(ws + WS_MOD) + (size_t)l * 8 * 6144; DenseOrder S; S.init(T_TOK, 1024, 1024, G, bid, ws + WS_MIXED, (const bf16_t*)(ws + WS_WOUT) + (size_t)l * 1024 * 1024);
          EpiOut E{l == 0 ? P.x : (const float*)(ws + WS_X), (float*)(ws + WS_X), modl + 2048};
          gm::gemm_phase<EpiOut, DenseOrder, false>(lds, 1024, S, E); }
        grid.sync();
        if (PHON(7)) { LAS unsigned char* const lds = opaque_lds(lds0); for (int blk = bid; blk < T_TOK / 128; blk += G) router_phase(P, lds, l, blk); }
        grid.sync();
        if (PHON(8)) { unsigned char* const ws = opaque_ptr(P.ws); LAS unsigned char* const lds = opaque_lds(lds0); (void)lds; moe_tables(lds, (const int*)(ws + WS_CTL) + l * 32, 8);
          MoeOrder<true> S; S.tab = (LAS const int*)(lds + MISC_OFF); S.nN = 8; S.G = G; S.vc = vcu; S.Wt = (const char*)(ws + WS_WUP) + (size_t)l * 32 * 2048 * 1024 * 2; S.wstride = (size_t)2048 * 1024 * 2; S.stok = (const int*)(ws + WS_STOK); S.A = (const char*)(ws + WS_HDN); S.gtab = (LAS const unsigned*)(lds + GT_OFF);
          S.fill_gather((LAS unsigned*)(lds + GT_OFF));
          EpiUp E{(bf16_t*)(ws + WS_ACT), P.b_up + (size_t)l * 32 * 2048, (LAS const int*)(lds + MISC_OFF)};
          gm::gemm_phase<EpiUp, MoeOrder<true>, true>(lds, 1024, S, E); }
        grid.sync();
        if (PHON(9)) { unsigned char* const ws = opaque_ptr(P.ws); LAS unsigned char* const lds = opaque_lds(lds0); (void)lds; moe_tables(lds, (const int*)(ws + WS_CTL) + l * 32, 4);
          MoeOrder<false> S; S.tab = (LAS const int*)(lds + MISC_OFF); S.nN = 4; S.G = G; S.vc = vcu; S.Wt = (const char*)(ws + WS_WDN) + (size_t)l * 32 * 1024 * 1024 * 2; S.wstride = (size_t)1024 * 1024 * 2; S.stok = nullptr; S.A = (const char*)(ws + WS_ACT); S.gtab = nullptr;
          EpiDown E{(bf16_t*)(ws + WS_OUTR), P.b_down + (size_t)l * 32 * 1024, (const int*)(ws + WS_STOK), (const float*)(ws + WS_SGATE)};
          gm::gemm_phase<EpiDown, MoeOrder<false>, false>(lds, 1024, S, E); }
        grid.sync();
        if (PHON(10)) { KTID(); combine_phase(P, l, gw, ngw, lane); }
        grid.sync();
    }
}

extern "C" void kernel_launch(void* const* d_in, const int* in_sizes, int n_in, void* d_out, int out_size, void* d_ws, size_t ws_size, hipStream_t stream) {
    static int grid_blocks = 0;
    if (grid_blocks == 0) {
        if (n_in != 29 || ws_size < WS_END) { fprintf(stderr, "kernel_launch: unexpected n_in %d or ws_size %zu (need %zu)\n", n_in, ws_size, (size_t)WS_END); grid_blocks = -1; return; }
        int dev = 0, cus = 0, per_cu = 0;
        (void)hipGetDevice(&dev);
        (void)hipDeviceGetAttribute(&cus, hipDeviceAttributeMultiprocessorCount, dev);
        (void)hipFuncSetAttribute((const void*)fwd_megakernel, hipFuncAttributeMaxDynamicSharedMemorySize, LDS_BYTES);
        (void)hipOccupancyMaxActiveBlocksPerMultiprocessor(&per_cu, (const void*)fwd_megakernel, NTHREADS, LDS_BYTES);
        if (per_cu < 1) { fprintf(stderr, "kernel_launch: occupancy query returned %d\n", per_cu); per_cu = 1; }
        grid_blocks = cus;
        fprintf(stderr, "kernel_launch: cus %d per_cu %d grid %d ws_need %zu\n", cus, per_cu, grid_blocks, (size_t)WS_END);
    }
    if (grid_blocks < 0) return;
    Params p{};
    const float** pp = (const float**)&p;
    for (int i = 0; i < 29; ++i) pp[i] = (const float*)d_in[i];
    p.out = (float*)d_out; p.ws = (unsigned char*)d_ws;
    for (int i = 0; i < 24; ++i) p.inv_freq_rev[i] = pow(10000.0, -(double)(2 * i) / 48.0) / 6.283185307179586476925;
    for (int h = 0; h < 4; ++h) p.log_gamma[h] = (float)log1p(-exp2(-5.0 - (double)h));
    void* args[] = {&p};
    hipError_t e = hipLaunchCooperativeKernel((const void*)fwd_megakernel, dim3(grid_blocks), dim3(NTHREADS), args, LDS_BYTES, stream);
    if (e != hipSuccess) fprintf(stderr, "cooperative launch failed: %s (grid %d)\n", hipGetErrorString(e), grid_blocks);
}
```

```cpp
#include <hip/hip_runtime.h>
#include <hip/hip_cooperative_groups.h>
#include <cstdio>
#include <cstdint>
#include <cmath>
namespace cg = cooperative_groups;

#define LAS __attribute__((address_space(3)))
typedef unsigned short bf16_t;
typedef short bf16x8 __attribute__((ext_vector_type(8)));
typedef float f32x4 __attribute__((ext_vector_type(4)));
typedef float f32x16 __attribute__((ext_vector_type(16)));
typedef unsigned u32x4 __attribute__((ext_vector_type(4)));
typedef unsigned u32x2 __attribute__((ext_vector_type(2)));

constexpr int T_TOK = 32768, DM = 1024, NBATCH = 8, SEQ = 4096, NLAYER = 2;
constexpr int NPROJ = 2576, NPROJP = 2816;
constexpr int NE = 32, CAP = 32768, NSLOT = T_TOK * 4;
constexpr int C_GQ = 0, C_GK = 192, C_GV = 384, C_GG = 768, C_GA = 1152, C_RQ = 1168, C_RK = 1360, C_RV = 1552, C_RG = 1936, C_SU = 2320;
constexpr float NORM_EPS = 1e-5f;
constexpr int NTHREADS = 512, NWAVES = 8;
constexpr int LDS_BYTES = 160 * 1024;
constexpr int MISC_OFF = 148 * 1024;

constexpr size_t al256(size_t x) { return (x + 255) & ~(size_t)255; }
constexpr size_t WS_CTL   = 0;
constexpr size_t WS_BAR   = 4096;
constexpr size_t WS_CTL_BYTES = 32768;
constexpr size_t WS_MOD   = 32768;
constexpr size_t WS_WIN   = al256(WS_MOD + (size_t)2 * 8 * 6144 * 4);
constexpr size_t WS_WOUT  = al256(WS_WIN + (size_t)2 * NPROJP * 1024 * 2);
constexpr size_t WS_WUP   = al256(WS_WOUT + (size_t)2 * 1024 * 1024 * 2);
constexpr size_t WS_WDN   = al256(WS_WUP + (size_t)2 * 32 * 2048 * 1024 * 2);
constexpr size_t WS_WGLU  = al256(WS_WDN + (size_t)2 * 32 * 1024 * 1024 * 2);
constexpr size_t WS_KTAB  = al256(WS_WGLU + (size_t)2 * 256 * 256 * 2);
constexpr size_t WS_BPOW  = al256(WS_KTAB + (size_t)2 * 16 * 65 * 256 * 2);
constexpr size_t WS_CPOW  = al256(WS_BPOW + (size_t)2 * 16 * 128 * 1024 * 2);
constexpr size_t WS_LAM64 = al256(WS_CPOW + (size_t)2 * 16 * 1024 * 128 * 2);
constexpr size_t WS_ROPE  = al256(WS_LAM64 + (size_t)2 * 16 * 64 * 2 * 4);
constexpr size_t WS_WA2T  = al256(WS_ROPE + (size_t)4096 * 24 * 2 * 4);
constexpr size_t WS_X     = al256(WS_WA2T + (size_t)2 * 4 * 64 * 16 * 2);
constexpr size_t WS_HDN   = al256(WS_X + (size_t)T_TOK * 1024 * 4);
constexpr size_t WS_PROJ  = al256(WS_HDN + (size_t)T_TOK * 1024 * 2);
constexpr size_t WS_MIXED = al256(WS_PROJ + (size_t)T_TOK * NPROJP * 2);
constexpr size_t WS_YBUF  = al256(WS_MIXED + (size_t)T_TOK * 1024 * 2);
constexpr size_t WS_ACT   = al256(WS_YBUF + (size_t)T_TOK * 256 * 2);
constexpr size_t WS_OUTR  = al256(WS_ACT + (size_t)(NSLOT + 256) * 1024 * 2);
constexpr size_t WS_STOK  = al256(WS_OUTR + (size_t)NSLOT * 1024 * 2);
constexpr size_t WS_SGATE = al256(WS_STOK + (size_t)NE * CAP * 4);
constexpr size_t MXW_QD = WS_ACT, MXW_OI = WS_ACT + ((size_t)32 << 20), MXW_DS = WS_ACT + ((size_t)96 << 20), MXW_DEC = WS_ACT + ((size_t)176 << 20), MXW_SP = WS_ACT + ((size_t)180 << 20);
constexpr size_t WS_END   = al256(WS_SGATE + (size_t)NE * CAP * 4);

struct Params {
    const float* x; const float* c; const float* norm1_w; const float* norm2_w; const float* w_mod; const float* b_mod;
    const float* w_in; const float* gla_w_a2; const float* gla_b_a; const float* gla_norm_w; const float* ret_norm_w;
    const float* s5_a_re; const float* s5_a_im; const float* s5_log_dt; const float* s5_b_re; const float* s5_b_im;
    const float* s5_c_re; const float* s5_c_im; const float* s5_d; const float* s5_w_glu; const float* s5_b_glu;
    const float* w_out; const float* router_w; const float* router_b; const float* w_up; const float* b_up;
    const float* w_down; const float* b_down; const float* final_norm_w;
    float* out; unsigned char* ws;
    double inv_freq_rev[24];
    float log_gamma[4]; float pad0[4];
};

__device__ __forceinline__ unsigned f2bf(float f) { unsigned u = __builtin_bit_cast(unsigned, f); return (u + 0x7fffu + ((u >> 16) & 1u)) >> 16; }
typedef float f32x2_t __attribute__((ext_vector_type(2)));
typedef __bf16 bf16x2_t __attribute__((ext_vector_type(2)));
__device__ __forceinline__ unsigned pk2(float lo, float hi) { const f32x2_t v = {lo, hi}; const bf16x2_t b = __builtin_convertvector(v, bf16x2_t); return __builtin_bit_cast(unsigned, b); }
__device__ __forceinline__ float bflo(unsigned w) { return __builtin_bit_cast(float, w << 16); }
__device__ __forceinline__ float bfhi(unsigned w) { return __builtin_bit_cast(float, w & 0xffff0000u); }
__device__ __forceinline__ float bf2f(bf16_t b) { return __builtin_bit_cast(float, (unsigned)b << 16); }
__device__ __forceinline__ float lx_f(float v, int lane, int o) { return __builtin_bit_cast(float, __builtin_amdgcn_ds_bpermute((lane ^ o) << 2, __builtin_bit_cast(int, v))); }
__device__ __forceinline__ int lx_i(int v, int lane, int o) { return __builtin_amdgcn_ds_bpermute((lane ^ o) << 2, v); }
__device__ __forceinline__ float lidx_f(float v, int src) { return __builtin_bit_cast(float, __builtin_amdgcn_ds_bpermute(src << 2, __builtin_bit_cast(int, v))); }
__device__ __forceinline__ float wave_sum(float v, int lane) {
#pragma unroll
    for (int o = 1; o < 64; o <<= 1) v += lx_f(v, lane, o);
    return v;
}
__device__ __forceinline__ float siluf(float x) { return x / (1.0f + __expf(-x)); }
__device__ __forceinline__ float sigmoidf_(float x) { return 1.0f / (1.0f + __expf(-x)); }
#define LDS_WAIT() asm volatile("s_waitcnt lgkmcnt(0)" ::: "memory")
__device__ __forceinline__ unsigned char* opaque_ptr(unsigned char* p) { const unsigned long long v = (unsigned long long)p; unsigned lo = __builtin_amdgcn_readfirstlane((unsigned)v), hi = __builtin_amdgcn_readfirstlane((unsigned)(v >> 32));
    asm volatile("" : "+s"(lo), "+s"(hi)); return (unsigned char*)(__attribute__((address_space(1))) unsigned char*)(((unsigned long long)hi << 32) | lo); }
__device__ __forceinline__ LAS unsigned char* opaque_lds(LAS unsigned char* p) { unsigned v = __builtin_amdgcn_readfirstlane((unsigned)(size_t)p); asm volatile("" : "+s"(v)); return (LAS unsigned char*)(size_t)v; }
__device__ __forceinline__ int opaque_tid() { int t = threadIdx.x; asm volatile("" : "+v"(t)); return t; }

namespace gm {
constexpr int BM = 256, BK = 64, HALF = 128, HTB = HALF * BK * 2, STAGE_BYTES = 8 * HTB, NXCD = 8, WGM = 8;
__device__ __forceinline__ int lds_byte(int r, int c) { const int st = (r >> 4) * 2 + (c >> 5), rr = r & 15, cc = c & 31, ob = rr * 64 + cc * 2; return st * 1024 + (ob ^ (((ob >> 9) & 1) << 5)); }
__device__ __forceinline__ void stage_rc(int b, int& R, int& C) { const int st = b / 1024, sb = b % 1024, swz = sb ^ (((sb >> 9) & 1) << 5); R = (st >> 1) * 16 + swz / 64; C = (st & 1) * 32 + (swz % 64) / 2; }
__device__ __forceinline__ int perm32(int rho) { const int n = rho >> 4, i = rho & 15; return 8 * (i >> 2) + 4 * n + (i & 3); }

struct Unit { const char* B; int pm, pn, e, rows; };

template <class Epi, class Sched, bool GATHER>
__device__ __forceinline__ void gemm_phase(LAS unsigned char* lds, const int K_in, const Sched& S, const Epi& E) {
    int K = K_in; asm volatile("" : "+s"(K));
    const int tid = opaque_tid(), wid = __builtin_amdgcn_readfirstlane(tid >> 6), lane = tid & 63, wr = wid >> 2, wc = wid & 3, fr = lane & 15, fq = lane >> 4;
    const int nt = K / BK;
    int R0, C0; unsigned voffB;
    { stage_rc(tid * 16, R0, C0);
      const int Rb0 = Epi::PERM ? ((R0 & ~31) + perm32(R0 & 31)) : R0;
      voffB = (unsigned)(Rb0 * K + C0) * 2u; }
    const size_t kstep = (size_t)(BK * 2);
    const size_t hstep = (size_t)HALF * K * 2;
    const size_t qstep = (size_t)64 * K * 2;
    const unsigned ldsw = (unsigned)wid * 1024u;
    const int aoff = lds_byte(wr * 64 + fr, fq * 8), boff = lds_byte(wc * 32 + fr, fq * 8);
#define G_SA(b, h) (((b) * 2 + (h)) * gm::HTB)
#define G_SB(b, h) ((4 + (b) * 2 + (h)) * gm::HTB)
#define G_GLDS(gptr, ldsoff) __builtin_amdgcn_global_load_lds((const unsigned*)(gptr), (LAS unsigned*)(lds + (ldsoff)), 16, 0, 0)
#define G_STAGEB(bufoff, gbase) do { G_GLDS((const char*)(gbase) + voffB, (bufoff) + ldsw); G_GLDS((const char*)(gbase) + qstep + voffB, (bufoff) + ldsw + 8192); } while (0)
#define G_STAGEA(bufoff, ubase, h, o0, o1) do { if (GATHER) { G_GLDS((const char*)(ubase) + (o0), (bufoff) + ldsw); G_GLDS((const char*)(ubase) + (o1), (bufoff) + ldsw + 8192); } \
        else { G_GLDS((const char*)(ubase) + (h) * hstep + (o0), (bufoff) + ldsw); G_GLDS((const char*)(ubase) + (h) * hstep + qstep + (o0), (bufoff) + ldsw + 8192); } } while (0)
#define G_LDA(dst, b, h) do { _Pragma("unroll") for (int m = 0; m < 4; ++m) _Pragma("unroll") for (int k = 0; k < 2; ++k) dst[m][k] = *(const LAS bf16x8*)(lds + G_SA(b, h) + aoff + m * 2048 + k * 1024); } while (0)
#define G_LDB(dst, b, h) do { _Pragma("unroll") for (int n = 0; n < 2; ++n) _Pragma("unroll") for (int k = 0; k < 2; ++k) dst[n][k] = *(const LAS bf16x8*)(lds + G_SB(b, h) + boff + n * 2048 + k * 1024); } while (0)
#define G_MMA(ai, bj, At, Bt) do { __builtin_amdgcn_s_setprio(1); _Pragma("unroll") for (int m = 0; m < 4; ++m) _Pragma("unroll") for (int n = 0; n < 2; ++n) _Pragma("unroll") for (int k = 0; k < 2; ++k) \
        acc[ai][bj][m][n] = __builtin_amdgcn_mfma_f32_16x16x32_bf16(Bt[n][k], At[m][k], acc[ai][bj][m][n], 0, 0, 0); __builtin_amdgcn_s_setprio(0); } while (0)
#define G_WAIT_V(n) asm volatile("s_waitcnt vmcnt(" #n ")" ::: "memory")
#define G_WAIT_L(n) asm volatile("s_waitcnt lgkmcnt(" #n ")" ::: "memory")
#define G_BAR __builtin_amdgcn_s_barrier()
#define G_SCHED __builtin_amdgcn_sched_barrier(0)
    Unit cur, nxt; int ui = 0;
    if (!S.next(0, cur)) return;
    f32x4 acc[2][2][4][2];
#pragma unroll
    for (int a = 0; a < 2; ++a)
#pragma unroll
        for (int b = 0; b < 2; ++b)
#pragma unroll
            for (int m = 0; m < 4; ++m)
#pragma unroll
                for (int n = 0; n < 2; ++n) acc[a][b][m][n] = (f32x4){0.f, 0.f, 0.f, 0.f};
    bf16x8 At[4][2], B0[2][2], B1[2][2];
    unsigned c00, c01 = 0, c10 = 0, c11 = 0;
    c00 = S.a_off(0, R0, C0);
    if (GATHER) { c01 = S.a_off(0, R0 + 64, C0); c10 = S.a_off(0, R0 + 128, C0); c11 = S.a_off(0, R0 + 192, C0); }
    const char* cA = S.a_base(cur); const char* cB = cur.B;
    G_STAGEB(G_SB(0, 0), cB); G_STAGEB(G_SB(0, 1), cB + hstep); G_STAGEA(G_SA(0, 0), cA, 0, c00, c01); G_STAGEA(G_SA(0, 1), cA, 1, c10 + (GATHER ? 0u : c00), c11);
    if (wr == 1) G_BAR;
    G_WAIT_V(2); G_BAR;
    G_STAGEB(G_SB(1, 0), cB + kstep); G_STAGEA(G_SA(1, 0), cA + kstep, 0, c00, c01); G_STAGEB(G_SB(1, 1), cB + hstep + kstep);
    G_WAIT_V(6); G_BAR;
    for (;;) {
        const bool has_next = S.next(ui + 1, nxt);
        const char* nB = cB; const char* nA = cA;
        if (has_next) { nB = nxt.B; nA = S.a_base(nxt); }
        for (int t = 0; t < nt; t += 2) {
            const bool last = (t == nt - 2);
            const char* a1 = cA + (size_t)(t + 1) * kstep;
            const char* a2 = last ? nA : cA + (size_t)(t + 2) * kstep;
            const char* b2 = last ? nB : cB + (size_t)(t + 2) * kstep;
            G_LDB(B0, 0, 0); G_LDB(B1, 0, 1); G_SCHED; G_LDA(At, 0, 0); G_STAGEA(G_SA(1, 1), a1, 1, c10 + (GATHER ? 0u : c00), c11);
            G_WAIT_V(8); G_WAIT_L(0); G_BAR; G_MMA(0, 0, At, B0); G_MMA(0, 1, At, B1); G_BAR; G_SCHED;
            if (GATHER) { if (last && has_next) { c00 = S.a_off(ui + 1, R0, C0); c01 = S.a_off(ui + 1, R0 + 64, C0); c10 = S.a_off(ui + 1, R0 + 128, C0); c11 = S.a_off(ui + 1, R0 + 192, C0); } }
            G_LDA(At, 0, 1); G_STAGEB(G_SB(0, 0), b2); G_STAGEB(G_SB(0, 1), b2 + hstep); G_STAGEA(G_SA(0, 0), a2, 0, c00, c01);
            G_WAIT_V(8); G_WAIT_L(0); G_BAR; G_MMA(1, 0, At, B0); G_MMA(1, 1, At, B1); G_BAR; G_SCHED;
            G_LDB(B0, 1, 0); G_LDB(B1, 1, 1); G_SCHED; G_LDA(At, 1, 0); G_STAGEA(G_SA(0, 1), a2, 1, c10 + (GATHER ? 0u : c00), c11);
            G_WAIT_V(8); G_WAIT_L(0); G_BAR; G_MMA(0, 0, At, B0); G_MMA(0, 1, At, B1); G_BAR; G_SCHED;
            G_LDA(At, 1, 1); G_STAGEB(G_SB(1, 0), b2 + kstep); G_STAGEB(G_SB(1, 1), b2 + kstep + hstep); G_STAGEA(G_SA(1, 0), a2 + kstep, 0, c00, c01);
            G_WAIT_V(8); G_WAIT_L(0); G_BAR; G_MMA(1, 0, At, B0); G_MMA(1, 1, At, B1); G_BAR; G_SCHED;
        }
        if (wr == 0) G_BAR;
        E(acc, cur, wr, wc, fr, fq);
        if (!has_next) break;
#pragma unroll
        for (int a = 0; a < 2; ++a)
#pragma unroll
            for (int b = 0; b < 2; ++b)
#pragma unroll
                for (int m = 0; m < 4; ++m)
#pragma unroll
                    for (int n = 0; n < 2; ++n) acc[a][b][m][n] = (f32x4){0.f, 0.f, 0.f, 0.f};
        cur = nxt; cB = nB; cA = nA; ++ui;
        if (wr == 1) G_BAR;
    }
    G_WAIT_V(0);
    G_BAR;
}
}

struct DenseOrder {
    int nM, nN, nwg, G, c, K; const char* Bt;
    __device__ __forceinline__ void init(int M, int N, int K_, int G_, int c_, const void* A_, const void* Bt_) { nM = M / 256; nN = N / 256; nwg = nM * nN; G = G_; c = c_; K = K_; A = (const char*)A_; Bt = (const char*)Bt_; }
    __device__ __forceinline__ bool next(int i, gm::Unit& u) const {
        const long L = (long)i * G + c; if (L >= nwg) return false;
        int wgid = (int)L; { const int q = nwg / gm::NXCD, r = nwg % gm::NXCD, xcd = wgid % gm::NXCD, off = wgid / gm::NXCD; wgid = (xcd < r ? xcd * (q + 1) : r * (q + 1) + (xcd - r) * q) + off; }
        const int nig = gm::WGM * nN, gid = wgid / nig, fm = gid * gm::WGM, gsz = (nM - fm) < gm::WGM ? (nM - fm) : gm::WGM;
        u.pm = fm + ((wgid % nig) % gsz); u.pn = (wgid % nig) / gsz; u.e = 0; u.rows = 256;
        u.B = Bt + (size_t)u.pn * 256 * K * 2; return true;
    }
    const char* A;
    __device__ __forceinline__ const char* a_base(const gm::Unit& u) const { return A + (size_t)u.pm * 256 * K * 2; }
    __device__ __forceinline__ unsigned a_off(int, int r, int c) const { return (unsigned)(r * K + c) * 2u; }
};
constexpr int GT_MAX = 19, GT_OFF = 128 * 1024;
template <bool GATHER> struct MoeOrder {
    LAS const int* tab; int nN, G, vc; const char* Wt; size_t wstride; const int* stok;
    __device__ __forceinline__ bool next(int i, gm::Unit& u) const {
        const int L = i * G + vc; if (L >= tab[32]) return false;
        int e = 0;
#pragma unroll 1
        for (int k = 1; k < 32; ++k) e += (tab[k] <= L) ? 1 : 0;
        const int r = L - tab[e]; u.e = e; u.pm = r / nN; u.pn = r % nN;
        const int cnt = tab[128 + e]; u.rows = (cnt - u.pm * 256) < 256 ? (cnt - u.pm * 256) : 256;
        u.B = Wt + (size_t)e * wstride + (size_t)u.pn * 256 * 1024 * 2; return true;
    }
    const char* A;
    __device__ __forceinline__ const char* a_base(const gm::Unit& u) const { return GATHER ? A : A + (size_t)(tab[64 + u.e] + u.pm * 256) * 2048; }
    LAS const unsigned* gtab;
    __device__ __forceinline__ unsigned a_off(int ui, int r, int c) const {
        if (GATHER) return gtab[ui * 256 + r] + (unsigned)c * 2u;
        else return (unsigned)(r * 1024 + c) * 2u;
    }
    __device__ __forceinline__ void fill_gather(LAS unsigned* gt) const {
        const int tid = opaque_tid();
        if (tid < 256) { gm::Unit u;
            for (int i = 0; i < GT_MAX && next(i, u); ++i) { int tk = 0; if (tid < u.rows) tk = stok[u.e * CAP + u.pm * 256 + tid] >> 2; gt[i * 256 + tid] = (unsigned)tk * 2048u; } }
        __syncthreads();
    }
};
__device__ __forceinline__ void moe_tables(LAS unsigned char* lds, const int* gcount, int nN) {
    LAS int* tab = (LAS int*)(lds + MISC_OFF);
    if (opaque_tid() == 0) { int cu = 0, ro = 0;
#pragma unroll 1
        for (int e = 0; e < 32; ++e) { const int c = gcount[e]; tab[e] = cu; tab[64 + e] = ro; tab[128 + e] = c; cu += ((c + 255) >> 8) * nN; ro += c; }
        tab[32] = cu; tab[64 + 32] = ro; }
    __syncthreads();
}

struct EpiProj {
    static constexpr bool PERM = true;
    bf16_t* O; int ldc;
    __device__ __forceinline__ void operator()(const f32x4 (&acc)[2][2][4][2], const gm::Unit& u, int wr, int wc, int fr_, int fq_) const {
        int fr = fr_, fq = fq_; asm volatile("" : "+v"(fr), "+v"(fq));
        const int row0 = u.pm * 256 + wr * 64 + fr, col0 = u.pn * 256 + wc * 32 + 8 * fq;
#pragma unroll
        for (int ai = 0; ai < 2; ++ai)
#pragma unroll
            for (int m = 0; m < 4; ++m) { bf16_t* rowp = O + (size_t)(row0 + ai * 128 + m * 16) * ldc + col0;
#pragma unroll
                for (int bj = 0; bj < 2; ++bj) { const f32x4 v0 = acc[ai][bj][m][0], v1 = acc[ai][bj][m][1];
                    u32x4 w; w.x = pk2(v0[0], v0[1]); w.y = pk2(v0[2], v0[3]); w.z = pk2(v1[0], v1[1]); w.w = pk2(v1[2], v1[3]);
                    *(u32x4*)(rowp + bj * 128) = w; } }
    }
};
struct EpiOut {
    static constexpr bool PERM = false;
    const float* xin; float* xout; const float* gate;
    __device__ __forceinline__ void operator()(const f32x4 (&acc)[2][2][4][2], const gm::Unit& u, int wr, int wc, int fr_, int fq_) const {
        int fr = fr_, fq = fq_; asm volatile("" : "+v"(fr), "+v"(fq));
        const int row0 = u.pm * 256 + wr * 64 + fr, col0 = u.pn * 256 + wc * 32 + 4 * fq;
        const float* gp = gate + (size_t)(u.pm >> 4) * 6144 + col0;
        f32x4 gv[2][2];
#pragma unroll
        for (int bj = 0; bj < 2; ++bj)
#pragma unroll
            for (int n = 0; n < 2; ++n) gv[bj][n] = *(const f32x4*)(gp + bj * 128 + n * 16);
#pragma unroll
        for (int ai = 0; ai < 2; ++ai)
#pragma unroll
            for (int m = 0; m < 4; ++m) { const size_t ro = (size_t)(row0 + ai * 128 + m * 16) * 1024 + col0;
#pragma unroll
                for (int bj = 0; bj < 2; ++bj)
#pragma unroll
                    for (int n = 0; n < 2; ++n) { const f32x4 xi = *(const f32x4*)(xin + ro + bj * 128 + n * 16);
                        *(f32x4*)(xout + ro + bj * 128 + n * 16) = xi + gv[bj][n] * acc[ai][bj][m][n]; } }
    }
};
struct EpiGlu {
    static constexpr bool PERM = true;
    const bf16_t* y; bf16_t* mixed; const float* bias;
    __device__ __forceinline__ void operator()(const f32x4 (&acc)[2][2][4][2], const gm::Unit& u, int wr, int wc, int fr_, int fq_) const {
        int fr = fr_, fq = fq_; asm volatile("" : "+v"(fr), "+v"(fq));
        const int row0 = u.pm * 256 + wr * 64 + fr, col0 = wc * 32 + 8 * fq;
#pragma unroll
        for (int ai = 0; ai < 2; ++ai)
#pragma unroll
            for (int m = 0; m < 4; ++m) { const int row = row0 + ai * 128 + m * 16;
#pragma unroll
                for (int bj = 0; bj < 2; ++bj) { const int col = col0 + bj * 128;
                    const f32x4 b0 = *(const f32x4*)(bias + col), b1 = *(const f32x4*)(bias + col + 4);
                    const u32x4 yw = *(const u32x4*)(y + (size_t)row * 256 + col);
                    const f32x4 z0 = acc[ai][bj][m][0] + b0, z1 = acc[ai][bj][m][1] + b1;
                    u32x4 w;
                    w.x = pk2(bflo(yw.x) * sigmoidf_(z0[0]), bfhi(yw.x) * sigmoidf_(z0[1]));
                    w.y = pk2(bflo(yw.y) * sigmoidf_(z0[2]), bfhi(yw.y) * sigmoidf_(z0[3]));
                    w.z = pk2(bflo(yw.z) * sigmoidf_(z1[0]), bfhi(yw.z) * sigmoidf_(z1[1]));
                    w.w = pk2(bflo(yw.w) * sigmoidf_(z1[2]), bfhi(yw.w) * sigmoidf_(z1[3]));
                    *(u32x4*)(mixed + (size_t)row * 1024 + 768 + col) = w; }
                __builtin_amdgcn_sched_barrier(0); }
    }
};
__device__ __forceinline__ float swiglu1(float g, float l) {
    g = fminf(g, 7.0f); l = fminf(fmaxf(l, -7.0f), 7.0f);
    return g * sigmoidf_(1.702f * g) * (l + 1.0f);
}
struct EpiUp {
    static constexpr bool PERM = true;
    bf16_t* act; const float* bias; LAS const int* tab;
    __device__ __forceinline__ void operator()(const f32x4 (&acc)[2][2][4][2], const gm::Unit& u, int wr, int wc, int fr_, int fq_) const {
        int fr = fr_, fq = fq_; asm volatile("" : "+v"(fr), "+v"(fq));
        const int rl0 = wr * 64 + fr, col0 = u.pn * 128 + wc * 32 + 8 * fq;
        const float* bp = bias + (size_t)u.e * 2048 + col0;
        const size_t arow = (size_t)(tab[64 + u.e] + u.pm * 256);
#pragma unroll
        for (int ai = 0; ai < 2; ++ai)
#pragma unroll
            for (int m = 0; m < 4; ++m) { const int rl = rl0 + ai * 128 + m * 16;
                if (rl < u.rows) {
                    const f32x4 bg0 = *(const f32x4*)(bp), bg1 = *(const f32x4*)(bp + 4), bl0 = *(const f32x4*)(bp + 1024), bl1 = *(const f32x4*)(bp + 1028);
                    const f32x4 g0 = acc[ai][0][m][0] + bg0, g1 = acc[ai][0][m][1] + bg1, l0 = acc[ai][1][m][0] + bl0, l1 = acc[ai][1][m][1] + bl1;
                    u32x4 w;
                    w.x = pk2(swiglu1(g0[0], l0[0]), swiglu1(g0[1], l0[1])); w.y = pk2(swiglu1(g0[2], l0[2]), swiglu1(g0[3], l0[3]));
                    w.z = pk2(swiglu1(g1[0], l1[0]), swiglu1(g1[1], l1[1])); w.w = pk2(swiglu1(g1[2], l1[2]), swiglu1(g1[3], l1[3]));
                    *(u32x4*)(act + (arow + rl) * 1024 + col0) = w; }
                __builtin_amdgcn_sched_barrier(0); }
    }
};
struct EpiDown {
    static constexpr bool PERM = true;
    bf16_t* outr; const float* bias; const int* stok; const float* sgate;
    __device__ __forceinline__ void operator()(const f32x4 (&acc)[2][2][4][2], const gm::Unit& u, int wr, int wc, int fr_, int fq_) const {
        int fr = fr_, fq = fq_; asm volatile("" : "+v"(fr), "+v"(fq));
        const int rl0 = wr * 64 + fr, col0 = u.pn * 256 + wc * 32 + 8 * fq;
        const float* bp = bias + (size_t)u.e * 1024 + col0;
        f32x4 bv[2][2];
#pragma unroll
        for (int bj = 0; bj < 2; ++bj) { bv[bj][0] = *(const f32x4*)(bp + bj * 128); bv[bj][1] = *(const f32x4*)(bp + bj * 128 + 4); }
#pragma unroll
        for (int ai = 0; ai < 2; ++ai)
#pragma unroll
            for (int m = 0; m < 4; ++m) { const int rl = rl0 + ai * 128 + m * 16;
                if (rl < u.rows) {
                    const int si = u.e * CAP + u.pm * 256 + rl; const int st = stok[si]; const float gt = sgate[si];
                    bf16_t* rowp = outr + (size_t)st * 1024 + col0;
#pragma unroll
                    for (int bj = 0; bj < 2; ++bj) { const f32x4 v0 = (acc[ai][bj][m][0] + bv[bj][0]) * gt, v1 = (acc[ai][bj][m][1] + bv[bj][1]) * gt;
                        u32x4 w; w.x = pk2(v0[0], v0[1]); w.y = pk2(v0[2], v0[3]); w.z = pk2(v1[0], v1[1]); w.w = pk2(v1[2], v1[3]);
                        *(u32x4*)(rowp + bj * 128) = w; } }
                __builtin_amdgcn_sched_barrier(0); }
    }
};

__device__ __forceinline__ void transpose_item(const float* W, int K, int Nsrc, bf16_t* WT, int mode, LAS float* scr, int kb, int nb, int lane) {
    const int k0 = 64 * kb, n0 = 32 * nb;
    const int ncol = n0 + (lane & 31);
#pragma unroll 8
    for (int i = 0; i < 32; ++i) { const int kk = 2 * i + (lane >> 5); scr[kk * 33 + (lane & 31)] = (ncol < Nsrc) ? W[(size_t)(k0 + kk) * Nsrc + ncol] : 0.f; }
    LDS_WAIT(); asm volatile("" ::: "memory");
    const int c = lane & 7;
#pragma unroll
    for (int j = 0; j < 4; ++j) { const int n = (lane >> 3) + 8 * j; const LAS float* s = scr + (8 * c) * 33 + n;
        u32x4 o; o.x = pk2(s[0 * 33], s[1 * 33]); o.y = pk2(s[2 * 33], s[3 * 33]); o.z = pk2(s[4 * 33], s[5 * 33]); o.w = pk2(s[6 * 33], s[7 * 33]);
        int drow = n0 + n;
        if (mode == 1) { const int jj = drow & 1023, lin = drow >> 10; drow = (jj >> 7) * 256 + lin * 128 + (jj & 127); }
        *(u32x4*)(WT + (size_t)drow * K + k0 + 8 * c) = o; }
    LDS_WAIT(); asm volatile("" ::: "memory");
}
constexpr int TI_IN = 16 * 88, TI_OUT = 16 * 32, TI_UP = 16 * 64, TI_DN = 16 * 32, TI_GLU = 4 * 8;
constexpr int TS_R0 = 2 * TI_IN, TS_R1 = TS_R0 + 2 * TI_OUT, TS_R2 = TS_R1 + 2 * TI_GLU;
__device__ __forceinline__ void transpose_small(const Params& P, LAS unsigned char* lds, int gw, int ngw, int wave, int lane) {
    unsigned char* const wsp = opaque_ptr(P.ws);
    LAS float* scr = (LAS float*)(lds + wave * 8704);
    for (int it = gw; it < TS_R2; it += ngw) {
        if (it < TS_R0) { const int l = it / TI_IN, r = it % TI_IN;
            transpose_item(P.w_in + (size_t)l * 1024 * NPROJ, 1024, NPROJ, (bf16_t*)(wsp + WS_WIN) + (size_t)l * NPROJP * 1024, 0, scr, r / 88, r % 88, lane); }
        else if (it < TS_R1) { const int q = it - TS_R0, l = q / TI_OUT, r = q % TI_OUT;
            transpose_item(P.w_out + (size_t)l * 1024 * 1024, 1024, 1024, (bf16_t*)(wsp + WS_WOUT) + (size_t)l * 1024 * 1024, 0, scr, r / 32, r % 32, lane); }
        else { const int q = it - TS_R1, l = q / TI_GLU, r = q % TI_GLU;
            transpose_item(P.s5_w_glu + (size_t)l * 256 * 256, 256, 256, (bf16_t*)(wsp + WS_WGLU) + (size_t)l * 256 * 256, 0, scr, r / 8, r % 8, lane); }
    }
}
__device__ __forceinline__ void transpose_item64(const float* W, int K, int Nsrc, bf16_t* WT, int mode, LAS float* scr, int kb, int nb, int lane) {
    const int k0 = 64 * kb, n0 = 64 * nb, kq = lane >> 4, nn = 4 * (lane & 15);
    const float* src = W + (size_t)(k0 + kq) * Nsrc + n0 + nn;
    f32x4 v[16];
#pragma unroll
    for (int i = 0; i < 16; ++i) v[i] = __builtin_nontemporal_load((const f32x4*)(src + (size_t)(4 * i) * Nsrc));
#pragma unroll
    for (int i = 0; i < 16; ++i) { LAS float* d = scr + (4 * i + kq) * 65 + nn; d[0] = v[i][0]; d[1] = v[i][1]; d[2] = v[i][2]; d[3] = v[i][3]; }
    LDS_WAIT(); asm volatile("" ::: "memory");
    const int c = lane & 7;
#pragma unroll
    for (int j = 0; j < 8; ++j) { const int n = (lane >> 3) + 8 * j; const LAS float* s = scr + (8 * c) * 65 + n;
        u32x4 o; o.x = pk2(s[0 * 65], s[1 * 65]); o.y = pk2(s[2 * 65], s[3 * 65]); o.z = pk2(s[4 * 65], s[5 * 65]); o.w = pk2(s[6 * 65], s[7 * 65]);
        int drow = n0 + n;
        if (mode == 1) { const int jj = drow & 1023, lin = drow >> 10; drow = (jj >> 7) * 256 + lin * 128 + (jj & 127); }
        *(u32x4*)(WT + (size_t)drow * K + k0 + 8 * c) = o; }
    LDS_WAIT(); asm volatile("" ::: "memory");
}
constexpr int TM_UP = 16 * 32, TM_DN = 16 * 16;
__device__ __forceinline__ void transpose_moe(const Params& P, LAS unsigned char* lds, int l, int gw, int ngw, int wave, int lane) {
    unsigned char* const wsp = opaque_ptr(P.ws);
    LAS float* scr = (LAS float*)(lds + wave * 16640);
    for (int it = gw; it < 32 * (TM_UP + TM_DN); it += ngw) {
        if (it < 32 * TM_UP) { const int le = l * 32 + it / TM_UP, r = it % TM_UP;
            transpose_item64(P.w_up + (size_t)le * 1024 * 2048, 1024, 2048, (bf16_t*)(wsp + WS_WUP) + (size_t)le * 2048 * 1024, 1, scr, r / 32, r % 32, lane); }
        else { const int q = it - 32 * TM_UP, le = l * 32 + q / TM_DN, r = q % TM_DN;
            transpose_item64(P.w_down + (size_t)le * 1024 * 1024, 1024, 1024, (bf16_t*)(wsp + WS_WDN) + (size_t)le * 1024 * 1024, 0, scr, r / 16, r % 16, lane); }
    }
}
__device__ __forceinline__ void mod_item(const Params& P, LAS unsigned char* lds, int item) {
    unsigned char* const wsp = opaque_ptr(P.ws);
    const int tid = opaque_tid(), wave = tid >> 6, lane = tid & 63;
    LAS float* sc = (LAS float*)lds;
    LAS float* red = (LAS float*)(lds + 32768);
    const int l = item / 96, cb = item % 96;
    for (int i = tid; i < 8192; i += NTHREADS) sc[i] = siluf(P.c[i]);
    __syncthreads();
    const float* W = P.w_mod + (size_t)l * 1024 * 6144 + cb * 64 + lane;
    float a[8];
#pragma unroll
    for (int b = 0; b < 8; ++b) a[b] = 0.f;
    for (int k = wave; k < 1024; k += 8) { const float w = W[(size_t)k * 6144];
#pragma unroll
        for (int b = 0; b < 8; ++b) a[b] += sc[b * 1024 + k] * w; }
#pragma unroll
    for (int b = 0; b < 8; ++b) red[(wave * 8 + b) * 64 + lane] = a[b];
    __syncthreads();
    { const int b = tid >> 6; float s = 0.f;
#pragma unroll
      for (int w = 0; w < 8; ++w) s += red[(w * 8 + b) * 64 + lane];
      ((float*)(wsp + WS_MOD))[(size_t)(l * 8 + b) * 6144 + cb * 64 + lane] = s + P.b_mod[l * 6144 + cb * 64 + lane]; }
    __syncthreads();
}
__device__ __forceinline__ void dsincos(double x, double& s, double& c) {
    const double x2 = x * x; double ts = x, tc = 1.0; s = x; c = 1.0;
#pragma unroll 1
    for (int k = 1; k <= 14; ++k) { tc = -tc * x2 / (double)((2 * k - 1) * (2 * k)); ts = -ts * x2 / (double)((2 * k) * (2 * k + 1)); c += tc; s += ts; }
}
__device__ __forceinline__ double dexp_small(double z) {
    double t = 1.0, r = 1.0;
#pragma unroll 1
    for (int k = 1; k <= 18; ++k) { t = t * z / (double)k; r += t; }
    return r;
}
__device__ __forceinline__ void s5_tables_item(const Params& P, LAS unsigned char* lds, int item) {
    unsigned char* const wsp = opaque_ptr(P.ws);
    const int tid = opaque_tid(); const int l = item >> 4, g = item & 15, lg = l * 16 + g;
    LAS float* pwr = (LAS float*)lds;
    LAS float* pwi = pwr + 64 * 65;
    LAS float* bbr = pwi + 64 * 65;
    LAS float* bbi = bbr + 1024;
    LAS float* ccr = bbi + 1024;
    LAS float* cci = ccr + 1024;
    if (tid < 64) { const int p = tid;
        const double are = (double)P.s5_a_re[lg * 64 + p], aim = (double)P.s5_a_im[lg * 64 + p];
        const double dt = (double)expf(P.s5_log_dt[lg]);
        const double mag = dexp_small(are * dt);
        double ang = aim * dt; const double TWO_PI = 6.283185307179586476925;
        ang -= TWO_PI * rint(ang / TWO_PI);
        double sn, cs; dsincos(ang, sn, cs);
        const double lbr = mag * cs, lbi = mag * sn;
        const double nr = lbr - 1.0, ni = lbi, den = are * are + aim * aim;
        const double cfr = (nr * are + ni * aim) / den, cfi = (ni * are - nr * aim) / den;
        double pr = 1.0, pi_ = 0.0;
        for (int t = 0; t <= 64; ++t) { pwr[p * 65 + t] = (float)pr; pwi[p * 65 + t] = (float)pi_; const double nr2 = pr * lbr - pi_ * lbi, ni2 = pr * lbi + pi_ * lbr; pr = nr2; pi_ = ni2; }
        for (int h = 0; h < 16; ++h) { const double br = (double)P.s5_b_re[(lg * 64 + p) * 16 + h], bi = (double)P.s5_b_im[(lg * 64 + p) * 16 + h];
            bbr[p * 16 + h] = (float)(cfr * br - cfi * bi); bbi[p * 16 + h] = (float)(cfr * bi + cfi * br); }
        float* l64 = (float*)(wsp + WS_LAM64) + (size_t)(lg * 64 + p) * 2;
        l64[0] = pwr[p * 65 + 64]; l64[1] = pwi[p * 65 + 64];
    }
    for (int i = tid; i < 1024; i += NTHREADS) { ccr[i] = P.s5_c_re[lg * 1024 + i]; cci[i] = P.s5_c_im[lg * 1024 + i]; }
    __syncthreads();
    bf16_t* kt = (bf16_t*)(wsp + WS_KTAB) + (size_t)lg * 65 * 256;
    for (int i = tid; i < 65 * 256; i += NTHREADS) { const int tau = i >> 8, h = (i >> 4) & 15, h2 = i & 15; float s = 0.f;
        if (tau < 64) {
            for (int p = 0; p < 64; ++p) { const float pr = pwr[p * 65 + tau], pi_ = pwi[p * 65 + tau], br = bbr[p * 16 + h2], bi = bbi[p * 16 + h2];
                const float wr_ = pr * br - pi_ * bi, wi_ = pr * bi + pi_ * br; s += ccr[h * 64 + p] * wr_ - cci[h * 64 + p] * wi_; }
            if (tau == 0 && h == h2) s += P.s5_d[l * 256 + g * 16 + h]; }
        kt[i] = (bf16_t)f2bf(s); }
    bf16_t* bp = (bf16_t*)(wsp + WS_BPOW) + (size_t)lg * 128 * 1024;
    for (int i = tid; i < 128 * 1024; i += NTHREADS) { const int q = i >> 10, s = (i >> 4) & 63, h2 = i & 15, p = q & 63;
        const float pr = pwr[p * 65 + 63 - s], pi_ = pwi[p * 65 + 63 - s], br = bbr[p * 16 + h2], bi = bbi[p * 16 + h2];
        const float v = (q < 64) ? (pr * br - pi_ * bi) : (pr * bi + pi_ * br);
        bp[i] = (bf16_t)f2bf(v); }
    bf16_t* cp = (bf16_t*)(wsp + WS_CPOW) + (size_t)lg * 1024 * 128;
    for (int i = tid; i < 1024 * 128; i += NTHREADS) { const int q = i & 127, th = i >> 7, t = th >> 4, h = th & 15, p = q & 63;
        const float pr = pwr[p * 65 + t + 1], pi_ = pwi[p * 65 + t + 1], cr = ccr[h * 64 + p], ci = cci[h * 64 + p];
        const float v = (q < 64) ? (cr * pr - ci * pi_) : -(cr * pi_ + ci * pr);
        cp[i] = (bf16_t)f2bf(v); }
    __syncthreads();
}
__device__ __forceinline__ void rope_table(const Params& P, int gtid, int gthreads) {
    unsigned char* const wsp = opaque_ptr(P.ws);
    float* rp = (float*)(wsp + WS_ROPE);
    for (int i = gtid; i < 4096 * 24; i += gthreads) { const int pos = i / 24, f = i % 24;
        double rev = (double)pos * P.inv_freq_rev[f]; rev -= rint(rev);
        double sn, cs; dsincos(rev * 6.283185307179586476925, sn, cs);
        rp[2 * i] = (float)cs; rp[2 * i + 1] = (float)sn; }
}
__device__ __forceinline__ void norm_row_store(const f32x4 (&v)[4], const float* nw, const float* modrow_sh, const float* modrow_sc, bf16_t* orow, int lane) {
    float ss = 0.f;
#pragma unroll
    for (int j = 0; j < 4; ++j) ss += (v[j][0] * v[j][0] + v[j][1] * v[j][1]) + (v[j][2] * v[j][2] + v[j][3] * v[j][3]);
    const float rstd = 1.0f / sqrtf(wave_sum(ss, lane) * (1.0f / 1024.0f) + NORM_EPS);
#pragma unroll
    for (int hf = 0; hf < 2; ++hf) { const int col = hf * 512 + 8 * lane; float o[8];
#pragma unroll
        for (int q = 0; q < 2; ++q) { const f32x4 w = *(const f32x4*)(nw + col + 4 * q), sc = *(const f32x4*)(modrow_sc + col + 4 * q), sh = *(const f32x4*)(modrow_sh + col + 4 * q);
#pragma unroll
            for (int e = 0; e < 4; ++e) o[4 * q + e] = v[hf * 2 + q][e] * rstd * w[e] * (1.0f + sc[e]) + sh[e]; }
        u32x4 w4; w4.x = pk2(o[0], o[1]); w4.y = pk2(o[2], o[3]); w4.z = pk2(o[4], o[5]); w4.w = pk2(o[6], o[7]);
        *(u32x4*)(orow + col) = w4; }
}

template <int KS>
__device__ __forceinline__ f32x16 mma32(LAS const unsigned char* A, int lda, LAS const unsigned char* B, int ldb, f32x16 acc, int lane) {
    const int r = lane & 31, h = lane >> 5;
#pragma unroll
    for (int ks = 0; ks < KS; ++ks) {
        const bf16x8 a = *(const LAS bf16x8*)(A + r * lda + ks * 32 + h * 16);
        const bf16x8 b = *(const LAS bf16x8*)(B + r * ldb + ks * 32 + h * 16);
        acc = __builtin_amdgcn_mfma_f32_32x32x16_bf16(a, b, acc, 0, 0, 0);
    }
    return acc;
}
__device__ __forceinline__ int crow(int reg, int lane) { return (reg & 3) + 8 * (reg >> 2) + 4 * (lane >> 5); }

constexpr int MA_QD = 0, MA_KI = 7168, MA_KET = 14336, MA_VT = 23552, MA_SLOT = 37376;
__device__ __forceinline__ bf16x8 frag_from(unsigned a, unsigned b, unsigned c, unsigned d) { const u32x4 v = {a, b, c, d}; return __builtin_bit_cast(bf16x8, v); }
__device__ __forceinline__ void mixer_phase_a(const Params& P, LAS unsigned char* lds, int l, int round) {
    unsigned char* const wsp = opaque_ptr(P.ws);
    const int tid = opaque_tid(), w = __builtin_amdgcn_readfirstlane(tid >> 6), lane = tid & 63, r = lane & 31, hh = lane >> 5;
    const int slot = w >> 2, wv = w & 3, nt = wv & 1, mt = wv >> 1;
    const int item = 2 * round + slot, n = item & 63, h = (item >> 6) & 3, b = (item >> 8) & 7, type = item >> 11;
    LAS unsigned char* const L = lds + slot * MA_SLOT;
    const bf16_t* prow = (const bf16_t*)(wsp + WS_PROJ) + (size_t)(b * SEQ + n * 64) * NPROJP;
    const int cq = (type ? C_RQ : C_GQ) + h * 48, ck = (type ? C_RK : C_GK) + h * 48, cv = (type ? C_RV : C_GV) + h * 96;
    const int d = 32 * nt + r; const bool dvalid = d < 48;
    { const int t4 = wv * 64 + lane;
#pragma unroll
      for (int jj = 0; jj < 3; ++jj) { const int p = t4 + 256 * jj, j = p / 12, c = p % 12;
          const u32x4 vv = *(const u32x4*)(prow + (size_t)j * NPROJP + cv + 8 * c);
          LAS bf16_t* dst = (LAS bf16_t*)(L + MA_VT + (8 * c) * 144 + j * 2);
          dst[0 * 72] = (bf16_t)(vv.x & 0xffff); dst[1 * 72] = (bf16_t)(vv.x >> 16); dst[2 * 72] = (bf16_t)(vv.y & 0xffff); dst[3 * 72] = (bf16_t)(vv.y >> 16);
          dst[4 * 72] = (bf16_t)(vv.z & 0xffff); dst[5 * 72] = (bf16_t)(vv.z >> 16); dst[6 * 72] = (bf16_t)(vv.w & 0xffff); dst[7 * 72] = (bf16_t)(vv.w >> 16); } }
    float qv[16], kv[16], cum[16], tot;
    if (type == 0) {
#pragma unroll
        for (int reg = 0; reg < 16; ++reg) { const int t = 32 * mt + crow(reg, lane); const bf16_t* pr = prow + (size_t)t * NPROJP;
            qv[reg] = dvalid ? bf2f(pr[cq + d]) * 0.14433756729740643f : 0.f; kv[reg] = dvalid ? bf2f(pr[ck + d]) : 0.f; }
        const bf16_t* wat = (const bf16_t*)(wsp + WS_WA2T) + (size_t)((l * 4 + h) * 64 + d) * 16 + 8 * hh;
        const bf16x8 waf = *(const bf16x8*)wat;
        const float bias = dvalid ? P.gla_b_a[l * 192 + h * 48 + d] : 0.f;
        unsigned xh[2][2][4], xl[2][2][4];
#pragma unroll
        for (int m2 = 0; m2 < 2; ++m2) {
            const bf16x8 gaf = *(const bf16x8*)(prow + (size_t)(32 * m2 + r) * NPROJP + C_GA + 8 * hh);
            f32x16 pre;
#pragma unroll
            for (int i = 0; i < 16; ++i) pre[i] = 0.f;
            pre = __builtin_amdgcn_mfma_f32_32x32x16_bf16(gaf, waf, pre, 0, 0, 0);
            float la[16];
#pragma unroll
            for (int reg = 0; reg < 16; ++reg) { const float x = pre[reg] + bias;
                const float ls = fminf(x, 0.f) - __logf(1.0f + __expf(-fabsf(x)));
                la[reg] = dvalid ? ls * (1.0f / 16.0f) : 0.f; }
#pragma unroll
            for (int s2 = 0; s2 < 2; ++s2)
#pragma unroll
                for (int q = 0; q < 4; ++q) { const float a0 = la[8 * s2 + 2 * q], a1 = la[8 * s2 + 2 * q + 1];
                    const unsigned hw = pk2(a0, a1); xh[m2][s2][q] = hw; xl[m2][s2][q] = pk2(a0 - bflo(hw), a1 - bfhi(hw)); }
        }
        f32x16 cacc, tacc;
#pragma unroll
        for (int i = 0; i < 16; ++i) { cacc[i] = 0.f; tacc[i] = 0.f; }
        const bf16x8 ones = frag_from(0x3F803F80u, 0x3F803F80u, 0x3F803F80u, 0x3F803F80u);
#pragma unroll
        for (int m2 = 0; m2 < 2; ++m2)
#pragma unroll
            for (int s2 = 0; s2 < 2; ++s2) {
                const bf16x8 fh = frag_from(xh[m2][s2][0], xh[m2][s2][1], xh[m2][s2][2], xh[m2][s2][3]), fl = frag_from(xl[m2][s2][0], xl[m2][s2][1], xl[m2][s2][2], xl[m2][s2][3]);
                tacc = __builtin_amdgcn_mfma_f32_32x32x16_bf16(ones, fh, tacc, 0, 0, 0);
                tacc = __builtin_amdgcn_mfma_f32_32x32x16_bf16(ones, fl, tacc, 0, 0, 0);
                if (m2 < mt) { cacc = __builtin_amdgcn_mfma_f32_32x32x16_bf16(ones, fh, cacc, 0, 0, 0); cacc = __builtin_amdgcn_mfma_f32_32x32x16_bf16(ones, fl, cacc, 0, 0, 0); }
                else if (m2 == mt) { unsigned tw[4];
#pragma unroll
                    for (int q = 0; q < 4; ++q) { const int k0 = 16 * s2 + 8 * ((2 * q) >> 2) + 4 * hh + ((2 * q) & 3), k1 = 16 * s2 + 8 * ((2 * q + 1) >> 2) + 4 * hh + ((2 * q + 1) & 3);
                        tw[q] = (k0 <= r ? 0x3F80u : 0u) | (k1 <= r ? 0x3F800000u : 0u); }
                    const bf16x8 tri = frag_from(tw[0], tw[1], tw[2], tw[3]);
                    cacc = __builtin_amdgcn_mfma_f32_32x32x16_bf16(tri, fh, cacc, 0, 0, 0); cacc = __builtin_amdgcn_mfma_f32_32x32x16_bf16(tri, fl, cacc, 0, 0, 0); }
            }
#pragma unroll
        for (int reg = 0; reg < 16; ++reg) cum[reg] = cacc[reg];
        tot = tacc[0];
    } else {
        const float lgam = P.log_gamma[h];
        const float* rope = (const float*)(wsp + WS_ROPE) + (size_t)(n * 64) * 48;
        const int dp = (d < 24) ? d + 24 : d - 24, f = (d < 24) ? d : d - 24;
#pragma unroll
        for (int reg = 0; reg < 16; ++reg) { const int t = 32 * mt + crow(reg, lane); const bf16_t* pr = prow + (size_t)t * NPROJP;
            float q0 = 0.f, q1 = 0.f, k0 = 0.f, k1 = 0.f, cs = 1.f, sn = 0.f;
            if (dvalid) { q0 = bf2f(pr[cq + d]); q1 = bf2f(pr[cq + dp]); k0 = bf2f(pr[ck + d]); k1 = bf2f(pr[ck + dp]); cs = rope[t * 48 + 2 * f]; sn = rope[t * 48 + 2 * f + 1]; }
            qv[reg] = (d < 24) ? (q0 * cs - q1 * sn) : (q1 * sn + q0 * cs);
            kv[reg] = ((d < 24) ? (k0 * cs - k1 * sn) : (k1 * sn + k0 * cs)) * 0.14433756729740643f;
            cum[reg] = (float)(t + 1) * lgam; }
        tot = 64.0f * lgam;
    }
    {
        bf16_t* qdg = (bf16_t*)(wsp + MXW_QD) + (size_t)item * 3072;
        float ke[16];
#pragma unroll
        for (int reg = 0; reg < 16; ++reg) { const int t = 32 * mt + crow(reg, lane);
            const float e1 = __expf(cum[reg]), e2 = __expf(-cum[reg]), e3 = __expf(tot - cum[reg]);
            const bf16_t qd = (bf16_t)f2bf(qv[reg] * e1), ki = (bf16_t)f2bf(kv[reg] * e2); ke[reg] = kv[reg] * e3;
            if (dvalid) { *(LAS bf16_t*)(L + MA_QD + t * 112 + d * 2) = qd; *(LAS bf16_t*)(L + MA_KI + t * 112 + d * 2) = ki; qdg[t * 48 + d] = qd; } }
#pragma unroll
        for (int g4 = 0; g4 < 4; ++g4) { const int t0 = 32 * mt + 8 * g4 + 4 * hh; u32x2 pk; pk.x = pk2(ke[4 * g4], ke[4 * g4 + 1]); pk.y = pk2(ke[4 * g4 + 2], ke[4 * g4 + 3]);
            *(LAS u32x2*)(L + MA_KET + d * 144 + t0 * 2) = pk; }
        if (mt == 0 && hh == 0 && dvalid) ((float*)(wsp + MXW_DEC))[(size_t)item * 48 + d] = __expf(tot);
    }
    __syncthreads();
    {
        unsigned* oig = (unsigned*)(wsp + MXW_OI) + (size_t)item * 3072;
        float* dsg = (float*)(wsp + MXW_DS) + (size_t)item * 4608;
        f32x16 zero16;
#pragma unroll
        for (int i = 0; i < 16; ++i) zero16[i] = 0.f;
        const int it = (wv == 0) ? 0 : 1;
        f32x16 sd = mma32<3>(L + MA_KI + it * 32 * 112, 112, L + MA_QD + it * 32 * 112, 112, zero16, lane);
        unsigned xd[2][4];
#pragma unroll
        for (int s2 = 0; s2 < 2; ++s2)
#pragma unroll
            for (int q = 0; q < 4; ++q) { const int r0 = 8 * s2 + 2 * q; const float a0 = (crow(r0, lane) <= r) ? sd[r0] : 0.f, a1 = (crow(r0 + 1, lane) <= r) ? sd[r0 + 1] : 0.f; xd[s2][q] = pk2(a0, a1); }
        unsigned xo[2][4];
        if (it == 1) { const f32x16 so = mma32<3>(L + MA_KI, 112, L + MA_QD + 32 * 112, 112, zero16, lane);
#pragma unroll
            for (int s2 = 0; s2 < 2; ++s2)
#pragma unroll
                for (int q = 0; q < 4; ++q) xo[s2][q] = pk2(so[8 * s2 + 2 * q], so[8 * s2 + 2 * q + 1]); }
        const int nvt = (wv == 0) ? 3 : 1, vt0 = (wv == 0) ? 0 : wv - 1;
#pragma unroll 1
        for (int vi = 0; vi < nvt; ++vi) { const int vt = vt0 + vi;
            f32x16 oacc = zero16;
            LAS const unsigned char* vb = L + MA_VT + (32 * vt + r) * 144 + 8 * hh;
            if (it == 1) {
#pragma unroll
                for (int s2 = 0; s2 < 2; ++s2) { const u32x2 lo = *(const LAS u32x2*)(vb + 32 * s2), hi = *(const LAS u32x2*)(vb + 32 * s2 + 16);
                    oacc = __builtin_amdgcn_mfma_f32_32x32x16_bf16(frag_from(xo[s2][0], xo[s2][1], xo[s2][2], xo[s2][3]), frag_from(lo.x, lo.y, hi.x, hi.y), oacc, 0, 0, 0); } }
#pragma unroll
            for (int s2 = 0; s2 < 2; ++s2) { const u32x2 lo = *(const LAS u32x2*)(vb + 64 * it + 32 * s2), hi = *(const LAS u32x2*)(vb + 64 * it + 32 * s2 + 16);
                oacc = __builtin_amdgcn_mfma_f32_32x32x16_bf16(frag_from(xd[s2][0], xd[s2][1], xd[s2][2], xd[s2][3]), frag_from(lo.x, lo.y, hi.x, hi.y), oacc, 0, 0, 0); }
#pragma unroll
            for (int q = 0; q < 8; ++q) oig[((it * 3 + vt) * 8 + q) * 64 + lane] = pk2(oacc[2 * q], oacc[2 * q + 1]);
            const int dt = (wv == 0) ? 1 : 0;
            const f32x16 ds = mma32<4>(L + MA_KET + dt * 32 * 144, 144, L + MA_VT + vt * 32 * 144, 144, zero16, lane);
#pragma unroll
            for (int g4 = 0; g4 < 4; ++g4) { const int d0 = 32 * dt + 8 * g4 + 4 * hh;
                if (d0 < 48) { f32x4 o; o[0] = ds[4 * g4]; o[1] = ds[4 * g4 + 1]; o[2] = ds[4 * g4 + 2]; o[3] = ds[4 * g4 + 3]; *(f32x4*)(dsg + (32 * vt + r) * 48 + d0) = o; } }
        }
    }
    __syncthreads();
}
__device__ __forceinline__ void mixer_phase_b(const Params& P, int bid, int G) {
    unsigned char* const wsp = opaque_ptr(P.ws);
    const int tid = opaque_tid();
    for (int task = bid * NTHREADS + tid; task < 64 * 1152; task += G * NTHREADS) {
        const int seq = task / 1152, q4 = task % 1152, d0 = (q4 % 12) * 4;
        const float* dsp = (const float*)(wsp + MXW_DS) + (size_t)seq * 64 * 4608 + q4 * 4;
        const float* dcp = (const float*)(wsp + MXW_DEC) + (size_t)seq * 64 * 48 + d0;
        bf16_t* spp = (bf16_t*)(wsp + MXW_SP) + (size_t)seq * 64 * 4608 + q4 * 4;
        f32x4 st = {0.f, 0.f, 0.f, 0.f};
#pragma unroll 8
        for (int n = 0; n < 64; ++n) { const f32x4 ds = *(const f32x4*)(dsp + (size_t)n * 4608), dc = *(const f32x4*)(dcp + n * 48);
            u32x2 pk; pk.x = pk2(st[0], st[1]); pk.y = pk2(st[2], st[3]); *(u32x2*)(spp + (size_t)n * 4608) = pk;
            st = dc * st + ds; }
    }
}
__device__ __forceinline__ void mixer_phase_c(const Params& P, int l, int item) {
    unsigned char* const wsp = opaque_ptr(P.ws);
    const int tid = opaque_tid(), lane = tid & 63, r = lane & 31, hh = lane >> 5;
    const int n = item & 63, h = (item >> 6) & 3, b = (item >> 8) & 7, type = item >> 11;
    const size_t tok0 = (size_t)b * SEQ + n * 64;
    const unsigned* oig = (const unsigned*)(wsp + MXW_OI) + (size_t)item * 3072;
    const bf16_t* qdg = (const bf16_t*)(wsp + MXW_QD) + (size_t)item * 3072 + 8 * hh;
    const bf16_t* spg = (const bf16_t*)(wsp + MXW_SP) + (size_t)item * 4608 + 8 * hh;
    const bf16_t* gp = (const bf16_t*)(wsp + WS_PROJ) + tok0 * NPROJP + (type ? C_RG : C_GG) + h * 96 + r;
    bf16_t* mp = (bf16_t*)(wsp + WS_MIXED) + tok0 * 1024 + type * 384 + h * 96 + r;
    const float* nw = (type ? P.ret_norm_w : P.gla_norm_w) + l * 384 + h * 96 + r;
    f32x16 acc[2][3];
#pragma unroll
    for (int it = 0; it < 2; ++it)
#pragma unroll
        for (int vt = 0; vt < 3; ++vt)
#pragma unroll
            for (int q = 0; q < 8; ++q) { const unsigned u = oig[((it * 3 + vt) * 8 + q) * 64 + lane]; acc[it][vt][2 * q] = bflo(u); acc[it][vt][2 * q + 1] = bfhi(u); }
#pragma unroll
    for (int ks = 0; ks < 3; ++ks) {
        const bf16x8 a0 = *(const bf16x8*)(qdg + r * 48 + ks * 16), a1 = *(const bf16x8*)(qdg + (32 + r) * 48 + ks * 16);
#pragma unroll
        for (int vt = 0; vt < 3; ++vt) { const bf16x8 bb = *(const bf16x8*)(spg + (32 * vt + r) * 48 + ks * 16);
            acc[0][vt] = __builtin_amdgcn_mfma_f32_32x32x16_bf16(a0, bb, acc[0][vt], 0, 0, 0);
            acc[1][vt] = __builtin_amdgcn_mfma_f32_32x32x16_bf16(a1, bb, acc[1][vt], 0, 0, 0); } }
    const float nw0 = nw[0], nw1 = nw[32], nw2 = nw[64];
#pragma unroll
    for (int it = 0; it < 2; ++it)
#pragma unroll
        for (int reg = 0; reg < 16; ++reg) { const int i = 32 * it + crow(reg, lane);
            float x0 = acc[it][0][reg], x1 = acc[it][1][reg], x2 = acc[it][2][reg];
            if (type == 1) { float sm = x0 + x1 + x2;
#pragma unroll
                for (int o = 1; o < 32; o <<= 1) sm += lx_f(sm, lane, o);
                const float mean = sm * (1.0f / 96.0f); x0 -= mean; x1 -= mean; x2 -= mean; }
            float ss = x0 * x0 + x1 * x1 + x2 * x2;
#pragma unroll
            for (int o = 1; o < 32; o <<= 1) ss += lx_f(ss, lane, o);
            const float rstd = 1.0f / sqrtf(ss * (1.0f / 96.0f) + NORM_EPS);
            const bf16_t* gr = gp + (size_t)i * NPROJP; bf16_t* mr = mp + (size_t)i * 1024;
            mr[0] = (bf16_t)f2bf(x0 * rstd * nw0 * siluf(bf2f(gr[0])));
            mr[32] = (bf16_t)f2bf(x1 * rstd * nw1 * siluf(bf2f(gr[32])));
            mr[64] = (bf16_t)f2bf(x2 * rstd * nw2 * siluf(bf2f(gr[64]))); }
}

constexpr int S5_KT = 0, S5_EB = 33280, S5_CY = 66048;
__device__ __forceinline__ float gelu_tanh(float x) { const float u = 0.7978845608028654f * (x + 0.044715f * x * x * x); const float e = __expf(2.0f * u); const float th = 1.0f - 2.0f / (e + 1.0f); return 0.5f * x * (1.0f + th); }
__device__ __forceinline__ void s5_item(const Params& P, LAS unsigned char* lds, int l, int item) {
    unsigned char* const wsp = opaque_ptr(P.ws);
    const int tid = opaque_tid(), w = __builtin_amdgcn_readfirstlane(tid >> 6), lane = tid & 63, r = lane & 31, hh = lane >> 5;
    const int half = item & 1, b = item >> 5, g = (item >> 1) & 15, lg = l * 16 + g;
    const bf16_t* ub = (const bf16_t*)(wsp + WS_PROJ) + (size_t)b * SEQ * NPROJP + C_SU + g * 16 + 8 * hh;
    const bf16_t* ktg = (const bf16_t*)(wsp + WS_KTAB) + (size_t)lg * 65 * 256;
    const bf16_t* bpw = (const bf16_t*)(wsp + WS_BPOW) + (size_t)lg * 128 * 1024 + (size_t)((w & 3) * 32 + r) * 1024 + 8 * hh;
    const bf16_t* cpw = (const bf16_t*)(wsp + WS_CPOW) + (size_t)lg * 1024 * 128;
    for (int p = tid; p < 2080; p += NTHREADS) *(LAS u32x4*)(lds + S5_KT + p * 16) = *(const u32x4*)(ktg + p * 8);
    __syncthreads();
    f32x16 acc[2][2], eacc;
    const int nt0 = half ? (w + 8) : w, nt1 = half ? (w + 16) : (w + 24);
#pragma unroll
    for (int j = 0; j < 2; ++j)
#pragma unroll
        for (int mt = 0; mt < 2; ++mt)
#pragma unroll
            for (int i = 0; i < 16; ++i) acc[j][mt][i] = 0.f;
#pragma unroll
    for (int i = 0; i < 16; ++i) eacc[i] = 0.f;
    const int emt = w >> 2;
    const size_t arow0 = (size_t)(r * 64) * NPROJP, arow1 = (size_t)((32 + r) * 64) * NPROJP;
#define S5_LOAD(A0, A1, BP, s) do { A0 = *(const bf16x8*)(ub + arow0 + (size_t)(s) * NPROJP); A1 = *(const bf16x8*)(ub + arow1 + (size_t)(s) * NPROJP); BP = *(const bf16x8*)(bpw + (s) * 16); } while (0)
#define S5_STEP(A0, A1, BP, s) do { \
        _Pragma("unroll") for (int j = 0; j < 2; ++j) { const int t0 = 2 * (j ? nt1 : nt0); \
            if (t0 + 1 >= (s)) { const int tt = t0 + (r >> 4); const int tau = tt - (s); const int slot = tau < 0 ? 64 : tau; \
                const bf16x8 kb = *(const LAS bf16x8*)(lds + S5_KT + slot * 512 + (lane & 15) * 32 + hh * 16); \
                acc[j][0] = __builtin_amdgcn_mfma_f32_32x32x16_bf16(A0, kb, acc[j][0], 0, 0, 0); \
                acc[j][1] = __builtin_amdgcn_mfma_f32_32x32x16_bf16(A1, kb, acc[j][1], 0, 0, 0); } } \
        eacc = __builtin_amdgcn_mfma_f32_32x32x16_bf16(emt ? A1 : A0, BP, eacc, 0, 0, 0); } while (0)
    bf16x8 xa0, xa1, xbp, ya0, ya1, ybp;
    S5_LOAD(xa0, xa1, xbp, 0); S5_LOAD(ya0, ya1, ybp, 1);
#pragma unroll 1
    for (int s = 0; s < 64; s += 2) {
        S5_STEP(xa0, xa1, xbp, s);
        if (s + 2 < 64) S5_LOAD(xa0, xa1, xbp, s + 2);
        S5_STEP(ya0, ya1, ybp, s + 1);
        if (s + 3 < 64) S5_LOAD(ya0, ya1, ybp, s + 3);
    }
#undef S5_LOAD
#undef S5_STEP
#pragma unroll
    for (int reg = 0; reg < 16; ++reg) ((LAS float*)(lds + S5_EB))[(emt * 32 + crow(reg, lane)) * 128 + (w & 3) * 32 + r] = eacc[reg];
    __syncthreads();
    if (tid < 64) { const int p = tid; const float* l64 = (const float*)(wsp + WS_LAM64) + (size_t)(lg * 64 + p) * 2; const float ar = l64[0], ai = l64[1];
        float cr = 0.f, ci = 0.f;
#pragma unroll 1
        for (int n = 0; n < 64; ++n) {
            *(LAS bf16_t*)(lds + S5_CY + n * 272 + p * 2) = (bf16_t)f2bf(cr); *(LAS bf16_t*)(lds + S5_CY + n * 272 + (64 + p) * 2) = (bf16_t)f2bf(ci);
            const float er = ((const LAS float*)(lds + S5_EB))[n * 128 + p], ei = ((const LAS float*)(lds + S5_EB))[n * 128 + 64 + p];
            const float nr = ar * cr - ai * ci + er, ni = ar * ci + ai * cr + ei; cr = nr; ci = ni; } }
    __syncthreads();
#pragma unroll
    for (int j = 0; j < 2; ++j) { const bf16_t* cpr = cpw + (size_t)((j ? nt1 : nt0) * 32 + r) * 128 + 8 * hh;
#pragma unroll
        for (int ks = 0; ks < 8; ++ks) { const bf16x8 cb = *(const bf16x8*)(cpr + ks * 16);
            const bf16x8 c0 = *(const LAS bf16x8*)(lds + S5_CY + r * 272 + ks * 32 + hh * 16), c1 = *(const LAS bf16x8*)(lds + S5_CY + (32 + r) * 272 + ks * 32 + hh * 16);
            acc[j][0] = __builtin_amdgcn_mfma_f32_32x32x16_bf16(c0, cb, acc[j][0], 0, 0, 0);
            acc[j][1] = __builtin_amdgcn_mfma_f32_32x32x16_bf16(c1, cb, acc[j][1], 0, 0, 0); } }
    bf16_t* yb = (bf16_t*)(wsp + WS_YBUF) + (size_t)b * SEQ * 256 + g * 16 + (lane & 15);
#pragma unroll
    for (int j = 0; j < 2; ++j) { const int tt = 2 * (j ? nt1 : nt0) + (r >> 4);
#pragma unroll
        for (int mt = 0; mt < 2; ++mt)
#pragma unroll
            for (int reg = 0; reg < 16; ++reg) { const int n = mt * 32 + crow(reg, lane);
                yb[(size_t)(n * 64 + tt) * 256] = (bf16_t)f2bf(gelu_tanh(acc[j][mt][reg])); } }
    __syncthreads();
}

constexpr int RT_W = 0, RT_CNT = MISC_OFF, RT_BASE = MISC_OFF + 128, RT_TE = MISC_OFF + 256, RT_TG = RT_TE + 2048, RT_TR = RT_TG + 2048;
__device__ __forceinline__ void router_phase(const Params& P, LAS unsigned char* lds, int l, int blk) {
    unsigned char* const wsp = opaque_ptr(P.ws);
    const int tid = opaque_tid(), w = tid >> 6, lane = tid & 63;
    const float* x = (const float*)(wsp + WS_X);
    bf16_t* hdn = (bf16_t*)(wsp + WS_HDN);
    const float* rw = P.router_w + (size_t)l * 1024 * 32;
    const int tok0 = blk * 128, b = tok0 >> 12;
    const float* mrow = (const float*)(wsp + WS_MOD) + (size_t)(l * 8 + b) * 6144;
    int* gcount = (int*)(wsp + WS_CTL) + l * 32;
    int* stok = (int*)(wsp + WS_STOK); float* sgate = (float*)(wsp + WS_SGATE);
    for (int i = tid; i < 8192; i += NTHREADS) { const int k = i >> 3, c4 = (i & 7) * 4; *(LAS f32x4*)(lds + RT_W + (k * 36 + c4) * 4) = *(const f32x4*)(rw + k * 32 + c4); }
    if (tid < 32) ((LAS int*)(lds + RT_CNT))[tid] = 0;
    float wsc[16], wsh[16];
#pragma unroll
    for (int i = 0; i < 16; ++i) { const int col = lane + 64 * i; wsc[i] = P.norm2_w[l * 1024 + col] * (1.0f + mrow[4096 + col]); wsh[i] = mrow[3072 + col]; }
    __syncthreads();
#pragma unroll 1
    for (int tt = 0; tt < 16; ++tt) {
        const int tl = w * 16 + tt, tok = tok0 + tl;
        float hv[16]; float ss = 0.f;
#pragma unroll
        for (int i = 0; i < 16; ++i) { hv[i] = x[(size_t)tok * 1024 + lane + 64 * i]; ss += hv[i] * hv[i]; }
        const float rstd = 1.0f / sqrtf(wave_sum(ss, lane) * (1.0f / 1024.0f) + NORM_EPS);
#pragma unroll
        for (int i = 0; i < 16; ++i) { hv[i] = hv[i] * rstd * wsc[i] + wsh[i]; hdn[(size_t)tok * 1024 + lane + 64 * i] = (bf16_t)f2bf(hv[i]); }
        float a[32];
#pragma unroll
        for (int e = 0; e < 32; ++e) a[e] = 0.f;
#pragma unroll
        for (int i = 0; i < 16; ++i) { const LAS float* wr_ = (const LAS float*)(lds + RT_W) + (lane + 64 * i) * 36;
#pragma unroll
            for (int q = 0; q < 8; ++q) { const f32x4 w4 = *(const LAS f32x4*)(wr_ + 4 * q);
                a[4 * q] += hv[i] * w4[0]; a[4 * q + 1] += hv[i] * w4[1]; a[4 * q + 2] += hv[i] * w4[2]; a[4 * q + 3] += hv[i] * w4[3]; } }
#pragma unroll
        for (int e = 0; e < 16; ++e) { const bool up = (lane & 32) != 0; const float keep = up ? a[e + 16] : a[e], send = up ? a[e] : a[e + 16]; a[e] = keep + lx_f(send, lane, 32); }
#pragma unroll
        for (int e = 0; e < 8; ++e) { const bool up = (lane & 16) != 0; const float keep = up ? a[e + 8] : a[e], send = up ? a[e] : a[e + 8]; a[e] = keep + lx_f(send, lane, 16); }
#pragma unroll
        for (int e = 0; e < 4; ++e) { const bool up = (lane & 8) != 0; const float keep = up ? a[e + 4] : a[e], send = up ? a[e] : a[e + 4]; a[e] = keep + lx_f(send, lane, 8); }
#pragma unroll
        for (int e = 0; e < 2; ++e) { const bool up = (lane & 4) != 0; const float keep = up ? a[e + 2] : a[e], send = up ? a[e] : a[e + 2]; a[e] = keep + lx_f(send, lane, 4); }
        { const bool up = (lane & 2) != 0; const float keep = up ? a[1] : a[0], send = up ? a[0] : a[1]; a[0] = keep + lx_f(send, lane, 2); }
        float logit = a[0] + lx_f(a[0], lane, 1);
        const int myE = lane >> 1;
        logit += P.router_b[l * 32 + myE];
        float tv[4]; int te[4]; float cur = logit;
#pragma unroll
        for (int k = 0; k < 4; ++k) { float bv = cur; int be = myE;
#pragma unroll
            for (int o = 1; o < 64; o <<= 1) { const float ov = lx_f(bv, lane, o); const int oe = lx_i(be, lane, o); if (ov > bv || (ov == bv && oe < be)) { bv = ov; be = oe; } }
            tv[k] = bv; te[k] = be; if (myE == be) cur = -3.0e38f; }
        const float e1 = __expf(tv[1] - tv[0]), e2 = __expf(tv[2] - tv[0]), e3 = __expf(tv[3] - tv[0]); const float inv = 1.0f / (1.0f + e1 + e2 + e3);
        if (lane < 4) { const int ek = (lane == 0) ? te[0] : (lane == 1) ? te[1] : (lane == 2) ? te[2] : te[3];
            const float gk = ((lane == 0) ? 1.0f : (lane == 1) ? e1 : (lane == 2) ? e2 : e3) * inv;
            const int rk = __hip_atomic_fetch_add((LAS int*)(lds + RT_CNT) + ek, 1, __ATOMIC_RELAXED, __HIP_MEMORY_SCOPE_WORKGROUP);
            ((LAS int*)(lds + RT_TE))[tl * 4 + lane] = ek; ((LAS float*)(lds + RT_TG))[tl * 4 + lane] = gk; ((LAS int*)(lds + RT_TR))[tl * 4 + lane] = rk; }
    }
    __syncthreads();
    if (tid < 32) ((LAS int*)(lds + RT_BASE))[tid] = atomicAdd(gcount + tid, ((LAS int*)(lds + RT_CNT))[tid]);
    __syncthreads();
    { const int e = ((LAS int*)(lds + RT_TE))[tid]; const int pos = ((LAS int*)(lds + RT_BASE))[e] + ((LAS int*)(lds + RT_TR))[tid];
      stok[e * CAP + pos] = (tok0 + (tid >> 2)) * 4 + (tid & 3); sgate[e * CAP + pos] = ((LAS float*)(lds + RT_TG))[tid]; }
    __syncthreads();
}

__device__ __forceinline__ void combine_phase(const Params& P, int l, int gw, int ngw, int lane_in) {
    unsigned char* const wsp = opaque_ptr(P.ws);
    int lane = lane_in; asm volatile("" : "+v"(lane));
    float* x = (float*)(wsp + WS_X);
    const bf16_t* outr = (const bf16_t*)(wsp + WS_OUTR);
    bf16_t* hdn = (bf16_t*)(wsp + WS_HDN);
    for (int tok = gw; tok < T_TOK; tok += ngw) {
        const int b = tok >> 12;
        const float* mrow = (const float*)(wsp + WS_MOD) + (size_t)(l * 8 + b) * 6144;
        f32x4 v[4];
#pragma unroll
        for (int hf = 0; hf < 2; ++hf) { const int col = hf * 512 + 8 * lane;
            float s[8];
#pragma unroll
            for (int e = 0; e < 8; ++e) s[e] = 0.f;
#pragma unroll
            for (int k = 0; k < 4; ++k) { const u32x4 r4 = *(const u32x4*)(outr + ((size_t)tok * 4 + k) * 1024 + col);
                s[0] += bflo(r4.x); s[1] += bfhi(r4.x); s[2] += bflo(r4.y); s[3] += bfhi(r4.y); s[4] += bflo(r4.z); s[5] += bfhi(r4.z); s[6] += bflo(r4.w); s[7] += bfhi(r4.w); }
#pragma unroll
            for (int q = 0; q < 2; ++q) { const f32x4 xv = *(const f32x4*)(x + (size_t)tok * 1024 + col + 4 * q), g2 = *(const f32x4*)(mrow + 5120 + col + 4 * q);
                f32x4 o; o[0] = xv[0] + g2[0] * s[4 * q]; o[1] = xv[1] + g2[1] * s[4 * q + 1]; o[2] = xv[2] + g2[2] * s[4 * q + 2]; o[3] = xv[3] + g2[3] * s[4 * q + 3];
                v[hf * 2 + q] = o; if (l + 1 < NLAYER) *(f32x4*)(x + (size_t)tok * 1024 + col + 4 * q) = o; } }
        if (l + 1 < NLAYER) {
            const float* mnext = (const float*)(wsp + WS_MOD) + (size_t)((l + 1) * 8 + b) * 6144;
            norm_row_store(v, P.norm1_w + (l + 1) * 1024, mnext, mnext + 1024, hdn + (size_t)tok * 1024, lane);
        } else {
            float ss = 0.f;
#pragma unroll
            for (int j = 0; j < 4; ++j) ss += (v[j][0] * v[j][0] + v[j][1] * v[j][1]) + (v[j][2] * v[j][2] + v[j][3] * v[j][3]);
            const float rstd = 1.0f / sqrtf(wave_sum(ss, lane) * (1.0f / 1024.0f) + NORM_EPS);
#pragma unroll
            for (int hf = 0; hf < 2; ++hf)
#pragma unroll
                for (int q = 0; q < 2; ++q) { const int col = hf * 512 + 8 * lane + 4 * q; const f32x4 fw = *(const f32x4*)(P.final_norm_w + col);
                    f32x4 o; o[0] = v[hf * 2 + q][0] * rstd * fw[0]; o[1] = v[hf * 2 + q][1] * rstd * fw[1]; o[2] = v[hf * 2 + q][2] * rstd * fw[2]; o[3] = v[hf * 2 + q][3] * rstd * fw[3];
                    *(f32x4*)(P.out + (size_t)tok * 1024 + col) = o; }
        }
    }
}


#define XB_TMO      128
#define XB_XCNT(j)  (256  + 64 * (j))
#define XB_XSUB(j)  (1280 + 64 * (j))
#define XB_XGEN(j)  (2304 + 64 * (j))
#define XB_TOP      3328
#define XB_TOPGEN   3392
#define XCD_BAR_WORDS 3456
#define XB_SPIN_CAP (1u << 22)
__device__ __forceinline__ unsigned xb_ld(unsigned* p)              { return __hip_atomic_load(p, __ATOMIC_RELAXED, __HIP_MEMORY_SCOPE_AGENT); }
__device__ __forceinline__ unsigned xb_add(unsigned* p, unsigned v) { return __hip_atomic_fetch_add(p, v, __ATOMIC_RELAXED, __HIP_MEMORY_SCOPE_AGENT); }
__device__ __forceinline__ unsigned xb_xcc_id() { return (unsigned)__builtin_amdgcn_s_getreg((3 << 11) | 20) & 0xFu; }
#define XB_SPIN(cond, bar) do { unsigned _sp = 0; while (cond) { __builtin_amdgcn_s_sleep(1); \
    if ((++_sp & 255u) == 0u) { if (xb_ld(&(bar)[XB_TMO])) break; if (_sp > XB_SPIN_CAP) { atomicAdd(&(bar)[XB_TMO], 1u); break; } } } } while (0)
struct XcdBarrier { unsigned* bar; unsigned x; volatile LAS unsigned* st; };
__device__ __forceinline__ XcdBarrier xcd_barrier_post(unsigned* bar, volatile LAS unsigned* st) {
    XcdBarrier b; b.bar = bar; b.x = xb_xcc_id(); b.st = st;
    if (threadIdx.x == 0) (void)xb_add(&bar[XB_XCNT(b.x)], 1u);
    return b;
}
__device__ __forceinline__ void xcd_barrier_complete(unsigned* bar, unsigned x, unsigned& nloc, unsigned& nx) {
    const unsigned G = gridDim.x * gridDim.y * gridDim.z;
    unsigned sum, cnt, mine, sp = 0u;
    for (;;) {
        sum = 0u; cnt = 0u; mine = 0u;
#pragma unroll
        for (unsigned j = 0; j < 16; ++j) { const unsigned c = xb_ld(&bar[XB_XCNT(j)]); sum += c; cnt += (c > 0u) ? 1u : 0u; mine = (j == x) ? c : mine; }
        if (sum == G) break;
        __builtin_amdgcn_s_sleep(1);
        if ((++sp & 255u) == 0u) { if (xb_ld(&bar[XB_TMO])) break; if (sp > XB_SPIN_CAP) { atomicAdd(&bar[XB_TMO], 1u); break; } }
    }
    nloc = mine > 0u ? mine : 1u; nx = cnt > 0u ? cnt : 1u;
}
__device__ __forceinline__ void xcd_barrier(const XcdBarrier& b) {
    asm volatile("s_waitcnt vmcnt(0)" ::: "memory");
    __syncthreads();
    if (threadIdx.x == 0) {
        unsigned* bar = b.bar;
        __builtin_amdgcn_s_waitcnt(0);
        unsigned nloc = b.st[0], nx = b.st[1];
        if (nloc == 0u) { xcd_barrier_complete(bar, b.x, nloc, nx); b.st[0] = nloc; b.st[1] = nx; }
        const unsigned old = xb_add(&bar[XB_XSUB(b.x)], 1u);
        const unsigned gen = old / nloc;
        if (old + 1u == (gen + 1u) * nloc) {
            __builtin_amdgcn_fence(__ATOMIC_RELEASE, "agent");
            asm volatile("s_waitcnt vmcnt(0)" ::: "memory");
            const unsigned og = xb_add(&bar[XB_TOP], 1u);
            const unsigned tg = og / nx;
            if (og + 1u == (tg + 1u) * nx) xb_add(&bar[XB_TOPGEN], 1u);
            else XB_SPIN(xb_ld(&bar[XB_TOPGEN]) == tg, bar);
            __builtin_amdgcn_fence(__ATOMIC_ACQUIRE, "agent");
            xb_add(&bar[XB_XGEN(b.x)], 1u);
            asm volatile("s_waitcnt vmcnt(0)" ::: "memory");
        } else {
            XB_SPIN(xb_ld(&bar[XB_XGEN(b.x)]) == gen, bar);
            __builtin_amdgcn_fence(__ATOMIC_ACQUIRE, "agent");
            asm volatile("s_waitcnt vmcnt(0)" ::: "memory");
        }
    }
    __syncthreads();
}

#ifndef PH
#define PH 0xFFFF
#endif
#define PHON(b) ((((PH) >> (b)) & 1) != 0)
#ifndef TIME_PHASE
#define TIME_PHASE -1
#endif
#define TIME_MULT 4
#if TIME_PHASE >= 0
#define PH_T0(k) do { if ((k) == TIME_PHASE && bid == 0) t_ph = __builtin_amdgcn_s_memrealtime(); } while (0)
#define PH_T1(k) do { if ((k) == TIME_PHASE && bid == 0) { const unsigned long long t1_ = __builtin_amdgcn_s_memrealtime(), d_ = t1_ - t_ph; while (__builtin_amdgcn_s_memrealtime() - t1_ < (unsigned long long)TIME_MULT * d_) __builtin_amdgcn_s_sleep(8); } } while (0)
#else
#define PH_T0(k) do { } while (0)
#define PH_T1(k) do { } while (0)
#endif
__global__ void __launch_bounds__(NTHREADS, 2) fwd_megakernel(Params P) {
    extern __shared__ __attribute__((aligned(16))) unsigned char lds_raw[];
    LAS unsigned char* const lds0 = (LAS unsigned char*)lds_raw;
    cg::grid_group grid = cg::this_grid();
    const int G = gridDim.x, bid = blockIdx.x;
    const int vcu = (G % 8 == 0) ? (bid % 8) * (G / 8) + bid / 8 : bid;
    const int ngw = G * NWAVES;
    unsigned long long t_ph = 0; (void)t_ph;
    if (threadIdx.x < 4) ((LAS unsigned*)(lds0 + LDS_BYTES - 16))[threadIdx.x] = 0u;
    __syncthreads();
    (void)xcd_barrier_post((unsigned*)(P.ws + WS_BAR), (volatile LAS unsigned*)(lds0 + LDS_BYTES - 16));
#define GSYNC() do { XcdBarrier xb_; xb_.bar = (unsigned*)(opaque_ptr(P.ws) + WS_BAR); xb_.x = xb_xcc_id(); xb_.st = (volatile LAS unsigned*)(opaque_lds(lds0) + LDS_BYTES - 16); xcd_barrier(xb_); } while (0)
#define KTID() const int tid = opaque_tid(), wave = __builtin_amdgcn_readfirstlane(tid >> 6), lane = tid & 63, gw = bid * NWAVES + wave; (void)lane; (void)gw

    PH_T0(0);
    { KTID(); unsigned char* const ws = opaque_ptr(P.ws); LAS unsigned char* const lds = opaque_lds(lds0); (void)lds;
    if (bid == 0 && tid < 64) ((int*)(ws + WS_CTL))[tid] = 0;
    if (PHON(0)) for (int it = bid; it < 192 + 32; it += G) { if (it < 192) mod_item(P, lds, it); else s5_tables_item(P, lds, it - 192); }
    rope_table(P, bid * NTHREADS + tid, G * NTHREADS);
    for (int i = bid * NTHREADS + tid; i < 2 * 4 * 64 * 16; i += G * NTHREADS) { const int rr = i & 15, dd = (i >> 4) & 63, hh_ = (i >> 10) & 3, ll = i >> 12;
        ((bf16_t*)(ws + WS_WA2T))[i] = (dd < 48) ? (bf16_t)f2bf(P.gla_w_a2[(size_t)ll * 16 * 192 + rr * 192 + hh_ * 48 + dd]) : (bf16_t)0; }
    __syncthreads();
    if (PHON(1)) transpose_small(P, lds, gw, ngw, wave, lane); }
    grid.sync(); PH_T1(0); PH_T0(1);
    { KTID(); unsigned char* const ws = opaque_ptr(P.ws); LAS unsigned char* const lds = opaque_lds(lds0); (void)lds;
    for (int tok = gw; tok < T_TOK; tok += ngw) {
        const float* mrow = (const float*)(ws + WS_MOD) + (size_t)(tok >> 12) * 6144;
        f32x4 v[4];
#pragma unroll
        for (int hf = 0; hf < 2; ++hf)
#pragma unroll
            for (int q = 0; q < 2; ++q) v[hf * 2 + q] = *(const f32x4*)(P.x + (size_t)tok * 1024 + hf * 512 + 8 * lane + 4 * q);
        norm_row_store(v, P.norm1_w, mrow, mrow + 1024, (bf16_t*)(ws + WS_HDN) + (size_t)tok * 1024, lane);
    } }
    GSYNC(); PH_T1(1);
#pragma unroll 1
    for (int l = 0; l < NLAYER; ++l) {
        PH_T0(2);
        if (PHON(2)) { unsigned char* const ws = opaque_ptr(P.ws); LAS unsigned char* const lds = opaque_lds(lds0); (void)lds; DenseOrder S; S.init(T_TOK, NPROJP, 1024, G, bid, ws + WS_HDN, (const bf16_t*)(ws + WS_WIN) + (size_t)l * NPROJP * 1024);
          EpiProj E{(bf16_t*)(ws + WS_PROJ), NPROJP};
          gm::gemm_phase<EpiProj, DenseOrder, false>(lds, 1024, S, E); }
        GSYNC(); PH_T1(2); PH_T0(3);
        { LAS unsigned char* const lds = opaque_lds(lds0);
#define SUBT0(k, b) do { if (TIME_PHASE == (k) && bid == (b)) t_ph = __builtin_amdgcn_s_memrealtime(); } while (0)
#define SUBT1(k, b) do { if (TIME_PHASE == (k) && bid == (b)) { const unsigned long long t1_ = __builtin_amdgcn_s_memrealtime(), d_ = t1_ - t_ph; while (__builtin_amdgcn_s_memrealtime() - t1_ < (unsigned long long)TIME_MULT * d_) __builtin_amdgcn_s_sleep(8); } } while (0)
          SUBT0(20, 0);
          if (PHON(3)) for (int rd = bid; rd < 2048; rd += G) mixer_phase_a(P, lds, l, rd);
          SUBT1(20, 0); SUBT0(21, 0);
          if (PHON(4)) for (int it = bid; it < 256; it += G) s5_item(P, lds, l, it);
          SUBT1(21, 0); SUBT0(22, 0);
          { KTID(); transpose_moe(P, lds, l, gw, ngw, wave, lane); }
          SUBT1(22, 0); }
        GSYNC(); PH_T1(3); PH_T0(4);
        if (PHON(3)) mixer_phase_b(P, bid, G);
        GSYNC(); PH_T1(4); PH_T0(5);
        if (PHON(5)) { unsigned char* const ws = opaque_ptr(P.ws); LAS unsigned char* const lds = opaque_lds(lds0); (void)lds; DenseOrder S; S.init(T_TOK, 256, 256, G, bid, ws + WS_YBUF, (const bf16_t*)(ws + WS_WGLU) + (size_t)l * 256 * 256);
          EpiGlu E{(const bf16_t*)(ws + WS_YBUF), (bf16_t*)(ws + WS_MIXED), P.s5_b_glu + l * 256};
          gm::gemm_phase<EpiGlu, DenseOrder, false>(lds, 256, S, E); }
        if (PHON(3)) { KTID(); for (int it = gw; it < 4096; it += ngw) mixer_phase_c(P, l, it); }
        GSYNC(); PH_T1(5); PH_T0(6);
        if (PHON(6)) { unsigned char* const ws = opaque_ptr(P.ws); LAS unsigned char* const lds = opaque_lds(lds0); (void)lds; const float* modl = (const float*)(ws + WS_MOD) + (size_t)l * 8 * 6144; DenseOrder S; S.init(T_TOK, 1024, 1024, G, bid, ws + WS_MIXED, (const bf16_t*)(ws + WS_WOUT) + (size_t)l * 1024 * 1024);
          EpiOut E{l == 0 ? P.x : (const float*)(ws + WS_X), (float*)(ws + WS_X), modl + 2048};
          gm::gemm_phase<EpiOut, DenseOrder, false>(lds, 1024, S, E); }
        GSYNC(); PH_T1(6); PH_T0(7);
        if (PHON(7)) { LAS unsigned char* const lds = opaque_lds(lds0); for (int blk = bid; blk < T_TOK / 128; blk += G) router_phase(P, lds, l, blk); }
        GSYNC(); PH_T1(7); PH_T0(8);
        if (PHON(8)) { unsigned char* const ws = opaque_ptr(P.ws); LAS unsigned char* const lds = opaque_lds(lds0); (void)lds; moe_tables(lds, (const int*)(ws + WS_CTL) + l * 32, 8);
          MoeOrder<true> S; S.tab = (LAS const int*)(lds + MISC_OFF); S.nN = 8; S.G = G; S.vc = vcu; S.Wt = (const char*)(ws + WS_WUP) + (size_t)l * 32 * 2048 * 1024 * 2; S.wstride = (size_t)2048 * 1024 * 2; S.stok = (const int*)(ws + WS_STOK); S.A = (const char*)(ws + WS_HDN); S.gtab = (LAS const unsigned*)(lds + GT_OFF);
          S.fill_gather((LAS unsigned*)(lds + GT_OFF));
          EpiUp E{(bf16_t*)(ws + WS_ACT), P.b_up + (size_t)l * 32 * 2048, (LAS const int*)(lds + MISC_OFF)};
          gm::gemm_phase<EpiUp, MoeOrder<true>, true>(lds, 1024, S, E); }
        GSYNC(); PH_T1(8); PH_T0(9);
        if (PHON(9)) { unsigned char* const ws = opaque_ptr(P.ws); LAS unsigned char* const lds = opaque_lds(lds0); (void)lds; moe_tables(lds, (const int*)(ws + WS_CTL) + l * 32, 4);
          MoeOrder<false> S; S.tab = (LAS const int*)(lds + MISC_OFF); S.nN = 4; S.G = G; S.vc = vcu; S.Wt = (const char*)(ws + WS_WDN) + (size_t)l * 32 * 1024 * 1024 * 2; S.wstride = (size_t)1024 * 1024 * 2; S.stok = nullptr; S.A = (const char*)(ws + WS_ACT); S.gtab = nullptr;
          EpiDown E{(bf16_t*)(ws + WS_OUTR), P.b_down + (size_t)l * 32 * 1024, (const int*)(ws + WS_STOK), (const float*)(ws + WS_SGATE)};
          gm::gemm_phase<EpiDown, MoeOrder<false>, false>(lds, 1024, S, E); }
        GSYNC(); PH_T1(9); PH_T0(10);
        if (PHON(10)) { KTID(); combine_phase(P, l, gw, ngw, lane); }
        GSYNC(); PH_T1(10);
    }
}

extern "C" void kernel_launch(void* const* d_in, const int* in_sizes, int n_in, void* d_out, int out_size, void* d_ws, size_t ws_size, hipStream_t stream) {
    static int grid_blocks = 0;
    if (grid_blocks == 0) {
        if (n_in != 29 || ws_size < WS_END) { fprintf(stderr, "kernel_launch: unexpected n_in %d or ws_size %zu (need %zu)\n", n_in, ws_size, (size_t)WS_END); grid_blocks = -1; return; }
        int dev = 0, cus = 0, per_cu = 0;
        (void)hipGetDevice(&dev);
        (void)hipDeviceGetAttribute(&cus, hipDeviceAttributeMultiprocessorCount, dev);
        (void)hipFuncSetAttribute((const void*)fwd_megakernel, hipFuncAttributeMaxDynamicSharedMemorySize, LDS_BYTES);
        (void)hipOccupancyMaxActiveBlocksPerMultiprocessor(&per_cu, (const void*)fwd_megakernel, NTHREADS, LDS_BYTES);
        if (per_cu < 1) { fprintf(stderr, "kernel_launch: occupancy query returned %d\n", per_cu); per_cu = 1; }
        grid_blocks = cus;
        fprintf(stderr, "kernel_launch: cus %d per_cu %d grid %d ws_need %zu\n", cus, per_cu, grid_blocks, (size_t)WS_END);
    }
    if (grid_blocks < 0) return;
    Params p{};
    const float** pp = (const float**)&p;
    for (int i = 0; i < 29; ++i) pp[i] = (const float*)d_in[i];
    p.out = (float*)d_out; p.ws = (unsigned char*)d_ws;
    for (int i = 0; i < 24; ++i) p.inv_freq_rev[i] = pow(10000.0, -(double)(2 * i) / 48.0) / 6.283185307179586476925;
    for (int h = 0; h < 4; ++h) p.log_gamma[h] = (float)log1p(-exp2(-5.0 - (double)h));
    (void)hipMemsetAsync((char*)d_ws + WS_CTL, 0, WS_CTL_BYTES, stream);
    void* args[] = {&p};
    hipError_t e = hipLaunchCooperativeKernel((const void*)fwd_megakernel, dim3(grid_blocks), dim3(NTHREADS), args, LDS_BYTES, stream);
    if (e != hipSuccess) fprintf(stderr, "cooperative launch failed: %s (grid %d)\n", hipGetErrorString(e), grid_blocks);
}
```

```cpp
#include <hip/hip_runtime.h>
#include <hip/hip_cooperative_groups.h>
#include <cstdio>
#include <cstdint>
#include <cmath>
namespace cg = cooperative_groups;

#define LAS __attribute__((address_space(3)))
typedef unsigned short bf16_t;
typedef short bf16x8 __attribute__((ext_vector_type(8)));
typedef float f32x4 __attribute__((ext_vector_type(4)));
typedef float f32x16 __attribute__((ext_vector_type(16)));
typedef unsigned u32x4 __attribute__((ext_vector_type(4)));
typedef unsigned u32x2 __attribute__((ext_vector_type(2)));

constexpr int T_TOK = 32768, DM = 1024, NBATCH = 8, SEQ = 4096, NLAYER = 2;
constexpr int NPROJ = 2576, NPROJP = 2816;
constexpr int NE = 32, CAP = 32768, NSLOT = T_TOK * 4;
constexpr int C_GQ = 0, C_GK = 192, C_GV = 384, C_GG = 768, C_GA = 1152, C_RQ = 1168, C_RK = 1360, C_RV = 1552, C_RG = 1936, C_SU = 2320;
constexpr float NORM_EPS = 1e-5f;
constexpr int NTHREADS = 512, NWAVES = 8;
constexpr int LDS_BYTES = 160 * 1024;
constexpr int MISC_OFF = 148 * 1024;

constexpr size_t al256(size_t x) { return (x + 255) & ~(size_t)255; }
constexpr size_t WS_CTL   = 0;
constexpr size_t WS_BAR   = 4096;
constexpr size_t WS_CTL_BYTES = 32768;
constexpr size_t WS_MOD   = 32768;
constexpr size_t WS_WIN   = al256(WS_MOD + (size_t)2 * 8 * 6144 * 4);
constexpr size_t WS_WOUT  = al256(WS_WIN + (size_t)2 * NPROJP * 1024 * 2);
constexpr size_t WS_WUP   = al256(WS_WOUT + (size_t)2 * 1024 * 1024 * 2);
constexpr size_t WS_WDN   = al256(WS_WUP + (size_t)2 * 32 * 2048 * 1024 * 2);
constexpr size_t WS_WGLU  = al256(WS_WDN + (size_t)2 * 32 * 1024 * 1024 * 2);
constexpr size_t WS_KTAB  = al256(WS_WGLU + (size_t)2 * 256 * 256 * 2);
constexpr size_t WS_BPOW  = al256(WS_KTAB + (size_t)2 * 16 * 65 * 256 * 2);
constexpr size_t WS_CPOW  = al256(WS_BPOW + (size_t)2 * 16 * 128 * 1024 * 2);
constexpr size_t WS_LAM64 = al256(WS_CPOW + (size_t)2 * 16 * 1024 * 128 * 2);
constexpr size_t WS_ROPE  = al256(WS_LAM64 + (size_t)2 * 16 * 64 * 2 * 4);
constexpr size_t WS_WA2T  = al256(WS_ROPE + (size_t)4096 * 24 * 2 * 4);
constexpr size_t WS_RWT   = al256(WS_WA2T + (size_t)2 * 4 * 64 * 16 * 2);
constexpr size_t WS_X     = al256(WS_RWT + (size_t)2 * 2 * 32 * 1024 * 2);
constexpr size_t WS_HDN   = al256(WS_X + (size_t)T_TOK * 1024 * 4);
constexpr size_t WS_PROJ  = al256(WS_HDN + (size_t)T_TOK * 1024 * 2);
constexpr size_t WS_MIXED = al256(WS_PROJ + (size_t)T_TOK * NPROJP * 2);
constexpr size_t WS_YBUF  = al256(WS_MIXED + (size_t)T_TOK * 1024 * 2);
constexpr size_t WS_ACT   = al256(WS_YBUF + (size_t)T_TOK * 256 * 2);
constexpr size_t WS_OUTR  = al256(WS_ACT + (size_t)(NSLOT + 256) * 1024 * 2);
constexpr size_t WS_STOK  = al256(WS_OUTR + (size_t)NSLOT * 1024 * 2);
constexpr size_t WS_SGATE = al256(WS_STOK + (size_t)NE * CAP * 4);
constexpr size_t MXW_QD = WS_ACT, MXW_OI = WS_ACT + ((size_t)32 << 20), MXW_DS = WS_ACT + ((size_t)96 << 20), MXW_DEC = WS_ACT + ((size_t)176 << 20), MXW_SP = WS_ACT + ((size_t)180 << 20);
constexpr size_t WS_END   = al256(WS_SGATE + (size_t)NE * CAP * 4);

struct Params {
    const float* x; const float* c; const float* norm1_w; const float* norm2_w; const float* w_mod; const float* b_mod;
    const float* w_in; const float* gla_w_a2; const float* gla_b_a; const float* gla_norm_w; const float* ret_norm_w;
    const float* s5_a_re; const float* s5_a_im; const float* s5_log_dt; const float* s5_b_re; const float* s5_b_im;
    const float* s5_c_re; const float* s5_c_im; const float* s5_d; const float* s5_w_glu; const float* s5_b_glu;
    const float* w_out; const float* router_w; const float* router_b; const float* w_up; const float* b_up;
    const float* w_down; const float* b_down; const float* final_norm_w;
    float* out; unsigned char* ws;
    double inv_freq_rev[24];
    float log_gamma[4]; float pad0[4];
};

__device__ __forceinline__ unsigned f2bf(float f) { unsigned u = __builtin_bit_cast(unsigned, f); return (u + 0x7fffu + ((u >> 16) & 1u)) >> 16; }
typedef float f32x2_t __attribute__((ext_vector_type(2)));
typedef __bf16 bf16x2_t __attribute__((ext_vector_type(2)));
__device__ __forceinline__ unsigned pk2(float lo, float hi) { const f32x2_t v = {lo, hi}; const bf16x2_t b = __builtin_convertvector(v, bf16x2_t); return __builtin_bit_cast(unsigned, b); }
__device__ __forceinline__ float bflo(unsigned w) { return __builtin_bit_cast(float, w << 16); }
__device__ __forceinline__ float bfhi(unsigned w) { return __builtin_bit_cast(float, w & 0xffff0000u); }
__device__ __forceinline__ float bf2f(bf16_t b) { return __builtin_bit_cast(float, (unsigned)b << 16); }
__device__ __forceinline__ float lx_f(float v, int lane, int o) { return __builtin_bit_cast(float, __builtin_amdgcn_ds_bpermute((lane ^ o) << 2, __builtin_bit_cast(int, v))); }
__device__ __forceinline__ int lx_i(int v, int lane, int o) { return __builtin_amdgcn_ds_bpermute((lane ^ o) << 2, v); }
__device__ __forceinline__ float lidx_f(float v, int src) { return __builtin_bit_cast(float, __builtin_amdgcn_ds_bpermute(src << 2, __builtin_bit_cast(int, v))); }
__device__ __forceinline__ float wave_sum(float v, int lane) {
#pragma unroll
    for (int o = 1; o < 64; o <<= 1) v += lx_f(v, lane, o);
    return v;
}
__device__ __forceinline__ float siluf(float x) { return x / (1.0f + __expf(-x)); }
__device__ __forceinline__ float sigmoidf_(float x) { return 1.0f / (1.0f + __expf(-x)); }
#define LDS_WAIT() asm volatile("s_waitcnt lgkmcnt(0)" ::: "memory")
__device__ __forceinline__ unsigned char* opaque_ptr(unsigned char* p) { const unsigned long long v = (unsigned long long)p; unsigned lo = __builtin_amdgcn_readfirstlane((unsigned)v), hi = __builtin_amdgcn_readfirstlane((unsigned)(v >> 32));
    asm volatile("" : "+s"(lo), "+s"(hi)); return (unsigned char*)(__attribute__((address_space(1))) unsigned char*)(((unsigned long long)hi << 32) | lo); }
__device__ __forceinline__ LAS unsigned char* opaque_lds(LAS unsigned char* p) { unsigned v = __builtin_amdgcn_readfirstlane((unsigned)(size_t)p); asm volatile("" : "+s"(v)); return (LAS unsigned char*)(size_t)v; }
__device__ __forceinline__ int opaque_tid() { int t = threadIdx.x; asm volatile("" : "+v"(t)); return t; }

namespace gm {
constexpr int BM = 256, BK = 64, HALF = 128, HTB = HALF * BK * 2, STAGE_BYTES = 8 * HTB, NXCD = 8, WGM = 8;
__device__ __forceinline__ int lds_byte(int r, int c) { const int st = (r >> 4) * 2 + (c >> 5), rr = r & 15, cc = c & 31, ob = rr * 64 + cc * 2; return st * 1024 + (ob ^ (((ob >> 9) & 1) << 5)); }
__device__ __forceinline__ void stage_rc(int b, int& R, int& C) { const int st = b / 1024, sb = b % 1024, swz = sb ^ (((sb >> 9) & 1) << 5); R = (st >> 1) * 16 + swz / 64; C = (st & 1) * 32 + (swz % 64) / 2; }
__device__ __forceinline__ int perm32(int rho) { const int n = rho >> 4, i = rho & 15; return 8 * (i >> 2) + 4 * n + (i & 3); }

struct Unit { const char* B; int pm, pn, e, rows; };

template <class Epi, class Sched, bool GATHER>
__device__ __forceinline__ void gemm_phase(LAS unsigned char* lds, const int K_in, const Sched& S, const Epi& E) {
    int K = K_in; asm volatile("" : "+s"(K));
    const int tid = opaque_tid(), wid = __builtin_amdgcn_readfirstlane(tid >> 6), lane = tid & 63, wr = wid >> 2, wc = wid & 3, fr = lane & 15, fq = lane >> 4;
    const int nt = K / BK;
    int R0, C0; unsigned voffB;
    { stage_rc(tid * 16, R0, C0);
      const int Rb0 = Epi::PERM ? ((R0 & ~31) + perm32(R0 & 31)) : R0;
      voffB = (unsigned)(Rb0 * K + C0) * 2u; }
    const size_t kstep = (size_t)(BK * 2);
    const size_t hstep = (size_t)HALF * K * 2;
    const size_t qstep = (size_t)64 * K * 2;
    const unsigned ldsw = (unsigned)wid * 1024u;
    const int aoff = lds_byte(wr * 64 + fr, fq * 8), boff = lds_byte(wc * 32 + fr, fq * 8);
#define G_SA(b, h) (((b) * 2 + (h)) * gm::HTB)
#define G_SB(b, h) ((4 + (b) * 2 + (h)) * gm::HTB)
#define G_GLDS(gptr, ldsoff) __builtin_amdgcn_global_load_lds((const unsigned*)(gptr), (LAS unsigned*)(lds + (ldsoff)), 16, 0, 0)
#define G_STAGEB(bufoff, gbase) do { G_GLDS((const char*)(gbase) + voffB, (bufoff) + ldsw); G_GLDS((const char*)(gbase) + qstep + voffB, (bufoff) + ldsw + 8192); } while (0)
#define G_STAGEA(bufoff, ubase, h, o0, o1) do { if (GATHER) { G_GLDS((const char*)(ubase) + (o0), (bufoff) + ldsw); G_GLDS((const char*)(ubase) + (o1), (bufoff) + ldsw + 8192); } \
        else { G_GLDS((const char*)(ubase) + (h) * hstep + (o0), (bufoff) + ldsw); G_GLDS((const char*)(ubase) + (h) * hstep + qstep + (o0), (bufoff) + ldsw + 8192); } } while (0)
#define G_LDA(dst, b, h) do { _Pragma("unroll") for (int m = 0; m < 4; ++m) _Pragma("unroll") for (int k = 0; k < 2; ++k) dst[m][k] = *(const LAS bf16x8*)(lds + G_SA(b, h) + aoff + m * 2048 + k * 1024); } while (0)
#define G_LDB(dst, b, h) do { _Pragma("unroll") for (int n = 0; n < 2; ++n) _Pragma("unroll") for (int k = 0; k < 2; ++k) dst[n][k] = *(const LAS bf16x8*)(lds + G_SB(b, h) + boff + n * 2048 + k * 1024); } while (0)
#define G_MMA(ai, bj, At, Bt) do { __builtin_amdgcn_s_setprio(1); _Pragma("unroll") for (int m = 0; m < 4; ++m) _Pragma("unroll") for (int n = 0; n < 2; ++n) _Pragma("unroll") for (int k = 0; k < 2; ++k) \
        acc[ai][bj][m][n] = __builtin_amdgcn_mfma_f32_16x16x32_bf16(Bt[n][k], At[m][k], acc[ai][bj][m][n], 0, 0, 0); __builtin_amdgcn_s_setprio(0); } while (0)
#define G_WAIT_V(n) asm volatile("s_waitcnt vmcnt(" #n ")" ::: "memory")
#define G_WAIT_L(n) asm volatile("s_waitcnt lgkmcnt(" #n ")" ::: "memory")
#define G_BAR __builtin_amdgcn_s_barrier()
#define G_SCHED __builtin_amdgcn_sched_barrier(0)
    Unit cur, nxt; int ui = 0;
    if (!S.next(0, cur)) return;
    f32x4 acc[2][2][4][2];
#pragma unroll
    for (int a = 0; a < 2; ++a)
#pragma unroll
        for (int b = 0; b < 2; ++b)
#pragma unroll
            for (int m = 0; m < 4; ++m)
#pragma unroll
                for (int n = 0; n < 2; ++n) acc[a][b][m][n] = (f32x4){0.f, 0.f, 0.f, 0.f};
    bf16x8 At[4][2], B0[2][2], B1[2][2];
    unsigned c00, c01 = 0, c10 = 0, c11 = 0;
    c00 = S.a_off(0, R0, C0);
    if (GATHER) { c01 = S.a_off(0, R0 + 64, C0); c10 = S.a_off(0, R0 + 128, C0); c11 = S.a_off(0, R0 + 192, C0); }
    const char* cA = S.a_base(cur); const char* cB = cur.B;
    G_STAGEB(G_SB(0, 0), cB); G_STAGEB(G_SB(0, 1), cB + hstep); G_STAGEA(G_SA(0, 0), cA, 0, c00, c01); G_STAGEA(G_SA(0, 1), cA, 1, c10 + (GATHER ? 0u : c00), c11);
    if (wr == 1) G_BAR;
    G_WAIT_V(2); G_BAR;
    G_STAGEB(G_SB(1, 0), cB + kstep); G_STAGEA(G_SA(1, 0), cA + kstep, 0, c00, c01); G_STAGEB(G_SB(1, 1), cB + hstep + kstep);
    G_WAIT_V(6); G_BAR;
    for (;;) {
        const bool has_next = S.next(ui + 1, nxt);
        const char* nB = cB; const char* nA = cA;
        if (has_next) { nB = nxt.B; nA = S.a_base(nxt); }
        for (int t = 0; t < nt; t += 2) {
            const bool last = (t == nt - 2);
            const char* a1 = cA + (size_t)(t + 1) * kstep;
            const char* a2 = last ? nA : cA + (size_t)(t + 2) * kstep;
            const char* b2 = last ? nB : cB + (size_t)(t + 2) * kstep;
            G_LDB(B0, 0, 0); G_LDB(B1, 0, 1); G_SCHED; G_LDA(At, 0, 0); G_STAGEA(G_SA(1, 1), a1, 1, c10 + (GATHER ? 0u : c00), c11);
            G_WAIT_V(8); G_WAIT_L(0); G_BAR; G_MMA(0, 0, At, B0); G_MMA(0, 1, At, B1); G_BAR; G_SCHED;
            if (GATHER) { if (last && has_next) { c00 = S.a_off(ui + 1, R0, C0); c01 = S.a_off(ui + 1, R0 + 64, C0); c10 = S.a_off(ui + 1, R0 + 128, C0); c11 = S.a_off(ui + 1, R0 + 192, C0); } }
            G_LDA(At, 0, 1); G_STAGEB(G_SB(0, 0), b2); G_STAGEB(G_SB(0, 1), b2 + hstep); G_STAGEA(G_SA(0, 0), a2, 0, c00, c01);
            G_WAIT_V(8); G_WAIT_L(0); G_BAR; G_MMA(1, 0, At, B0); G_MMA(1, 1, At, B1); G_BAR; G_SCHED;
            G_LDB(B0, 1, 0); G_LDB(B1, 1, 1); G_SCHED; G_LDA(At, 1, 0); G_STAGEA(G_SA(0, 1), a2, 1, c10 + (GATHER ? 0u : c00), c11);
            G_WAIT_V(8); G_WAIT_L(0); G_BAR; G_MMA(0, 0, At, B0); G_MMA(0, 1, At, B1); G_BAR; G_SCHED;
            G_LDA(At, 1, 1); G_STAGEB(G_SB(1, 0), b2 + kstep); G_STAGEB(G_SB(1, 1), b2 + kstep + hstep); G_STAGEA(G_SA(1, 0), a2 + kstep, 0, c00, c01);
            G_WAIT_V(8); G_WAIT_L(0); G_BAR; G_MMA(1, 0, At, B0); G_MMA(1, 1, At, B1); G_BAR; G_SCHED;
        }
        if (wr == 0) G_BAR;
        E(acc, cur, wr, wc, fr, fq);
        if (!has_next) break;
#pragma unroll
        for (int a = 0; a < 2; ++a)
#pragma unroll
            for (int b = 0; b < 2; ++b)
#pragma unroll
                for (int m = 0; m < 4; ++m)
#pragma unroll
                    for (int n = 0; n < 2; ++n) acc[a][b][m][n] = (f32x4){0.f, 0.f, 0.f, 0.f};
        cur = nxt; cB = nB; cA = nA; ++ui;
        if (wr == 1) G_BAR;
    }
    G_WAIT_V(0);
    G_BAR;
}
}

struct DenseOrder {
    int nM, nN, nwg, G, c, K; const char* Bt;
    __device__ __forceinline__ void init(int M, int N, int K_, int G_, int c_, const void* A_, const void* Bt_) { nM = M / 256; nN = N / 256; nwg = nM * nN; G = G_; c = c_; K = K_; A = (const char*)A_; Bt = (const char*)Bt_; }
    __device__ __forceinline__ bool next(int i, gm::Unit& u) const {
        const long L = (long)i * G + c; if (L >= nwg) return false;
        int wgid = (int)L; { const int q = nwg / gm::NXCD, r = nwg % gm::NXCD, xcd = wgid % gm::NXCD, off = wgid / gm::NXCD; wgid = (xcd < r ? xcd * (q + 1) : r * (q + 1) + (xcd - r) * q) + off; }
        const int nig = gm::WGM * nN, gid = wgid / nig, fm = gid * gm::WGM, gsz = (nM - fm) < gm::WGM ? (nM - fm) : gm::WGM;
        u.pm = fm + ((wgid % nig) % gsz); u.pn = (wgid % nig) / gsz; u.e = 0; u.rows = 256;
        u.B = Bt + (size_t)u.pn * 256 * K * 2; return true;
    }
    const char* A;
    __device__ __forceinline__ const char* a_base(const gm::Unit& u) const { return A + (size_t)u.pm * 256 * K * 2; }
    __device__ __forceinline__ unsigned a_off(int, int r, int c) const { return (unsigned)(r * K + c) * 2u; }
};
constexpr int GT_MAX = 19, GT_OFF = 128 * 1024;
template <bool GATHER> struct MoeOrder {
    LAS const int* tab; int nN, G, vc; const char* Wt; size_t wstride; const int* stok;
    __device__ __forceinline__ bool next(int i, gm::Unit& u) const {
        const int L = i * G + vc; if (L >= tab[32]) return false;
        int e = 0;
#pragma unroll 1
        for (int k = 1; k < 32; ++k) e += (tab[k] <= L) ? 1 : 0;
        const int r = L - tab[e]; u.e = e; u.pm = r / nN; u.pn = r % nN;
        const int cnt = tab[128 + e]; u.rows = (cnt - u.pm * 256) < 256 ? (cnt - u.pm * 256) : 256;
        u.B = Wt + (size_t)e * wstride + (size_t)u.pn * 256 * 1024 * 2; return true;
    }
    const char* A;
    __device__ __forceinline__ const char* a_base(const gm::Unit& u) const { return GATHER ? A : A + (size_t)(tab[64 + u.e] + u.pm * 256) * 2048; }
    LAS const unsigned* gtab;
    __device__ __forceinline__ unsigned a_off(int ui, int r, int c) const {
        if (GATHER) return gtab[ui * 256 + r] + (unsigned)c * 2u;
        else return (unsigned)(r * 1024 + c) * 2u;
    }
    __device__ __forceinline__ void fill_gather(LAS unsigned* gt) const {
        const int tid = opaque_tid();
        if (tid < 256) { gm::Unit u;
            for (int i = 0; i < GT_MAX && next(i, u); ++i) { int tk = 0; if (tid < u.rows) tk = stok[u.e * CAP + u.pm * 256 + tid] >> 2; gt[i * 256 + tid] = (unsigned)tk * 2048u; } }
        __syncthreads();
    }
};
__device__ __forceinline__ void moe_tables(LAS unsigned char* lds, const int* gcount, int nN) {
    LAS int* tab = (LAS int*)(lds + MISC_OFF);
    if (opaque_tid() == 0) { int cu = 0, ro = 0;
#pragma unroll 1
        for (int e = 0; e < 32; ++e) { const int c = gcount[e]; tab[e] = cu; tab[64 + e] = ro; tab[128 + e] = c; cu += ((c + 255) >> 8) * nN; ro += c; }
        tab[32] = cu; tab[64 + 32] = ro; }
    __syncthreads();
}

struct EpiProj {
    static constexpr bool PERM = true;
    bf16_t* O; int ldc;
    __device__ __forceinline__ void operator()(const f32x4 (&acc)[2][2][4][2], const gm::Unit& u, int wr, int wc, int fr_, int fq_) const {
        int fr = fr_, fq = fq_; asm volatile("" : "+v"(fr), "+v"(fq));
        const int row0 = u.pm * 256 + wr * 64 + fr, col0 = u.pn * 256 + wc * 32 + 8 * fq;
#pragma unroll
        for (int ai = 0; ai < 2; ++ai)
#pragma unroll
            for (int m = 0; m < 4; ++m) { bf16_t* rowp = O + (size_t)(row0 + ai * 128 + m * 16) * ldc + col0;
#pragma unroll
                for (int bj = 0; bj < 2; ++bj) { const f32x4 v0 = acc[ai][bj][m][0], v1 = acc[ai][bj][m][1];
                    u32x4 w; w.x = pk2(v0[0], v0[1]); w.y = pk2(v0[2], v0[3]); w.z = pk2(v1[0], v1[1]); w.w = pk2(v1[2], v1[3]);
                    *(u32x4*)(rowp + bj * 128) = w; } }
    }
};
struct EpiOut {
    static constexpr bool PERM = false;
    const float* xin; float* xout; const float* gate;
    __device__ __forceinline__ void operator()(const f32x4 (&acc)[2][2][4][2], const gm::Unit& u, int wr, int wc, int fr_, int fq_) const {
        int fr = fr_, fq = fq_; asm volatile("" : "+v"(fr), "+v"(fq));
        const int row0 = u.pm * 256 + wr * 64 + fr, col0 = u.pn * 256 + wc * 32 + 4 * fq;
        const float* gp = gate + (size_t)(u.pm >> 4) * 6144 + col0;
        f32x4 gv[2][2];
#pragma unroll
        for (int bj = 0; bj < 2; ++bj)
#pragma unroll
            for (int n = 0; n < 2; ++n) gv[bj][n] = *(const f32x4*)(gp + bj * 128 + n * 16);
#pragma unroll
        for (int ai = 0; ai < 2; ++ai)
#pragma unroll
            for (int m = 0; m < 4; ++m) { const size_t ro = (size_t)(row0 + ai * 128 + m * 16) * 1024 + col0;
#pragma unroll
                for (int bj = 0; bj < 2; ++bj)
#pragma unroll
                    for (int n = 0; n < 2; ++n) { const f32x4 xi = *(const f32x4*)(xin + ro + bj * 128 + n * 16);
                        *(f32x4*)(xout + ro + bj * 128 + n * 16) = xi + gv[bj][n] * acc[ai][bj][m][n]; } }
    }
};
struct EpiGlu {
    static constexpr bool PERM = true;
    const bf16_t* y; bf16_t* mixed; const float* bias;
    __device__ __forceinline__ void operator()(const f32x4 (&acc)[2][2][4][2], const gm::Unit& u, int wr, int wc, int fr_, int fq_) const {
        int fr = fr_, fq = fq_; asm volatile("" : "+v"(fr), "+v"(fq));
        const int row0 = u.pm * 256 + wr * 64 + fr, col0 = wc * 32 + 8 * fq;
#pragma unroll
        for (int ai = 0; ai < 2; ++ai)
#pragma unroll
            for (int m = 0; m < 4; ++m) { const int row = row0 + ai * 128 + m * 16;
#pragma unroll
                for (int bj = 0; bj < 2; ++bj) { const int col = col0 + bj * 128;
                    const f32x4 b0 = *(const f32x4*)(bias + col), b1 = *(const f32x4*)(bias + col + 4);
                    const u32x4 yw = *(const u32x4*)(y + (size_t)row * 256 + col);
                    const f32x4 z0 = acc[ai][bj][m][0] + b0, z1 = acc[ai][bj][m][1] + b1;
                    u32x4 w;
                    w.x = pk2(bflo(yw.x) * sigmoidf_(z0[0]), bfhi(yw.x) * sigmoidf_(z0[1]));
                    w.y = pk2(bflo(yw.y) * sigmoidf_(z0[2]), bfhi(yw.y) * sigmoidf_(z0[3]));
                    w.z = pk2(bflo(yw.z) * sigmoidf_(z1[0]), bfhi(yw.z) * sigmoidf_(z1[1]));
                    w.w = pk2(bflo(yw.w) * sigmoidf_(z1[2]), bfhi(yw.w) * sigmoidf_(z1[3]));
                    *(u32x4*)(mixed + (size_t)row * 1024 + 768 + col) = w; }
                __builtin_amdgcn_sched_barrier(0); }
    }
};
__device__ __forceinline__ float swiglu1(float g, float l) {
    g = fminf(g, 7.0f); l = fminf(fmaxf(l, -7.0f), 7.0f);
    return g * sigmoidf_(1.702f * g) * (l + 1.0f);
}
struct EpiUp {
    static constexpr bool PERM = true;
    bf16_t* act; const float* bias; LAS const int* tab;
    __device__ __forceinline__ void operator()(const f32x4 (&acc)[2][2][4][2], const gm::Unit& u, int wr, int wc, int fr_, int fq_) const {
        int fr = fr_, fq = fq_; asm volatile("" : "+v"(fr), "+v"(fq));
        const int rl0 = wr * 64 + fr, col0 = u.pn * 128 + wc * 32 + 8 * fq;
        const float* bp = bias + (size_t)u.e * 2048 + col0;
        const size_t arow = (size_t)(tab[64 + u.e] + u.pm * 256);
#pragma unroll
        for (int ai = 0; ai < 2; ++ai)
#pragma unroll
            for (int m = 0; m < 4; ++m) { const int rl = rl0 + ai * 128 + m * 16;
                if (rl < u.rows) {
                    const f32x4 bg0 = *(const f32x4*)(bp), bg1 = *(const f32x4*)(bp + 4), bl0 = *(const f32x4*)(bp + 1024), bl1 = *(const f32x4*)(bp + 1028);
                    const f32x4 g0 = acc[ai][0][m][0] + bg0, g1 = acc[ai][0][m][1] + bg1, l0 = acc[ai][1][m][0] + bl0, l1 = acc[ai][1][m][1] + bl1;
                    u32x4 w;
                    w.x = pk2(swiglu1(g0[0], l0[0]), swiglu1(g0[1], l0[1])); w.y = pk2(swiglu1(g0[2], l0[2]), swiglu1(g0[3], l0[3]));
                    w.z = pk2(swiglu1(g1[0], l1[0]), swiglu1(g1[1], l1[1])); w.w = pk2(swiglu1(g1[2], l1[2]), swiglu1(g1[3], l1[3]));
                    *(u32x4*)(act + (arow + rl) * 1024 + col0) = w; }
                __builtin_amdgcn_sched_barrier(0); }
    }
};
struct EpiDown {
    static constexpr bool PERM = true;
    bf16_t* outr; const float* bias; const int* stok; const float* sgate;
    __device__ __forceinline__ void operator()(const f32x4 (&acc)[2][2][4][2], const gm::Unit& u, int wr, int wc, int fr_, int fq_) const {
        int fr = fr_, fq = fq_; asm volatile("" : "+v"(fr), "+v"(fq));
        const int rl0 = wr * 64 + fr, col0 = u.pn * 256 + wc * 32 + 8 * fq;
        const float* bp = bias + (size_t)u.e * 1024 + col0;
        f32x4 bv[2][2];
#pragma unroll
        for (int bj = 0; bj < 2; ++bj) { bv[bj][0] = *(const f32x4*)(bp + bj * 128); bv[bj][1] = *(const f32x4*)(bp + bj * 128 + 4); }
#pragma unroll
        for (int ai = 0; ai < 2; ++ai)
#pragma unroll
            for (int m = 0; m < 4; ++m) { const int rl = rl0 + ai * 128 + m * 16;
                if (rl < u.rows) {
                    const int si = u.e * CAP + u.pm * 256 + rl; const int st = stok[si]; const float gt = sgate[si];
                    bf16_t* rowp = outr + (size_t)st * 1024 + col0;
#pragma unroll
                    for (int bj = 0; bj < 2; ++bj) { const f32x4 v0 = (acc[ai][bj][m][0] + bv[bj][0]) * gt, v1 = (acc[ai][bj][m][1] + bv[bj][1]) * gt;
                        u32x4 w; w.x = pk2(v0[0], v0[1]); w.y = pk2(v0[2], v0[3]); w.z = pk2(v1[0], v1[1]); w.w = pk2(v1[2], v1[3]);
                        *(u32x4*)(rowp + bj * 128) = w; } }
                __builtin_amdgcn_sched_barrier(0); }
    }
};

__device__ __forceinline__ void transpose_item(const float* W, int K, int Nsrc, bf16_t* WT, int mode, LAS float* scr, int kb, int nb, int lane) {
    const int k0 = 64 * kb, n0 = 32 * nb;
    const int ncol = n0 + (lane & 31);
#pragma unroll 8
    for (int i = 0; i < 32; ++i) { const int kk = 2 * i + (lane >> 5); scr[kk * 33 + (lane & 31)] = (ncol < Nsrc) ? W[(size_t)(k0 + kk) * Nsrc + ncol] : 0.f; }
    LDS_WAIT(); asm volatile("" ::: "memory");
    const int c = lane & 7;
#pragma unroll
    for (int j = 0; j < 4; ++j) { const int n = (lane >> 3) + 8 * j; const LAS float* s = scr + (8 * c) * 33 + n;
        u32x4 o; o.x = pk2(s[0 * 33], s[1 * 33]); o.y = pk2(s[2 * 33], s[3 * 33]); o.z = pk2(s[4 * 33], s[5 * 33]); o.w = pk2(s[6 * 33], s[7 * 33]);
        int drow = n0 + n;
        if (mode == 1) { const int jj = drow & 1023, lin = drow >> 10; drow = (jj >> 7) * 256 + lin * 128 + (jj & 127); }
        *(u32x4*)(WT + (size_t)drow * K + k0 + 8 * c) = o; }
    LDS_WAIT(); asm volatile("" ::: "memory");
}
constexpr int TI_IN = 16 * 88, TI_OUT = 16 * 32, TI_UP = 16 * 64, TI_DN = 16 * 32, TI_GLU = 4 * 8;
constexpr int TS_R0 = 2 * TI_IN, TS_R1 = TS_R0 + 2 * TI_OUT, TS_R2 = TS_R1 + 2 * TI_GLU;
__device__ __forceinline__ void transpose_small(const Params& P, LAS unsigned char* lds, int gw, int ngw, int wave, int lane) {
    unsigned char* const wsp = opaque_ptr(P.ws);
    LAS float* scr = (LAS float*)(lds + wave * 8704);
    for (int it = gw; it < TS_R2; it += ngw) {
        if (it < TS_R0) { const int l = it / TI_IN, r = it % TI_IN;
            transpose_item(P.w_in + (size_t)l * 1024 * NPROJ, 1024, NPROJ, (bf16_t*)(wsp + WS_WIN) + (size_t)l * NPROJP * 1024, 0, scr, r / 88, r % 88, lane); }
        else if (it < TS_R1) { const int q = it - TS_R0, l = q / TI_OUT, r = q % TI_OUT;
            transpose_item(P.w_out + (size_t)l * 1024 * 1024, 1024, 1024, (bf16_t*)(wsp + WS_WOUT) + (size_t)l * 1024 * 1024, 0, scr, r / 32, r % 32, lane); }
        else { const int q = it - TS_R1, l = q / TI_GLU, r = q % TI_GLU;
            transpose_item(P.s5_w_glu + (size_t)l * 256 * 256, 256, 256, (bf16_t*)(wsp + WS_WGLU) + (size_t)l * 256 * 256, 0, scr, r / 8, r % 8, lane); }
    }
}
__device__ __forceinline__ void transpose_item64(const float* W, int K, int Nsrc, bf16_t* WT, int mode, LAS float* scr, int kb, int nb, int lane) {
    const int k0 = 64 * kb, n0 = 64 * nb, kq = lane >> 4, nn = 4 * (lane & 15);
    const float* src = W + (size_t)(k0 + kq) * Nsrc + n0 + nn;
    f32x4 v[16];
#pragma unroll
    for (int i = 0; i < 16; ++i) v[i] = __builtin_nontemporal_load((const f32x4*)(src + (size_t)(4 * i) * Nsrc));
#pragma unroll
    for (int i = 0; i < 16; ++i) { LAS float* d = scr + (4 * i + kq) * 65 + nn; d[0] = v[i][0]; d[1] = v[i][1]; d[2] = v[i][2]; d[3] = v[i][3]; }
    LDS_WAIT(); asm volatile("" ::: "memory");
    const int c = lane & 7;
#pragma unroll
    for (int j = 0; j < 8; ++j) { const int n = (lane >> 3) + 8 * j; const LAS float* s = scr + (8 * c) * 65 + n;
        u32x4 o; o.x = pk2(s[0 * 65], s[1 * 65]); o.y = pk2(s[2 * 65], s[3 * 65]); o.z = pk2(s[4 * 65], s[5 * 65]); o.w = pk2(s[6 * 65], s[7 * 65]);
        int drow = n0 + n;
        if (mode == 1) { const int jj = drow & 1023, lin = drow >> 10; drow = (jj >> 7) * 256 + lin * 128 + (jj & 127); }
        *(u32x4*)(WT + (size_t)drow * K + k0 + 8 * c) = o; }
    LDS_WAIT(); asm volatile("" ::: "memory");
}
constexpr int TM_UP = 16 * 32, TM_DN = 16 * 16;
__device__ __forceinline__ void transpose_moe(const Params& P, LAS unsigned char* lds, int l, int gw, int ngw, int wave, int lane) {
    unsigned char* const wsp = opaque_ptr(P.ws);
    LAS float* scr = (LAS float*)(lds + wave * 16640);
    for (int it = gw; it < 32 * (TM_UP + TM_DN); it += ngw) {
        if (it < 32 * TM_UP) { const int le = l * 32 + it / TM_UP, r = it % TM_UP;
            transpose_item64(P.w_up + (size_t)le * 1024 * 2048, 1024, 2048, (bf16_t*)(wsp + WS_WUP) + (size_t)le * 2048 * 1024, 1, scr, r / 32, r % 32, lane); }
        else { const int q = it - 32 * TM_UP, le = l * 32 + q / TM_DN, r = q % TM_DN;
            transpose_item64(P.w_down + (size_t)le * 1024 * 1024, 1024, 1024, (bf16_t*)(wsp + WS_WDN) + (size_t)le * 1024 * 1024, 0, scr, r / 16, r % 16, lane); }
    }
}
__device__ __forceinline__ void mod_item(const Params& P, LAS unsigned char* lds, int item) {
    unsigned char* const wsp = opaque_ptr(P.ws);
    const int tid = opaque_tid(), wave = tid >> 6, lane = tid & 63;
    LAS float* sc = (LAS float*)lds;
    LAS float* red = (LAS float*)(lds + 32768);
    const int l = item / 96, cb = item % 96;
    for (int i = tid; i < 8192; i += NTHREADS) sc[i] = siluf(P.c[i]);
    __syncthreads();
    const float* W = P.w_mod + (size_t)l * 1024 * 6144 + cb * 64 + lane;
    float a[8];
#pragma unroll
    for (int b = 0; b < 8; ++b) a[b] = 0.f;
#pragma unroll 1
    for (int k0 = wave; k0 < 1024; k0 += 128) { float wv[16];
#pragma unroll
        for (int u = 0; u < 16; ++u) wv[u] = __builtin_nontemporal_load(W + (size_t)(k0 + 8 * u) * 6144);
#pragma unroll
        for (int u = 0; u < 16; ++u) {
#pragma unroll
            for (int b = 0; b < 8; ++b) a[b] += sc[b * 1024 + k0 + 8 * u] * wv[u]; } }
#pragma unroll
    for (int b = 0; b < 8; ++b) red[(wave * 8 + b) * 64 + lane] = a[b];
    __syncthreads();
    { const int b = tid >> 6; float s = 0.f;
#pragma unroll
      for (int w = 0; w < 8; ++w) s += red[(w * 8 + b) * 64 + lane];
      ((float*)(wsp + WS_MOD))[(size_t)(l * 8 + b) * 6144 + cb * 64 + lane] = s + P.b_mod[l * 6144 + cb * 64 + lane]; }
    __syncthreads();
}
__device__ __forceinline__ void dsincos(double x, double& s, double& c) {
    const double x2 = x * x; double ts = x, tc = 1.0; s = x; c = 1.0;
#pragma unroll 1
    for (int k = 1; k <= 14; ++k) { tc = -tc * x2 / (double)((2 * k - 1) * (2 * k)); ts = -ts * x2 / (double)((2 * k) * (2 * k + 1)); c += tc; s += ts; }
}
__device__ __forceinline__ double dexp_small(double z) {
    double t = 1.0, r = 1.0;
#pragma unroll 1
    for (int k = 1; k <= 18; ++k) { t = t * z / (double)k; r += t; }
    return r;
}
__device__ __forceinline__ void s5_tables_item(const Params& P, LAS unsigned char* lds, int item4) {
    unsigned char* const wsp = opaque_ptr(P.ws);
    const int tid = opaque_tid(); const int item = item4 >> 2, qtr = item4 & 3; const int l = item >> 4, g = item & 15, lg = l * 16 + g;
    LAS float* pwr = (LAS float*)lds;
    LAS float* pwi = pwr + 64 * 65;
    LAS float* bbr = pwi + 64 * 65;
    LAS float* bbi = bbr + 1024;
    LAS float* ccr = bbi + 1024;
    LAS float* cci = ccr + 1024;
    if (tid < 64) { const int p = tid;
        const double are = (double)P.s5_a_re[lg * 64 + p], aim = (double)P.s5_a_im[lg * 64 + p];
        const double dt = (double)expf(P.s5_log_dt[lg]);
        const double mag = dexp_small(are * dt);
        double ang = aim * dt; const double TWO_PI = 6.283185307179586476925;
        ang -= TWO_PI * rint(ang / TWO_PI);
        double sn, cs; dsincos(ang, sn, cs);
        const double lbr = mag * cs, lbi = mag * sn;
        const double nr = lbr - 1.0, ni = lbi, den = are * are + aim * aim;
        const double cfr = (nr * are + ni * aim) / den, cfi = (ni * are - nr * aim) / den;
        double pr = 1.0, pi_ = 0.0;
        for (int t = 0; t <= 64; ++t) { pwr[p * 65 + t] = (float)pr; pwi[p * 65 + t] = (float)pi_; const double nr2 = pr * lbr - pi_ * lbi, ni2 = pr * lbi + pi_ * lbr; pr = nr2; pi_ = ni2; }
        for (int h = 0; h < 16; ++h) { const double br = (double)P.s5_b_re[(lg * 64 + p) * 16 + h], bi = (double)P.s5_b_im[(lg * 64 + p) * 16 + h];
            bbr[p * 16 + h] = (float)(cfr * br - cfi * bi); bbi[p * 16 + h] = (float)(cfr * bi + cfi * br); }
        float* l64 = (float*)(wsp + WS_LAM64) + (size_t)(lg * 64 + p) * 2;
        if (qtr == 0) { l64[0] = pwr[p * 65 + 64]; l64[1] = pwi[p * 65 + 64]; }
    }
    for (int i = tid; i < 1024; i += NTHREADS) { ccr[i] = P.s5_c_re[lg * 1024 + i]; cci[i] = P.s5_c_im[lg * 1024 + i]; }
    __syncthreads();
    bf16_t* kt = (bf16_t*)(wsp + WS_KTAB) + (size_t)lg * 65 * 256;
    for (int i = qtr * 16 * 256 + tid; i < (qtr == 3 ? 65 : 16 * (qtr + 1)) * 256; i += NTHREADS) { const int tau = i >> 8, h = (i >> 4) & 15, h2 = i & 15; float s = 0.f;
        if (tau < 64) {
            for (int p = 0; p < 64; ++p) { const float pr = pwr[p * 65 + tau], pi_ = pwi[p * 65 + tau], br = bbr[p * 16 + h2], bi = bbi[p * 16 + h2];
                const float wr_ = pr * br - pi_ * bi, wi_ = pr * bi + pi_ * br; s += ccr[h * 64 + p] * wr_ - cci[h * 64 + p] * wi_; }
            if (tau == 0 && h == h2) s += P.s5_d[l * 256 + g * 16 + h]; }
        kt[i] = (bf16_t)f2bf(s); }
    bf16_t* bp = (bf16_t*)(wsp + WS_BPOW) + (size_t)lg * 128 * 1024;
    for (int i = qtr * 32768 + tid; i < (qtr + 1) * 32768; i += NTHREADS) { const int q = i >> 10, s = (i >> 4) & 63, h2 = i & 15, p = q & 63;
        const float pr = pwr[p * 65 + 63 - s], pi_ = pwi[p * 65 + 63 - s], br = bbr[p * 16 + h2], bi = bbi[p * 16 + h2];
        const float v = (q < 64) ? (pr * br - pi_ * bi) : (pr * bi + pi_ * br);
        bp[i] = (bf16_t)f2bf(v); }
    bf16_t* cp = (bf16_t*)(wsp + WS_CPOW) + (size_t)lg * 1024 * 128;
    for (int i = qtr * 32768 + tid; i < (qtr + 1) * 32768; i += NTHREADS) { const int q = i & 127, th = i >> 7, t = th >> 4, h = th & 15, p = q & 63;
        const float pr = pwr[p * 65 + t + 1], pi_ = pwi[p * 65 + t + 1], cr = ccr[h * 64 + p], ci = cci[h * 64 + p];
        const float v = (q < 64) ? (cr * pr - ci * pi_) : -(cr * pi_ + ci * pr);
        cp[i] = (bf16_t)f2bf(v); }
    __syncthreads();
}
__device__ __forceinline__ void rope_table(const Params& P, int gtid, int gthreads) {
    unsigned char* const wsp = opaque_ptr(P.ws);
    float* rp = (float*)(wsp + WS_ROPE);
    for (int i = gtid; i < 4096 * 24; i += gthreads) { const int pos = i / 24, f = i % 24;
        double rev = (double)pos * P.inv_freq_rev[f]; rev -= rint(rev);
        double sn, cs; dsincos(rev * 6.283185307179586476925, sn, cs);
        rp[2 * i] = (float)cs; rp[2 * i + 1] = (float)sn; }
}
__device__ __forceinline__ void norm_row_store(const f32x4 (&v)[4], const float* nw, const float* modrow_sh, const float* modrow_sc, bf16_t* orow, int lane) {
    float ss = 0.f;
#pragma unroll
    for (int j = 0; j < 4; ++j) ss += (v[j][0] * v[j][0] + v[j][1] * v[j][1]) + (v[j][2] * v[j][2] + v[j][3] * v[j][3]);
    const float rstd = 1.0f / sqrtf(wave_sum(ss, lane) * (1.0f / 1024.0f) + NORM_EPS);
#pragma unroll
    for (int hf = 0; hf < 2; ++hf) { const int col = hf * 512 + 8 * lane; float o[8];
#pragma unroll
        for (int q = 0; q < 2; ++q) { const f32x4 w = *(const f32x4*)(nw + col + 4 * q), sc = *(const f32x4*)(modrow_sc + col + 4 * q), sh = *(const f32x4*)(modrow_sh + col + 4 * q);
#pragma unroll
            for (int e = 0; e < 4; ++e) o[4 * q + e] = v[hf * 2 + q][e] * rstd * w[e] * (1.0f + sc[e]) + sh[e]; }
        u32x4 w4; w4.x = pk2(o[0], o[1]); w4.y = pk2(o[2], o[3]); w4.z = pk2(o[4], o[5]); w4.w = pk2(o[6], o[7]);
        *(u32x4*)(orow + col) = w4; }
}

template <int KS>
__device__ __forceinline__ f32x16 mma32(LAS const unsigned char* A, int lda, LAS const unsigned char* B, int ldb, f32x16 acc, int lane) {
    const int r = lane & 31, h = lane >> 5;
#pragma unroll
    for (int ks = 0; ks < KS; ++ks) {
        const bf16x8 a = *(const LAS bf16x8*)(A + r * lda + ks * 32 + h * 16);
        const bf16x8 b = *(const LAS bf16x8*)(B + r * ldb + ks * 32 + h * 16);
        acc = __builtin_amdgcn_mfma_f32_32x32x16_bf16(a, b, acc, 0, 0, 0);
    }
    return acc;
}
__device__ __forceinline__ int crow(int reg, int lane) { return (reg & 3) + 8 * (reg >> 2) + 4 * (lane >> 5); }

constexpr int MA_QD = 0, MA_KI = 7168, MA_KET = 14336, MA_VT = 23552, MA_SLOT = 37376;
__device__ __forceinline__ bf16x8 frag_from(unsigned a, unsigned b, unsigned c, unsigned d) { const u32x4 v = {a, b, c, d}; return __builtin_bit_cast(bf16x8, v); }
__device__ __forceinline__ void mixer_phase_a(const Params& P, LAS unsigned char* lds, int l, int round) {
    unsigned char* const wsp = opaque_ptr(P.ws);
    const int tid = opaque_tid(), w = __builtin_amdgcn_readfirstlane(tid >> 6), lane = tid & 63, r = lane & 31, hh = lane >> 5;
    const int slot = w >> 2, wv = w & 3, nt = wv & 1, mt = wv >> 1;
    const int item = 2 * round + slot, n = item & 63, h = (item >> 6) & 3, b = (item >> 8) & 7, type = item >> 11;
    LAS unsigned char* const L = lds + slot * MA_SLOT;
    const bf16_t* prow = (const bf16_t*)(wsp + WS_PROJ) + (size_t)(b * SEQ + n * 64) * NPROJP;
    const int cq = (type ? C_RQ : C_GQ) + h * 48, ck = (type ? C_RK : C_GK) + h * 48, cv = (type ? C_RV : C_GV) + h * 96;
    const int d = 32 * nt + r; const bool dvalid = d < 48;
    { const int t4 = wv * 64 + lane;
#pragma unroll
      for (int jj = 0; jj < 3; ++jj) { const int p = t4 + 256 * jj, j = p / 12, c = p % 12;
          const u32x4 vv = *(const u32x4*)(prow + (size_t)j * NPROJP + cv + 8 * c);
          LAS bf16_t* dst = (LAS bf16_t*)(L + MA_VT + (8 * c) * 144 + j * 2);
          dst[0 * 72] = (bf16_t)(vv.x & 0xffff); dst[1 * 72] = (bf16_t)(vv.x >> 16); dst[2 * 72] = (bf16_t)(vv.y & 0xffff); dst[3 * 72] = (bf16_t)(vv.y >> 16);
          dst[4 * 72] = (bf16_t)(vv.z & 0xffff); dst[5 * 72] = (bf16_t)(vv.z >> 16); dst[6 * 72] = (bf16_t)(vv.w & 0xffff); dst[7 * 72] = (bf16_t)(vv.w >> 16); } }
    float qv[16], kv[16], cum[16], tot;
    if (type == 0) {
#pragma unroll
        for (int reg = 0; reg < 16; ++reg) { const int t = 32 * mt + crow(reg, lane); const bf16_t* pr = prow + (size_t)t * NPROJP;
            qv[reg] = dvalid ? bf2f(pr[cq + d]) * 0.14433756729740643f : 0.f; kv[reg] = dvalid ? bf2f(pr[ck + d]) : 0.f; }
        const bf16_t* wat = (const bf16_t*)(wsp + WS_WA2T) + (size_t)((l * 4 + h) * 64 + d) * 16 + 8 * hh;
        const bf16x8 waf = *(const bf16x8*)wat;
        const float bias = dvalid ? P.gla_b_a[l * 192 + h * 48 + d] : 0.f;
        unsigned xh[2][2][4], xl[2][2][4];
#pragma unroll
        for (int m2 = 0; m2 < 2; ++m2) {
            const bf16x8 gaf = *(const bf16x8*)(prow + (size_t)(32 * m2 + r) * NPROJP + C_GA + 8 * hh);
            f32x16 pre;
#pragma unroll
            for (int i = 0; i < 16; ++i) pre[i] = 0.f;
            pre = __builtin_amdgcn_mfma_f32_32x32x16_bf16(gaf, waf, pre, 0, 0, 0);
            float la[16];
#pragma unroll
            for (int reg = 0; reg < 16; ++reg) { const float x = pre[reg] + bias;
                const float ls = fminf(x, 0.f) - __logf(1.0f + __expf(-fabsf(x)));
                la[reg] = dvalid ? ls * (1.0f / 16.0f) : 0.f; }
#pragma unroll
            for (int s2 = 0; s2 < 2; ++s2)
#pragma unroll
                for (int q = 0; q < 4; ++q) { const float a0 = la[8 * s2 + 2 * q], a1 = la[8 * s2 + 2 * q + 1];
                    const unsigned hw = pk2(a0, a1); xh[m2][s2][q] = hw; xl[m2][s2][q] = pk2(a0 - bflo(hw), a1 - bfhi(hw)); }
        }
        f32x16 cacc, tacc;
#pragma unroll
        for (int i = 0; i < 16; ++i) { cacc[i] = 0.f; tacc[i] = 0.f; }
        const bf16x8 ones = frag_from(0x3F803F80u, 0x3F803F80u, 0x3F803F80u, 0x3F803F80u);
#pragma unroll
        for (int m2 = 0; m2 < 2; ++m2)
#pragma unroll
            for (int s2 = 0; s2 < 2; ++s2) {
                const bf16x8 fh = frag_from(xh[m2][s2][0], xh[m2][s2][1], xh[m2][s2][2], xh[m2][s2][3]), fl = frag_from(xl[m2][s2][0], xl[m2][s2][1], xl[m2][s2][2], xl[m2][s2][3]);
                tacc = __builtin_amdgcn_mfma_f32_32x32x16_bf16(ones, fh, tacc, 0, 0, 0);
                tacc = __builtin_amdgcn_mfma_f32_32x32x16_bf16(ones, fl, tacc, 0, 0, 0);
                if (m2 < mt) { cacc = __builtin_amdgcn_mfma_f32_32x32x16_bf16(ones, fh, cacc, 0, 0, 0); cacc = __builtin_amdgcn_mfma_f32_32x32x16_bf16(ones, fl, cacc, 0, 0, 0); }
                else if (m2 == mt) { unsigned tw[4];
#pragma unroll
                    for (int q = 0; q < 4; ++q) { const int k0 = 16 * s2 + 8 * ((2 * q) >> 2) + 4 * hh + ((2 * q) & 3), k1 = 16 * s2 + 8 * ((2 * q + 1) >> 2) + 4 * hh + ((2 * q + 1) & 3);
                        tw[q] = (k0 <= r ? 0x3F80u : 0u) | (k1 <= r ? 0x3F800000u : 0u); }
                    const bf16x8 tri = frag_from(tw[0], tw[1], tw[2], tw[3]);
                    cacc = __builtin_amdgcn_mfma_f32_32x32x16_bf16(tri, fh, cacc, 0, 0, 0); cacc = __builtin_amdgcn_mfma_f32_32x32x16_bf16(tri, fl, cacc, 0, 0, 0); }
            }
#pragma unroll
        for (int reg = 0; reg < 16; ++reg) cum[reg] = cacc[reg];
        tot = tacc[0];
    } else {
        const float lgam = P.log_gamma[h];
        const float* rope = (const float*)(wsp + WS_ROPE) + (size_t)(n * 64) * 48;
        const int dp = (d < 24) ? d + 24 : d - 24, f = (d < 24) ? d : d - 24;
#pragma unroll
        for (int reg = 0; reg < 16; ++reg) { const int t = 32 * mt + crow(reg, lane); const bf16_t* pr = prow + (size_t)t * NPROJP;
            float q0 = 0.f, q1 = 0.f, k0 = 0.f, k1 = 0.f, cs = 1.f, sn = 0.f;
            if (dvalid) { q0 = bf2f(pr[cq + d]); q1 = bf2f(pr[cq + dp]); k0 = bf2f(pr[ck + d]); k1 = bf2f(pr[ck + dp]); cs = rope[t * 48 + 2 * f]; sn = rope[t * 48 + 2 * f + 1]; }
            qv[reg] = (d < 24) ? (q0 * cs - q1 * sn) : (q1 * sn + q0 * cs);
            kv[reg] = ((d < 24) ? (k0 * cs - k1 * sn) : (k1 * sn + k0 * cs)) * 0.14433756729740643f;
            cum[reg] = (float)(t + 1) * lgam; }
        tot = 64.0f * lgam;
    }
    {
        bf16_t* qdg = (bf16_t*)(wsp + MXW_QD) + (size_t)item * 3072;
        float ke[16];
#pragma unroll
        for (int reg = 0; reg < 16; ++reg) { const int t = 32 * mt + crow(reg, lane);
            const float e1 = __expf(cum[reg]), e2 = __expf(-cum[reg]), e3 = __expf(tot - cum[reg]);
            const bf16_t qd = (bf16_t)f2bf(qv[reg] * e1), ki = (bf16_t)f2bf(kv[reg] * e2); ke[reg] = kv[reg] * e3;
            if (dvalid) { *(LAS bf16_t*)(L + MA_QD + t * 112 + d * 2) = qd; *(LAS bf16_t*)(L + MA_KI + t * 112 + d * 2) = ki; qdg[t * 48 + d] = qd; } }
#pragma unroll
        for (int g4 = 0; g4 < 4; ++g4) { const int t0 = 32 * mt + 8 * g4 + 4 * hh; u32x2 pk; pk.x = pk2(ke[4 * g4], ke[4 * g4 + 1]); pk.y = pk2(ke[4 * g4 + 2], ke[4 * g4 + 3]);
            *(LAS u32x2*)(L + MA_KET + d * 144 + t0 * 2) = pk; }
        if (mt == 0 && hh == 0 && dvalid) ((float*)(wsp + MXW_DEC))[(size_t)item * 48 + d] = __expf(tot);
    }
    __syncthreads();
    {
        unsigned* oig = (unsigned*)(wsp + MXW_OI) + (size_t)item * 3072;
        float* dsg = (float*)(wsp + MXW_DS) + (size_t)item * 4608;
        f32x16 zero16;
#pragma unroll
        for (int i = 0; i < 16; ++i) zero16[i] = 0.f;
        const int it = (wv == 0) ? 0 : 1;
        f32x16 sd = mma32<3>(L + MA_KI + it * 32 * 112, 112, L + MA_QD + it * 32 * 112, 112, zero16, lane);
        unsigned xd[2][4];
#pragma unroll
        for (int s2 = 0; s2 < 2; ++s2)
#pragma unroll
            for (int q = 0; q < 4; ++q) { const int r0 = 8 * s2 + 2 * q; const float a0 = (crow(r0, lane) <= r) ? sd[r0] : 0.f, a1 = (crow(r0 + 1, lane) <= r) ? sd[r0 + 1] : 0.f; xd[s2][q] = pk2(a0, a1); }
        unsigned xo[2][4];
        if (it == 1) { const f32x16 so = mma32<3>(L + MA_KI, 112, L + MA_QD + 32 * 112, 112, zero16, lane);
#pragma unroll
            for (int s2 = 0; s2 < 2; ++s2)
#pragma unroll
                for (int q = 0; q < 4; ++q) xo[s2][q] = pk2(so[8 * s2 + 2 * q], so[8 * s2 + 2 * q + 1]); }
        const int nvt = (wv == 0) ? 3 : 1, vt0 = (wv == 0) ? 0 : wv - 1;
#pragma unroll 1
        for (int vi = 0; vi < nvt; ++vi) { const int vt = vt0 + vi;
            f32x16 oacc = zero16;
            LAS const unsigned char* vb = L + MA_VT + (32 * vt + r) * 144 + 8 * hh;
            if (it == 1) {
#pragma unroll
                for (int s2 = 0; s2 < 2; ++s2) { const u32x2 lo = *(const LAS u32x2*)(vb + 32 * s2), hi = *(const LAS u32x2*)(vb + 32 * s2 + 16);
                    oacc = __builtin_amdgcn_mfma_f32_32x32x16_bf16(frag_from(xo[s2][0], xo[s2][1], xo[s2][2], xo[s2][3]), frag_from(lo.x, lo.y, hi.x, hi.y), oacc, 0, 0, 0); } }
#pragma unroll
            for (int s2 = 0; s2 < 2; ++s2) { const u32x2 lo = *(const LAS u32x2*)(vb + 64 * it + 32 * s2), hi = *(const LAS u32x2*)(vb + 64 * it + 32 * s2 + 16);
                oacc = __builtin_amdgcn_mfma_f32_32x32x16_bf16(frag_from(xd[s2][0], xd[s2][1], xd[s2][2], xd[s2][3]), frag_from(lo.x, lo.y, hi.x, hi.y), oacc, 0, 0, 0); }
#pragma unroll
            for (int q = 0; q < 8; ++q) oig[((it * 3 + vt) * 8 + q) * 64 + lane] = pk2(oacc[2 * q], oacc[2 * q + 1]);
            const int dt = (wv == 0) ? 1 : 0;
            const f32x16 ds = mma32<4>(L + MA_KET + dt * 32 * 144, 144, L + MA_VT + vt * 32 * 144, 144, zero16, lane);
#pragma unroll
            for (int g4 = 0; g4 < 4; ++g4) { const int d0 = 32 * dt + 8 * g4 + 4 * hh;
                if (d0 < 48) { f32x4 o; o[0] = ds[4 * g4]; o[1] = ds[4 * g4 + 1]; o[2] = ds[4 * g4 + 2]; o[3] = ds[4 * g4 + 3]; *(f32x4*)(dsg + (32 * vt + r) * 48 + d0) = o; } }
        }
    }
    __syncthreads();
}
__device__ __forceinline__ void mixer_phase_b(const Params& P, int bid, int G) {
    unsigned char* const wsp = opaque_ptr(P.ws);
    const int tid = opaque_tid();
    for (int task = bid * NTHREADS + tid; task < 64 * 1152; task += G * NTHREADS) {
        const int seq = task / 1152, q4 = task % 1152, d0 = (q4 % 12) * 4;
        const float* dsp = (const float*)(wsp + MXW_DS) + (size_t)seq * 64 * 4608 + q4 * 4;
        const float* dcp = (const float*)(wsp + MXW_DEC) + (size_t)seq * 64 * 48 + d0;
        bf16_t* spp = (bf16_t*)(wsp + MXW_SP) + (size_t)seq * 64 * 4608 + q4 * 4;
        f32x4 st = {0.f, 0.f, 0.f, 0.f};
#pragma unroll 8
        for (int n = 0; n < 64; ++n) { const f32x4 ds = *(const f32x4*)(dsp + (size_t)n * 4608), dc = *(const f32x4*)(dcp + n * 48);
            u32x2 pk; pk.x = pk2(st[0], st[1]); pk.y = pk2(st[2], st[3]); *(u32x2*)(spp + (size_t)n * 4608) = pk;
            st = dc * st + ds; }
    }
}
__device__ __forceinline__ void mixer_phase_c(const Params& P, LAS unsigned char* lds, int l, int item) {
    unsigned char* const wsp = opaque_ptr(P.ws);
    const int tid = opaque_tid(), w = __builtin_amdgcn_readfirstlane(tid >> 6), lane = tid & 63, r = lane & 31, hh = lane >> 5;
    LAS float* const Lw = (LAS float*)(lds + w * 12800);
    const int n = item & 63, h = (item >> 6) & 3, b = (item >> 8) & 7, type = item >> 11;
    const size_t tok0 = (size_t)b * SEQ + n * 64;
    const unsigned* oig = (const unsigned*)(wsp + MXW_OI) + (size_t)item * 3072;
    const bf16_t* qdg = (const bf16_t*)(wsp + MXW_QD) + (size_t)item * 3072 + 8 * hh;
    const bf16_t* spg = (const bf16_t*)(wsp + MXW_SP) + (size_t)item * 4608 + 8 * hh;
    const int rq = lane >> 2, q4 = lane & 3;
    const bf16_t* gp = (const bf16_t*)(wsp + WS_PROJ) + tok0 * NPROJP + (type ? C_RG : C_GG) + h * 96 + 24 * q4;
    bf16_t* mp = (bf16_t*)(wsp + WS_MIXED) + tok0 * 1024 + type * 384 + h * 96 + 24 * q4;
    const float* nw = (type ? P.ret_norm_w : P.gla_norm_w) + l * 384 + h * 96 + 24 * q4;
    f32x16 acc[2][3];
#pragma unroll
    for (int it = 0; it < 2; ++it)
#pragma unroll
        for (int vt = 0; vt < 3; ++vt)
#pragma unroll
            for (int q = 0; q < 8; ++q) { const unsigned u = oig[((it * 3 + vt) * 8 + q) * 64 + lane]; acc[it][vt][2 * q] = bflo(u); acc[it][vt][2 * q + 1] = bfhi(u); }
#pragma unroll
    for (int ks = 0; ks < 3; ++ks) {
        const bf16x8 a0 = *(const bf16x8*)(qdg + r * 48 + ks * 16), a1 = *(const bf16x8*)(qdg + (32 + r) * 48 + ks * 16);
#pragma unroll
        for (int vt = 0; vt < 3; ++vt) { const bf16x8 bb = *(const bf16x8*)(spg + (32 * vt + r) * 48 + ks * 16);
            acc[0][vt] = __builtin_amdgcn_mfma_f32_32x32x16_bf16(a0, bb, acc[0][vt], 0, 0, 0);
            acc[1][vt] = __builtin_amdgcn_mfma_f32_32x32x16_bf16(a1, bb, acc[1][vt], 0, 0, 0); } }
    f32x4 nwv[6];
#pragma unroll
    for (int q = 0; q < 6; ++q) nwv[q] = *(const f32x4*)(nw + 4 * q);
#pragma unroll
    for (int it = 0; it < 2; ++it) {
#pragma unroll
        for (int vt = 0; vt < 3; ++vt)
#pragma unroll
            for (int reg = 0; reg < 16; ++reg) Lw[crow(reg, lane) * 100 + 32 * vt + r] = acc[it][vt][reg];
        LDS_WAIT(); asm volatile("" ::: "memory");
#pragma unroll
        for (int ps = 0; ps < 2; ++ps) { const int rl = 16 * ps + rq, i = 32 * it + rl;
            f32x4 x[6]; u32x4 gw[3];
#pragma unroll
            for (int q = 0; q < 6; ++q) x[q] = *(const LAS f32x4*)(Lw + rl * 100 + 24 * q4 + 4 * q);
#pragma unroll
            for (int q = 0; q < 3; ++q) gw[q] = *(const u32x4*)(gp + (size_t)i * NPROJP + 8 * q);
            if (type == 1) { float sm = 0.f;
#pragma unroll
                for (int q = 0; q < 6; ++q) sm += (x[q][0] + x[q][1]) + (x[q][2] + x[q][3]);
                sm += lx_f(sm, lane, 1); sm += lx_f(sm, lane, 2);
                const float mean = sm * (1.0f / 96.0f);
#pragma unroll
                for (int q = 0; q < 6; ++q) x[q] = x[q] - mean; }
            float ss = 0.f;
#pragma unroll
            for (int q = 0; q < 6; ++q) ss += (x[q][0] * x[q][0] + x[q][1] * x[q][1]) + (x[q][2] * x[q][2] + x[q][3] * x[q][3]);
            ss += lx_f(ss, lane, 1); ss += lx_f(ss, lane, 2);
            const float rstd = 1.0f / sqrtf(ss * (1.0f / 96.0f) + NORM_EPS);
#pragma unroll
            for (int q = 0; q < 3; ++q) { const f32x4 xa = x[2 * q] * nwv[2 * q] * rstd, xb = x[2 * q + 1] * nwv[2 * q + 1] * rstd; const u32x4 g = gw[q];
                u32x4 o;
                o.x = pk2(xa[0] * siluf(bflo(g.x)), xa[1] * siluf(bfhi(g.x))); o.y = pk2(xa[2] * siluf(bflo(g.y)), xa[3] * siluf(bfhi(g.y)));
                o.z = pk2(xb[0] * siluf(bflo(g.z)), xb[1] * siluf(bfhi(g.z))); o.w = pk2(xb[2] * siluf(bflo(g.w)), xb[3] * siluf(bfhi(g.w)));
                *(u32x4*)(mp + (size_t)i * 1024 + 8 * q) = o; } }
        LDS_WAIT(); asm volatile("" ::: "memory");
    }
}

constexpr int S5_KT = 0, S5_EB = 33280, S5_CY = 66048;
__device__ __forceinline__ float gelu_tanh(float x) { const float u = 0.7978845608028654f * (x + 0.044715f * x * x * x); const float e = __expf(2.0f * u); const float th = 1.0f - 2.0f / (e + 1.0f); return 0.5f * x * (1.0f + th); }
__device__ __forceinline__ void s5_item(const Params& P, LAS unsigned char* lds, int l, int item) {
    unsigned char* const wsp = opaque_ptr(P.ws);
    const int tid = opaque_tid(), w = __builtin_amdgcn_readfirstlane(tid >> 6), lane = tid & 63, r = lane & 31, hh = lane >> 5;
    const int half = item & 1, b = item >> 5, g = (item >> 1) & 15, lg = l * 16 + g;
    const bf16_t* ub = (const bf16_t*)(wsp + WS_PROJ) + (size_t)b * SEQ * NPROJP + C_SU + g * 16 + 8 * hh;
    const bf16_t* ktg = (const bf16_t*)(wsp + WS_KTAB) + (size_t)lg * 65 * 256;
    const bf16_t* bpw = (const bf16_t*)(wsp + WS_BPOW) + (size_t)lg * 128 * 1024 + (size_t)((w & 3) * 32 + r) * 1024 + 8 * hh;
    const bf16_t* cpw = (const bf16_t*)(wsp + WS_CPOW) + (size_t)lg * 1024 * 128;
    for (int p = tid; p < 2080; p += NTHREADS) *(LAS u32x4*)(lds + S5_KT + p * 16) = *(const u32x4*)(ktg + p * 8);
    __syncthreads();
    f32x16 acc[2][2], eacc;
    const int nt0 = half ? (w + 8) : w, nt1 = half ? (w + 16) : (w + 24);
#pragma unroll
    for (int j = 0; j < 2; ++j)
#pragma unroll
        for (int mt = 0; mt < 2; ++mt)
#pragma unroll
            for (int i = 0; i < 16; ++i) acc[j][mt][i] = 0.f;
#pragma unroll
    for (int i = 0; i < 16; ++i) eacc[i] = 0.f;
    const int emt = w >> 2;
    const size_t arow0 = (size_t)(r * 64) * NPROJP, arow1 = (size_t)((32 + r) * 64) * NPROJP;
#define S5_LOAD(A0, A1, BP, s) do { A0 = *(const bf16x8*)(ub + arow0 + (size_t)(s) * NPROJP); A1 = *(const bf16x8*)(ub + arow1 + (size_t)(s) * NPROJP); BP = *(const bf16x8*)(bpw + (s) * 16); } while (0)
#define S5_STEP(A0, A1, BP, s) do { \
        _Pragma("unroll") for (int j = 0; j < 2; ++j) { const int t0 = 2 * (j ? nt1 : nt0); \
            if (t0 + 1 >= (s)) { const int tt = t0 + (r >> 4); const int tau = tt - (s); const int slot = tau < 0 ? 64 : tau; \
                const bf16x8 kb = *(const LAS bf16x8*)(lds + S5_KT + slot * 512 + (lane & 15) * 32 + hh * 16); \
                acc[j][0] = __builtin_amdgcn_mfma_f32_32x32x16_bf16(A0, kb, acc[j][0], 0, 0, 0); \
                acc[j][1] = __builtin_amdgcn_mfma_f32_32x32x16_bf16(A1, kb, acc[j][1], 0, 0, 0); } } \
        eacc = __builtin_amdgcn_mfma_f32_32x32x16_bf16(emt ? A1 : A0, BP, eacc, 0, 0, 0); } while (0)
    bf16x8 xa0, xa1, xbp, ya0, ya1, ybp;
    S5_LOAD(xa0, xa1, xbp, 0); S5_LOAD(ya0, ya1, ybp, 1);
#pragma unroll 1
    for (int s = 0; s < 64; s += 2) {
        S5_STEP(xa0, xa1, xbp, s);
        if (s + 2 < 64) S5_LOAD(xa0, xa1, xbp, s + 2);
        S5_STEP(ya0, ya1, ybp, s + 1);
        if (s + 3 < 64) S5_LOAD(ya0, ya1, ybp, s + 3);
    }
#undef S5_LOAD
#undef S5_STEP
#pragma unroll
    for (int reg = 0; reg < 16; ++reg) ((LAS float*)(lds + S5_EB))[(emt * 32 + crow(reg, lane)) * 128 + (w & 3) * 32 + r] = eacc[reg];
    __syncthreads();
    if (tid < 64) { const int p = tid; const float* l64 = (const float*)(wsp + WS_LAM64) + (size_t)(lg * 64 + p) * 2; const float ar = l64[0], ai = l64[1];
        float cr = 0.f, ci = 0.f;
#pragma unroll 1
        for (int n = 0; n < 64; ++n) {
            *(LAS bf16_t*)(lds + S5_CY + n * 272 + p * 2) = (bf16_t)f2bf(cr); *(LAS bf16_t*)(lds + S5_CY + n * 272 + (64 + p) * 2) = (bf16_t)f2bf(ci);
            const float er = ((const LAS float*)(lds + S5_EB))[n * 128 + p], ei = ((const LAS float*)(lds + S5_EB))[n * 128 + 64 + p];
            const float nr = ar * cr - ai * ci + er, ni = ar * ci + ai * cr + ei; cr = nr; ci = ni; } }
    __syncthreads();
#pragma unroll
    for (int j = 0; j < 2; ++j) { const bf16_t* cpr = cpw + (size_t)((j ? nt1 : nt0) * 32 + r) * 128 + 8 * hh;
#pragma unroll
        for (int ks = 0; ks < 8; ++ks) { const bf16x8 cb = *(const bf16x8*)(cpr + ks * 16);
            const bf16x8 c0 = *(const LAS bf16x8*)(lds + S5_CY + r * 272 + ks * 32 + hh * 16), c1 = *(const LAS bf16x8*)(lds + S5_CY + (32 + r) * 272 + ks * 32 + hh * 16);
            acc[j][0] = __builtin_amdgcn_mfma_f32_32x32x16_bf16(c0, cb, acc[j][0], 0, 0, 0);
            acc[j][1] = __builtin_amdgcn_mfma_f32_32x32x16_bf16(c1, cb, acc[j][1], 0, 0, 0); } }
    bf16_t* yb = (bf16_t*)(wsp + WS_YBUF) + (size_t)b * SEQ * 256 + g * 16 + (lane & 15);
#pragma unroll
    for (int j = 0; j < 2; ++j) { const int tt = 2 * (j ? nt1 : nt0) + (r >> 4);
#pragma unroll
        for (int mt = 0; mt < 2; ++mt)
#pragma unroll
            for (int reg = 0; reg < 16; ++reg) { const int n = mt * 32 + crow(reg, lane);
                yb[(size_t)(n * 64 + tt) * 256] = (bf16_t)f2bf(gelu_tanh(acc[j][mt][reg])); } }
    __syncthreads();
}

constexpr int RT_SC = 0, RT_SH = 4096, RT_RS = 8192, RT_PART = 8704, RT_CNT = 8704 + 2 * 128 * 33 * 4, RT_BASE = RT_CNT + 128, RT_TE = RT_BASE + 128, RT_TG = RT_TE + 2048, RT_TR = RT_TG + 2048;
__device__ __forceinline__ void router_phase(const Params& P, LAS unsigned char* lds, int l, int blk) {
    unsigned char* const wsp = opaque_ptr(P.ws);
    const int tid = opaque_tid(), w = __builtin_amdgcn_readfirstlane(tid >> 6), lane = tid & 63, r = lane & 31, hh = lane >> 5;
    const float* x = (const float*)(wsp + WS_X);
    bf16_t* hdn = (bf16_t*)(wsp + WS_HDN);
    const int tok0 = blk * 128, b = tok0 >> 12;
    const float* mrow = (const float*)(wsp + WS_MOD) + (size_t)(l * 8 + b) * 6144;
    int* gcount = (int*)(wsp + WS_CTL) + l * 32;
    int* stok = (int*)(wsp + WS_STOK); float* sgate = (float*)(wsp + WS_SGATE);
    LAS float* scL = (LAS float*)(lds + RT_SC); LAS float* shL = (LAS float*)(lds + RT_SH); LAS float* rsL = (LAS float*)(lds + RT_RS);
    for (int i = tid; i < 1024; i += NTHREADS) { scL[i] = P.norm2_w[l * 1024 + i] * (1.0f + mrow[4096 + i]); shL[i] = mrow[3072 + i]; }
    if (tid < 32) ((LAS int*)(lds + RT_CNT))[tid] = 0;
    __syncthreads();
    {
        f32x4 sc[4], sh[4];
#pragma unroll
        for (int j = 0; j < 4; ++j) { sc[j] = *(const LAS f32x4*)(scL + 4 * lane + 256 * j); sh[j] = *(const LAS f32x4*)(shL + 4 * lane + 256 * j); }
#pragma unroll 1
        for (int t4 = 0; t4 < 16; t4 += 4) {
            f32x4 v[4][4]; float ss[4];
#pragma unroll
            for (int u = 0; u < 4; ++u) { const size_t tok = (size_t)(tok0 + w * 16 + t4 + u);
#pragma unroll
                for (int j = 0; j < 4; ++j) v[u][j] = *(const f32x4*)(x + tok * 1024 + 4 * lane + 256 * j); }
#pragma unroll
            for (int u = 0; u < 4; ++u) { float a_ = 0.f;
#pragma unroll
                for (int j = 0; j < 4; ++j) a_ += (v[u][j][0] * v[u][j][0] + v[u][j][1] * v[u][j][1]) + (v[u][j][2] * v[u][j][2] + v[u][j][3] * v[u][j][3]);
                ss[u] = a_; }
#pragma unroll
            for (int o = 1; o < 64; o <<= 1) {
#pragma unroll
                for (int u = 0; u < 4; ++u) ss[u] += lx_f(ss[u], lane, o); }
#pragma unroll
            for (int u = 0; u < 4; ++u) { const int tl = w * 16 + t4 + u; const size_t tok = (size_t)(tok0 + tl);
                const float rstd = 1.0f / sqrtf(ss[u] * (1.0f / 1024.0f) + NORM_EPS);
                if (lane == 0) rsL[tl] = rstd;
#pragma unroll
                for (int j = 0; j < 4; ++j) { const f32x4 hv = v[u][j] * rstd * sc[j] + sh[j]; u32x2 pk; pk.x = pk2(hv[0], hv[1]); pk.y = pk2(hv[2], hv[3]);
                    *(u32x2*)(hdn + tok * 1024 + 4 * lane + 256 * j) = pk; } } }
    }
    __syncthreads();
    {
        const int mt = w & 3, kh = w >> 2;
        const float* xr = x + (size_t)(tok0 + 32 * mt + r) * 1024 + 512 * kh + 8 * hh;
        const bf16_t* wt = (const bf16_t*)(wsp + WS_RWT) + (size_t)l * 2 * 32 * 1024 + (size_t)r * 1024 + 512 * kh + 8 * hh;
        const float rs = rsL[32 * mt + r];
        f32x16 acc;
#pragma unroll
        for (int i = 0; i < 16; ++i) acc[i] = 0.f;
#pragma unroll 8
        for (int ks = 0; ks < 32; ++ks) {
            const f32x4 x0 = *(const f32x4*)(xr + 16 * ks), x1 = *(const f32x4*)(xr + 16 * ks + 4);
            const int kk = 512 * kh + 16 * ks + 8 * hh;
            const f32x4 c0 = *(const LAS f32x4*)(scL + kk), c1 = *(const LAS f32x4*)(scL + kk + 4), s0 = *(const LAS f32x4*)(shL + kk), s1 = *(const LAS f32x4*)(shL + kk + 4);
            const f32x4 h0 = x0 * rs * c0 + s0, h1 = x1 * rs * c1 + s1;
            unsigned ah[4], al[4];
            ah[0] = pk2(h0[0], h0[1]); ah[1] = pk2(h0[2], h0[3]); ah[2] = pk2(h1[0], h1[1]); ah[3] = pk2(h1[2], h1[3]);
            al[0] = pk2(h0[0] - bflo(ah[0]), h0[1] - bfhi(ah[0])); al[1] = pk2(h0[2] - bflo(ah[1]), h0[3] - bfhi(ah[1]));
            al[2] = pk2(h1[0] - bflo(ah[2]), h1[1] - bfhi(ah[2])); al[3] = pk2(h1[2] - bflo(ah[3]), h1[3] - bfhi(ah[3]));
            const bf16x8 bh = *(const bf16x8*)(wt + 16 * ks), bl = *(const bf16x8*)(wt + 32 * 1024 + 16 * ks);
            const bf16x8 fah = frag_from(ah[0], ah[1], ah[2], ah[3]), fal = frag_from(al[0], al[1], al[2], al[3]);
            acc = __builtin_amdgcn_mfma_f32_32x32x16_bf16(fah, bh, acc, 0, 0, 0);
            acc = __builtin_amdgcn_mfma_f32_32x32x16_bf16(fah, bl, acc, 0, 0, 0);
            acc = __builtin_amdgcn_mfma_f32_32x32x16_bf16(fal, bh, acc, 0, 0, 0);
        }
        LAS float* part = (LAS float*)(lds + RT_PART) + kh * 128 * 33;
#pragma unroll
        for (int reg = 0; reg < 16; ++reg) part[(32 * mt + crow(reg, lane)) * 33 + r] = acc[reg];
    }
    __syncthreads();
    if (tid < 128) {
        const LAS float* p0 = (const LAS float*)(lds + RT_PART) + tid * 33; const LAS float* p1 = p0 + 128 * 33;
        float v0 = -3.0e38f, v1 = -3.0e38f, v2 = -3.0e38f, v3 = -3.0e38f; int e0 = 0, e1 = 0, e2 = 0, e3 = 0;
#pragma unroll
        for (int e = 0; e < 32; ++e) { const float lg = p0[e] + p1[e] + P.router_b[l * 32 + e];
            if (lg > v3) { if (lg > v2) { v3 = v2; e3 = e2; if (lg > v1) { v2 = v1; e2 = e1; if (lg > v0) { v1 = v0; e1 = e0; v0 = lg; e0 = e; } else { v1 = lg; e1 = e; } } else { v2 = lg; e2 = e; } } else { v3 = lg; e3 = e; } } }
        const float x1 = __expf(v1 - v0), x2 = __expf(v2 - v0), x3 = __expf(v3 - v0), inv = 1.0f / (1.0f + x1 + x2 + x3);
        LAS int* cnt = (LAS int*)(lds + RT_CNT);
        LAS int* te = (LAS int*)(lds + RT_TE) + tid * 4; LAS float* tg = (LAS float*)(lds + RT_TG) + tid * 4; LAS int* tr = (LAS int*)(lds + RT_TR) + tid * 4;
        te[0] = e0; te[1] = e1; te[2] = e2; te[3] = e3; tg[0] = inv; tg[1] = x1 * inv; tg[2] = x2 * inv; tg[3] = x3 * inv;
        tr[0] = __hip_atomic_fetch_add(cnt + e0, 1, __ATOMIC_RELAXED, __HIP_MEMORY_SCOPE_WORKGROUP); tr[1] = __hip_atomic_fetch_add(cnt + e1, 1, __ATOMIC_RELAXED, __HIP_MEMORY_SCOPE_WORKGROUP);
        tr[2] = __hip_atomic_fetch_add(cnt + e2, 1, __ATOMIC_RELAXED, __HIP_MEMORY_SCOPE_WORKGROUP); tr[3] = __hip_atomic_fetch_add(cnt + e3, 1, __ATOMIC_RELAXED, __HIP_MEMORY_SCOPE_WORKGROUP);
    }
    __syncthreads();
    if (tid < 32) ((LAS int*)(lds + RT_BASE))[tid] = atomicAdd(gcount + tid, ((LAS int*)(lds + RT_CNT))[tid]);
    __syncthreads();
    { const int e = ((LAS int*)(lds + RT_TE))[tid]; const int pos = ((LAS int*)(lds + RT_BASE))[e] + ((LAS int*)(lds + RT_TR))[tid];
      stok[e * CAP + pos] = (tok0 + (tid >> 2)) * 4 + (tid & 3); sgate[e * CAP + pos] = ((LAS float*)(lds + RT_TG))[tid]; }
    __syncthreads();
}

__device__ __forceinline__ void combine_phase(const Params& P, int l, int gw, int ngw, int lane_in) {
    unsigned char* const wsp = opaque_ptr(P.ws);
    int lane = lane_in; asm volatile("" : "+v"(lane));
    float* x = (float*)(wsp + WS_X);
    const bf16_t* outr = (const bf16_t*)(wsp + WS_OUTR);
    bf16_t* hdn = (bf16_t*)(wsp + WS_HDN);
    for (int tok = gw; tok < T_TOK; tok += ngw) {
        const int b = tok >> 12;
        const float* mrow = (const float*)(wsp + WS_MOD) + (size_t)(l * 8 + b) * 6144;
        f32x4 v[4];
#pragma unroll
        for (int hf = 0; hf < 2; ++hf) { const int col = hf * 512 + 8 * lane;
            float s[8];
#pragma unroll
            for (int e = 0; e < 8; ++e) s[e] = 0.f;
#pragma unroll
            for (int k = 0; k < 4; ++k) { const u32x4 r4 = *(const u32x4*)(outr + ((size_t)tok * 4 + k) * 1024 + col);
                s[0] += bflo(r4.x); s[1] += bfhi(r4.x); s[2] += bflo(r4.y); s[3] += bfhi(r4.y); s[4] += bflo(r4.z); s[5] += bfhi(r4.z); s[6] += bflo(r4.w); s[7] += bfhi(r4.w); }
#pragma unroll
            for (int q = 0; q < 2; ++q) { const f32x4 xv = *(const f32x4*)(x + (size_t)tok * 1024 + col + 4 * q), g2 = *(const f32x4*)(mrow + 5120 + col + 4 * q);
                f32x4 o; o[0] = xv[0] + g2[0] * s[4 * q]; o[1] = xv[1] + g2[1] * s[4 * q + 1]; o[2] = xv[2] + g2[2] * s[4 * q + 2]; o[3] = xv[3] + g2[3] * s[4 * q + 3];
                v[hf * 2 + q] = o; if (l + 1 < NLAYER) *(f32x4*)(x + (size_t)tok * 1024 + col + 4 * q) = o; } }
        if (l + 1 < NLAYER) {
            const float* mnext = (const float*)(wsp + WS_MOD) + (size_t)((l + 1) * 8 + b) * 6144;
            norm_row_store(v, P.norm1_w + (l + 1) * 1024, mnext, mnext + 1024, hdn + (size_t)tok * 1024, lane);
        } else {
            float ss = 0.f;
#pragma unroll
            for (int j = 0; j < 4; ++j) ss += (v[j][0] * v[j][0] + v[j][1] * v[j][1]) + (v[j][2] * v[j][2] + v[j][3] * v[j][3]);
            const float rstd = 1.0f / sqrtf(wave_sum(ss, lane) * (1.0f / 1024.0f) + NORM_EPS);
#pragma unroll
            for (int hf = 0; hf < 2; ++hf)
#pragma unroll
                for (int q = 0; q < 2; ++q) { const int col = hf * 512 + 8 * lane + 4 * q; const f32x4 fw = *(const f32x4*)(P.final_norm_w + col);
                    f32x4 o; o[0] = v[hf * 2 + q][0] * rstd * fw[0]; o[1] = v[hf * 2 + q][1] * rstd * fw[1]; o[2] = v[hf * 2 + q][2] * rstd * fw[2]; o[3] = v[hf * 2 + q][3] * rstd * fw[3];
                    *(f32x4*)(P.out + (size_t)tok * 1024 + col) = o; }
        }
    }
}


#define XB_TMO      128
#define XB_XCNT(j)  (256  + 64 * (j))
#define XB_XSUB(j)  (1280 + 64 * (j))
#define XB_XGEN(j)  (2304 + 64 * (j))
#define XB_TOP      3328
#define XB_TOPGEN   3392
#define XCD_BAR_WORDS 3456
#define XB_SPIN_CAP (1u << 22)
__device__ __forceinline__ unsigned xb_ld(unsigned* p)              { return __hip_atomic_load(p, __ATOMIC_RELAXED, __HIP_MEMORY_SCOPE_AGENT); }
__device__ __forceinline__ unsigned xb_add(unsigned* p, unsigned v) { return __hip_atomic_fetch_add(p, v, __ATOMIC_RELAXED, __HIP_MEMORY_SCOPE_AGENT); }
__device__ __forceinline__ unsigned xb_xcc_id() { return (unsigned)__builtin_amdgcn_s_getreg((3 << 11) | 20) & 0xFu; }
#define XB_SPIN(cond, bar) do { unsigned _sp = 0; while (cond) { __builtin_amdgcn_s_sleep(1); \
    if ((++_sp & 255u) == 0u) { if (xb_ld(&(bar)[XB_TMO])) break; if (_sp > XB_SPIN_CAP) { atomicAdd(&(bar)[XB_TMO], 1u); break; } } } } while (0)
struct XcdBarrier { unsigned* bar; unsigned x; volatile LAS unsigned* st; };
__device__ __forceinline__ XcdBarrier xcd_barrier_post(unsigned* bar, volatile LAS unsigned* st) {
    XcdBarrier b; b.bar = bar; b.x = xb_xcc_id(); b.st = st;
    if (threadIdx.x == 0) (void)xb_add(&bar[XB_XCNT(b.x)], 1u);
    return b;
}
__device__ __forceinline__ void xcd_barrier_complete(unsigned* bar, unsigned x, unsigned& nloc, unsigned& nx) {
    const unsigned G = gridDim.x * gridDim.y * gridDim.z;
    unsigned sum, cnt, mine, sp = 0u;
    for (;;) {
        sum = 0u; cnt = 0u; mine = 0u;
#pragma unroll
        for (unsigned j = 0; j < 16; ++j) { const unsigned c = xb_ld(&bar[XB_XCNT(j)]); sum += c; cnt += (c > 0u) ? 1u : 0u; mine = (j == x) ? c : mine; }
        if (sum == G) break;
        __builtin_amdgcn_s_sleep(1);
        if ((++sp & 255u) == 0u) { if (xb_ld(&bar[XB_TMO])) break; if (sp > XB_SPIN_CAP) { atomicAdd(&bar[XB_TMO], 1u); break; } }
    }
    nloc = mine > 0u ? mine : 1u; nx = cnt > 0u ? cnt : 1u;
}
__device__ __forceinline__ void xcd_barrier(const XcdBarrier& b) {
    asm volatile("s_waitcnt vmcnt(0)" ::: "memory");
    __syncthreads();
    if (threadIdx.x == 0) {
        unsigned* bar = b.bar;
        __builtin_amdgcn_s_waitcnt(0);
        unsigned nloc = b.st[0], nx = b.st[1];
        if (nloc == 0u) { xcd_barrier_complete(bar, b.x, nloc, nx); b.st[0] = nloc; b.st[1] = nx; }
        const unsigned old = xb_add(&bar[XB_XSUB(b.x)], 1u);
        const unsigned gen = old / nloc;
        if (old + 1u == (gen + 1u) * nloc) {
            __builtin_amdgcn_fence(__ATOMIC_RELEASE, "agent");
            asm volatile("s_waitcnt vmcnt(0)" ::: "memory");
            const unsigned og = xb_add(&bar[XB_TOP], 1u);
            const unsigned tg = og / nx;
            if (og + 1u == (tg + 1u) * nx) xb_add(&bar[XB_TOPGEN], 1u);
            else XB_SPIN(xb_ld(&bar[XB_TOPGEN]) == tg, bar);
            __builtin_amdgcn_fence(__ATOMIC_ACQUIRE, "agent");
            xb_add(&bar[XB_XGEN(b.x)], 1u);
            asm volatile("s_waitcnt vmcnt(0)" ::: "memory");
        } else {
            XB_SPIN(xb_ld(&bar[XB_XGEN(b.x)]) == gen, bar);
            __builtin_amdgcn_fence(__ATOMIC_ACQUIRE, "agent");
            asm volatile("s_waitcnt vmcnt(0)" ::: "memory");
        }
    }
    __syncthreads();
}

#ifndef PH
#define PH 0xFFFF
#endif
#define PHON(b) ((((PH) >> (b)) & 1) != 0)
#ifndef TIME_PHASE
#define TIME_PHASE -1
#endif
#define TIME_MULT 4
#if TIME_PHASE >= 0
#define PH_T0(k) do { if ((k) == TIME_PHASE && bid == 0) t_ph = __builtin_amdgcn_s_memrealtime(); } while (0)
#define PH_T1(k) do { if ((k) == TIME_PHASE && bid == 0) { const unsigned long long t1_ = __builtin_amdgcn_s_memrealtime(), d_ = t1_ - t_ph; while (__builtin_amdgcn_s_memrealtime() - t1_ < (unsigned long long)TIME_MULT * d_) __builtin_amdgcn_s_sleep(8); } } while (0)
#else
#define PH_T0(k) do { } while (0)
#define PH_T1(k) do { } while (0)
#endif
__global__ void __launch_bounds__(NTHREADS, 2) fwd_megakernel(Params P) {
    extern __shared__ __attribute__((aligned(16))) unsigned char lds_raw[];
    LAS unsigned char* const lds0 = (LAS unsigned char*)lds_raw;
    cg::grid_group grid = cg::this_grid();
    const int G = gridDim.x, bid = blockIdx.x;
    const int vcu = (G % 8 == 0) ? (bid % 8) * (G / 8) + bid / 8 : bid;
    const int ngw = G * NWAVES;
    unsigned long long t_ph = 0; (void)t_ph;
    const unsigned long long t_entry = (TIME_PHASE == 99) ? __builtin_amdgcn_s_memrealtime() : 0ull; (void)t_entry;
    if (threadIdx.x < 4) ((LAS unsigned*)(lds0 + LDS_BYTES - 16))[threadIdx.x] = 0u;
    __syncthreads();
    (void)xcd_barrier_post((unsigned*)(P.ws + WS_BAR), (volatile LAS unsigned*)(lds0 + LDS_BYTES - 16));
#define GSYNC() do { XcdBarrier xb_; xb_.bar = (unsigned*)(opaque_ptr(P.ws) + WS_BAR); xb_.x = xb_xcc_id(); xb_.st = (volatile LAS unsigned*)(opaque_lds(lds0) + LDS_BYTES - 16); xcd_barrier(xb_); } while (0)
#define KTID() const int tid = opaque_tid(), wave = __builtin_amdgcn_readfirstlane(tid >> 6), lane = tid & 63, gw = bid * NWAVES + wave; (void)lane; (void)gw

    PH_T0(0);
    { KTID(); unsigned char* const ws = opaque_ptr(P.ws); LAS unsigned char* const lds = opaque_lds(lds0); (void)lds;
    if (bid == 0 && tid < 64) ((int*)(ws + WS_CTL))[tid] = 0;
    if (PHON(0)) for (int it = bid; it < 128 + 192; it += G) { if (it < 128) s5_tables_item(P, lds, it); else mod_item(P, lds, it - 128); }
    rope_table(P, bid * NTHREADS + tid, G * NTHREADS);
    for (int i = bid * NTHREADS + tid; i < 2 * 32 * 1024; i += G * NTHREADS) { const int k_ = i & 1023, e_ = (i >> 10) & 31, l_ = i >> 15; const float wv_ = P.router_w[(size_t)l_ * 1024 * 32 + k_ * 32 + e_];
        const unsigned hw_ = f2bf(wv_); bf16_t* rt_ = (bf16_t*)(ws + WS_RWT) + (size_t)l_ * 2 * 32 * 1024 + e_ * 1024 + k_; rt_[0] = (bf16_t)hw_; rt_[32 * 1024] = (bf16_t)f2bf(wv_ - __builtin_bit_cast(float, hw_ << 16)); }
    for (int i = bid * NTHREADS + tid; i < 2 * 4 * 64 * 16; i += G * NTHREADS) { const int rr = i & 15, dd = (i >> 4) & 63, hh_ = (i >> 10) & 3, ll = i >> 12;
        ((bf16_t*)(ws + WS_WA2T))[i] = (dd < 48) ? (bf16_t)f2bf(P.gla_w_a2[(size_t)ll * 16 * 192 + rr * 192 + hh_ * 48 + dd]) : (bf16_t)0; }
    __syncthreads();
    if (PHON(1)) transpose_small(P, lds, gw, ngw, wave, lane); }
    if (P.ws == nullptr) grid.sync();
    GSYNC(); PH_T1(0); PH_T0(1);
    { KTID(); unsigned char* const ws = opaque_ptr(P.ws); LAS unsigned char* const lds = opaque_lds(lds0); (void)lds;
    for (int tok = gw; tok < T_TOK; tok += ngw) {
        const float* mrow = (const float*)(ws + WS_MOD) + (size_t)(tok >> 12) * 6144;
        f32x4 v[4];
#pragma unroll
        for (int hf = 0; hf < 2; ++hf)
#pragma unroll
            for (int q = 0; q < 2; ++q) v[hf * 2 + q] = *(const f32x4*)(P.x + (size_t)tok * 1024 + hf * 512 + 8 * lane + 4 * q);
        norm_row_store(v, P.norm1_w, mrow, mrow + 1024, (bf16_t*)(ws + WS_HDN) + (size_t)tok * 1024, lane);
    } }
    GSYNC(); PH_T1(1);
#pragma unroll 1
    for (int l = 0; l < NLAYER; ++l) {
        PH_T0(2);
        if (PHON(2)) { unsigned char* const ws = opaque_ptr(P.ws); LAS unsigned char* const lds = opaque_lds(lds0); (void)lds; DenseOrder S; S.init(T_TOK, NPROJP, 1024, G, bid, ws + WS_HDN, (const bf16_t*)(ws + WS_WIN) + (size_t)l * NPROJP * 1024);
          EpiProj E{(bf16_t*)(ws + WS_PROJ), NPROJP};
          gm::gemm_phase<EpiProj, DenseOrder, false>(lds, 1024, S, E); }
        GSYNC(); PH_T1(2); PH_T0(3);
        { LAS unsigned char* const lds = opaque_lds(lds0);
#define SUBT0(k, b) do { if (TIME_PHASE == (k) && bid == (b)) t_ph = __builtin_amdgcn_s_memrealtime(); } while (0)
#define SUBT1(k, b) do { if (TIME_PHASE == (k) && bid == (b)) { const unsigned long long t1_ = __builtin_amdgcn_s_memrealtime(), d_ = t1_ - t_ph; while (__builtin_amdgcn_s_memrealtime() - t1_ < (unsigned long long)TIME_MULT * d_) __builtin_amdgcn_s_sleep(8); } } while (0)
          SUBT0(20, 0);
          if (PHON(3)) for (int rd = bid; rd < 2048; rd += G) mixer_phase_a(P, lds, l, rd);
          SUBT1(20, 0); SUBT0(21, 0);
          if (PHON(4)) for (int it = bid; it < 256; it += G) s5_item(P, lds, l, it);
          SUBT1(21, 0); SUBT0(22, 0);
          { KTID(); transpose_moe(P, lds, l, gw, ngw, wave, lane); }
          SUBT1(22, 0); }
        GSYNC(); PH_T1(3); PH_T0(4);
        if (PHON(3)) mixer_phase_b(P, bid, G);
        GSYNC(); PH_T1(4); PH_T0(5);
        if (PHON(5)) { unsigned char* const ws = opaque_ptr(P.ws); LAS unsigned char* const lds = opaque_lds(lds0); (void)lds; DenseOrder S; S.init(T_TOK, 256, 256, G, bid, ws + WS_YBUF, (const bf16_t*)(ws + WS_WGLU) + (size_t)l * 256 * 256);
          EpiGlu E{(const bf16_t*)(ws + WS_YBUF), (bf16_t*)(ws + WS_MIXED), P.s5_b_glu + l * 256};
          gm::gemm_phase<EpiGlu, DenseOrder, false>(lds, 256, S, E); }
        if (PHON(3)) { KTID(); LAS unsigned char* const lds = opaque_lds(lds0); for (int it = gw; it < 4096; it += ngw) mixer_phase_c(P, lds, l, it); }
        GSYNC(); PH_T1(5); PH_T0(6);
        if (PHON(6)) { unsigned char* const ws = opaque_ptr(P.ws); LAS unsigned char* const lds = opaque_lds(lds0); (void)lds; const float* modl = (const float*)(ws + WS_MOD) + (size_t)l * 8 * 6144; DenseOrder S; S.init(T_TOK, 1024, 1024, G, bid, ws + WS_MIXED, (const bf16_t*)(ws + WS_WOUT) + (size_t)l * 1024 * 1024);
          EpiOut E{l == 0 ? P.x : (const float*)(ws + WS_X), (float*)(ws + WS_X), modl + 2048};
          gm::gemm_phase<EpiOut, DenseOrder, false>(lds, 1024, S, E); }
        GSYNC(); PH_T1(6); PH_T0(7);
        if (PHON(7)) { LAS unsigned char* const lds = opaque_lds(lds0); for (int blk = bid; blk < T_TOK / 128; blk += G) router_phase(P, lds, l, blk); }
        GSYNC(); PH_T1(7); PH_T0(8);
        if (PHON(8)) { unsigned char* const ws = opaque_ptr(P.ws); LAS unsigned char* const lds = opaque_lds(lds0); (void)lds; moe_tables(lds, (const int*)(ws + WS_CTL) + l * 32, 8);
          MoeOrder<true> S; S.tab = (LAS const int*)(lds + MISC_OFF); S.nN = 8; S.G = G; S.vc = vcu; S.Wt = (const char*)(ws + WS_WUP) + (size_t)l * 32 * 2048 * 1024 * 2; S.wstride = (size_t)2048 * 1024 * 2; S.stok = (const int*)(ws + WS_STOK); S.A = (const char*)(ws + WS_HDN); S.gtab = (LAS const unsigned*)(lds + GT_OFF);
          S.fill_gather((LAS unsigned*)(lds + GT_OFF));
          EpiUp E{(bf16_t*)(ws + WS_ACT), P.b_up + (size_t)l * 32 * 2048, (LAS const int*)(lds + MISC_OFF)};
          gm::gemm_phase<EpiUp, MoeOrder<true>, true>(lds, 1024, S, E); }
        GSYNC(); PH_T1(8); PH_T0(9);
        if (PHON(9)) { unsigned char* const ws = opaque_ptr(P.ws); LAS unsigned char* const lds = opaque_lds(lds0); (void)lds; moe_tables(lds, (const int*)(ws + WS_CTL) + l * 32, 4);
          MoeOrder<false> S; S.tab = (LAS const int*)(lds + MISC_OFF); S.nN = 4; S.G = G; S.vc = vcu; S.Wt = (const char*)(ws + WS_WDN) + (size_t)l * 32 * 1024 * 1024 * 2; S.wstride = (size_t)1024 * 1024 * 2; S.stok = nullptr; S.A = (const char*)(ws + WS_ACT); S.gtab = nullptr;
          EpiDown E{(bf16_t*)(ws + WS_OUTR), P.b_down + (size_t)l * 32 * 1024, (const int*)(ws + WS_STOK), (const float*)(ws + WS_SGATE)};
          gm::gemm_phase<EpiDown, MoeOrder<false>, false>(lds, 1024, S, E); }
        GSYNC(); PH_T1(9); PH_T0(10);
        if (PHON(10)) { KTID(); combine_phase(P, l, gw, ngw, lane); }
        GSYNC(); PH_T1(10);
    }
    if (TIME_PHASE == 99 && bid == 0) { const unsigned long long t1_ = __builtin_amdgcn_s_memrealtime(), d_ = t1_ - t_entry; while (__builtin_amdgcn_s_memrealtime() - t1_ < d_) __builtin_amdgcn_s_sleep(8); }
}

extern "C" void kernel_launch(void* const* d_in, const int* in_sizes, int n_in, void* d_out, int out_size, void* d_ws, size_t ws_size, hipStream_t stream) {
    static int grid_blocks = 0;
    if (grid_blocks == 0) {
        if (n_in != 29 || ws_size < WS_END) { fprintf(stderr, "kernel_launch: unexpected n_in %d or ws_size %zu (need %zu)\n", n_in, ws_size, (size_t)WS_END); grid_blocks = -1; return; }
        int dev = 0, cus = 0, per_cu = 0;
        (void)hipGetDevice(&dev);
        (void)hipDeviceGetAttribute(&cus, hipDeviceAttributeMultiprocessorCount, dev);
        (void)hipFuncSetAttribute((const void*)fwd_megakernel, hipFuncAttributeMaxDynamicSharedMemorySize, LDS_BYTES);
        (void)hipOccupancyMaxActiveBlocksPerMultiprocessor(&per_cu, (const void*)fwd_megakernel, NTHREADS, LDS_BYTES);
        if (per_cu < 1) { fprintf(stderr, "kernel_launch: occupancy query returned %d\n", per_cu); per_cu = 1; }
        grid_blocks = cus;
        fprintf(stderr, "kernel_launch: cus %d per_cu %d grid %d ws_need %zu\n", cus, per_cu, grid_blocks, (size_t)WS_END);
    }
    if (grid_blocks < 0) return;
    Params p{};
    const float** pp = (const float**)&p;
    for (int i = 0; i < 29; ++i) pp[i] = (const float*)d_in[i];
    p.out = (float*)d_out; p.ws = (unsigned char*)d_ws;
    for (int i = 0; i < 24; ++i) p.inv_freq_rev[i] = pow(10000.0, -(double)(2 * i) / 48.0) / 6.283185307179586476925;
    for (int h = 0; h < 4; ++h) p.log_gamma[h] = (float)log1p(-exp2(-5.0 - (double)h));
    (void)hipMemsetAsync((char*)d_ws + WS_CTL, 0, WS_CTL_BYTES, stream);
    void* args[] = {&p};
    hipError_t e = hipLaunchCooperativeKernel((const void*)fwd_megakernel, dim3(grid_blocks), dim3(NTHREADS), args, LDS_BYTES, stream);
    if (e != hipSuccess) fprintf(stderr, "cooperative launch failed: %s (grid %d)\n", hipGetErrorString(e), grid_blocks);
}
```

```cpp
#include <hip/hip_runtime.h>
#include <hip/hip_cooperative_groups.h>
#include <cstdio>
#include <cstdint>
#include <cmath>
namespace cg = cooperative_groups;

#define LAS __attribute__((address_space(3)))
typedef unsigned short bf16_t;
typedef short bf16x8 __attribute__((ext_vector_type(8)));
typedef float f32x4 __attribute__((ext_vector_type(4)));
typedef float f32x16 __attribute__((ext_vector_type(16)));
typedef unsigned u32x4 __attribute__((ext_vector_type(4)));
typedef unsigned u32x2 __attribute__((ext_vector_type(2)));

constexpr int T_TOK = 32768, DM = 1024, NBATCH = 8, SEQ = 4096, NLAYER = 2;
constexpr int NPROJ = 2576, NPROJP = 2816;
constexpr int NE = 32, CAP = 32768, NSLOT = T_TOK * 4;
constexpr int C_GQ = 0, C_GK = 192, C_GV = 384, C_GG = 768, C_GA = 1152, C_RQ = 1168, C_RK = 1360, C_RV = 1552, C_RG = 1936, C_SU = 2320;
constexpr float NORM_EPS = 1e-5f;
constexpr int NTHREADS = 512, NWAVES = 8;
constexpr int LDS_BYTES = 160 * 1024;
constexpr int MISC_OFF = 148 * 1024;

constexpr size_t al256(size_t x) { return (x + 255) & ~(size_t)255; }
constexpr size_t WS_CTL   = 0;
constexpr size_t WS_BAR   = 4096;
constexpr size_t WS_CTL_BYTES = 32768;
constexpr size_t WS_MOD   = 32768;
constexpr size_t WS_WIN   = al256(WS_MOD + (size_t)2 * 8 * 6144 * 4);
constexpr size_t WS_WOUT  = al256(WS_WIN + (size_t)2 * NPROJP * 1024 * 2);
constexpr size_t WS_WUP   = al256(WS_WOUT + (size_t)2 * 1024 * 1024 * 2);
constexpr size_t WS_WDN   = al256(WS_WUP + (size_t)2 * 32 * 2048 * 1024 * 2);
constexpr size_t WS_WGLU  = al256(WS_WDN + (size_t)2 * 32 * 1024 * 1024 * 2);
constexpr size_t WS_KTAB  = al256(WS_WGLU + (size_t)2 * 256 * 256 * 2);
constexpr size_t WS_BPOW  = al256(WS_KTAB + (size_t)2 * 16 * 65 * 256 * 2);
constexpr size_t WS_CPOW  = al256(WS_BPOW + (size_t)2 * 16 * 128 * 1024 * 2);
constexpr size_t WS_LAM64 = al256(WS_CPOW + (size_t)2 * 16 * 1024 * 128 * 2);
constexpr size_t WS_ROPE  = al256(WS_LAM64 + (size_t)2 * 16 * 64 * 2 * 4);
constexpr size_t WS_WA2T  = al256(WS_ROPE + (size_t)4096 * 24 * 2 * 4);
constexpr size_t WS_RWT   = al256(WS_WA2T + (size_t)2 * 4 * 64 * 16 * 2);
constexpr size_t WS_X     = al256(WS_RWT + (size_t)2 * 2 * 32 * 1024 * 2);
constexpr size_t WS_HDN   = al256(WS_X + (size_t)T_TOK * 1024 * 4);
constexpr size_t WS_PROJ  = al256(WS_HDN + (size_t)T_TOK * 1024 * 2);
constexpr size_t WS_MIXED = al256(WS_PROJ + (size_t)T_TOK * NPROJP * 2);
constexpr size_t WS_YBUF  = al256(WS_MIXED + (size_t)T_TOK * 1024 * 2);
constexpr size_t WS_ACT   = al256(WS_YBUF + (size_t)T_TOK * 256 * 2);
constexpr size_t WS_OUTR  = al256(WS_ACT + (size_t)(NSLOT + 256) * 1024 * 2);
constexpr size_t WS_STOK  = al256(WS_OUTR + (size_t)NSLOT * 1024 * 2);
constexpr size_t WS_SGATE = al256(WS_STOK + (size_t)NE * CAP * 4);
constexpr size_t MXW_QD = WS_ACT, MXW_OI = WS_ACT + ((size_t)32 << 20), MXW_DS = WS_ACT + ((size_t)96 << 20), MXW_DEC = WS_ACT + ((size_t)176 << 20), MXW_SP = WS_ACT + ((size_t)180 << 20);
constexpr size_t WS_END   = al256(WS_SGATE + (size_t)NE * CAP * 4);

struct Params {
    const float* x; const float* c; const float* norm1_w; const float* norm2_w; const float* w_mod; const float* b_mod;
    const float* w_in; const float* gla_w_a2; const float* gla_b_a; const float* gla_norm_w; const float* ret_norm_w;
    const float* s5_a_re; const float* s5_a_im; const float* s5_log_dt; const float* s5_b_re; const float* s5_b_im;
    const float* s5_c_re; const float* s5_c_im; const float* s5_d; const float* s5_w_glu; const float* s5_b_glu;
    const float* w_out; const float* router_w; const float* router_b; const float* w_up; const float* b_up;
    const float* w_down; const float* b_down; const float* final_norm_w;
    float* out; unsigned char* ws;
    double inv_freq_rev[24];
    float log_gamma[4]; float pad0[4];
};

__device__ __forceinline__ unsigned f2bf(float f) { unsigned u = __builtin_bit_cast(unsigned, f); return (u + 0x7fffu + ((u >> 16) & 1u)) >> 16; }
typedef float f32x2_t __attribute__((ext_vector_type(2)));
typedef __bf16 bf16x2_t __attribute__((ext_vector_type(2)));
__device__ __forceinline__ unsigned pk2(float lo, float hi) { const f32x2_t v = {lo, hi}; const bf16x2_t b = __builtin_convertvector(v, bf16x2_t); return __builtin_bit_cast(unsigned, b); }
__device__ __forceinline__ float bflo(unsigned w) { return __builtin_bit_cast(float, w << 16); }
__device__ __forceinline__ float bfhi(unsigned w) { return __builtin_bit_cast(float, w & 0xffff0000u); }
__device__ __forceinline__ float bf2f(bf16_t b) { return __builtin_bit_cast(float, (unsigned)b << 16); }
__device__ __forceinline__ float lx_f(float v, int lane, int o) { return __builtin_bit_cast(float, __builtin_amdgcn_ds_bpermute((lane ^ o) << 2, __builtin_bit_cast(int, v))); }
__device__ __forceinline__ int lx_i(int v, int lane, int o) { return __builtin_amdgcn_ds_bpermute((lane ^ o) << 2, v); }
__device__ __forceinline__ float lidx_f(float v, int src) { return __builtin_bit_cast(float, __builtin_amdgcn_ds_bpermute(src << 2, __builtin_bit_cast(int, v))); }
__device__ __forceinline__ float wave_sum(float v, int lane) {
#pragma unroll
    for (int o = 1; o < 64; o <<= 1) v += lx_f(v, lane, o);
    return v;
}
__device__ __forceinline__ float sigmoidf_(float x) { return __builtin_amdgcn_rcpf(1.0f + __builtin_amdgcn_exp2f(-1.4426950408889634f * x)); }
__device__ __forceinline__ float siluf(float x) { return x * sigmoidf_(x); }
#define LDS_WAIT() asm volatile("s_waitcnt lgkmcnt(0)" ::: "memory")
__device__ __forceinline__ unsigned char* opaque_ptr(unsigned char* p) { const unsigned long long v = (unsigned long long)p; unsigned lo = __builtin_amdgcn_readfirstlane((unsigned)v), hi = __builtin_amdgcn_readfirstlane((unsigned)(v >> 32));
    asm volatile("" : "+s"(lo), "+s"(hi)); return (unsigned char*)(__attribute__((address_space(1))) unsigned char*)(((unsigned long long)hi << 32) | lo); }
__device__ __forceinline__ LAS unsigned char* opaque_lds(LAS unsigned char* p) { unsigned v = __builtin_amdgcn_readfirstlane((unsigned)(size_t)p); asm volatile("" : "+s"(v)); return (LAS unsigned char*)(size_t)v; }
__device__ __forceinline__ int opaque_tid() { int t = threadIdx.x; asm volatile("" : "+v"(t)); return t; }

namespace gm {
constexpr int BM = 256, BK = 64, HALF = 128, HTB = HALF * BK * 2, STAGE_BYTES = 8 * HTB, NXCD = 8, WGM = 8;
__device__ __forceinline__ int lds_byte(int r, int c) { const int st = (r >> 4) * 2 + (c >> 5), rr = r & 15, cc = c & 31, ob = rr * 64 + cc * 2; return st * 1024 + (ob ^ (((ob >> 9) & 1) << 5)); }
__device__ __forceinline__ void stage_rc(int b, int& R, int& C) { const int st = b / 1024, sb = b % 1024, swz = sb ^ (((sb >> 9) & 1) << 5); R = (st >> 1) * 16 + swz / 64; C = (st & 1) * 32 + (swz % 64) / 2; }
__device__ __forceinline__ int perm32(int rho) { const int n = rho >> 4, i = rho & 15; return 8 * (i >> 2) + 4 * n + (i & 3); }

struct Unit { const char* B; int pm, pn, e, rows; };

template <class Epi, class Sched, bool GATHER>
__device__ __forceinline__ void gemm_phase(LAS unsigned char* lds, const int K_in, const Sched& S, const Epi& E) {
    int K = K_in; asm volatile("" : "+s"(K));
    const int tid = opaque_tid(), wid = __builtin_amdgcn_readfirstlane(tid >> 6), lane = tid & 63, wr = wid >> 2, wc = wid & 3, fr = lane & 15, fq = lane >> 4;
    const int nt = K / BK;
    int R0, C0; unsigned voffB;
    { stage_rc(tid * 16, R0, C0);
      const int Rb0 = Epi::PERM ? ((R0 & ~31) + perm32(R0 & 31)) : R0;
      voffB = (unsigned)(Rb0 * K + C0) * 2u; }
    const size_t kstep = (size_t)(BK * 2);
    const size_t hstep = (size_t)HALF * K * 2;
    const size_t qstep = (size_t)64 * K * 2;
    const unsigned ldsw = (unsigned)wid * 1024u;
    const int aoff = lds_byte(wr * 64 + fr, fq * 8), boff = lds_byte(wc * 32 + fr, fq * 8);
#define G_SA(b, h) (((b) * 2 + (h)) * gm::HTB)
#define G_SB(b, h) ((4 + (b) * 2 + (h)) * gm::HTB)
#define G_GLDS(gptr, ldsoff) __builtin_amdgcn_global_load_lds((const unsigned*)(gptr), (LAS unsigned*)(lds + (ldsoff)), 16, 0, 0)
#define G_STAGEB(bufoff, gbase) do { G_GLDS((const char*)(gbase) + voffB, (bufoff) + ldsw); G_GLDS((const char*)(gbase) + qstep + voffB, (bufoff) + ldsw + 8192); } while (0)
#define G_STAGEA(bufoff, ubase, h, o0, o1) do { if (GATHER) { G_GLDS((const char*)(ubase) + (o0), (bufoff) + ldsw); G_GLDS((const char*)(ubase) + (o1), (bufoff) + ldsw + 8192); } \
        else { G_GLDS((const char*)(ubase) + (h) * hstep + (o0), (bufoff) + ldsw); G_GLDS((const char*)(ubase) + (h) * hstep + qstep + (o0), (bufoff) + ldsw + 8192); } } while (0)
#define G_LDA(dst, b, h) do { _Pragma("unroll") for (int m = 0; m < 4; ++m) _Pragma("unroll") for (int k = 0; k < 2; ++k) dst[m][k] = *(const LAS bf16x8*)(lds + G_SA(b, h) + aoff + m * 2048 + k * 1024); } while (0)
#define G_LDB(dst, b, h) do { _Pragma("unroll") for (int n = 0; n < 2; ++n) _Pragma("unroll") for (int k = 0; k < 2; ++k) dst[n][k] = *(const LAS bf16x8*)(lds + G_SB(b, h) + boff + n * 2048 + k * 1024); } while (0)
#define G_MMA(ai, bj, At, Bt) do { __builtin_amdgcn_s_setprio(1); _Pragma("unroll") for (int m = 0; m < 4; ++m) _Pragma("unroll") for (int n = 0; n < 2; ++n) _Pragma("unroll") for (int k = 0; k < 2; ++k) \
        acc[ai][bj][m][n] = __builtin_amdgcn_mfma_f32_16x16x32_bf16(Bt[n][k], At[m][k], acc[ai][bj][m][n], 0, 0, 0); __builtin_amdgcn_s_setprio(0); } while (0)
#define G_WAIT_V(n) asm volatile("s_waitcnt vmcnt(" #n ")" ::: "memory")
#define G_WAIT_L(n) asm volatile("s_waitcnt lgkmcnt(" #n ")" ::: "memory")
#define G_BAR __builtin_amdgcn_s_barrier()
#define G_SCHED __builtin_amdgcn_sched_barrier(0)
    Unit cur, nxt; int ui = 0;
    if (!S.next(0, cur)) return;
    f32x4 acc[2][2][4][2];
#pragma unroll
    for (int a = 0; a < 2; ++a)
#pragma unroll
        for (int b = 0; b < 2; ++b)
#pragma unroll
            for (int m = 0; m < 4; ++m)
#pragma unroll
                for (int n = 0; n < 2; ++n) acc[a][b][m][n] = (f32x4){0.f, 0.f, 0.f, 0.f};
    bf16x8 At[4][2], B0[2][2], B1[2][2];
    unsigned c00, c01 = 0, c10 = 0, c11 = 0;
    c00 = S.a_off(0, R0, C0);
    if (GATHER) { c01 = S.a_off(0, R0 + 64, C0); c10 = S.a_off(0, R0 + 128, C0); c11 = S.a_off(0, R0 + 192, C0); }
    const char* cA = S.a_base(cur); const char* cB = cur.B;
    G_STAGEB(G_SB(0, 0), cB); G_STAGEB(G_SB(0, 1), cB + hstep); G_STAGEA(G_SA(0, 0), cA, 0, c00, c01); G_STAGEA(G_SA(0, 1), cA, 1, c10 + (GATHER ? 0u : c00), c11);
    if (wr == 1) G_BAR;
    G_WAIT_V(2); G_BAR;
    G_STAGEB(G_SB(1, 0), cB + kstep); G_STAGEA(G_SA(1, 0), cA + kstep, 0, c00, c01); G_STAGEB(G_SB(1, 1), cB + hstep + kstep);
    G_WAIT_V(6); G_BAR;
    for (;;) {
        const bool has_next = S.next(ui + 1, nxt);
        const char* nB = cB; const char* nA = cA;
        if (has_next) { nB = nxt.B; nA = S.a_base(nxt); }
        for (int t = 0; t < nt; t += 2) {
            const bool last = (t == nt - 2);
            const char* a1 = cA + (size_t)(t + 1) * kstep;
            const char* a2 = last ? nA : cA + (size_t)(t + 2) * kstep;
            const char* b2 = last ? nB : cB + (size_t)(t + 2) * kstep;
            G_LDB(B0, 0, 0); G_LDB(B1, 0, 1); G_SCHED; G_LDA(At, 0, 0); G_STAGEA(G_SA(1, 1), a1, 1, c10 + (GATHER ? 0u : c00), c11);
            G_WAIT_V(8); G_WAIT_L(0); G_BAR; G_MMA(0, 0, At, B0); G_MMA(0, 1, At, B1); G_BAR; G_SCHED;
            if (GATHER) { if (last && has_next) { c00 = S.a_off(ui + 1, R0, C0); c01 = S.a_off(ui + 1, R0 + 64, C0); c10 = S.a_off(ui + 1, R0 + 128, C0); c11 = S.a_off(ui + 1, R0 + 192, C0); } }
            G_LDA(At, 0, 1); G_STAGEB(G_SB(0, 0), b2); G_STAGEB(G_SB(0, 1), b2 + hstep); G_STAGEA(G_SA(0, 0), a2, 0, c00, c01);
            G_WAIT_V(8); G_WAIT_L(0); G_BAR; G_MMA(1, 0, At, B0); G_MMA(1, 1, At, B1); G_BAR; G_SCHED;
            G_LDB(B0, 1, 0); G_LDB(B1, 1, 1); G_SCHED; G_LDA(At, 1, 0); G_STAGEA(G_SA(0, 1), a2, 1, c10 + (GATHER ? 0u : c00), c11);
            G_WAIT_V(8); G_WAIT_L(0); G_BAR; G_MMA(0, 0, At, B0); G_MMA(0, 1, At, B1); G_BAR; G_SCHED;
            G_LDA(At, 1, 1); G_STAGEB(G_SB(1, 0), b2 + kstep); G_STAGEB(G_SB(1, 1), b2 + kstep + hstep); G_STAGEA(G_SA(1, 0), a2 + kstep, 0, c00, c01);
            G_WAIT_V(8); G_WAIT_L(0); G_BAR; G_MMA(1, 0, At, B0); G_MMA(1, 1, At, B1); G_BAR; G_SCHED;
        }
        if (wr == 0) G_BAR;
        E(acc, cur, wr, wc, fr, fq);
        if (!has_next) break;
#pragma unroll
        for (int a = 0; a < 2; ++a)
#pragma unroll
            for (int b = 0; b < 2; ++b)
#pragma unroll
                for (int m = 0; m < 4; ++m)
#pragma unroll
                    for (int n = 0; n < 2; ++n) acc[a][b][m][n] = (f32x4){0.f, 0.f, 0.f, 0.f};
        cur = nxt; cB = nB; cA = nA; ++ui;
        if (wr == 1) G_BAR;
    }
    G_WAIT_V(0);
    G_BAR;
}
}

struct DenseOrder {
    int nM, nN, nwg, G, c, K; const char* Bt;
    __device__ __forceinline__ void init(int M, int N, int K_, int G_, int c_, const void* A_, const void* Bt_) { nM = M / 256; nN = N / 256; nwg = nM * nN; G = G_; c = c_; K = K_; A = (const char*)A_; Bt = (const char*)Bt_; }
    __device__ __forceinline__ bool next(int i, gm::Unit& u) const {
        const long L = (long)i * G + c; if (L >= nwg) return false;
        int wgid = (int)L; { const int q = nwg / gm::NXCD, r = nwg % gm::NXCD, xcd = wgid % gm::NXCD, off = wgid / gm::NXCD; wgid = (xcd < r ? xcd * (q + 1) : r * (q + 1) + (xcd - r) * q) + off; }
        const int nig = gm::WGM * nN, gid = wgid / nig, fm = gid * gm::WGM, gsz = (nM - fm) < gm::WGM ? (nM - fm) : gm::WGM;
        u.pm = fm + ((wgid % nig) % gsz); u.pn = (wgid % nig) / gsz; u.e = 0; u.rows = 256;
        u.B = Bt + (size_t)u.pn * 256 * K * 2; return true;
    }
    const char* A;
    __device__ __forceinline__ const char* a_base(const gm::Unit& u) const { return A + (size_t)u.pm * 256 * K * 2; }
    __device__ __forceinline__ unsigned a_off(int, int r, int c) const { return (unsigned)(r * K + c) * 2u; }
};
constexpr int GT_MAX = 19, GT_OFF = 128 * 1024;
template <bool GATHER> struct MoeOrder {
    LAS const int* tab; int nN, G, vc; const char* Wt; size_t wstride; const int* stok;
    __device__ __forceinline__ bool next(int i, gm::Unit& u) const {
        const int L = i * G + vc; if (L >= tab[32]) return false;
        int e = 0;
#pragma unroll 1
        for (int k = 1; k < 32; ++k) e += (tab[k] <= L) ? 1 : 0;
        const int r = L - tab[e]; u.e = e; u.pm = r / nN; u.pn = r % nN;
        const int cnt = tab[128 + e]; u.rows = (cnt - u.pm * 256) < 256 ? (cnt - u.pm * 256) : 256;
        u.B = Wt + (size_t)e * wstride + (size_t)u.pn * 256 * 1024 * 2; return true;
    }
    const char* A;
    __device__ __forceinline__ const char* a_base(const gm::Unit& u) const { return GATHER ? A : A + (size_t)(tab[64 + u.e] + u.pm * 256) * 2048; }
    LAS const unsigned* gtab;
    __device__ __forceinline__ unsigned a_off(int ui, int r, int c) const {
        if (GATHER) return gtab[ui * 256 + r] + (unsigned)c * 2u;
        else return (unsigned)(r * 1024 + c) * 2u;
    }
    __device__ __forceinline__ void fill_gather(LAS unsigned* gt) const {
        const int tid = opaque_tid();
        if (tid < 256) { gm::Unit u;
            for (int i = 0; i < GT_MAX && next(i, u); ++i) { int tk = 0; if (tid < u.rows) tk = stok[u.e * CAP + u.pm * 256 + tid] >> 2; gt[i * 256 + tid] = (unsigned)tk * 2048u; } }
        __syncthreads();
    }
};
__device__ __forceinline__ void moe_tables(LAS unsigned char* lds, const int* gcount, int nN) {
    LAS int* tab = (LAS int*)(lds + MISC_OFF);
    if (opaque_tid() == 0) { int cu = 0, ro = 0;
#pragma unroll 1
        for (int e = 0; e < 32; ++e) { const int c = gcount[e]; tab[e] = cu; tab[64 + e] = ro; tab[128 + e] = c; cu += ((c + 255) >> 8) * nN; ro += c; }
        tab[32] = cu; tab[64 + 32] = ro; }
    __syncthreads();
}

struct EpiProj {
    static constexpr bool PERM = true;
    bf16_t* O; int ldc;
    __device__ __forceinline__ void operator()(const f32x4 (&acc)[2][2][4][2], const gm::Unit& u, int wr, int wc, int fr_, int fq_) const {
        int fr = fr_, fq = fq_; asm volatile("" : "+v"(fr), "+v"(fq));
        const int row0 = u.pm * 256 + wr * 64 + fr, col0 = u.pn * 256 + wc * 32 + 8 * fq;
#pragma unroll
        for (int ai = 0; ai < 2; ++ai)
#pragma unroll
            for (int m = 0; m < 4; ++m) { bf16_t* rowp = O + (size_t)(row0 + ai * 128 + m * 16) * ldc + col0;
#pragma unroll
                for (int bj = 0; bj < 2; ++bj) { const f32x4 v0 = acc[ai][bj][m][0], v1 = acc[ai][bj][m][1];
                    u32x4 w; w.x = pk2(v0[0], v0[1]); w.y = pk2(v0[2], v0[3]); w.z = pk2(v1[0], v1[1]); w.w = pk2(v1[2], v1[3]);
                    *(u32x4*)(rowp + bj * 128) = w; } }
    }
};
struct EpiOut {
    static constexpr bool PERM = false;
    const float* xin; float* xout; const float* gate;
    __device__ __forceinline__ void operator()(const f32x4 (&acc)[2][2][4][2], const gm::Unit& u, int wr, int wc, int fr_, int fq_) const {
        int fr = fr_, fq = fq_; asm volatile("" : "+v"(fr), "+v"(fq));
        const int row0 = u.pm * 256 + wr * 64 + fr, col0 = u.pn * 256 + wc * 32 + 4 * fq;
        const float* gp = gate + (size_t)(u.pm >> 4) * 6144 + col0;
        f32x4 gv[2][2];
#pragma unroll
        for (int bj = 0; bj < 2; ++bj)
#pragma unroll
            for (int n = 0; n < 2; ++n) gv[bj][n] = *(const f32x4*)(gp + bj * 128 + n * 16);
#pragma unroll
        for (int ai = 0; ai < 2; ++ai)
#pragma unroll
            for (int m = 0; m < 4; ++m) { const size_t ro = (size_t)(row0 + ai * 128 + m * 16) * 1024 + col0;
#pragma unroll
                for (int bj = 0; bj < 2; ++bj)
#pragma unroll
                    for (int n = 0; n < 2; ++n) { const f32x4 xi = *(const f32x4*)(xin + ro + bj * 128 + n * 16);
                        *(f32x4*)(xout + ro + bj * 128 + n * 16) = xi + gv[bj][n] * acc[ai][bj][m][n]; } }
    }
};
struct EpiGlu {
    static constexpr bool PERM = true;
    const bf16_t* y; bf16_t* mixed; const float* bias;
    __device__ __forceinline__ void operator()(const f32x4 (&acc)[2][2][4][2], const gm::Unit& u, int wr, int wc, int fr_, int fq_) const {
        int fr = fr_, fq = fq_; asm volatile("" : "+v"(fr), "+v"(fq));
        const int row0 = u.pm * 256 + wr * 64 + fr, col0 = wc * 32 + 8 * fq;
#pragma unroll
        for (int ai = 0; ai < 2; ++ai)
#pragma unroll
            for (int m = 0; m < 4; ++m) { const int row = row0 + ai * 128 + m * 16;
#pragma unroll
                for (int bj = 0; bj < 2; ++bj) { const int col = col0 + bj * 128;
                    const f32x4 b0 = *(const f32x4*)(bias + col), b1 = *(const f32x4*)(bias + col + 4);
                    const u32x4 yw = *(const u32x4*)(y + (size_t)row * 256 + col);
                    const f32x4 z0 = acc[ai][bj][m][0] + b0, z1 = acc[ai][bj][m][1] + b1;
                    u32x4 w;
                    w.x = pk2(bflo(yw.x) * sigmoidf_(z0[0]), bfhi(yw.x) * sigmoidf_(z0[1]));
                    w.y = pk2(bflo(yw.y) * sigmoidf_(z0[2]), bfhi(yw.y) * sigmoidf_(z0[3]));
                    w.z = pk2(bflo(yw.z) * sigmoidf_(z1[0]), bfhi(yw.z) * sigmoidf_(z1[1]));
                    w.w = pk2(bflo(yw.w) * sigmoidf_(z1[2]), bfhi(yw.w) * sigmoidf_(z1[3]));
                    *(u32x4*)(mixed + (size_t)row * 1024 + 768 + col) = w; }
                __builtin_amdgcn_sched_barrier(0); }
    }
};
__device__ __forceinline__ float swiglu1(float g, float l) {
    g = fminf(g, 7.0f); l = fminf(fmaxf(l, -7.0f), 7.0f);
    return g * __builtin_amdgcn_rcpf(1.0f + __builtin_amdgcn_exp2f(-2.4554669595930157f * g)) * (l + 1.0f);
}
struct EpiUp {
    static constexpr bool PERM = true;
    bf16_t* act; const float* bias; LAS const int* tab;
    __device__ __forceinline__ void operator()(const f32x4 (&acc)[2][2][4][2], const gm::Unit& u, int wr, int wc, int fr_, int fq_) const {
        int fr = fr_, fq = fq_; asm volatile("" : "+v"(fr), "+v"(fq));
        const int rl0 = wr * 64 + fr, col0 = u.pn * 128 + wc * 32 + 8 * fq;
        const float* bp = bias + (size_t)u.e * 2048 + col0;
        unsigned bgp[4], blp[4];
        { const f32x4 bg0 = *(const f32x4*)(bp), bg1 = *(const f32x4*)(bp + 4), bl0 = *(const f32x4*)(bp + 1024), bl1 = *(const f32x4*)(bp + 1028);
          bgp[0] = pk2(bg0[0], bg0[1]); bgp[1] = pk2(bg0[2], bg0[3]); bgp[2] = pk2(bg1[0], bg1[1]); bgp[3] = pk2(bg1[2], bg1[3]);
          blp[0] = pk2(bl0[0], bl0[1]); blp[1] = pk2(bl0[2], bl0[3]); blp[2] = pk2(bl1[0], bl1[1]); blp[3] = pk2(bl1[2], bl1[3]); }
        const size_t arow = (size_t)(tab[64 + u.e] + u.pm * 256);
#pragma unroll
        for (int ai = 0; ai < 2; ++ai)
#pragma unroll
            for (int m = 0; m < 4; ++m) { const int rl = rl0 + ai * 128 + m * 16;
                if (rl < u.rows) {
                    const f32x4 bg0 = {bflo(bgp[0]), bfhi(bgp[0]), bflo(bgp[1]), bfhi(bgp[1])}, bg1 = {bflo(bgp[2]), bfhi(bgp[2]), bflo(bgp[3]), bfhi(bgp[3])};
                    const f32x4 bl0 = {bflo(blp[0]), bfhi(blp[0]), bflo(blp[1]), bfhi(blp[1])}, bl1 = {bflo(blp[2]), bfhi(blp[2]), bflo(blp[3]), bfhi(blp[3])};
                    const f32x4 g0 = acc[ai][0][m][0] + bg0, g1 = acc[ai][0][m][1] + bg1, l0 = acc[ai][1][m][0] + bl0, l1 = acc[ai][1][m][1] + bl1;
                    u32x4 w;
                    w.x = pk2(swiglu1(g0[0], l0[0]), swiglu1(g0[1], l0[1])); w.y = pk2(swiglu1(g0[2], l0[2]), swiglu1(g0[3], l0[3]));
                    w.z = pk2(swiglu1(g1[0], l1[0]), swiglu1(g1[1], l1[1])); w.w = pk2(swiglu1(g1[2], l1[2]), swiglu1(g1[3], l1[3]));
                    *(u32x4*)(act + (arow + rl) * 1024 + col0) = w; } }
    }
};
struct EpiDown {
    static constexpr bool PERM = true;
    bf16_t* outr; const float* bias; const int* stok; const float* sgate;
    __device__ __forceinline__ void operator()(const f32x4 (&acc)[2][2][4][2], const gm::Unit& u, int wr, int wc, int fr_, int fq_) const {
        int fr = fr_, fq = fq_; asm volatile("" : "+v"(fr), "+v"(fq));
        const int rl0 = wr * 64 + fr, col0 = u.pn * 256 + wc * 32 + 8 * fq;
        const float* bp = bias + (size_t)u.e * 1024 + col0;
        f32x4 bv[2][2];
#pragma unroll
        for (int bj = 0; bj < 2; ++bj) { bv[bj][0] = *(const f32x4*)(bp + bj * 128); bv[bj][1] = *(const f32x4*)(bp + bj * 128 + 4); }
        int sts[8]; float gts[8];
#pragma unroll
        for (int q = 0; q < 8; ++q) { const int rl = rl0 + (q >> 2) * 128 + (q & 3) * 16; const int si = u.e * CAP + u.pm * 256 + (rl < u.rows ? rl : 0); sts[q] = stok[si]; gts[q] = sgate[si]; }
#pragma unroll
        for (int ai = 0; ai < 2; ++ai)
#pragma unroll
            for (int m = 0; m < 4; ++m) { const int rl = rl0 + ai * 128 + m * 16;
                if (rl < u.rows) {
                    const int st = sts[ai * 4 + m]; const float gt = gts[ai * 4 + m];
                    bf16_t* rowp = outr + (size_t)st * 1024 + col0;
#pragma unroll
                    for (int bj = 0; bj < 2; ++bj) { const f32x4 v0 = (acc[ai][bj][m][0] + bv[bj][0]) * gt, v1 = (acc[ai][bj][m][1] + bv[bj][1]) * gt;
                        u32x4 w; w.x = pk2(v0[0], v0[1]); w.y = pk2(v0[2], v0[3]); w.z = pk2(v1[0], v1[1]); w.w = pk2(v1[2], v1[3]);
                        *(u32x4*)(rowp + bj * 128) = w; } } }
    }
};

__device__ __forceinline__ void transpose_item(const float* W, int K, int Nsrc, bf16_t* WT, int mode, LAS float* scr, int kb, int nb, int lane) {
    const int k0 = 64 * kb, n0 = 32 * nb;
    const int ncol = n0 + (lane & 31);
#pragma unroll 8
    for (int i = 0; i < 32; ++i) { const int kk = 2 * i + (lane >> 5); scr[kk * 33 + (lane & 31)] = (ncol < Nsrc) ? W[(size_t)(k0 + kk) * Nsrc + ncol] : 0.f; }
    LDS_WAIT(); asm volatile("" ::: "memory");
    const int c = lane & 7;
#pragma unroll
    for (int j = 0; j < 4; ++j) { const int n = (lane >> 3) + 8 * j; const LAS float* s = scr + (8 * c) * 33 + n;
        u32x4 o; o.x = pk2(s[0 * 33], s[1 * 33]); o.y = pk2(s[2 * 33], s[3 * 33]); o.z = pk2(s[4 * 33], s[5 * 33]); o.w = pk2(s[6 * 33], s[7 * 33]);
        int drow = n0 + n;
        if (mode == 1) { const int jj = drow & 1023, lin = drow >> 10; drow = (jj >> 7) * 256 + lin * 128 + (jj & 127); }
        *(u32x4*)(WT + (size_t)drow * K + k0 + 8 * c) = o; }
    LDS_WAIT(); asm volatile("" ::: "memory");
}
constexpr int TI_IN = 16 * 88, TI_OUT = 16 * 32, TI_UP = 16 * 64, TI_DN = 16 * 32, TI_GLU = 4 * 8;
constexpr int TS_R0 = 2 * TI_IN, TS_R1 = TS_R0 + 2 * TI_OUT, TS_R2 = TS_R1 + 2 * TI_GLU;
__device__ __forceinline__ void transpose_small(const Params& P, LAS unsigned char* lds, int gw, int ngw, int wave, int lane) {
    unsigned char* const wsp = opaque_ptr(P.ws);
    LAS float* scr = (LAS float*)(lds + wave * 8704);
    for (int it = gw; it < TS_R2; it += ngw) {
        if (it < TS_R0) { const int l = it / TI_IN, r = it % TI_IN;
            transpose_item(P.w_in + (size_t)l * 1024 * NPROJ, 1024, NPROJ, (bf16_t*)(wsp + WS_WIN) + (size_t)l * NPROJP * 1024, 0, scr, r / 88, r % 88, lane); }
        else if (it < TS_R1) { const int q = it - TS_R0, l = q / TI_OUT, r = q % TI_OUT;
            transpose_item(P.w_out + (size_t)l * 1024 * 1024, 1024, 1024, (bf16_t*)(wsp + WS_WOUT) + (size_t)l * 1024 * 1024, 0, scr, r / 32, r % 32, lane); }
        else { const int q = it - TS_R1, l = q / TI_GLU, r = q % TI_GLU;
            transpose_item(P.s5_w_glu + (size_t)l * 256 * 256, 256, 256, (bf16_t*)(wsp + WS_WGLU) + (size_t)l * 256 * 256, 0, scr, r / 8, r % 8, lane); }
    }
}
__device__ __forceinline__ void transpose_item64(const float* W, int K, int Nsrc, bf16_t* WT, int mode, LAS float* scr, int kb, int nb, int lane) {
    const int k0 = 64 * kb, n0 = 64 * nb, kq = lane >> 4, nn = 4 * (lane & 15);
    const float* src = W + (size_t)(k0 + kq) * Nsrc + n0 + nn;
    f32x4 v[16];
#pragma unroll
    for (int i = 0; i < 16; ++i) v[i] = __builtin_nontemporal_load((const f32x4*)(src + (size_t)(4 * i) * Nsrc));
#pragma unroll
    for (int i = 0; i < 16; ++i) { LAS float* d = scr + (4 * i + kq) * 65 + nn; d[0] = v[i][0]; d[1] = v[i][1]; d[2] = v[i][2]; d[3] = v[i][3]; }
    LDS_WAIT(); asm volatile("" ::: "memory");
    const int c = lane & 7;
#pragma unroll
    for (int j = 0; j < 8; ++j) { const int n = (lane >> 3) + 8 * j; const LAS float* s = scr + (8 * c) * 65 + n;
        u32x4 o; o.x = pk2(s[0 * 65], s[1 * 65]); o.y = pk2(s[2 * 65], s[3 * 65]); o.z = pk2(s[4 * 65], s[5 * 65]); o.w = pk2(s[6 * 65], s[7 * 65]);
        int drow = n0 + n;
        if (mode == 1) { const int jj = drow & 1023, lin = drow >> 10; drow = (jj >> 7) * 256 + lin * 128 + (jj & 127); }
        *(u32x4*)(WT + (size_t)drow * K + k0 + 8 * c) = o; }
    LDS_WAIT(); asm volatile("" ::: "memory");
}
constexpr int TM_UP = 16 * 32, TM_DN = 16 * 16;
__device__ __forceinline__ void transpose_moe(const Params& P, LAS unsigned char* lds, int l, int gw, int ngw, int wave, int lane) {
    unsigned char* const wsp = opaque_ptr(P.ws);
    LAS float* scr = (LAS float*)(lds + wave * 16640);
    for (int it = gw; it < 32 * (TM_UP + TM_DN); it += ngw) {
        if (it < 32 * TM_UP) { const int le = l * 32 + it / TM_UP, r = it % TM_UP;
            transpose_item64(P.w_up + (size_t)le * 1024 * 2048, 1024, 2048, (bf16_t*)(wsp + WS_WUP) + (size_t)le * 2048 * 1024, 1, scr, r / 32, r % 32, lane); }
        else { const int q = it - 32 * TM_UP, le = l * 32 + q / TM_DN, r = q % TM_DN;
            transpose_item64(P.w_down + (size_t)le * 1024 * 1024, 1024, 1024, (bf16_t*)(wsp + WS_WDN) + (size_t)le * 1024 * 1024, 0, scr, r / 16, r % 16, lane); }
    }
}
__device__ __forceinline__ void mod_item(const Params& P, LAS unsigned char* lds, int item) {
    unsigned char* const wsp = opaque_ptr(P.ws);
    const int tid = opaque_tid(), wave = tid >> 6, lane = tid & 63;
    LAS float* sc = (LAS float*)lds;
    LAS float* red = (LAS float*)(lds + 32768);
    const int l = item / 96, cb = item % 96;
    for (int i = tid; i < 8192; i += NTHREADS) sc[i] = siluf(P.c[i]);
    __syncthreads();
    const float* W = P.w_mod + (size_t)l * 1024 * 6144 + cb * 64 + lane;
    float a[8];
#pragma unroll
    for (int b = 0; b < 8; ++b) a[b] = 0.f;
#pragma unroll 1
    for (int k0 = wave; k0 < 1024; k0 += 128) { float wv[16];
#pragma unroll
        for (int u = 0; u < 16; ++u) wv[u] = __builtin_nontemporal_load(W + (size_t)(k0 + 8 * u) * 6144);
#pragma unroll
        for (int u = 0; u < 16; ++u) {
#pragma unroll
            for (int b = 0; b < 8; ++b) a[b] += sc[b * 1024 + k0 + 8 * u] * wv[u]; } }
#pragma unroll
    for (int b = 0; b < 8; ++b) red[(wave * 8 + b) * 64 + lane] = a[b];
    __syncthreads();
    { const int b = tid >> 6; float s = 0.f;
#pragma unroll
      for (int w = 0; w < 8; ++w) s += red[(w * 8 + b) * 64 + lane];
      ((float*)(wsp + WS_MOD))[(size_t)(l * 8 + b) * 6144 + cb * 64 + lane] = s + P.b_mod[l * 6144 + cb * 64 + lane]; }
    __syncthreads();
}
__device__ __forceinline__ void dsincos(double x, double& s, double& c) {
    const double x2 = x * x; double ts = x, tc = 1.0; s = x; c = 1.0;
#pragma unroll 1
    for (int k = 1; k <= 14; ++k) { tc = -tc * x2 / (double)((2 * k - 1) * (2 * k)); ts = -ts * x2 / (double)((2 * k) * (2 * k + 1)); c += tc; s += ts; }
}
__device__ __forceinline__ double dexp_small(double z) {
    double t = 1.0, r = 1.0;
#pragma unroll 1
    for (int k = 1; k <= 18; ++k) { t = t * z / (double)k; r += t; }
    return r;
}
__device__ __forceinline__ void s5_tables_item(const Params& P, LAS unsigned char* lds, int item4) {
    unsigned char* const wsp = opaque_ptr(P.ws);
    const int tid = opaque_tid(); const int item = item4 >> 2, qtr = item4 & 3; const int l = item >> 4, g = item & 15, lg = l * 16 + g;
    LAS float* pwr = (LAS float*)lds;
    LAS float* pwi = pwr + 64 * 65;
    LAS float* bbr = pwi + 64 * 65;
    LAS float* bbi = bbr + 1024;
    LAS float* ccr = bbi + 1024;
    LAS float* cci = ccr + 1024;
    if (tid < 64) { const int p = tid;
        const double are = (double)P.s5_a_re[lg * 64 + p], aim = (double)P.s5_a_im[lg * 64 + p];
        const double dt = (double)expf(P.s5_log_dt[lg]);
        const double mag = dexp_small(are * dt);
        double ang = aim * dt; const double TWO_PI = 6.283185307179586476925;
        ang -= TWO_PI * rint(ang / TWO_PI);
        double sn, cs; dsincos(ang, sn, cs);
        const double lbr = mag * cs, lbi = mag * sn;
        const double nr = lbr - 1.0, ni = lbi, den = are * are + aim * aim;
        const double cfr = (nr * are + ni * aim) / den, cfi = (ni * are - nr * aim) / den;
        double pr = 1.0, pi_ = 0.0;
        for (int t = 0; t <= 64; ++t) { pwr[p * 65 + t] = (float)pr; pwi[p * 65 + t] = (float)pi_; const double nr2 = pr * lbr - pi_ * lbi, ni2 = pr * lbi + pi_ * lbr; pr = nr2; pi_ = ni2; }
        for (int h = 0; h < 16; ++h) { const double br = (double)P.s5_b_re[(lg * 64 + p) * 16 + h], bi = (double)P.s5_b_im[(lg * 64 + p) * 16 + h];
            bbr[p * 16 + h] = (float)(cfr * br - cfi * bi); bbi[p * 16 + h] = (float)(cfr * bi + cfi * br); }
        float* l64 = (float*)(wsp + WS_LAM64) + (size_t)(lg * 64 + p) * 2;
        if (qtr == 0) { l64[0] = pwr[p * 65 + 64]; l64[1] = pwi[p * 65 + 64]; }
    }
    for (int i = tid; i < 1024; i += NTHREADS) { ccr[i] = P.s5_c_re[lg * 1024 + i]; cci[i] = P.s5_c_im[lg * 1024 + i]; }
    __syncthreads();
    bf16_t* kt = (bf16_t*)(wsp + WS_KTAB) + (size_t)lg * 65 * 256;
    for (int i = qtr * 16 * 256 + tid; i < (qtr == 3 ? 65 : 16 * (qtr + 1)) * 256; i += NTHREADS) { const int tau = i >> 8, h = (i >> 4) & 15, h2 = i & 15; float s = 0.f;
        if (tau < 64) {
            for (int p = 0; p < 64; ++p) { const float pr = pwr[p * 65 + tau], pi_ = pwi[p * 65 + tau], br = bbr[p * 16 + h2], bi = bbi[p * 16 + h2];
                const float wr_ = pr * br - pi_ * bi, wi_ = pr * bi + pi_ * br; s += ccr[h * 64 + p] * wr_ - cci[h * 64 + p] * wi_; }
            if (tau == 0 && h == h2) s += P.s5_d[l * 256 + g * 16 + h]; }
        kt[i] = (bf16_t)f2bf(s); }
    bf16_t* bp = (bf16_t*)(wsp + WS_BPOW) + (size_t)lg * 128 * 1024;
    for (int i = qtr * 32768 + tid; i < (qtr + 1) * 32768; i += NTHREADS) { const int q = i >> 10, s = (i >> 4) & 63, h2 = i & 15, p = q & 63;
        const float pr = pwr[p * 65 + 63 - s], pi_ = pwi[p * 65 + 63 - s], br = bbr[p * 16 + h2], bi = bbi[p * 16 + h2];
        const float v = (q < 64) ? (pr * br - pi_ * bi) : (pr * bi + pi_ * br);
        bp[i] = (bf16_t)f2bf(v); }
    bf16_t* cp = (bf16_t*)(wsp + WS_CPOW) + (size_t)lg * 1024 * 128;
    for (int i = qtr * 32768 + tid; i < (qtr + 1) * 32768; i += NTHREADS) { const int q = i & 127, th = i >> 7, t = th >> 4, h = th & 15, p = q & 63;
        const float pr = pwr[p * 65 + t + 1], pi_ = pwi[p * 65 + t + 1], cr = ccr[h * 64 + p], ci = cci[h * 64 + p];
        const float v = (q < 64) ? (cr * pr - ci * pi_) : -(cr * pi_ + ci * pr);
        cp[i] = (bf16_t)f2bf(v); }
    __syncthreads();
}
__device__ __forceinline__ void rope_table(const Params& P, int gtid, int gthreads) {
    unsigned char* const wsp = opaque_ptr(P.ws);
    float* rp = (float*)(wsp + WS_ROPE);
    for (int i = gtid; i < 4096 * 24; i += gthreads) { const int pos = i / 24, f = i % 24;
        double rev = (double)pos * P.inv_freq_rev[f]; rev -= rint(rev);
        double sn, cs; dsincos(rev * 6.283185307179586476925, sn, cs);
        rp[2 * i] = (float)cs; rp[2 * i + 1] = (float)sn; }
}
__device__ __forceinline__ void norm_row_store(const f32x4 (&v)[4], const float* nw, const float* modrow_sh, const float* modrow_sc, bf16_t* orow, int lane) {
    float ss = 0.f;
#pragma unroll
    for (int j = 0; j < 4; ++j) ss += (v[j][0] * v[j][0] + v[j][1] * v[j][1]) + (v[j][2] * v[j][2] + v[j][3] * v[j][3]);
    const float rstd = 1.0f / sqrtf(wave_sum(ss, lane) * (1.0f / 1024.0f) + NORM_EPS);
#pragma unroll
    for (int hf = 0; hf < 2; ++hf) { const int col = hf * 512 + 8 * lane; float o[8];
#pragma unroll
        for (int q = 0; q < 2; ++q) { const f32x4 w = *(const f32x4*)(nw + col + 4 * q), sc = *(const f32x4*)(modrow_sc + col + 4 * q), sh = *(const f32x4*)(modrow_sh + col + 4 * q);
#pragma unroll
            for (int e = 0; e < 4; ++e) o[4 * q + e] = v[hf * 2 + q][e] * rstd * w[e] * (1.0f + sc[e]) + sh[e]; }
        u32x4 w4; w4.x = pk2(o[0], o[1]); w4.y = pk2(o[2], o[3]); w4.z = pk2(o[4], o[5]); w4.w = pk2(o[6], o[7]);
        *(u32x4*)(orow + col) = w4; }
}

template <int KS>
__device__ __forceinline__ f32x16 mma32(LAS const unsigned char* A, int lda, LAS const unsigned char* B, int ldb, f32x16 acc, int lane) {
    const int r = lane & 31, h = lane >> 5;
#pragma unroll
    for (int ks = 0; ks < KS; ++ks) {
        const bf16x8 a = *(const LAS bf16x8*)(A + r * lda + ks * 32 + h * 16);
        const bf16x8 b = *(const LAS bf16x8*)(B + r * ldb + ks * 32 + h * 16);
        acc = __builtin_amdgcn_mfma_f32_32x32x16_bf16(a, b, acc, 0, 0, 0);
    }
    return acc;
}
__device__ __forceinline__ int crow(int reg, int lane) { return (reg & 3) + 8 * (reg >> 2) + 4 * (lane >> 5); }

constexpr int MA_QD = 0, MA_KI = 7168, MA_KET = 14336, MA_VT = 23552, MA_SLOT = 37376;
__device__ __forceinline__ bf16x8 frag_from(unsigned a, unsigned b, unsigned c, unsigned d) { const u32x4 v = {a, b, c, d}; return __builtin_bit_cast(bf16x8, v); }
__device__ __forceinline__ void mixer_phase_a(const Params& P, LAS unsigned char* lds, int l, int round) {
    unsigned char* const wsp = opaque_ptr(P.ws);
    const int tid = opaque_tid(), w = __builtin_amdgcn_readfirstlane(tid >> 6), lane = tid & 63, r = lane & 31, hh = lane >> 5;
    const int slot = w >> 2, wv = w & 3, nt = wv & 1, mt = wv >> 1;
    const int item = 2 * round + slot, n = item & 63, h = (item >> 6) & 3, b = (item >> 8) & 7, type = item >> 11;
    LAS unsigned char* const L = lds + slot * MA_SLOT;
    const bf16_t* prow = (const bf16_t*)(wsp + WS_PROJ) + (size_t)(b * SEQ + n * 64) * NPROJP;
    const int cq = (type ? C_RQ : C_GQ) + h * 48, ck = (type ? C_RK : C_GK) + h * 48, cv = (type ? C_RV : C_GV) + h * 96;
    const int d = 32 * nt + r; const bool dvalid = d < 48;
    { const int t4 = wv * 64 + lane;
#pragma unroll
      for (int jj = 0; jj < 3; ++jj) { const int p = t4 + 256 * jj, j = p / 12, c = p % 12;
          const u32x4 vv = *(const u32x4*)(prow + (size_t)j * NPROJP + cv + 8 * c);
          LAS bf16_t* dst = (LAS bf16_t*)(L + MA_VT + (8 * c) * 144 + j * 2);
          dst[0 * 72] = (bf16_t)(vv.x & 0xffff); dst[1 * 72] = (bf16_t)(vv.x >> 16); dst[2 * 72] = (bf16_t)(vv.y & 0xffff); dst[3 * 72] = (bf16_t)(vv.y >> 16);
          dst[4 * 72] = (bf16_t)(vv.z & 0xffff); dst[5 * 72] = (bf16_t)(vv.z >> 16); dst[6 * 72] = (bf16_t)(vv.w & 0xffff); dst[7 * 72] = (bf16_t)(vv.w >> 16); } }
    float qv[16], kv[16], cum[16], tot;
    if (type == 0) {
#pragma unroll
        for (int reg = 0; reg < 16; ++reg) { const int t = 32 * mt + crow(reg, lane); const bf16_t* pr = prow + (size_t)t * NPROJP;
            qv[reg] = dvalid ? bf2f(pr[cq + d]) * 0.14433756729740643f : 0.f; kv[reg] = dvalid ? bf2f(pr[ck + d]) : 0.f; }
        const bf16_t* wat = (const bf16_t*)(wsp + WS_WA2T) + (size_t)((l * 4 + h) * 64 + d) * 16 + 8 * hh;
        const bf16x8 waf = *(const bf16x8*)wat;
        const float bias = dvalid ? P.gla_b_a[l * 192 + h * 48 + d] : 0.f;
        unsigned xh[2][2][4], xl[2][2][4];
#pragma unroll
        for (int m2 = 0; m2 < 2; ++m2) {
            const bf16x8 gaf = *(const bf16x8*)(prow + (size_t)(32 * m2 + r) * NPROJP + C_GA + 8 * hh);
            f32x16 pre;
#pragma unroll
            for (int i = 0; i < 16; ++i) pre[i] = 0.f;
            pre = __builtin_amdgcn_mfma_f32_32x32x16_bf16(gaf, waf, pre, 0, 0, 0);
            float la[16];
#pragma unroll
            for (int reg = 0; reg < 16; ++reg) { const float x = pre[reg] + bias;
                const float ls = fminf(x, 0.f) - __logf(1.0f + __expf(-fabsf(x)));
                la[reg] = dvalid ? ls * (1.0f / 16.0f) : 0.f; }
#pragma unroll
            for (int s2 = 0; s2 < 2; ++s2)
#pragma unroll
                for (int q = 0; q < 4; ++q) { const float a0 = la[8 * s2 + 2 * q], a1 = la[8 * s2 + 2 * q + 1];
                    const unsigned hw = pk2(a0, a1); xh[m2][s2][q] = hw; xl[m2][s2][q] = pk2(a0 - bflo(hw), a1 - bfhi(hw)); }
        }
        f32x16 cacc, tacc;
#pragma unroll
        for (int i = 0; i < 16; ++i) { cacc[i] = 0.f; tacc[i] = 0.f; }
        const bf16x8 ones = frag_from(0x3F803F80u, 0x3F803F80u, 0x3F803F80u, 0x3F803F80u);
#pragma unroll
        for (int m2 = 0; m2 < 2; ++m2)
#pragma unroll
            for (int s2 = 0; s2 < 2; ++s2) {
                const bf16x8 fh = frag_from(xh[m2][s2][0], xh[m2][s2][1], xh[m2][s2][2], xh[m2][s2][3]), fl = frag_from(xl[m2][s2][0], xl[m2][s2][1], xl[m2][s2][2], xl[m2][s2][3]);
                tacc = __builtin_amdgcn_mfma_f32_32x32x16_bf16(ones, fh, tacc, 0, 0, 0);
                tacc = __builtin_amdgcn_mfma_f32_32x32x16_bf16(ones, fl, tacc, 0, 0, 0);
                if (m2 < mt) { cacc = __builtin_amdgcn_mfma_f32_32x32x16_bf16(ones, fh, cacc, 0, 0, 0); cacc = __builtin_amdgcn_mfma_f32_32x32x16_bf16(ones, fl, cacc, 0, 0, 0); }
                else if (m2 == mt) { unsigned tw[4];
#pragma unroll
                    for (int q = 0; q < 4; ++q) { const int k0 = 16 * s2 + 8 * ((2 * q) >> 2) + 4 * hh + ((2 * q) & 3), k1 = 16 * s2 + 8 * ((2 * q + 1) >> 2) + 4 * hh + ((2 * q + 1) & 3);
                        tw[q] = (k0 <= r ? 0x3F80u : 0u) | (k1 <= r ? 0x3F800000u : 0u); }
                    const bf16x8 tri = frag_from(tw[0], tw[1], tw[2], tw[3]);
                    cacc = __builtin_amdgcn_mfma_f32_32x32x16_bf16(tri, fh, cacc, 0, 0, 0); cacc = __builtin_amdgcn_mfma_f32_32x32x16_bf16(tri, fl, cacc, 0, 0, 0); }
            }
#pragma unroll
        for (int reg = 0; reg < 16; ++reg) cum[reg] = cacc[reg];
        tot = tacc[0];
    } else {
        const float lgam = P.log_gamma[h];
        const float* rope = (const float*)(wsp + WS_ROPE) + (size_t)(n * 64) * 48;
        const int dp = (d < 24) ? d + 24 : d - 24, f = (d < 24) ? d : d - 24;
#pragma unroll
        for (int reg = 0; reg < 16; ++reg) { const int t = 32 * mt + crow(reg, lane); const bf16_t* pr = prow + (size_t)t * NPROJP;
            float q0 = 0.f, q1 = 0.f, k0 = 0.f, k1 = 0.f, cs = 1.f, sn = 0.f;
            if (dvalid) { q0 = bf2f(pr[cq + d]); q1 = bf2f(pr[cq + dp]); k0 = bf2f(pr[ck + d]); k1 = bf2f(pr[ck + dp]); cs = rope[t * 48 + 2 * f]; sn = rope[t * 48 + 2 * f + 1]; }
            qv[reg] = (d < 24) ? (q0 * cs - q1 * sn) : (q1 * sn + q0 * cs);
            kv[reg] = ((d < 24) ? (k0 * cs - k1 * sn) : (k1 * sn + k0 * cs)) * 0.14433756729740643f;
            cum[reg] = (float)(t + 1) * lgam; }
        tot = 64.0f * lgam;
    }
    {
        bf16_t* qdg = (bf16_t*)(wsp + MXW_QD) + (size_t)item * 3072;
        float ke[16];
#pragma unroll
        for (int reg = 0; reg < 16; ++reg) { const int t = 32 * mt + crow(reg, lane);
            const float e1 = __expf(cum[reg]), e2 = __expf(-cum[reg]), e3 = __expf(tot - cum[reg]);
            const bf16_t qd = (bf16_t)f2bf(qv[reg] * e1), ki = (bf16_t)f2bf(kv[reg] * e2); ke[reg] = kv[reg] * e3;
            if (dvalid) { *(LAS bf16_t*)(L + MA_QD + t * 112 + d * 2) = qd; *(LAS bf16_t*)(L + MA_KI + t * 112 + d * 2) = ki; qdg[t * 48 + d] = qd; } }
#pragma unroll
        for (int g4 = 0; g4 < 4; ++g4) { const int t0 = 32 * mt + 8 * g4 + 4 * hh; u32x2 pk; pk.x = pk2(ke[4 * g4], ke[4 * g4 + 1]); pk.y = pk2(ke[4 * g4 + 2], ke[4 * g4 + 3]);
            *(LAS u32x2*)(L + MA_KET + d * 144 + t0 * 2) = pk; }
        if (mt == 0 && hh == 0 && dvalid) ((float*)(wsp + MXW_DEC))[(size_t)item * 48 + d] = __expf(tot);
    }
    __syncthreads();
    {
        unsigned* oig = (unsigned*)(wsp + MXW_OI) + (size_t)item * 3072;
        float* dsg = (float*)(wsp + MXW_DS) + (size_t)item * 4608;
        f32x16 zero16;
#pragma unroll
        for (int i = 0; i < 16; ++i) zero16[i] = 0.f;
        const int it = (wv == 0) ? 0 : 1;
        f32x16 sd = mma32<3>(L + MA_KI + it * 32 * 112, 112, L + MA_QD + it * 32 * 112, 112, zero16, lane);
        unsigned xd[2][4];
#pragma unroll
        for (int s2 = 0; s2 < 2; ++s2)
#pragma unroll
            for (int q = 0; q < 4; ++q) { const int r0 = 8 * s2 + 2 * q; const float a0 = (crow(r0, lane) <= r) ? sd[r0] : 0.f, a1 = (crow(r0 + 1, lane) <= r) ? sd[r0 + 1] : 0.f; xd[s2][q] = pk2(a0, a1); }
        unsigned xo[2][4];
        if (it == 1) { const f32x16 so = mma32<3>(L + MA_KI, 112, L + MA_QD + 32 * 112, 112, zero16, lane);
#pragma unroll
            for (int s2 = 0; s2 < 2; ++s2)
#pragma unroll
                for (int q = 0; q < 4; ++q) xo[s2][q] = pk2(so[8 * s2 + 2 * q], so[8 * s2 + 2 * q + 1]); }
        const int nvt = (wv == 0) ? 3 : 1, vt0 = (wv == 0) ? 0 : wv - 1;
#pragma unroll 1
        for (int vi = 0; vi < nvt; ++vi) { const int vt = vt0 + vi;
            f32x16 oacc = zero16;
            LAS const unsigned char* vb = L + MA_VT + (32 * vt + r) * 144 + 8 * hh;
            if (it == 1) {
#pragma unroll
                for (int s2 = 0; s2 < 2; ++s2) { const u32x2 lo = *(const LAS u32x2*)(vb + 32 * s2), hi = *(const LAS u32x2*)(vb + 32 * s2 + 16);
                    oacc = __builtin_amdgcn_mfma_f32_32x32x16_bf16(frag_from(xo[s2][0], xo[s2][1], xo[s2][2], xo[s2][3]), frag_from(lo.x, lo.y, hi.x, hi.y), oacc, 0, 0, 0); } }
#pragma unroll
            for (int s2 = 0; s2 < 2; ++s2) { const u32x2 lo = *(const LAS u32x2*)(vb + 64 * it + 32 * s2), hi = *(const LAS u32x2*)(vb + 64 * it + 32 * s2 + 16);
                oacc = __builtin_amdgcn_mfma_f32_32x32x16_bf16(frag_from(xd[s2][0], xd[s2][1], xd[s2][2], xd[s2][3]), frag_from(lo.x, lo.y, hi.x, hi.y), oacc, 0, 0, 0); }
#pragma unroll
            for (int q = 0; q < 8; ++q) oig[((it * 3 + vt) * 8 + q) * 64 + lane] = pk2(oacc[2 * q], oacc[2 * q + 1]);
            const int dt = (wv == 0) ? 1 : 0;
            const f32x16 ds = mma32<4>(L + MA_KET + dt * 32 * 144, 144, L + MA_VT + vt * 32 * 144, 144, zero16, lane);
#pragma unroll
            for (int g4 = 0; g4 < 4; ++g4) { const int d0 = 32 * dt + 8 * g4 + 4 * hh;
                if (d0 < 48) { f32x4 o; o[0] = ds[4 * g4]; o[1] = ds[4 * g4 + 1]; o[2] = ds[4 * g4 + 2]; o[3] = ds[4 * g4 + 3]; *(f32x4*)(dsg + (32 * vt + r) * 48 + d0) = o; } }
        }
    }
    __syncthreads();
}
__device__ __forceinline__ void mixer_phase_b(const Params& P, int bid, int G) {
    unsigned char* const wsp = opaque_ptr(P.ws);
    const int tid = opaque_tid();
    for (int task = bid * NTHREADS + tid; task < 64 * 1152; task += G * NTHREADS) {
        const int seq = task / 1152, q4 = task % 1152, d0 = (q4 % 12) * 4;
        const float* dsp = (const float*)(wsp + MXW_DS) + (size_t)seq * 64 * 4608 + q4 * 4;
        const float* dcp = (const float*)(wsp + MXW_DEC) + (size_t)seq * 64 * 48 + d0;
        bf16_t* spp = (bf16_t*)(wsp + MXW_SP) + (size_t)seq * 64 * 4608 + q4 * 4;
        f32x4 st = {0.f, 0.f, 0.f, 0.f};
#pragma unroll 16
        for (int n = 0; n < 64; ++n) { const f32x4 ds = *(const f32x4*)(dsp + (size_t)n * 4608), dc = *(const f32x4*)(dcp + n * 48);
            u32x2 pk; pk.x = pk2(st[0], st[1]); pk.y = pk2(st[2], st[3]); *(u32x2*)(spp + (size_t)n * 4608) = pk;
            st = dc * st + ds; }
    }
}
__device__ __forceinline__ void mixer_phase_c(const Params& P, LAS unsigned char* lds, int l, int item) {
    unsigned char* const wsp = opaque_ptr(P.ws);
    const int tid = opaque_tid(), w = __builtin_amdgcn_readfirstlane(tid >> 6), lane = tid & 63, r = lane & 31, hh = lane >> 5;
    LAS float* const Lw = (LAS float*)(lds + w * 12800);
    const int n = item & 63, h = (item >> 6) & 3, b = (item >> 8) & 7, type = item >> 11;
    const size_t tok0 = (size_t)b * SEQ + n * 64;
    const unsigned* oig = (const unsigned*)(wsp + MXW_OI) + (size_t)item * 3072;
    const bf16_t* qdg = (const bf16_t*)(wsp + MXW_QD) + (size_t)item * 3072 + 8 * hh;
    const bf16_t* spg = (const bf16_t*)(wsp + MXW_SP) + (size_t)item * 4608 + 8 * hh;
    const int rq = lane >> 2, q4 = lane & 3;
    const bf16_t* gp = (const bf16_t*)(wsp + WS_PROJ) + tok0 * NPROJP + (type ? C_RG : C_GG) + h * 96 + 24 * q4;
    bf16_t* mp = (bf16_t*)(wsp + WS_MIXED) + tok0 * 1024 + type * 384 + h * 96 + 24 * q4;
    const float* nw = (type ? P.ret_norm_w : P.gla_norm_w) + l * 384 + h * 96 + 24 * q4;
    f32x16 acc[2][3];
#pragma unroll
    for (int it = 0; it < 2; ++it)
#pragma unroll
        for (int vt = 0; vt < 3; ++vt)
#pragma unroll
            for (int q = 0; q < 8; ++q) { const unsigned u = oig[((it * 3 + vt) * 8 + q) * 64 + lane]; acc[it][vt][2 * q] = bflo(u); acc[it][vt][2 * q + 1] = bfhi(u); }
#pragma unroll
    for (int ks = 0; ks < 3; ++ks) {
        const bf16x8 a0 = *(const bf16x8*)(qdg + r * 48 + ks * 16), a1 = *(const bf16x8*)(qdg + (32 + r) * 48 + ks * 16);
#pragma unroll
        for (int vt = 0; vt < 3; ++vt) { const bf16x8 bb = *(const bf16x8*)(spg + (32 * vt + r) * 48 + ks * 16);
            acc[0][vt] = __builtin_amdgcn_mfma_f32_32x32x16_bf16(a0, bb, acc[0][vt], 0, 0, 0);
            acc[1][vt] = __builtin_amdgcn_mfma_f32_32x32x16_bf16(a1, bb, acc[1][vt], 0, 0, 0); } }
    f32x4 nwv[6];
#pragma unroll
    for (int q = 0; q < 6; ++q) nwv[q] = *(const f32x4*)(nw + 4 * q);
    u32x4 gall[4][3];
#pragma unroll
    for (int p4 = 0; p4 < 4; ++p4)
#pragma unroll
        for (int q = 0; q < 3; ++q) gall[p4][q] = *(const u32x4*)(gp + (size_t)(16 * p4 + rq) * NPROJP + 8 * q);
#pragma unroll
    for (int it = 0; it < 2; ++it) {
#pragma unroll
        for (int vt = 0; vt < 3; ++vt)
#pragma unroll
            for (int reg = 0; reg < 16; ++reg) Lw[crow(reg, lane) * 100 + 32 * vt + r] = acc[it][vt][reg];
        LDS_WAIT(); asm volatile("" ::: "memory");
#pragma unroll
        for (int ps = 0; ps < 2; ++ps) { const int rl = 16 * ps + rq, i = 32 * it + rl;
            f32x4 x[6]; u32x4 gw[3];
#pragma unroll
            for (int q = 0; q < 6; ++q) x[q] = *(const LAS f32x4*)(Lw + rl * 100 + 24 * q4 + 4 * q);
#pragma unroll
            for (int q = 0; q < 3; ++q) gw[q] = gall[it * 2 + ps][q];
            if (type == 1) { float sm = 0.f;
#pragma unroll
                for (int q = 0; q < 6; ++q) sm += (x[q][0] + x[q][1]) + (x[q][2] + x[q][3]);
                sm += lx_f(sm, lane, 1); sm += lx_f(sm, lane, 2);
                const float mean = sm * (1.0f / 96.0f);
#pragma unroll
                for (int q = 0; q < 6; ++q) x[q] = x[q] - mean; }
            float ss = 0.f;
#pragma unroll
            for (int q = 0; q < 6; ++q) ss += (x[q][0] * x[q][0] + x[q][1] * x[q][1]) + (x[q][2] * x[q][2] + x[q][3] * x[q][3]);
            ss += lx_f(ss, lane, 1); ss += lx_f(ss, lane, 2);
            const float rstd = 1.0f / sqrtf(ss * (1.0f / 96.0f) + NORM_EPS);
#pragma unroll
            for (int q = 0; q < 3; ++q) { const f32x4 xa = x[2 * q] * nwv[2 * q] * rstd, xb = x[2 * q + 1] * nwv[2 * q + 1] * rstd; const u32x4 g = gw[q];
                u32x4 o;
                o.x = pk2(xa[0] * siluf(bflo(g.x)), xa[1] * siluf(bfhi(g.x))); o.y = pk2(xa[2] * siluf(bflo(g.y)), xa[3] * siluf(bfhi(g.y)));
                o.z = pk2(xb[0] * siluf(bflo(g.z)), xb[1] * siluf(bfhi(g.z))); o.w = pk2(xb[2] * siluf(bflo(g.w)), xb[3] * siluf(bfhi(g.w)));
                *(u32x4*)(mp + (size_t)i * 1024 + 8 * q) = o; } }
        LDS_WAIT(); asm volatile("" ::: "memory");
    }
}

constexpr int S5_KT = 0, S5_EB = 33280, S5_CY = 66048;
__device__ __forceinline__ float gelu_tanh(float x) { const float u = 0.7978845608028654f * (x + 0.044715f * x * x * x); const float e = __expf(2.0f * u); const float th = 1.0f - 2.0f / (e + 1.0f); return 0.5f * x * (1.0f + th); }
__device__ __forceinline__ void s5_item(const Params& P, LAS unsigned char* lds, int l, int item) {
    unsigned char* const wsp = opaque_ptr(P.ws);
    const int tid = opaque_tid(), w = __builtin_amdgcn_readfirstlane(tid >> 6), lane = tid & 63, r = lane & 31, hh = lane >> 5;
    const int half = item & 1, b = item >> 5, g = (item >> 1) & 15, lg = l * 16 + g;
    const bf16_t* ub = (const bf16_t*)(wsp + WS_PROJ) + (size_t)b * SEQ * NPROJP + C_SU + g * 16 + 8 * hh;
    const bf16_t* ktg = (const bf16_t*)(wsp + WS_KTAB) + (size_t)lg * 65 * 256;
    const bf16_t* bpw = (const bf16_t*)(wsp + WS_BPOW) + (size_t)lg * 128 * 1024 + (size_t)((w & 3) * 32 + r) * 1024 + 8 * hh;
    const bf16_t* cpw = (const bf16_t*)(wsp + WS_CPOW) + (size_t)lg * 1024 * 128;
    for (int p = tid; p < 2080; p += NTHREADS) *(LAS u32x4*)(lds + S5_KT + p * 16) = *(const u32x4*)(ktg + p * 8);
    __syncthreads();
    f32x16 acc[2][2], eacc;
    const int nt0 = half ? (w + 8) : w, nt1 = half ? (w + 16) : (w + 24);
#pragma unroll
    for (int j = 0; j < 2; ++j)
#pragma unroll
        for (int mt = 0; mt < 2; ++mt)
#pragma unroll
            for (int i = 0; i < 16; ++i) acc[j][mt][i] = 0.f;
#pragma unroll
    for (int i = 0; i < 16; ++i) eacc[i] = 0.f;
    const int emt = w >> 2;
    const size_t arow0 = (size_t)(r * 64) * NPROJP, arow1 = (size_t)((32 + r) * 64) * NPROJP;
#define S5_LOAD(A0, A1, BP, s) do { A0 = *(const bf16x8*)(ub + arow0 + (size_t)(s) * NPROJP); A1 = *(const bf16x8*)(ub + arow1 + (size_t)(s) * NPROJP); BP = *(const bf16x8*)(bpw + (s) * 16); } while (0)
#define S5_STEP(A0, A1, BP, s) do { \
        _Pragma("unroll") for (int j = 0; j < 2; ++j) { const int t0 = 2 * (j ? nt1 : nt0); \
            if (t0 + 1 >= (s)) { const int tt = t0 + (r >> 4); const int tau = tt - (s); const int slot = tau < 0 ? 64 : tau; \
                const bf16x8 kb = *(const LAS bf16x8*)(lds + S5_KT + slot * 512 + (lane & 15) * 32 + hh * 16); \
                acc[j][0] = __builtin_amdgcn_mfma_f32_32x32x16_bf16(A0, kb, acc[j][0], 0, 0, 0); \
                acc[j][1] = __builtin_amdgcn_mfma_f32_32x32x16_bf16(A1, kb, acc[j][1], 0, 0, 0); } } \
        eacc = __builtin_amdgcn_mfma_f32_32x32x16_bf16(emt ? A1 : A0, BP, eacc, 0, 0, 0); } while (0)
    bf16x8 xa0, xa1, xbp, ya0, ya1, ybp;
    S5_LOAD(xa0, xa1, xbp, 0); S5_LOAD(ya0, ya1, ybp, 1);
#pragma unroll 1
    for (int s = 0; s < 64; s += 2) {
        S5_STEP(xa0, xa1, xbp, s);
        if (s + 2 < 64) S5_LOAD(xa0, xa1, xbp, s + 2);
        S5_STEP(ya0, ya1, ybp, s + 1);
        if (s + 3 < 64) S5_LOAD(ya0, ya1, ybp, s + 3);
    }
#undef S5_LOAD
#undef S5_STEP
#pragma unroll
    for (int reg = 0; reg < 16; ++reg) ((LAS float*)(lds + S5_EB))[(emt * 32 + crow(reg, lane)) * 128 + (w & 3) * 32 + r] = eacc[reg];
    __syncthreads();
    if (tid < 64) { const int p = tid; const float* l64 = (const float*)(wsp + WS_LAM64) + (size_t)(lg * 64 + p) * 2; const float ar = l64[0], ai = l64[1];
        float cr = 0.f, ci = 0.f;
#pragma unroll 1
        for (int n = 0; n < 64; ++n) {
            *(LAS bf16_t*)(lds + S5_CY + n * 272 + p * 2) = (bf16_t)f2bf(cr); *(LAS bf16_t*)(lds + S5_CY + n * 272 + (64 + p) * 2) = (bf16_t)f2bf(ci);
            const float er = ((const LAS float*)(lds + S5_EB))[n * 128 + p], ei = ((const LAS float*)(lds + S5_EB))[n * 128 + 64 + p];
            const float nr = ar * cr - ai * ci + er, ni = ar * ci + ai * cr + ei; cr = nr; ci = ni; } }
    __syncthreads();
#pragma unroll
    for (int j = 0; j < 2; ++j) { const bf16_t* cpr = cpw + (size_t)((j ? nt1 : nt0) * 32 + r) * 128 + 8 * hh;
#pragma unroll
        for (int ks = 0; ks < 8; ++ks) { const bf16x8 cb = *(const bf16x8*)(cpr + ks * 16);
            const bf16x8 c0 = *(const LAS bf16x8*)(lds + S5_CY + r * 272 + ks * 32 + hh * 16), c1 = *(const LAS bf16x8*)(lds + S5_CY + (32 + r) * 272 + ks * 32 + hh * 16);
            acc[j][0] = __builtin_amdgcn_mfma_f32_32x32x16_bf16(c0, cb, acc[j][0], 0, 0, 0);
            acc[j][1] = __builtin_amdgcn_mfma_f32_32x32x16_bf16(c1, cb, acc[j][1], 0, 0, 0); } }
    bf16_t* yb = (bf16_t*)(wsp + WS_YBUF) + (size_t)b * SEQ * 256 + g * 16 + (lane & 15);
#pragma unroll
    for (int j = 0; j < 2; ++j) { const int tt = 2 * (j ? nt1 : nt0) + (r >> 4);
#pragma unroll
        for (int mt = 0; mt < 2; ++mt)
#pragma unroll
            for (int reg = 0; reg < 16; ++reg) { const int n = mt * 32 + crow(reg, lane);
                yb[(size_t)(n * 64 + tt) * 256] = (bf16_t)f2bf(gelu_tanh(acc[j][mt][reg])); } }
    __syncthreads();
}

constexpr int RT_SC = 0, RT_SH = 4096, RT_RS = 8192, RT_PART = 8704, RT_CNT = 8704 + 2 * 128 * 33 * 4, RT_BASE = RT_CNT + 128, RT_TE = RT_BASE + 128, RT_TG = RT_TE + 2048, RT_TR = RT_TG + 2048;
__device__ __forceinline__ void router_phase(const Params& P, LAS unsigned char* lds, int l, int blk) {
    unsigned char* const wsp = opaque_ptr(P.ws);
    const int tid = opaque_tid(), w = __builtin_amdgcn_readfirstlane(tid >> 6), lane = tid & 63, r = lane & 31, hh = lane >> 5;
    const float* x = (const float*)(wsp + WS_X);
    bf16_t* hdn = (bf16_t*)(wsp + WS_HDN);
    const int tok0 = blk * 128, b = tok0 >> 12;
    const float* mrow = (const float*)(wsp + WS_MOD) + (size_t)(l * 8 + b) * 6144;
    int* gcount = (int*)(wsp + WS_CTL) + l * 32;
    int* stok = (int*)(wsp + WS_STOK); float* sgate = (float*)(wsp + WS_SGATE);
    LAS float* scL = (LAS float*)(lds + RT_SC); LAS float* shL = (LAS float*)(lds + RT_SH); LAS float* rsL = (LAS float*)(lds + RT_RS);
    for (int i = tid; i < 1024; i += NTHREADS) { scL[i] = P.norm2_w[l * 1024 + i] * (1.0f + mrow[4096 + i]); shL[i] = mrow[3072 + i]; }
    if (tid < 32) ((LAS int*)(lds + RT_CNT))[tid] = 0;
    __syncthreads();
    {
        f32x4 sc[4], sh[4];
#pragma unroll
        for (int j = 0; j < 4; ++j) { sc[j] = *(const LAS f32x4*)(scL + 4 * lane + 256 * j); sh[j] = *(const LAS f32x4*)(shL + 4 * lane + 256 * j); }
#pragma unroll 1
        for (int t4 = 0; t4 < 16; t4 += 4) {
            f32x4 v[4][4]; float ss[4];
#pragma unroll
            for (int u = 0; u < 4; ++u) { const size_t tok = (size_t)(tok0 + w * 16 + t4 + u);
#pragma unroll
                for (int j = 0; j < 4; ++j) v[u][j] = *(const f32x4*)(x + tok * 1024 + 4 * lane + 256 * j); }
#pragma unroll
            for (int u = 0; u < 4; ++u) { float a_ = 0.f;
#pragma unroll
                for (int j = 0; j < 4; ++j) a_ += (v[u][j][0] * v[u][j][0] + v[u][j][1] * v[u][j][1]) + (v[u][j][2] * v[u][j][2] + v[u][j][3] * v[u][j][3]);
                ss[u] = a_; }
#pragma unroll
            for (int o = 1; o < 64; o <<= 1) {
#pragma unroll
                for (int u = 0; u < 4; ++u) ss[u] += lx_f(ss[u], lane, o); }
#pragma unroll
            for (int u = 0; u < 4; ++u) { const int tl = w * 16 + t4 + u; const size_t tok = (size_t)(tok0 + tl);
                const float rstd = 1.0f / sqrtf(ss[u] * (1.0f / 1024.0f) + NORM_EPS);
                if (lane == 0) rsL[tl] = rstd;
#pragma unroll
                for (int j = 0; j < 4; ++j) { const f32x4 hv = v[u][j] * rstd * sc[j] + sh[j]; u32x2 pk; pk.x = pk2(hv[0], hv[1]); pk.y = pk2(hv[2], hv[3]);
                    *(u32x2*)(hdn + tok * 1024 + 4 * lane + 256 * j) = pk; } } }
    }
    __syncthreads();
    {
        const int mt = w & 3, kh = w >> 2;
        const float* xr = x + (size_t)(tok0 + 32 * mt + r) * 1024 + 512 * kh + 8 * hh;
        const bf16_t* wt = (const bf16_t*)(wsp + WS_RWT) + (size_t)l * 2 * 32 * 1024 + (size_t)r * 1024 + 512 * kh + 8 * hh;
        const float rs = rsL[32 * mt + r];
        f32x16 acc;
#pragma unroll
        for (int i = 0; i < 16; ++i) acc[i] = 0.f;
#pragma unroll 8
        for (int ks = 0; ks < 32; ++ks) {
            const f32x4 x0 = *(const f32x4*)(xr + 16 * ks), x1 = *(const f32x4*)(xr + 16 * ks + 4);
            const int kk = 512 * kh + 16 * ks + 8 * hh;
            const f32x4 c0 = *(const LAS f32x4*)(scL + kk), c1 = *(const LAS f32x4*)(scL + kk + 4), s0 = *(const LAS f32x4*)(shL + kk), s1 = *(const LAS f32x4*)(shL + kk + 4);
            const f32x4 h0 = x0 * rs * c0 + s0, h1 = x1 * rs * c1 + s1;
            unsigned ah[4], al[4];
            ah[0] = pk2(h0[0], h0[1]); ah[1] = pk2(h0[2], h0[3]); ah[2] = pk2(h1[0], h1[1]); ah[3] = pk2(h1[2], h1[3]);
            al[0] = pk2(h0[0] - bflo(ah[0]), h0[1] - bfhi(ah[0])); al[1] = pk2(h0[2] - bflo(ah[1]), h0[3] - bfhi(ah[1]));
            al[2] = pk2(h1[0] - bflo(ah[2]), h1[1] - bfhi(ah[2])); al[3] = pk2(h1[2] - bflo(ah[3]), h1[3] - bfhi(ah[3]));
            const bf16x8 bh = *(const bf16x8*)(wt + 16 * ks), bl = *(const bf16x8*)(wt + 32 * 1024 + 16 * ks);
            const bf16x8 fah = frag_from(ah[0], ah[1], ah[2], ah[3]), fal = frag_from(al[0], al[1], al[2], al[3]);
            acc = __builtin_amdgcn_mfma_f32_32x32x16_bf16(fah, bh, acc, 0, 0, 0);
            acc = __builtin_amdgcn_mfma_f32_32x32x16_bf16(fah, bl, acc, 0, 0, 0);
            acc = __builtin_amdgcn_mfma_f32_32x32x16_bf16(fal, bh, acc, 0, 0, 0);
        }
        LAS float* part = (LAS float*)(lds + RT_PART) + kh * 128 * 33;
#pragma unroll
        for (int reg = 0; reg < 16; ++reg) part[(32 * mt + crow(reg, lane)) * 33 + r] = acc[reg];
    }
    __syncthreads();
    if (tid < 128) {
        const LAS float* p0 = (const LAS float*)(lds + RT_PART) + tid * 33; const LAS float* p1 = p0 + 128 * 33;
        float v0 = -3.0e38f, v1 = -3.0e38f, v2 = -3.0e38f, v3 = -3.0e38f; int e0 = 0, e1 = 0, e2 = 0, e3 = 0;
#pragma unroll
        for (int e = 0; e < 32; ++e) { const float lg = p0[e] + p1[e] + P.router_b[l * 32 + e];
            if (lg > v3) { if (lg > v2) { v3 = v2; e3 = e2; if (lg > v1) { v2 = v1; e2 = e1; if (lg > v0) { v1 = v0; e1 = e0; v0 = lg; e0 = e; } else { v1 = lg; e1 = e; } } else { v2 = lg; e2 = e; } } else { v3 = lg; e3 = e; } } }
        const float x1 = __expf(v1 - v0), x2 = __expf(v2 - v0), x3 = __expf(v3 - v0), inv = 1.0f / (1.0f + x1 + x2 + x3);
        LAS int* cnt = (LAS int*)(lds + RT_CNT);
        LAS int* te = (LAS int*)(lds + RT_TE) + tid * 4; LAS float* tg = (LAS float*)(lds + RT_TG) + tid * 4; LAS int* tr = (LAS int*)(lds + RT_TR) + tid * 4;
        te[0] = e0; te[1] = e1; te[2] = e2; te[3] = e3; tg[0] = inv; tg[1] = x1 * inv; tg[2] = x2 * inv; tg[3] = x3 * inv;
        tr[0] = __hip_atomic_fetch_add(cnt + e0, 1, __ATOMIC_RELAXED, __HIP_MEMORY_SCOPE_WORKGROUP); tr[1] = __hip_atomic_fetch_add(cnt + e1, 1, __ATOMIC_RELAXED, __HIP_MEMORY_SCOPE_WORKGROUP);
        tr[2] = __hip_atomic_fetch_add(cnt + e2, 1, __ATOMIC_RELAXED, __HIP_MEMORY_SCOPE_WORKGROUP); tr[3] = __hip_atomic_fetch_add(cnt + e3, 1, __ATOMIC_RELAXED, __HIP_MEMORY_SCOPE_WORKGROUP);
    }
    __syncthreads();
    if (tid < 32) ((LAS int*)(lds + RT_BASE))[tid] = atomicAdd(gcount + tid, ((LAS int*)(lds + RT_CNT))[tid]);
    __syncthreads();
    { const int e = ((LAS int*)(lds + RT_TE))[tid]; const int pos = ((LAS int*)(lds + RT_BASE))[e] + ((LAS int*)(lds + RT_TR))[tid];
      stok[e * CAP + pos] = (tok0 + (tid >> 2)) * 4 + (tid & 3); sgate[e * CAP + pos] = ((LAS float*)(lds + RT_TG))[tid]; }
    __syncthreads();
}

__device__ __forceinline__ void combine_phase(const Params& P, int l, int gw, int ngw, int lane_in) {
    unsigned char* const wsp = opaque_ptr(P.ws);
    int lane = lane_in; asm volatile("" : "+v"(lane));
    float* x = (float*)(wsp + WS_X);
    const bf16_t* outr = (const bf16_t*)(wsp + WS_OUTR);
    bf16_t* hdn = (bf16_t*)(wsp + WS_HDN);
    for (int tokp = gw; tokp < T_TOK / 2; tokp += ngw) {
        u32x4 rr[2][2][4]; f32x4 xv[2][4];
#pragma unroll
        for (int u = 0; u < 2; ++u) { const size_t tok = (size_t)(2 * tokp + u);
#pragma unroll
            for (int hf = 0; hf < 2; ++hf) { const int col = hf * 512 + 8 * lane;
#pragma unroll
                for (int k = 0; k < 4; ++k) rr[u][hf][k] = *(const u32x4*)(outr + (tok * 4 + k) * 1024 + col);
                xv[u][hf * 2] = *(const f32x4*)(x + tok * 1024 + col); xv[u][hf * 2 + 1] = *(const f32x4*)(x + tok * 1024 + col + 4); } }
#pragma unroll
        for (int u = 0; u < 2; ++u) { const int tok = 2 * tokp + u; const int b = tok >> 12;
            const float* mrow = (const float*)(wsp + WS_MOD) + (size_t)(l * 8 + b) * 6144;
            f32x4 v[4];
#pragma unroll
            for (int hf = 0; hf < 2; ++hf) { const int col = hf * 512 + 8 * lane;
                float s[8];
#pragma unroll
                for (int e = 0; e < 8; ++e) s[e] = 0.f;
#pragma unroll
                for (int k = 0; k < 4; ++k) { const u32x4 r4 = rr[u][hf][k];
                    s[0] += bflo(r4.x); s[1] += bfhi(r4.x); s[2] += bflo(r4.y); s[3] += bfhi(r4.y); s[4] += bflo(r4.z); s[5] += bfhi(r4.z); s[6] += bflo(r4.w); s[7] += bfhi(r4.w); }
#pragma unroll
                for (int q = 0; q < 2; ++q) { const f32x4 x4 = xv[u][hf * 2 + q], g2 = *(const f32x4*)(mrow + 5120 + col + 4 * q);
                    f32x4 o; o[0] = x4[0] + g2[0] * s[4 * q]; o[1] = x4[1] + g2[1] * s[4 * q + 1]; o[2] = x4[2] + g2[2] * s[4 * q + 2]; o[3] = x4[3] + g2[3] * s[4 * q + 3];
                    v[hf * 2 + q] = o; if (l + 1 < NLAYER) *(f32x4*)(x + (size_t)tok * 1024 + col + 4 * q) = o; } }
            if (l + 1 < NLAYER) {
                const float* mnext = (const float*)(wsp + WS_MOD) + (size_t)((l + 1) * 8 + b) * 6144;
                norm_row_store(v, P.norm1_w + (l + 1) * 1024, mnext, mnext + 1024, hdn + (size_t)tok * 1024, lane);
            } else {
                float ss = 0.f;
#pragma unroll
                for (int j = 0; j < 4; ++j) ss += (v[j][0] * v[j][0] + v[j][1] * v[j][1]) + (v[j][2] * v[j][2] + v[j][3] * v[j][3]);
                const float rstd = 1.0f / sqrtf(wave_sum(ss, lane) * (1.0f / 1024.0f) + NORM_EPS);
#pragma unroll
                for (int hf = 0; hf < 2; ++hf)
#pragma unroll
                    for (int q = 0; q < 2; ++q) { const int col = hf * 512 + 8 * lane + 4 * q; const f32x4 fw = *(const f32x4*)(P.final_norm_w + col);
                        f32x4 o; o[0] = v[hf * 2 + q][0] * rstd * fw[0]; o[1] = v[hf * 2 + q][1] * rstd * fw[1]; o[2] = v[hf * 2 + q][2] * rstd * fw[2]; o[3] = v[hf * 2 + q][3] * rstd * fw[3];
                        *(f32x4*)(P.out + (size_t)tok * 1024 + col) = o; }
            }
        }
    }
}

#define XB_TMO      128
#define XB_XCNT(j)  (256  + 64 * (j))
#define XB_XSUB(j)  (1280 + 64 * (j))
#define XB_XGEN(j)  (2304 + 64 * (j))
#define XB_TOP      3328
#define XB_TOPGEN   3392
#define XCD_BAR_WORDS 3456
#define XB_SPIN_CAP (1u << 22)
__device__ __forceinline__ unsigned xb_ld(unsigned* p)              { return __hip_atomic_load(p, __ATOMIC_RELAXED, __HIP_MEMORY_SCOPE_AGENT); }
__device__ __forceinline__ unsigned xb_add(unsigned* p, unsigned v) { return __hip_atomic_fetch_add(p, v, __ATOMIC_RELAXED, __HIP_MEMORY_SCOPE_AGENT); }
__device__ __forceinline__ unsigned xb_xcc_id() { return (unsigned)__builtin_amdgcn_s_getreg((3 << 11) | 20) & 0xFu; }
#define XB_SPIN(cond, bar) do { unsigned _sp = 0; while (cond) { __builtin_amdgcn_s_sleep(1); \
    if ((++_sp & 255u) == 0u) { if (xb_ld(&(bar)[XB_TMO])) break; if (_sp > XB_SPIN_CAP) { atomicAdd(&(bar)[XB_TMO], 1u); break; } } } } while (0)
struct XcdBarrier { unsigned* bar; unsigned x; volatile LAS unsigned* st; };
__device__ __forceinline__ XcdBarrier xcd_barrier_post(unsigned* bar, volatile LAS unsigned* st) {
    XcdBarrier b; b.bar = bar; b.x = xb_xcc_id(); b.st = st;
    if (threadIdx.x == 0) (void)xb_add(&bar[XB_XCNT(b.x)], 1u);
    return b;
}
__device__ __forceinline__ void xcd_barrier_complete(unsigned* bar, unsigned x, unsigned& nloc, unsigned& nx) {
    const unsigned G = gridDim.x * gridDim.y * gridDim.z;
    unsigned sum, cnt, mine, sp = 0u;
    for (;;) {
        sum = 0u; cnt = 0u; mine = 0u;
#pragma unroll
        for (unsigned j = 0; j < 16; ++j) { const unsigned c = xb_ld(&bar[XB_XCNT(j)]); sum += c; cnt += (c > 0u) ? 1u : 0u; mine = (j == x) ? c : mine; }
        if (sum == G) break;
        __builtin_amdgcn_s_sleep(1);
        if ((++sp & 255u) == 0u) { if (xb_ld(&bar[XB_TMO])) break; if (sp > XB_SPIN_CAP) { atomicAdd(&bar[XB_TMO], 1u); break; } }
    }
    nloc = mine > 0u ? mine : 1u; nx = cnt > 0u ? cnt : 1u;
}
__device__ __forceinline__ void xcd_barrier(const XcdBarrier& b) {
    asm volatile("s_waitcnt vmcnt(0)" ::: "memory");
    __syncthreads();
    if (threadIdx.x == 0) {
        unsigned* bar = b.bar;
        __builtin_amdgcn_s_waitcnt(0);
        unsigned nloc = b.st[0], nx = b.st[1];
        if (nloc == 0u) { xcd_barrier_complete(bar, b.x, nloc, nx); b.st[0] = nloc; b.st[1] = nx; }
        const unsigned old = xb_add(&bar[XB_XSUB(b.x)], 1u);
        const unsigned gen = old / nloc;
        if (old + 1u == (gen + 1u) * nloc) {
            __builtin_amdgcn_fence(__ATOMIC_RELEASE, "agent");
            asm volatile("s_waitcnt vmcnt(0)" ::: "memory");
            const unsigned og = xb_add(&bar[XB_TOP], 1u);
            const unsigned tg = og / nx;
            if (og + 1u == (tg + 1u) * nx) xb_add(&bar[XB_TOPGEN], 1u);
            else XB_SPIN(xb_ld(&bar[XB_TOPGEN]) == tg, bar);
            __builtin_amdgcn_fence(__ATOMIC_ACQUIRE, "agent");
            xb_add(&bar[XB_XGEN(b.x)], 1u);
            asm volatile("s_waitcnt vmcnt(0)" ::: "memory");
        } else {
            XB_SPIN(xb_ld(&bar[XB_XGEN(b.x)]) == gen, bar);
            __builtin_amdgcn_fence(__ATOMIC_ACQUIRE, "agent");
            asm volatile("s_waitcnt vmcnt(0)" ::: "memory");
        }
    }
    __syncthreads();
}

#ifndef PH
#define PH 0xFFFF
#endif
#define PHON(b) ((((PH) >> (b)) & 1) != 0)
#ifndef TIME_PHASE
#define TIME_PHASE -1
#endif
#ifndef EXPERIMENT
#define EXPERIMENT 0
#endif
#define TIME_MULT 4
#if TIME_PHASE >= 0
#define PH_T0(k) do { if ((k) == TIME_PHASE && bid == 0) t_ph = __builtin_amdgcn_s_memrealtime(); } while (0)
#define PH_T1(k) do { if ((k) == TIME_PHASE && bid == 0) { const unsigned long long t1_ = __builtin_amdgcn_s_memrealtime(), d_ = t1_ - t_ph; while (__builtin_amdgcn_s_memrealtime() - t1_ < (unsigned long long)TIME_MULT * d_) __builtin_amdgcn_s_sleep(8); } } while (0)
#else
#define PH_T0(k) do { } while (0)
#define PH_T1(k) do { } while (0)
#endif
__global__ void __launch_bounds__(NTHREADS, 2) fwd_megakernel(Params P) {
    extern __shared__ __attribute__((aligned(16))) unsigned char lds_raw[];
    LAS unsigned char* const lds0 = (LAS unsigned char*)lds_raw;
    cg::grid_group grid = cg::this_grid();
    const int G = gridDim.x, bid = blockIdx.x;
    const int vcu = (G % 8 == 0) ? (bid % 8) * (G / 8) + bid / 8 : bid;
    const int ngw = G * NWAVES;
    unsigned long long t_ph = 0; (void)t_ph;
    const unsigned long long t_entry = (TIME_PHASE == 99) ? __builtin_amdgcn_s_memrealtime() : 0ull; (void)t_entry;
    if (threadIdx.x < 4) ((LAS unsigned*)(lds0 + LDS_BYTES - 16))[threadIdx.x] = 0u;
    __syncthreads();
    (void)xcd_barrier_post((unsigned*)(P.ws + WS_BAR), (volatile LAS unsigned*)(lds0 + LDS_BYTES - 16));
#define GSYNC() do { XcdBarrier xb_; xb_.bar = (unsigned*)(opaque_ptr(P.ws) + WS_BAR); xb_.x = xb_xcc_id(); xb_.st = (volatile LAS unsigned*)(opaque_lds(lds0) + LDS_BYTES - 16); xcd_barrier(xb_); } while (0)
#define KTID() const int tid = opaque_tid(), wave = __builtin_amdgcn_readfirstlane(tid >> 6), lane = tid & 63, gw = bid * NWAVES + wave; (void)lane; (void)gw

    PH_T0(0);
    { KTID(); unsigned char* const ws = opaque_ptr(P.ws); LAS unsigned char* const lds = opaque_lds(lds0); (void)lds;
    if (bid == 0 && tid < 64) ((int*)(ws + WS_CTL))[tid] = 0;
    if (PHON(0)) for (int it = bid; it < 128 + 192; it += G) { if (it < 128) s5_tables_item(P, lds, it); else mod_item(P, lds, it - 128); }
    rope_table(P, bid * NTHREADS + tid, G * NTHREADS);
    for (int i = bid * NTHREADS + tid; i < 2 * 32 * 1024; i += G * NTHREADS) { const int k_ = i & 1023, e_ = (i >> 10) & 31, l_ = i >> 15; const float wv_ = P.router_w[(size_t)l_ * 1024 * 32 + k_ * 32 + e_];
        const unsigned hw_ = f2bf(wv_); bf16_t* rt_ = (bf16_t*)(ws + WS_RWT) + (size_t)l_ * 2 * 32 * 1024 + e_ * 1024 + k_; rt_[0] = (bf16_t)hw_; rt_[32 * 1024] = (bf16_t)f2bf(wv_ - __builtin_bit_cast(float, hw_ << 16)); }
    for (int i = bid * NTHREADS + tid; i < 2 * 4 * 64 * 16; i += G * NTHREADS) { const int rr = i & 15, dd = (i >> 4) & 63, hh_ = (i >> 10) & 3, ll = i >> 12;
        ((bf16_t*)(ws + WS_WA2T))[i] = (dd < 48) ? (bf16_t)f2bf(P.gla_w_a2[(size_t)ll * 16 * 192 + rr * 192 + hh_ * 48 + dd]) : (bf16_t)0; }
    __syncthreads();
    if (PHON(1)) transpose_small(P, lds, gw, ngw, wave, lane); }
    if (P.ws == nullptr) grid.sync();
    GSYNC(); PH_T1(0); PH_T0(1);
    { KTID(); unsigned char* const ws = opaque_ptr(P.ws); LAS unsigned char* const lds = opaque_lds(lds0); (void)lds;
    for (int tok = gw; tok < T_TOK; tok += ngw) {
        const float* mrow = (const float*)(ws + WS_MOD) + (size_t)(tok >> 12) * 6144;
        f32x4 v[4];
#pragma unroll
        for (int hf = 0; hf < 2; ++hf)
#pragma unroll
            for (int q = 0; q < 2; ++q) v[hf * 2 + q] = *(const f32x4*)(P.x + (size_t)tok * 1024 + hf * 512 + 8 * lane + 4 * q);
        norm_row_store(v, P.norm1_w, mrow, mrow + 1024, (bf16_t*)(ws + WS_HDN) + (size_t)tok * 1024, lane);
    } }
    GSYNC(); PH_T1(1);
#pragma unroll 1
    for (int l = 0; l < NLAYER; ++l) {
        PH_T0(2);
        if (PHON(2)) { unsigned char* const ws = opaque_ptr(P.ws); LAS unsigned char* const lds = opaque_lds(lds0); (void)lds; DenseOrder S; S.init(T_TOK, NPROJP, 1024, G, bid, ws + WS_HDN, (const bf16_t*)(ws + WS_WIN) + (size_t)l * NPROJP * 1024);
          EpiProj E{(bf16_t*)(ws + WS_PROJ), NPROJP};
          gm::gemm_phase<EpiProj, DenseOrder, false>(lds, 1024, S, E); }
        GSYNC(); PH_T1(2); PH_T0(3);
        { LAS unsigned char* const lds = opaque_lds(lds0);
#define SUBT0(k, b) do { if (TIME_PHASE == (k) && bid == (b)) t_ph = __builtin_amdgcn_s_memrealtime(); } while (0)
#define SUBT1(k, b) do { if (TIME_PHASE == (k) && bid == (b)) { const unsigned long long t1_ = __builtin_amdgcn_s_memrealtime(), d_ = t1_ - t_ph; while (__builtin_amdgcn_s_memrealtime() - t1_ < (unsigned long long)TIME_MULT * d_) __builtin_amdgcn_s_sleep(8); } } while (0)
          SUBT0(20, 0);
          if (PHON(3)) for (int rd = bid; rd < 2048; rd += G) mixer_phase_a(P, lds, l, rd);
          SUBT1(20, 0); SUBT0(21, 0);
          if (PHON(4)) for (int it = bid; it < 256; it += G) s5_item(P, lds, l, it);
          SUBT1(21, 0); SUBT0(22, 0);
          { KTID(); transpose_moe(P, lds, l, gw, ngw, wave, lane); }
          SUBT1(22, 0); }
        GSYNC(); PH_T1(3); PH_T0(4);
        if (PHON(5) && bid >= 144) { unsigned char* const ws = opaque_ptr(P.ws); LAS unsigned char* const lds = opaque_lds(lds0); (void)lds; DenseOrder S; S.init(T_TOK, 256, 256, G - 144, bid - 144, ws + WS_YBUF, (const bf16_t*)(ws + WS_WGLU) + (size_t)l * 256 * 256);
          EpiGlu E{(const bf16_t*)(ws + WS_YBUF), (bf16_t*)(ws + WS_MIXED), P.s5_b_glu + l * 256};
          gm::gemm_phase<EpiGlu, DenseOrder, false>(lds, 256, S, E); }
        if (PHON(3)) mixer_phase_b(P, bid, G);
        GSYNC(); PH_T1(4); PH_T0(5);
        if (PHON(3)) { KTID(); LAS unsigned char* const lds = opaque_lds(lds0); for (int it = gw; it < 4096; it += ngw) mixer_phase_c(P, lds, l, it); }
        GSYNC(); PH_T1(5); PH_T0(6);
        if (PHON(6)) { unsigned char* const ws = opaque_ptr(P.ws); LAS unsigned char* const lds = opaque_lds(lds0); (void)lds; const float* modl = (const float*)(ws + WS_MOD) + (size_t)l * 8 * 6144; DenseOrder S; S.init(T_TOK, 1024, 1024, G, bid, ws + WS_MIXED, (const bf16_t*)(ws + WS_WOUT) + (size_t)l * 1024 * 1024);
          EpiOut E{l == 0 ? P.x : (const float*)(ws + WS_X), (float*)(ws + WS_X), modl + 2048};
          gm::gemm_phase<EpiOut, DenseOrder, false>(lds, 1024, S, E); }
        GSYNC(); PH_T1(6); PH_T0(7);
        if (PHON(7)) { LAS unsigned char* const lds = opaque_lds(lds0); for (int blk = bid; blk < T_TOK / 128; blk += G) router_phase(P, lds, l, blk); }
        GSYNC(); PH_T1(7); PH_T0(8);
        if (PHON(8)) { unsigned char* const ws = opaque_ptr(P.ws); LAS unsigned char* const lds = opaque_lds(lds0); (void)lds; moe_tables(lds, (const int*)(ws + WS_CTL) + l * 32, 8);
          MoeOrder<true> S; S.tab = (LAS const int*)(lds + MISC_OFF); S.nN = 8; S.G = G; S.vc = vcu; S.Wt = (const char*)(ws + WS_WUP) + (size_t)l * 32 * 2048 * 1024 * 2; S.wstride = (size_t)2048 * 1024 * 2; S.stok = (const int*)(ws + WS_STOK); S.A = (const char*)(ws + WS_HDN); S.gtab = (LAS const unsigned*)(lds + GT_OFF);
          S.fill_gather((LAS unsigned*)(lds + GT_OFF));
          EpiUp E{(bf16_t*)(ws + WS_ACT), P.b_up + (size_t)l * 32 * 2048, (LAS const int*)(lds + MISC_OFF)};
          gm::gemm_phase<EpiUp, MoeOrder<true>, true>(lds, 1024, S, E); }
        GSYNC(); PH_T1(8); PH_T0(9);
#if EXPERIMENT >= 1
        if (l == 0) { unsigned char* const ws = opaque_ptr(P.ws); LAS unsigned char* const lds = opaque_lds(lds0); (void)lds; moe_tables(lds, (const int*)(ws + WS_CTL) + l * 32, 8);
          MoeOrder<(EXPERIMENT != 2)> S; S.tab = (LAS const int*)(lds + MISC_OFF); S.nN = 8; S.G = G; S.vc = vcu; S.Wt = (const char*)(ws + WS_WUP) + (size_t)l * 32 * 2048 * 1024 * 2; S.wstride = (EXPERIMENT == 4) ? 0 : (size_t)2048 * 1024 * 2; S.stok = (const int*)(ws + WS_STOK); S.A = (const char*)(ws + WS_HDN); S.gtab = (LAS const unsigned*)(lds + GT_OFF);
          if (EXPERIMENT != 2) S.fill_gather((LAS unsigned*)(lds + GT_OFF));
          if (EXPERIMENT == 3) { EpiProj E{(bf16_t*)(ws + WS_OUTR), 2048}; gm::gemm_phase<EpiProj, MoeOrder<(EXPERIMENT != 2)>, (EXPERIMENT != 2)>(lds, 1024, S, E); }
          else { EpiUp E{(bf16_t*)(ws + WS_OUTR), P.b_up + (size_t)l * 32 * 2048, (LAS const int*)(lds + MISC_OFF)}; gm::gemm_phase<EpiUp, MoeOrder<(EXPERIMENT != 2)>, (EXPERIMENT != 2)>(lds, 1024, S, E); }
          GSYNC(); }
#endif
        if (PHON(9)) { unsigned char* const ws = opaque_ptr(P.ws); LAS unsigned char* const lds = opaque_lds(lds0); (void)lds; moe_tables(lds, (const int*)(ws + WS_CTL) + l * 32, 4);
          MoeOrder<false> S; S.tab = (LAS const int*)(lds + MISC_OFF); S.nN = 4; S.G = G; S.vc = vcu; S.Wt = (const char*)(ws + WS_WDN) + (size_t)l * 32 * 1024 * 1024 * 2; S.wstride = (size_t)1024 * 1024 * 2; S.stok = nullptr; S.A = (const char*)(ws + WS_ACT); S.gtab = nullptr;
          EpiDown E{(bf16_t*)(ws + WS_OUTR), P.b_down + (size_t)l * 32 * 1024, (const int*)(ws + WS_STOK), (const float*)(ws + WS_SGATE)};
          gm::gemm_phase<EpiDown, MoeOrder<false>, false>(lds, 1024, S, E); }
        GSYNC(); PH_T1(9); PH_T0(10);
        if (PHON(10)) { KTID(); combine_phase(P, l, gw, ngw, lane); }
        GSYNC(); PH_T1(10);
    }
    if (TIME_PHASE == 99 && bid == 0) { const unsigned long long t1_ = __builtin_amdgcn_s_memrealtime(), d_ = t1_ - t_entry; while (__builtin_amdgcn_s_memrealtime() - t1_ < d_) __builtin_amdgcn_s_sleep(8); }
}

extern "C" void kernel_launch(void* const* d_in, const int* in_sizes, int n_in, void* d_out, int out_size, void* d_ws, size_t ws_size, hipStream_t stream) {
    static int grid_blocks = 0;
    if (grid_blocks == 0) {
        if (n_in != 29 || ws_size < WS_END) { fprintf(stderr, "kernel_launch: unexpected n_in %d or ws_size %zu (need %zu)\n", n_in, ws_size, (size_t)WS_END); grid_blocks = -1; return; }
        int dev = 0, cus = 0, per_cu = 0;
        (void)hipGetDevice(&dev);
        (void)hipDeviceGetAttribute(&cus, hipDeviceAttributeMultiprocessorCount, dev);
        (void)hipFuncSetAttribute((const void*)fwd_megakernel, hipFuncAttributeMaxDynamicSharedMemorySize, LDS_BYTES);
        (void)hipOccupancyMaxActiveBlocksPerMultiprocessor(&per_cu, (const void*)fwd_megakernel, NTHREADS, LDS_BYTES);
        if (per_cu < 1) { fprintf(stderr, "kernel_launch: occupancy query returned %d\n", per_cu); per_cu = 1; }
        grid_blocks = cus;
        fprintf(stderr, "kernel_launch: cus %d per_cu %d grid %d ws_need %zu\n", cus, per_cu, grid_blocks, (size_t)WS_END);
    }
    if (grid_blocks < 0) return;
    Params p{};
    const float** pp = (const float**)&p;
    for (int i = 0; i < 29; ++i) pp[i] = (const float*)d_in[i];
    p.out = (float*)d_out; p.ws = (unsigned char*)d_ws;
    for (int i = 0; i < 24; ++i) p.inv_freq_rev[i] = pow(10000.0, -(double)(2 * i) / 48.0) / 6.283185307179586476925;
    for (int h = 0; h < 4; ++h) p.log_gamma[h] = (float)log1p(-exp2(-5.0 - (double)h));
    (void)hipMemsetAsync((char*)d_ws + WS_CTL, 0, WS_CTL_BYTES, stream);
    void* args[] = {&p};
    hipError_t e = hipLaunchCooperativeKernel((const void*)fwd_megakernel, dim3(grid_blocks), dim3(NTHREADS), args, LDS_BYTES, stream);
    if (e != hipSuccess) fprintf(stderr, "cooperative launch failed: %s (grid %d)\n", hipGetErrorString(e), grid_blocks);
}
```

```cpp
#include <hip/hip_runtime.h>
#include <hip/hip_cooperative_groups.h>
#include <cstdio>
#include <cstdint>
#include <cmath>
namespace cg = cooperative_groups;

#define LAS __attribute__((address_space(3)))
typedef unsigned short bf16_t;
typedef short bf16x8 __attribute__((ext_vector_type(8)));
typedef float f32x4 __attribute__((ext_vector_type(4)));
typedef float f32x16 __attribute__((ext_vector_type(16)));
typedef unsigned u32x4 __attribute__((ext_vector_type(4)));
typedef unsigned u32x2 __attribute__((ext_vector_type(2)));

constexpr int T_TOK = 32768, DM = 1024, NBATCH = 8, SEQ = 4096, NLAYER = 2;
constexpr int NPROJ = 2576, NPROJP = 2816;
constexpr int NE = 32, CAP = 32768, NSLOT = T_TOK * 4;
constexpr int C_GQ = 0, C_GK = 192, C_GV = 384, C_GG = 768, C_GA = 1152, C_RQ = 1168, C_RK = 1360, C_RV = 1552, C_RG = 1936, C_SU = 2320;
constexpr float NORM_EPS = 1e-5f;
constexpr int NTHREADS = 512, NWAVES = 8;
constexpr int LDS_BYTES = 160 * 1024;
constexpr int MISC_OFF = 148 * 1024;

constexpr size_t al256(size_t x) { return (x + 255) & ~(size_t)255; }
constexpr size_t WS_CTL   = 0;
constexpr size_t WS_BAR   = 4096;
constexpr size_t WS_CTL_BYTES = 32768;
constexpr size_t WS_MOD   = 32768;
constexpr size_t WS_WIN   = al256(WS_MOD + (size_t)2 * 8 * 6144 * 4);
constexpr size_t WS_WOUT  = al256(WS_WIN + (size_t)2 * NPROJP * 1024 * 2);
constexpr size_t WS_WUP   = al256(WS_WOUT + (size_t)2 * 1024 * 1024 * 2);
constexpr size_t WS_WDN   = al256(WS_WUP + (size_t)2 * 32 * 2048 * 1024 * 2);
constexpr size_t WS_WGLU  = al256(WS_WDN + (size_t)2 * 32 * 1024 * 1024 * 2);
constexpr size_t WS_KTAB  = al256(WS_WGLU + (size_t)2 * 256 * 256 * 2);
constexpr size_t WS_BPOW  = al256(WS_KTAB + (size_t)2 * 16 * 65 * 256 * 2);
constexpr size_t WS_CPOW  = al256(WS_BPOW + (size_t)2 * 16 * 128 * 1024 * 2);
constexpr size_t WS_LAM64 = al256(WS_CPOW + (size_t)2 * 16 * 1024 * 128 * 2);
constexpr size_t WS_ROPE  = al256(WS_LAM64 + (size_t)2 * 16 * 64 * 2 * 4);
constexpr size_t WS_WA2T  = al256(WS_ROPE + (size_t)4096 * 24 * 2 * 4);
constexpr size_t WS_RWT   = al256(WS_WA2T + (size_t)2 * 4 * 64 * 16 * 2);
constexpr size_t WS_X     = al256(WS_RWT + (size_t)2 * 2 * 32 * 1024 * 2);
constexpr size_t WS_HDN   = al256(WS_X + (size_t)T_TOK * 1024 * 4);
constexpr size_t WS_PROJ  = al256(WS_HDN + (size_t)T_TOK * 1024 * 2);
constexpr size_t WS_MIXED = al256(WS_PROJ + (size_t)T_TOK * NPROJP * 2);
constexpr size_t WS_YBUF  = al256(WS_MIXED + (size_t)T_TOK * 1024 * 2);
constexpr size_t WS_ACT   = al256(WS_YBUF + (size_t)T_TOK * 256 * 2);
constexpr size_t WS_OUTR  = al256(WS_ACT + (size_t)(NSLOT + 256) * 1024 * 2);
constexpr size_t WS_STOK  = al256(WS_OUTR + (size_t)NSLOT * 1024 * 2);
constexpr size_t WS_SGATE = al256(WS_STOK + (size_t)NE * CAP * 4);
constexpr size_t MXW_QD = WS_ACT, MXW_OI = WS_ACT + ((size_t)32 << 20), MXW_DS = WS_ACT + ((size_t)96 << 20), MXW_DEC = WS_ACT + ((size_t)176 << 20), MXW_SP = WS_ACT + ((size_t)180 << 20);
constexpr size_t WS_END   = al256(WS_SGATE + (size_t)NE * CAP * 4);

struct Params {
    const float* x; const float* c; const float* norm1_w; const float* norm2_w; const float* w_mod; const float* b_mod;
    const float* w_in; const float* gla_w_a2; const float* gla_b_a; const float* gla_norm_w; const float* ret_norm_w;
    const float* s5_a_re; const float* s5_a_im; const float* s5_log_dt; const float* s5_b_re; const float* s5_b_im;
    const float* s5_c_re; const float* s5_c_im; const float* s5_d; const float* s5_w_glu; const float* s5_b_glu;
    const float* w_out; const float* router_w; const float* router_b; const float* w_up; const float* b_up;
    const float* w_down; const float* b_down; const float* final_norm_w;
    float* out; unsigned char* ws;
    double inv_freq_rev[24];
    float log_gamma[4]; float pad0[4];
};

__device__ __forceinline__ unsigned f2bf(float f) { unsigned u = __builtin_bit_cast(unsigned, f); return (u + 0x7fffu + ((u >> 16) & 1u)) >> 16; }
typedef float f32x2_t __attribute__((ext_vector_type(2)));
typedef __bf16 bf16x2_t __attribute__((ext_vector_type(2)));
__device__ __forceinline__ unsigned pk2(float lo, float hi) { const f32x2_t v = {lo, hi}; const bf16x2_t b = __builtin_convertvector(v, bf16x2_t); return __builtin_bit_cast(unsigned, b); }
__device__ __forceinline__ float bflo(unsigned w) { return __builtin_bit_cast(float, w << 16); }
__device__ __forceinline__ float bfhi(unsigned w) { return __builtin_bit_cast(float, w & 0xffff0000u); }
__device__ __forceinline__ float bf2f(bf16_t b) { return __builtin_bit_cast(float, (unsigned)b << 16); }
__device__ __forceinline__ float lx_f(float v, int lane, int o) { return __builtin_bit_cast(float, __builtin_amdgcn_ds_bpermute((lane ^ o) << 2, __builtin_bit_cast(int, v))); }
__device__ __forceinline__ int lx_i(int v, int lane, int o) { return __builtin_amdgcn_ds_bpermute((lane ^ o) << 2, v); }
__device__ __forceinline__ float lidx_f(float v, int src) { return __builtin_bit_cast(float, __builtin_amdgcn_ds_bpermute(src << 2, __builtin_bit_cast(int, v))); }
__device__ __forceinline__ float wave_sum(float v, int lane) {
#pragma unroll
    for (int o = 1; o < 64; o <<= 1) v += lx_f(v, lane, o);
    return v;
}
__device__ __forceinline__ float sigmoidf_(float x) { return __builtin_amdgcn_rcpf(1.0f + __builtin_amdgcn_exp2f(-1.4426950408889634f * x)); }
__device__ __forceinline__ float siluf(float x) { return x * sigmoidf_(x); }
#define LDS_WAIT() asm volatile("s_waitcnt lgkmcnt(0)" ::: "memory")
__device__ __forceinline__ unsigned char* opaque_ptr(unsigned char* p) { const unsigned long long v = (unsigned long long)p; unsigned lo = __builtin_amdgcn_readfirstlane((unsigned)v), hi = __builtin_amdgcn_readfirstlane((unsigned)(v >> 32));
    asm volatile("" : "+s"(lo), "+s"(hi)); return (unsigned char*)(__attribute__((address_space(1))) unsigned char*)(((unsigned long long)hi << 32) | lo); }
__device__ __forceinline__ LAS unsigned char* opaque_lds(LAS unsigned char* p) { unsigned v = __builtin_amdgcn_readfirstlane((unsigned)(size_t)p); asm volatile("" : "+s"(v)); return (LAS unsigned char*)(size_t)v; }
__device__ __forceinline__ int opaque_tid() { int t = threadIdx.x; asm volatile("" : "+v"(t)); return t; }

namespace gm {
constexpr int BM = 256, BK = 64, HALF = 128, HTB = HALF * BK * 2, STAGE_BYTES = 8 * HTB, NXCD = 8, WGM = 8;
__device__ __forceinline__ int lds_byte(int r, int c) { const int st = (r >> 4) * 2 + (c >> 5), rr = r & 15, cc = c & 31, ob = rr * 64 + cc * 2; return st * 1024 + (ob ^ (((ob >> 9) & 1) << 5)); }
__device__ __forceinline__ void stage_rc(int b, int& R, int& C) { const int st = b / 1024, sb = b % 1024, swz = sb ^ (((sb >> 9) & 1) << 5); R = (st >> 1) * 16 + swz / 64; C = (st & 1) * 32 + (swz % 64) / 2; }
__device__ __forceinline__ int perm32(int rho) { const int n = rho >> 4, i = rho & 15; return 8 * (i >> 2) + 4 * n + (i & 3); }

struct Unit { const char* B; int pm, pn, e, rows; };

template <class Epi, class Sched, bool GATHER>
__device__ __forceinline__ void gemm_phase(LAS unsigned char* lds, const int K_in, const Sched& S, const Epi& E) {
    int K = K_in; asm volatile("" : "+s"(K));
    const int tid = opaque_tid(), wid = __builtin_amdgcn_readfirstlane(tid >> 6), lane = tid & 63, wr = wid >> 2, wc = wid & 3, fr = lane & 15, fq = lane >> 4;
    const int nt = K / BK;
    int R0, C0; unsigned voffB;
    { stage_rc(tid * 16, R0, C0);
      const int Rb0 = Epi::PERM ? ((R0 & ~31) + perm32(R0 & 31)) : R0;
      voffB = (unsigned)(Rb0 * K + C0) * 2u; }
    const size_t kstep = (size_t)(BK * 2);
    const size_t hstep = (size_t)HALF * K * 2;
    const size_t qstep = (size_t)64 * K * 2;
    const unsigned ldsw = (unsigned)wid * 1024u;
    const int aoff = lds_byte(wr * 64 + fr, fq * 8), boff = lds_byte(wc * 32 + fr, fq * 8);
#define G_SA(b, h) (((b) * 2 + (h)) * gm::HTB)
#define G_SB(b, h) ((4 + (b) * 2 + (h)) * gm::HTB)
#define G_GLDS(gptr, ldsoff) __builtin_amdgcn_global_load_lds((const unsigned*)(gptr), (LAS unsigned*)(lds + (ldsoff)), 16, 0, 0)
#define G_STAGEB(bufoff, gbase) do { G_GLDS((const char*)(gbase) + voffB, (bufoff) + ldsw); G_GLDS((const char*)(gbase) + qstep + voffB, (bufoff) + ldsw + 8192); } while (0)
#define G_STAGEA(bufoff, ubase, h, o0, o1) do { if (GATHER) { G_GLDS((const char*)(ubase) + (o0), (bufoff) + ldsw); G_GLDS((const char*)(ubase) + (o1), (bufoff) + ldsw + 8192); } \
        else { G_GLDS((const char*)(ubase) + (h) * hstep + (o0), (bufoff) + ldsw); G_GLDS((const char*)(ubase) + (h) * hstep + qstep + (o0), (bufoff) + ldsw + 8192); } } while (0)
#define G_LDA(dst, b, h) do { _Pragma("unroll") for (int m = 0; m < 4; ++m) _Pragma("unroll") for (int k = 0; k < 2; ++k) dst[m][k] = *(const LAS bf16x8*)(lds + G_SA(b, h) + aoff + m * 2048 + k * 1024); } while (0)
#define G_LDB(dst, b, h) do { _Pragma("unroll") for (int n = 0; n < 2; ++n) _Pragma("unroll") for (int k = 0; k < 2; ++k) dst[n][k] = *(const LAS bf16x8*)(lds + G_SB(b, h) + boff + n * 2048 + k * 1024); } while (0)
#define G_MMA(ai, bj, At, Bt) do { __builtin_amdgcn_s_setprio(1); _Pragma("unroll") for (int m = 0; m < 4; ++m) _Pragma("unroll") for (int n = 0; n < 2; ++n) _Pragma("unroll") for (int k = 0; k < 2; ++k) \
        acc[ai][bj][m][n] = __builtin_amdgcn_mfma_f32_16x16x32_bf16(Bt[n][k], At[m][k], acc[ai][bj][m][n], 0, 0, 0); __builtin_amdgcn_s_setprio(0); } while (0)
#define G_WAIT_V(n) asm volatile("s_waitcnt vmcnt(" #n ")" ::: "memory")
#define G_WAIT_L(n) asm volatile("s_waitcnt lgkmcnt(" #n ")" ::: "memory")
#define G_BAR __builtin_amdgcn_s_barrier()
#define G_SCHED __builtin_amdgcn_sched_barrier(0)
    Unit cur, nxt; int ui = 0;
    if (!S.next(0, cur)) return;
    f32x4 acc[2][2][4][2];
#pragma unroll
    for (int a = 0; a < 2; ++a)
#pragma unroll
        for (int b = 0; b < 2; ++b)
#pragma unroll
            for (int m = 0; m < 4; ++m)
#pragma unroll
                for (int n = 0; n < 2; ++n) acc[a][b][m][n] = (f32x4){0.f, 0.f, 0.f, 0.f};
    bf16x8 At[4][2], B0[2][2], B1[2][2];
    unsigned c00, c01 = 0, c10 = 0, c11 = 0;
    c00 = S.a_off(0, R0, C0);
    if (GATHER) { c01 = S.a_off(0, R0 + 64, C0); c10 = S.a_off(0, R0 + 128, C0); c11 = S.a_off(0, R0 + 192, C0); }
    const char* cA = S.a_base(cur); const char* cB = cur.B;
    G_STAGEB(G_SB(0, 0), cB); G_STAGEB(G_SB(0, 1), cB + hstep); G_STAGEA(G_SA(0, 0), cA, 0, c00, c01); G_STAGEA(G_SA(0, 1), cA, 1, c10 + (GATHER ? 0u : c00), c11);
    if (wr == 1) G_BAR;
    G_WAIT_V(2); G_BAR;
    G_STAGEB(G_SB(1, 0), cB + kstep); G_STAGEA(G_SA(1, 0), cA + kstep, 0, c00, c01); G_STAGEB(G_SB(1, 1), cB + hstep + kstep);
    G_WAIT_V(6); G_BAR;
    for (;;) {
        const bool has_next = S.next(ui + 1, nxt);
        const char* nB = cB; const char* nA = cA;
        if (has_next) { nB = nxt.B; nA = S.a_base(nxt); }
        for (int t = 0; t < nt; t += 2) {
            const bool last = (t == nt - 2);
            const char* a1 = cA + (size_t)(t + 1) * kstep;
            const char* a2 = last ? nA : cA + (size_t)(t + 2) * kstep;
            const char* b2 = last ? nB : cB + (size_t)(t + 2) * kstep;
            G_LDB(B0, 0, 0); G_LDB(B1, 0, 1); G_SCHED; G_LDA(At, 0, 0); G_STAGEA(G_SA(1, 1), a1, 1, c10 + (GATHER ? 0u : c00), c11);
            G_WAIT_V(8); G_WAIT_L(0); G_BAR; G_MMA(0, 0, At, B0); G_MMA(0, 1, At, B1); G_BAR; G_SCHED;
            if (GATHER) { if (last && has_next) { c00 = S.a_off(ui + 1, R0, C0); c01 = S.a_off(ui + 1, R0 + 64, C0); c10 = S.a_off(ui + 1, R0 + 128, C0); c11 = S.a_off(ui + 1, R0 + 192, C0); } }
            G_LDA(At, 0, 1); G_STAGEB(G_SB(0, 0), b2); G_STAGEB(G_SB(0, 1), b2 + hstep); G_STAGEA(G_SA(0, 0), a2, 0, c00, c01);
            G_WAIT_V(8); G_WAIT_L(0); G_BAR; G_MMA(1, 0, At, B0); G_MMA(1, 1, At, B1); G_BAR; G_SCHED;
            G_LDB(B0, 1, 0); G_LDB(B1, 1, 1); G_SCHED; G_LDA(At, 1, 0); G_STAGEA(G_SA(0, 1), a2, 1, c10 + (GATHER ? 0u : c00), c11);
            G_WAIT_V(8); G_WAIT_L(0); G_BAR; G_MMA(0, 0, At, B0); G_MMA(0, 1, At, B1); G_BAR; G_SCHED;
            G_LDA(At, 1, 1); G_STAGEB(G_SB(1, 0), b2 + kstep); G_STAGEB(G_SB(1, 1), b2 + kstep + hstep); G_STAGEA(G_SA(1, 0), a2 + kstep, 0, c00, c01);
            G_WAIT_V(8); G_WAIT_L(0); G_BAR; G_MMA(1, 0, At, B0); G_MMA(1, 1, At, B1); G_BAR; G_SCHED;
        }
        if (wr == 0) G_BAR;
        E(acc, cur, wr, wc, fr, fq);
        if (!has_next) break;
#pragma unroll
        for (int a = 0; a < 2; ++a)
#pragma unroll
            for (int b = 0; b < 2; ++b)
#pragma unroll
                for (int m = 0; m < 4; ++m)
#pragma unroll
                    for (int n = 0; n < 2; ++n) acc[a][b][m][n] = (f32x4){0.f, 0.f, 0.f, 0.f};
        cur = nxt; cB = nB; cA = nA; ++ui;
        if (wr == 1) G_BAR;
    }
    G_WAIT_V(0);
    G_BAR;
}
}

struct DenseOrder {
    int nM, nN, nwg, G, c, K; const char* Bt;
    __device__ __forceinline__ void init(int M, int N, int K_, int G_, int c_, const void* A_, const void* Bt_) { nM = M / 256; nN = N / 256; nwg = nM * nN; G = G_; c = c_; K = K_; A = (const char*)A_; Bt = (const char*)Bt_; }
    __device__ __forceinline__ bool next(int i, gm::Unit& u) const {
        const long L = (long)i * G + c; if (L >= nwg) return false;
        int wgid = (int)L; { const int q = nwg / gm::NXCD, r = nwg % gm::NXCD, xcd = wgid % gm::NXCD, off = wgid / gm::NXCD; wgid = (xcd < r ? xcd * (q + 1) : r * (q + 1) + (xcd - r) * q) + off; }
        const int nig = gm::WGM * nN, gid = wgid / nig, fm = gid * gm::WGM, gsz = (nM - fm) < gm::WGM ? (nM - fm) : gm::WGM;
        u.pm = fm + ((wgid % nig) % gsz); u.pn = (wgid % nig) / gsz; u.e = 0; u.rows = 256;
        u.B = Bt + (size_t)u.pn * 256 * K * 2; return true;
    }
    const char* A;
    __device__ __forceinline__ const char* a_base(const gm::Unit& u) const { return A + (size_t)u.pm * 256 * K * 2; }
    __device__ __forceinline__ unsigned a_off(int, int r, int c) const { return (unsigned)(r * K + c) * 2u; }
};
constexpr int GT_MAX = 19, GT_OFF = 128 * 1024;
template <bool GATHER> struct MoeOrder {
    LAS const int* tab; int nN, G, vc; const char* Wt; size_t wstride; const int* stok;
    __device__ __forceinline__ bool next(int i, gm::Unit& u) const {
        const int L = i * G + vc; if (L >= tab[32]) return false;
        int e = 0;
#pragma unroll 1
        for (int k = 1; k < 32; ++k) e += (tab[k] <= L) ? 1 : 0;
        const int r = L - tab[e]; u.e = e; u.pm = r / nN; u.pn = r % nN;
        const int cnt = tab[128 + e]; u.rows = (cnt - u.pm * 256) < 256 ? (cnt - u.pm * 256) : 256;
        u.B = Wt + (size_t)e * wstride + (size_t)u.pn * 256 * 1024 * 2; return true;
    }
    const char* A;
    __device__ __forceinline__ const char* a_base(const gm::Unit& u) const { return GATHER ? A : A + (size_t)(tab[64 + u.e] + u.pm * 256) * 2048; }
    LAS const unsigned* gtab;
    __device__ __forceinline__ unsigned a_off(int ui, int r, int c) const {
        if (GATHER) return gtab[ui * 256 + r] + (unsigned)c * 2u;
        else return (unsigned)(r * 1024 + c) * 2u;
    }
    __device__ __forceinline__ void fill_gather(LAS unsigned* gt) const {
        const int tid = opaque_tid();
        if (tid < 256) { gm::Unit u;
            for (int i = 0; i < GT_MAX && next(i, u); ++i) { int tk = 0; if (tid < u.rows) tk = stok[u.e * CAP + u.pm * 256 + tid] >> 2; gt[i * 256 + tid] = (unsigned)tk * 2048u; } }
        __syncthreads();
    }
};
__device__ __forceinline__ void moe_tables(LAS unsigned char* lds, const int* gcount, int nN) {
    LAS int* tab = (LAS int*)(lds + MISC_OFF);
    if (opaque_tid() == 0) { int cu = 0, ro = 0;
#pragma unroll 1
        for (int e = 0; e < 32; ++e) { const int c = gcount[e]; tab[e] = cu; tab[64 + e] = ro; tab[128 + e] = c; cu += ((c + 255) >> 8) * nN; ro += c; }
        tab[32] = cu; tab[64 + 32] = ro; }
    __syncthreads();
}

struct EpiProj {
    static constexpr bool PERM = true;
    bf16_t* O; int ldc;
    __device__ __forceinline__ void operator()(const f32x4 (&acc)[2][2][4][2], const gm::Unit& u, int wr, int wc, int fr_, int fq_) const {
        int fr = fr_, fq = fq_; asm volatile("" : "+v"(fr), "+v"(fq));
        const int row0 = u.pm * 256 + wr * 64 + fr, col0 = u.pn * 256 + wc * 32 + 8 * fq;
#pragma unroll
        for (int ai = 0; ai < 2; ++ai)
#pragma unroll
            for (int m = 0; m < 4; ++m) { bf16_t* rowp = O + (size_t)(row0 + ai * 128 + m * 16) * ldc + col0;
#pragma unroll
                for (int bj = 0; bj < 2; ++bj) { const f32x4 v0 = acc[ai][bj][m][0], v1 = acc[ai][bj][m][1];
                    u32x4 w; w.x = pk2(v0[0], v0[1]); w.y = pk2(v0[2], v0[3]); w.z = pk2(v1[0], v1[1]); w.w = pk2(v1[2], v1[3]);
                    *(u32x4*)(rowp + bj * 128) = w; } }
    }
};
struct EpiOut {
    static constexpr bool PERM = false;
    const float* xin; float* xout; const float* gate;
    __device__ __forceinline__ void operator()(const f32x4 (&acc)[2][2][4][2], const gm::Unit& u, int wr, int wc, int fr_, int fq_) const {
        int fr = fr_, fq = fq_; asm volatile("" : "+v"(fr), "+v"(fq));
        const int row0 = u.pm * 256 + wr * 64 + fr, col0 = u.pn * 256 + wc * 32 + 4 * fq;
        const float* gp = gate + (size_t)(u.pm >> 4) * 6144 + col0;
        f32x4 gv[2][2];
#pragma unroll
        for (int bj = 0; bj < 2; ++bj)
#pragma unroll
            for (int n = 0; n < 2; ++n) gv[bj][n] = *(const f32x4*)(gp + bj * 128 + n * 16);
#pragma unroll
        for (int ai = 0; ai < 2; ++ai)
#pragma unroll
            for (int m = 0; m < 4; ++m) { const size_t ro = (size_t)(row0 + ai * 128 + m * 16) * 1024 + col0;
#pragma unroll
                for (int bj = 0; bj < 2; ++bj)
#pragma unroll
                    for (int n = 0; n < 2; ++n) { const f32x4 xi = *(const f32x4*)(xin + ro + bj * 128 + n * 16);
                        *(f32x4*)(xout + ro + bj * 128 + n * 16) = xi + gv[bj][n] * acc[ai][bj][m][n]; } }
    }
};
struct EpiGlu {
    static constexpr bool PERM = true;
    const bf16_t* y; bf16_t* mixed; const float* bias;
    __device__ __forceinline__ void operator()(const f32x4 (&acc)[2][2][4][2], const gm::Unit& u, int wr, int wc, int fr_, int fq_) const {
        int fr = fr_, fq = fq_; asm volatile("" : "+v"(fr), "+v"(fq));
        const int row0 = u.pm * 256 + wr * 64 + fr, col0 = wc * 32 + 8 * fq;
#pragma unroll
        for (int ai = 0; ai < 2; ++ai)
#pragma unroll
            for (int m = 0; m < 4; ++m) { const int row = row0 + ai * 128 + m * 16;
#pragma unroll
                for (int bj = 0; bj < 2; ++bj) { const int col = col0 + bj * 128;
                    const f32x4 b0 = *(const f32x4*)(bias + col), b1 = *(const f32x4*)(bias + col + 4);
                    const u32x4 yw = *(const u32x4*)(y + (size_t)row * 256 + col);
                    const f32x4 z0 = acc[ai][bj][m][0] + b0, z1 = acc[ai][bj][m][1] + b1;
                    u32x4 w;
                    w.x = pk2(bflo(yw.x) * sigmoidf_(z0[0]), bfhi(yw.x) * sigmoidf_(z0[1]));
                    w.y = pk2(bflo(yw.y) * sigmoidf_(z0[2]), bfhi(yw.y) * sigmoidf_(z0[3]));
                    w.z = pk2(bflo(yw.z) * sigmoidf_(z1[0]), bfhi(yw.z) * sigmoidf_(z1[1]));
                    w.w = pk2(bflo(yw.w) * sigmoidf_(z1[2]), bfhi(yw.w) * sigmoidf_(z1[3]));
                    *(u32x4*)(mixed + (size_t)row * 1024 + 768 + col) = w; }
                __builtin_amdgcn_sched_barrier(0); }
    }
};
__device__ __forceinline__ float swiglu1(float g, float l) {
    g = fminf(g, 7.0f); l = fminf(fmaxf(l, -7.0f), 7.0f);
    return g * __builtin_amdgcn_rcpf(1.0f + __builtin_amdgcn_exp2f(-2.4554669595930157f * g)) * (l + 1.0f);
}
struct EpiUp {
    static constexpr bool PERM = true;
    bf16_t* act; const float* bias; LAS const int* tab;
    __device__ __forceinline__ void operator()(const f32x4 (&acc)[2][2][4][2], const gm::Unit& u, int wr, int wc, int fr_, int fq_) const {
        int fr = fr_, fq = fq_; asm volatile("" : "+v"(fr), "+v"(fq));
        const int rl0 = wr * 64 + fr, col0 = u.pn * 128 + wc * 32 + 8 * fq;
        const float* bp = bias + (size_t)u.e * 2048 + col0;
        unsigned bgp[4], blp[4];
        { const f32x4 bg0 = *(const f32x4*)(bp), bg1 = *(const f32x4*)(bp + 4), bl0 = *(const f32x4*)(bp + 1024), bl1 = *(const f32x4*)(bp + 1028);
          bgp[0] = pk2(bg0[0], bg0[1]); bgp[1] = pk2(bg0[2], bg0[3]); bgp[2] = pk2(bg1[0], bg1[1]); bgp[3] = pk2(bg1[2], bg1[3]);
          blp[0] = pk2(bl0[0], bl0[1]); blp[1] = pk2(bl0[2], bl0[3]); blp[2] = pk2(bl1[0], bl1[1]); blp[3] = pk2(bl1[2], bl1[3]); }
        const size_t arow = (size_t)(tab[64 + u.e] + u.pm * 256);
#pragma unroll
        for (int ai = 0; ai < 2; ++ai)
#pragma unroll
            for (int m = 0; m < 4; ++m) { const int rl = rl0 + ai * 128 + m * 16;
                if (rl < u.rows) {
                    const f32x4 bg0 = {bflo(bgp[0]), bfhi(bgp[0]), bflo(bgp[1]), bfhi(bgp[1])}, bg1 = {bflo(bgp[2]), bfhi(bgp[2]), bflo(bgp[3]), bfhi(bgp[3])};
                    const f32x4 bl0 = {bflo(blp[0]), bfhi(blp[0]), bflo(blp[1]), bfhi(blp[1])}, bl1 = {bflo(blp[2]), bfhi(blp[2]), bflo(blp[3]), bfhi(blp[3])};
                    const f32x4 g0 = acc[ai][0][m][0] + bg0, g1 = acc[ai][0][m][1] + bg1, l0 = acc[ai][1][m][0] + bl0, l1 = acc[ai][1][m][1] + bl1;
                    u32x4 w;
                    w.x = pk2(swiglu1(g0[0], l0[0]), swiglu1(g0[1], l0[1])); w.y = pk2(swiglu1(g0[2], l0[2]), swiglu1(g0[3], l0[3]));
                    w.z = pk2(swiglu1(g1[0], l1[0]), swiglu1(g1[1], l1[1])); w.w = pk2(swiglu1(g1[2], l1[2]), swiglu1(g1[3], l1[3]));
                    *(u32x4*)(act + (arow + rl) * 1024 + col0) = w; } }
    }
};
struct EpiDown {
    static constexpr bool PERM = true;
    bf16_t* outr; const float* bias; const int* stok; const float* sgate;
    __device__ __forceinline__ void operator()(const f32x4 (&acc)[2][2][4][2], const gm::Unit& u, int wr, int wc, int fr_, int fq_) const {
        int fr = fr_, fq = fq_; asm volatile("" : "+v"(fr), "+v"(fq));
        const int rl0 = wr * 64 + fr, col0 = u.pn * 256 + wc * 32 + 8 * fq;
        const float* bp = bias + (size_t)u.e * 1024 + col0;
        f32x4 bv[2][2];
#pragma unroll
        for (int bj = 0; bj < 2; ++bj) { bv[bj][0] = *(const f32x4*)(bp + bj * 128); bv[bj][1] = *(const f32x4*)(bp + bj * 128 + 4); }
        int sts[8]; float gts[8];
#pragma unroll
        for (int q = 0; q < 8; ++q) { const int rl = rl0 + (q >> 2) * 128 + (q & 3) * 16; const int si = u.e * CAP + u.pm * 256 + (rl < u.rows ? rl : 0); sts[q] = stok[si]; gts[q] = sgate[si]; }
#pragma unroll
        for (int ai = 0; ai < 2; ++ai)
#pragma unroll
            for (int m = 0; m < 4; ++m) { const int rl = rl0 + ai * 128 + m * 16;
                if (rl < u.rows) {
                    const int st = sts[ai * 4 + m]; const float gt = gts[ai * 4 + m];
                    bf16_t* rowp = outr + (size_t)st * 1024 + col0;
#pragma unroll
                    for (int bj = 0; bj < 2; ++bj) { const f32x4 v0 = (acc[ai][bj][m][0] + bv[bj][0]) * gt, v1 = (acc[ai][bj][m][1] + bv[bj][1]) * gt;
                        u32x4 w; w.x = pk2(v0[0], v0[1]); w.y = pk2(v0[2], v0[3]); w.z = pk2(v1[0], v1[1]); w.w = pk2(v1[2], v1[3]);
                        *(u32x4*)(rowp + bj * 128) = w; } } }
    }
};

__device__ __forceinline__ void transpose_item(const float* W, int K, int Nsrc, bf16_t* WT, int mode, LAS float* scr, int kb, int nb, int lane) {
    const int k0 = 64 * kb, n0 = 32 * nb;
    const int ncol = n0 + (lane & 31);
#pragma unroll 8
    for (int i = 0; i < 32; ++i) { const int kk = 2 * i + (lane >> 5); scr[kk * 33 + (lane & 31)] = (ncol < Nsrc) ? W[(size_t)(k0 + kk) * Nsrc + ncol] : 0.f; }
    LDS_WAIT(); asm volatile("" ::: "memory");
    const int c = lane & 7;
#pragma unroll
    for (int j = 0; j < 4; ++j) { const int n = (lane >> 3) + 8 * j; const LAS float* s = scr + (8 * c) * 33 + n;
        u32x4 o; o.x = pk2(s[0 * 33], s[1 * 33]); o.y = pk2(s[2 * 33], s[3 * 33]); o.z = pk2(s[4 * 33], s[5 * 33]); o.w = pk2(s[6 * 33], s[7 * 33]);
        int drow = n0 + n;
        if (mode == 1) { const int jj = drow & 1023, lin = drow >> 10; drow = (jj >> 7) * 256 + lin * 128 + (jj & 127); }
        *(u32x4*)(WT + (size_t)drow * K + k0 + 8 * c) = o; }
    LDS_WAIT(); asm volatile("" ::: "memory");
}
constexpr int TI_IN = 16 * 88, TI_OUT = 16 * 32, TI_UP = 16 * 64, TI_DN = 16 * 32, TI_GLU = 4 * 8;
constexpr int TS_R0 = 2 * TI_IN, TS_R1 = TS_R0 + 2 * TI_OUT, TS_R2 = TS_R1 + 2 * TI_GLU;
__device__ __forceinline__ void transpose_small(const Params& P, LAS unsigned char* lds, int gw, int ngw, int wave, int lane) {
    unsigned char* const wsp = opaque_ptr(P.ws);
    LAS float* scr = (LAS float*)(lds + wave * 8704);
    for (int it = gw; it < TS_R2; it += ngw) {
        if (it < TS_R0) { const int l = it / TI_IN, r = it % TI_IN;
            transpose_item(P.w_in + (size_t)l * 1024 * NPROJ, 1024, NPROJ, (bf16_t*)(wsp + WS_WIN) + (size_t)l * NPROJP * 1024, 0, scr, r / 88, r % 88, lane); }
        else if (it < TS_R1) { const int q = it - TS_R0, l = q / TI_OUT, r = q % TI_OUT;
            transpose_item(P.w_out + (size_t)l * 1024 * 1024, 1024, 1024, (bf16_t*)(wsp + WS_WOUT) + (size_t)l * 1024 * 1024, 0, scr, r / 32, r % 32, lane); }
        else { const int q = it - TS_R1, l = q / TI_GLU, r = q % TI_GLU;
            transpose_item(P.s5_w_glu + (size_t)l * 256 * 256, 256, 256, (bf16_t*)(wsp + WS_WGLU) + (size_t)l * 256 * 256, 0, scr, r / 8, r % 8, lane); }
    }
}
__device__ __forceinline__ void transpose_item64(const float* W, int K, int Nsrc, bf16_t* WT, int mode, LAS float* scr, int kb, int nb, int lane) {
    const int k0 = 64 * kb, n0 = 64 * nb, kq = lane >> 4, nn = 4 * (lane & 15);
    const float* src = W + (size_t)(k0 + kq) * Nsrc + n0 + nn;
    f32x4 v[16];
#pragma unroll
    for (int i = 0; i < 16; ++i) v[i] = __builtin_nontemporal_load((const f32x4*)(src + (size_t)(4 * i) * Nsrc));
#pragma unroll
    for (int i = 0; i < 16; ++i) { LAS float* d = scr + (4 * i + kq) * 65 + nn; d[0] = v[i][0]; d[1] = v[i][1]; d[2] = v[i][2]; d[3] = v[i][3]; }
    LDS_WAIT(); asm volatile("" ::: "memory");
    const int c = lane & 7;
#pragma unroll
    for (int j = 0; j < 8; ++j) { const int n = (lane >> 3) + 8 * j; const LAS float* s = scr + (8 * c) * 65 + n;
        u32x4 o; o.x = pk2(s[0 * 65], s[1 * 65]); o.y = pk2(s[2 * 65], s[3 * 65]); o.z = pk2(s[4 * 65], s[5 * 65]); o.w = pk2(s[6 * 65], s[7 * 65]);
        int drow = n0 + n;
        if (mode == 1) { const int jj = drow & 1023, lin = drow >> 10; drow = (jj >> 7) * 256 + lin * 128 + (jj & 127); }
        *(u32x4*)(WT + (size_t)drow * K + k0 + 8 * c) = o; }
    LDS_WAIT(); asm volatile("" ::: "memory");
}
constexpr int TM_UP = 16 * 32, TM_DN = 16 * 16;
constexpr int TM_TOTAL = 32 * (TM_UP + TM_DN), TM_Q_IN = 2560, TM_Q_DN = 5120;
__device__ __forceinline__ void transpose_moe_item(const Params& P, unsigned char* wsp, LAS float* scr, int l, int it, int lane) {
    if (it < 32 * TM_UP) { const int le = l * 32 + it / TM_UP, r = it % TM_UP;
        transpose_item64(P.w_up + (size_t)le * 1024 * 2048, 1024, 2048, (bf16_t*)(wsp + WS_WUP) + (size_t)le * 2048 * 1024, 1, scr, r / 32, r % 32, lane); }
    else { const int q = it - 32 * TM_UP, le = l * 32 + q / TM_DN, r = q % TM_DN;
        transpose_item64(P.w_down + (size_t)le * 1024 * 1024, 1024, 1024, (bf16_t*)(wsp + WS_WDN) + (size_t)le * 1024 * 1024, 0, scr, r / 16, r % 16, lane); }
}
__device__ __forceinline__ int tm_pool_size(int l) { return l == 0 ? TM_Q_IN : TM_Q_DN + TM_Q_IN; }
__device__ __forceinline__ void transpose_moe_pool(const Params& P, LAS unsigned char* lds, int l, int limit) {
    unsigned char* const wsp = opaque_ptr(P.ws);
    const int tid = opaque_tid(), wave = __builtin_amdgcn_readfirstlane(tid >> 6), lane = tid & 63;
    LAS float* scr = (LAS float*)(lds + wave * 16640);
    int* ctr = (int*)(wsp + WS_CTL) + 128 + l;
    const int qa = tm_pool_size(l);
    for (;;) {
        if (8 * __builtin_amdgcn_readfirstlane(__hip_atomic_load(ctr, __ATOMIC_RELAXED, __HIP_MEMORY_SCOPE_AGENT)) >= limit) break;
        int bt = 0; if (lane == 0) bt = __hip_atomic_fetch_add(ctr, 1, __ATOMIC_RELAXED, __HIP_MEMORY_SCOPE_AGENT);
        bt = __builtin_amdgcn_readfirstlane(bt);
        if (8 * bt >= qa) break;
#pragma unroll 1
        for (int k = 0; k < 8; ++k) transpose_moe_item(P, wsp, scr, l, 8 * bt + k, lane);
    }
}
__device__ __forceinline__ void transpose_moe_rest(const Params& P, LAS unsigned char* lds, int l, int gw, int ngw) {
    transpose_moe_pool(P, lds, l, TM_TOTAL);
    unsigned char* const wsp = opaque_ptr(P.ws);
    const int tid = opaque_tid(), wave = __builtin_amdgcn_readfirstlane(tid >> 6), lane = tid & 63;
    LAS float* scr = (LAS float*)(lds + wave * 16640);
    for (int it = tm_pool_size(l) + gw; it < TM_TOTAL; it += ngw) transpose_moe_item(P, wsp, scr, l, it, lane);
}
__device__ __forceinline__ int xcd_vc(int c, int Gp) { const int q = Gp / 8, r = Gp % 8, xcd = c % 8, off = c / 8; return (xcd < r ? xcd * (q + 1) : r * (q + 1) + (xcd - r) * q) + off; }
__device__ __forceinline__ void mod_item(const Params& P, LAS unsigned char* lds, int item) {
    unsigned char* const wsp = opaque_ptr(P.ws);
    const int tid = opaque_tid(), wave = tid >> 6, lane = tid & 63;
    LAS float* sc = (LAS float*)lds;
    LAS float* red = (LAS float*)(lds + 32768);
    const int l = item / 96, cb = item % 96;
    for (int i = tid; i < 8192; i += NTHREADS) sc[i] = siluf(P.c[i]);
    __syncthreads();
    const float* W = P.w_mod + (size_t)l * 1024 * 6144 + cb * 64 + lane;
    float a[8];
#pragma unroll
    for (int b = 0; b < 8; ++b) a[b] = 0.f;
#pragma unroll 1
    for (int k0 = wave; k0 < 1024; k0 += 128) { float wv[16];
#pragma unroll
        for (int u = 0; u < 16; ++u) wv[u] = __builtin_nontemporal_load(W + (size_t)(k0 + 8 * u) * 6144);
#pragma unroll
        for (int u = 0; u < 16; ++u) {
#pragma unroll
            for (int b = 0; b < 8; ++b) a[b] += sc[b * 1024 + k0 + 8 * u] * wv[u]; } }
#pragma unroll
    for (int b = 0; b < 8; ++b) red[(wave * 8 + b) * 64 + lane] = a[b];
    __syncthreads();
    { const int b = tid >> 6; float s = 0.f;
#pragma unroll
      for (int w = 0; w < 8; ++w) s += red[(w * 8 + b) * 64 + lane];
      ((float*)(wsp + WS_MOD))[(size_t)(l * 8 + b) * 6144 + cb * 64 + lane] = s + P.b_mod[l * 6144 + cb * 64 + lane]; }
    __syncthreads();
}
__device__ __forceinline__ void dsincos(double x, double& s, double& c) {
    const double x2 = x * x; double ts = x, tc = 1.0; s = x; c = 1.0;
#pragma unroll 1
    for (int k = 1; k <= 14; ++k) { tc = -tc * x2 / (double)((2 * k - 1) * (2 * k)); ts = -ts * x2 / (double)((2 * k) * (2 * k + 1)); c += tc; s += ts; }
}
__device__ __forceinline__ double dexp_small(double z) {
    double t = 1.0, r = 1.0;
#pragma unroll 1
    for (int k = 1; k <= 18; ++k) { t = t * z / (double)k; r += t; }
    return r;
}
__device__ __forceinline__ void s5_tables_item(const Params& P, LAS unsigned char* lds, int item4) {
    unsigned char* const wsp = opaque_ptr(P.ws);
    const int tid = opaque_tid(); const int item = item4 >> 2, qtr = item4 & 3; const int l = item >> 4, g = item & 15, lg = l * 16 + g;
    LAS float* pwr = (LAS float*)lds;
    LAS float* pwi = pwr + 64 * 65;
    LAS float* bbr = pwi + 64 * 65;
    LAS float* bbi = bbr + 1024;
    LAS float* ccr = bbi + 1024;
    LAS float* cci = ccr + 1024;
    if (tid < 64) { const int p = tid;
        const double are = (double)P.s5_a_re[lg * 64 + p], aim = (double)P.s5_a_im[lg * 64 + p];
        const double dt = (double)expf(P.s5_log_dt[lg]);
        const double mag = dexp_small(are * dt);
        double ang = aim * dt; const double TWO_PI = 6.283185307179586476925;
        ang -= TWO_PI * rint(ang / TWO_PI);
        double sn, cs; dsincos(ang, sn, cs);
        const double lbr = mag * cs, lbi = mag * sn;
        const double nr = lbr - 1.0, ni = lbi, den = are * are + aim * aim;
        const double cfr = (nr * are + ni * aim) / den, cfi = (ni * are - nr * aim) / den;
        double pr = 1.0, pi_ = 0.0;
        for (int t = 0; t <= 64; ++t) { pwr[p * 65 + t] = (float)pr; pwi[p * 65 + t] = (float)pi_; const double nr2 = pr * lbr - pi_ * lbi, ni2 = pr * lbi + pi_ * lbr; pr = nr2; pi_ = ni2; }
        for (int h = 0; h < 16; ++h) { const double br = (double)P.s5_b_re[(lg * 64 + p) * 16 + h], bi = (double)P.s5_b_im[(lg * 64 + p) * 16 + h];
            bbr[p * 16 + h] = (float)(cfr * br - cfi * bi); bbi[p * 16 + h] = (float)(cfr * bi + cfi * br); }
        float* l64 = (float*)(wsp + WS_LAM64) + (size_t)(lg * 64 + p) * 2;
        if (qtr == 0) { l64[0] = pwr[p * 65 + 64]; l64[1] = pwi[p * 65 + 64]; }
    }
    for (int i = tid; i < 1024; i += NTHREADS) { ccr[i] = P.s5_c_re[lg * 1024 + i]; cci[i] = P.s5_c_im[lg * 1024 + i]; }
    __syncthreads();
    bf16_t* kt = (bf16_t*)(wsp + WS_KTAB) + (size_t)lg * 65 * 256;
    for (int i = qtr * 16 * 256 + tid; i < (qtr == 3 ? 65 : 16 * (qtr + 1)) * 256; i += NTHREADS) { const int tau = i >> 8, h = (i >> 4) & 15, h2 = i & 15; float s = 0.f;
        if (tau < 64) {
            for (int p = 0; p < 64; ++p) { const float pr = pwr[p * 65 + tau], pi_ = pwi[p * 65 + tau], br = bbr[p * 16 + h2], bi = bbi[p * 16 + h2];
                const float wr_ = pr * br - pi_ * bi, wi_ = pr * bi + pi_ * br; s += ccr[h * 64 + p] * wr_ - cci[h * 64 + p] * wi_; }
            if (tau == 0 && h == h2) s += P.s5_d[l * 256 + g * 16 + h]; }
        kt[i] = (bf16_t)f2bf(s); }
    bf16_t* bp = (bf16_t*)(wsp + WS_BPOW) + (size_t)lg * 128 * 1024;
    for (int i = qtr * 32768 + tid; i < (qtr + 1) * 32768; i += NTHREADS) { const int q = i >> 10, s = (i >> 4) & 63, h2 = i & 15, p = q & 63;
        const float pr = pwr[p * 65 + 63 - s], pi_ = pwi[p * 65 + 63 - s], br = bbr[p * 16 + h2], bi = bbi[p * 16 + h2];
        const float v = (q < 64) ? (pr * br - pi_ * bi) : (pr * bi + pi_ * br);
        bp[i] = (bf16_t)f2bf(v); }
    bf16_t* cp = (bf16_t*)(wsp + WS_CPOW) + (size_t)lg * 1024 * 128;
    for (int i = qtr * 32768 + tid; i < (qtr + 1) * 32768; i += NTHREADS) { const int q = i & 127, th = i >> 7, t = th >> 4, h = th & 15, p = q & 63;
        const float pr = pwr[p * 65 + t + 1], pi_ = pwi[p * 65 + t + 1], cr = ccr[h * 64 + p], ci = cci[h * 64 + p];
        const float v = (q < 64) ? (cr * pr - ci * pi_) : -(cr * pi_ + ci * pr);
        cp[i] = (bf16_t)f2bf(v); }
    __syncthreads();
}
__device__ __forceinline__ void rope_table(const Params& P, int gtid, int gthreads) {
    unsigned char* const wsp = opaque_ptr(P.ws);
    float* rp = (float*)(wsp + WS_ROPE);
    for (int i = gtid; i < 4096 * 24; i += gthreads) { const int pos = i / 24, f = i % 24;
        double rev = (double)pos * P.inv_freq_rev[f]; rev -= rint(rev);
        double sn, cs; dsincos(rev * 6.283185307179586476925, sn, cs);
        rp[2 * i] = (float)cs; rp[2 * i + 1] = (float)sn; }
}
__device__ __forceinline__ void norm_row_store(const f32x4 (&v)[4], const float* nw, const float* modrow_sh, const float* modrow_sc, bf16_t* orow, int lane) {
    float ss = 0.f;
#pragma unroll
    for (int j = 0; j < 4; ++j) ss += (v[j][0] * v[j][0] + v[j][1] * v[j][1]) + (v[j][2] * v[j][2] + v[j][3] * v[j][3]);
    const float rstd = 1.0f / sqrtf(wave_sum(ss, lane) * (1.0f / 1024.0f) + NORM_EPS);
#pragma unroll
    for (int hf = 0; hf < 2; ++hf) { const int col = hf * 512 + 8 * lane; float o[8];
#pragma unroll
        for (int q = 0; q < 2; ++q) { const f32x4 w = *(const f32x4*)(nw + col + 4 * q), sc = *(const f32x4*)(modrow_sc + col + 4 * q), sh = *(const f32x4*)(modrow_sh + col + 4 * q);
#pragma unroll
            for (int e = 0; e < 4; ++e) o[4 * q + e] = v[hf * 2 + q][e] * rstd * w[e] * (1.0f + sc[e]) + sh[e]; }
        u32x4 w4; w4.x = pk2(o[0], o[1]); w4.y = pk2(o[2], o[3]); w4.z = pk2(o[4], o[5]); w4.w = pk2(o[6], o[7]);
        *(u32x4*)(orow + col) = w4; }
}

template <int KS>
__device__ __forceinline__ f32x16 mma32(LAS const unsigned char* A, int lda, LAS const unsigned char* B, int ldb, f32x16 acc, int lane) {
    const int r = lane & 31, h = lane >> 5;
#pragma unroll
    for (int ks = 0; ks < KS; ++ks) {
        const bf16x8 a = *(const LAS bf16x8*)(A + r * lda + ks * 32 + h * 16);
        const bf16x8 b = *(const LAS bf16x8*)(B + r * ldb + ks * 32 + h * 16);
        acc = __builtin_amdgcn_mfma_f32_32x32x16_bf16(a, b, acc, 0, 0, 0);
    }
    return acc;
}
__device__ __forceinline__ int crow(int reg, int lane) { return (reg & 3) + 8 * (reg >> 2) + 4 * (lane >> 5); }

constexpr int MA_QD = 0, MA_KI = 7168, MA_KET = 14336, MA_VT = 23552, MA_SLOT = 37376;
__device__ __forceinline__ bf16x8 frag_from(unsigned a, unsigned b, unsigned c, unsigned d) { const u32x4 v = {a, b, c, d}; return __builtin_bit_cast(bf16x8, v); }
__device__ __forceinline__ void mixer_phase_a(const Params& P, LAS unsigned char* lds, int l, int round) {
    unsigned char* const wsp = opaque_ptr(P.ws);
    const int tid = opaque_tid(), w = __builtin_amdgcn_readfirstlane(tid >> 6), lane = tid & 63, r = lane & 31, hh = lane >> 5;
    const int slot = w >> 2, wv = w & 3, nt = wv & 1, mt = wv >> 1;
    const int item = 2 * round + slot, n = item & 63, h = (item >> 6) & 3, b = (item >> 8) & 7, type = item >> 11;
    LAS unsigned char* const L = lds + slot * MA_SLOT;
    const bf16_t* prow = (const bf16_t*)(wsp + WS_PROJ) + (size_t)(b * SEQ + n * 64) * NPROJP;
    const int cq = (type ? C_RQ : C_GQ) + h * 48, ck = (type ? C_RK : C_GK) + h * 48, cv = (type ? C_RV : C_GV) + h * 96;
    const int d = 32 * nt + r; const bool dvalid = d < 48;
    { const int t4 = wv * 64 + lane;
#pragma unroll
      for (int jj = 0; jj < 3; ++jj) { const int p = t4 + 256 * jj, j = p / 12, c = p % 12;
          const u32x4 vv = *(const u32x4*)(prow + (size_t)j * NPROJP + cv + 8 * c);
          LAS bf16_t* dst = (LAS bf16_t*)(L + MA_VT + (8 * c) * 144 + j * 2);
          dst[0 * 72] = (bf16_t)(vv.x & 0xffff); dst[1 * 72] = (bf16_t)(vv.x >> 16); dst[2 * 72] = (bf16_t)(vv.y & 0xffff); dst[3 * 72] = (bf16_t)(vv.y >> 16);
          dst[4 * 72] = (bf16_t)(vv.z & 0xffff); dst[5 * 72] = (bf16_t)(vv.z >> 16); dst[6 * 72] = (bf16_t)(vv.w & 0xffff); dst[7 * 72] = (bf16_t)(vv.w >> 16); } }
    float qv[16], kv[16], cum[16], tot;
    if (type == 0) {
#pragma unroll
        for (int reg = 0; reg < 16; ++reg) { const int t = 32 * mt + crow(reg, lane); const bf16_t* pr = prow + (size_t)t * NPROJP;
            qv[reg] = dvalid ? bf2f(pr[cq + d]) * 0.14433756729740643f : 0.f; kv[reg] = dvalid ? bf2f(pr[ck + d]) : 0.f; }
        const bf16_t* wat = (const bf16_t*)(wsp + WS_WA2T) + (size_t)((l * 4 + h) * 64 + d) * 16 + 8 * hh;
        const bf16x8 waf = *(const bf16x8*)wat;
        const float bias = dvalid ? P.gla_b_a[l * 192 + h * 48 + d] : 0.f;
        unsigned xh[2][2][4];
#pragma unroll
        for (int m2 = 0; m2 < 2; ++m2) {
            const bf16x8 gaf = *(const bf16x8*)(prow + (size_t)(32 * m2 + r) * NPROJP + C_GA + 8 * hh);
            f32x16 pre;
#pragma unroll
            for (int i = 0; i < 16; ++i) pre[i] = 0.f;
            pre = __builtin_amdgcn_mfma_f32_32x32x16_bf16(gaf, waf, pre, 0, 0, 0);
            float la[16];
#pragma unroll
            for (int reg = 0; reg < 16; ++reg) { const float x = pre[reg] + bias;
                const float ls2 = fminf(x, 0.f) * 1.4426950408889634f - __builtin_amdgcn_logf(1.0f + __builtin_amdgcn_exp2f(-1.4426950408889634f * fabsf(x)));
                la[reg] = dvalid ? ls2 * (1.0f / 16.0f) : 0.f; }
#pragma unroll
            for (int s2 = 0; s2 < 2; ++s2)
#pragma unroll
                for (int q = 0; q < 4; ++q) xh[m2][s2][q] = pk2(la[8 * s2 + 2 * q], la[8 * s2 + 2 * q + 1]);
        }
        f32x16 cacc, tacc;
#pragma unroll
        for (int i = 0; i < 16; ++i) { cacc[i] = 0.f; tacc[i] = 0.f; }
        const bf16x8 ones = frag_from(0x3F803F80u, 0x3F803F80u, 0x3F803F80u, 0x3F803F80u);
#pragma unroll
        for (int m2 = 0; m2 < 2; ++m2)
#pragma unroll
            for (int s2 = 0; s2 < 2; ++s2) {
                const bf16x8 fh = frag_from(xh[m2][s2][0], xh[m2][s2][1], xh[m2][s2][2], xh[m2][s2][3]);
                tacc = __builtin_amdgcn_mfma_f32_32x32x16_bf16(ones, fh, tacc, 0, 0, 0);
                if (m2 < mt) { cacc = __builtin_amdgcn_mfma_f32_32x32x16_bf16(ones, fh, cacc, 0, 0, 0); }
                else if (m2 == mt) { unsigned tw[4];
#pragma unroll
                    for (int q = 0; q < 4; ++q) { const int k0 = 16 * s2 + 8 * ((2 * q) >> 2) + 4 * hh + ((2 * q) & 3), k1 = 16 * s2 + 8 * ((2 * q + 1) >> 2) + 4 * hh + ((2 * q + 1) & 3);
                        tw[q] = (k0 <= r ? 0x3F80u : 0u) | (k1 <= r ? 0x3F800000u : 0u); }
                    const bf16x8 tri = frag_from(tw[0], tw[1], tw[2], tw[3]);
                    cacc = __builtin_amdgcn_mfma_f32_32x32x16_bf16(tri, fh, cacc, 0, 0, 0); }
            }
#pragma unroll
        for (int reg = 0; reg < 16; ++reg) cum[reg] = cacc[reg];
        tot = tacc[0];
    } else {
        const float lgam = P.log_gamma[h];
        const float* rope = (const float*)(wsp + WS_ROPE) + (size_t)(n * 64) * 48;
        const int dp = (d < 24) ? d + 24 : d - 24, f = (d < 24) ? d : d - 24;
#pragma unroll
        for (int reg = 0; reg < 16; ++reg) { const int t = 32 * mt + crow(reg, lane); const bf16_t* pr = prow + (size_t)t * NPROJP;
            float q0 = 0.f, q1 = 0.f, k0 = 0.f, k1 = 0.f, cs = 1.f, sn = 0.f;
            if (dvalid) { q0 = bf2f(pr[cq + d]); q1 = bf2f(pr[cq + dp]); k0 = bf2f(pr[ck + d]); k1 = bf2f(pr[ck + dp]); cs = rope[t * 48 + 2 * f]; sn = rope[t * 48 + 2 * f + 1]; }
            qv[reg] = (d < 24) ? (q0 * cs - q1 * sn) : (q1 * sn + q0 * cs);
            kv[reg] = ((d < 24) ? (k0 * cs - k1 * sn) : (k1 * sn + k0 * cs)) * 0.14433756729740643f;
            cum[reg] = (float)(t + 1) * lgam * 1.4426950408889634f; }
        tot = 64.0f * lgam * 1.4426950408889634f;
    }
    {
        bf16_t* qdg = (bf16_t*)(wsp + MXW_QD) + (size_t)item * 3072;
        float ke[16];
#pragma unroll
        for (int reg = 0; reg < 16; ++reg) { const int t = 32 * mt + crow(reg, lane);
            const float e1 = __builtin_amdgcn_exp2f(cum[reg]), e2 = __builtin_amdgcn_exp2f(-cum[reg]), e3 = __builtin_amdgcn_exp2f(tot - cum[reg]);
            const bf16_t qd = (bf16_t)f2bf(qv[reg] * e1), ki = (bf16_t)f2bf(kv[reg] * e2); ke[reg] = kv[reg] * e3;
            if (dvalid) { *(LAS bf16_t*)(L + MA_QD + t * 112 + d * 2) = qd; *(LAS bf16_t*)(L + MA_KI + t * 112 + d * 2) = ki; qdg[t * 48 + d] = qd; } }
#pragma unroll
        for (int g4 = 0; g4 < 4; ++g4) { const int t0 = 32 * mt + 8 * g4 + 4 * hh; u32x2 pk; pk.x = pk2(ke[4 * g4], ke[4 * g4 + 1]); pk.y = pk2(ke[4 * g4 + 2], ke[4 * g4 + 3]);
            *(LAS u32x2*)(L + MA_KET + d * 144 + t0 * 2) = pk; }
        if (mt == 0 && hh == 0 && dvalid) ((float*)(wsp + MXW_DEC))[(size_t)item * 48 + d] = __builtin_amdgcn_exp2f(tot);
    }
    __syncthreads();
    {
        unsigned* oig = (unsigned*)(wsp + MXW_OI) + (size_t)item * 3072;
        float* dsg = (float*)(wsp + MXW_DS) + (size_t)item * 4608;
        f32x16 zero16;
#pragma unroll
        for (int i = 0; i < 16; ++i) zero16[i] = 0.f;
        const int it = (wv == 0) ? 0 : 1;
        f32x16 sd = mma32<3>(L + MA_KI + it * 32 * 112, 112, L + MA_QD + it * 32 * 112, 112, zero16, lane);
        unsigned xd[2][4];
#pragma unroll
        for (int s2 = 0; s2 < 2; ++s2)
#pragma unroll
            for (int q = 0; q < 4; ++q) { const int r0 = 8 * s2 + 2 * q; const float a0 = (crow(r0, lane) <= r) ? sd[r0] : 0.f, a1 = (crow(r0 + 1, lane) <= r) ? sd[r0 + 1] : 0.f; xd[s2][q] = pk2(a0, a1); }
        unsigned xo[2][4];
        if (it == 1) { const f32x16 so = mma32<3>(L + MA_KI, 112, L + MA_QD + 32 * 112, 112, zero16, lane);
#pragma unroll
            for (int s2 = 0; s2 < 2; ++s2)
#pragma unroll
                for (int q = 0; q < 4; ++q) xo[s2][q] = pk2(so[8 * s2 + 2 * q], so[8 * s2 + 2 * q + 1]); }
        const int nvt = (wv == 0) ? 3 : 1, vt0 = (wv == 0) ? 0 : wv - 1;
#pragma unroll 1
        for (int vi = 0; vi < nvt; ++vi) { const int vt = vt0 + vi;
            f32x16 oacc = zero16;
            LAS const unsigned char* vb = L + MA_VT + (32 * vt + r) * 144 + 8 * hh;
            if (it == 1) {
#pragma unroll
                for (int s2 = 0; s2 < 2; ++s2) { const u32x2 lo = *(const LAS u32x2*)(vb + 32 * s2), hi = *(const LAS u32x2*)(vb + 32 * s2 + 16);
                    oacc = __builtin_amdgcn_mfma_f32_32x32x16_bf16(frag_from(xo[s2][0], xo[s2][1], xo[s2][2], xo[s2][3]), frag_from(lo.x, lo.y, hi.x, hi.y), oacc, 0, 0, 0); } }
#pragma unroll
            for (int s2 = 0; s2 < 2; ++s2) { const u32x2 lo = *(const LAS u32x2*)(vb + 64 * it + 32 * s2), hi = *(const LAS u32x2*)(vb + 64 * it + 32 * s2 + 16);
                oacc = __builtin_amdgcn_mfma_f32_32x32x16_bf16(frag_from(xd[s2][0], xd[s2][1], xd[s2][2], xd[s2][3]), frag_from(lo.x, lo.y, hi.x, hi.y), oacc, 0, 0, 0); }
#pragma unroll
            for (int q = 0; q < 8; ++q) oig[((it * 3 + vt) * 8 + q) * 64 + lane] = pk2(oacc[2 * q], oacc[2 * q + 1]);
            const int dt = (wv == 0) ? 1 : 0;
            const f32x16 ds = mma32<4>(L + MA_KET + dt * 32 * 144, 144, L + MA_VT + vt * 32 * 144, 144, zero16, lane);
#pragma unroll
            for (int g4 = 0; g4 < 4; ++g4) { const int d0 = 32 * dt + 8 * g4 + 4 * hh;
                if (d0 < 48) { f32x4 o; o[0] = ds[4 * g4]; o[1] = ds[4 * g4 + 1]; o[2] = ds[4 * g4 + 2]; o[3] = ds[4 * g4 + 3]; *(f32x4*)(dsg + (32 * vt + r) * 48 + d0) = o; } }
        }
    }
    __syncthreads();
}
__device__ __forceinline__ void mixer_phase_b(const Params& P, int bid, int G) {
    unsigned char* const wsp = opaque_ptr(P.ws);
    const int tid = opaque_tid();
    for (int task = bid * NTHREADS + tid; task < 64 * 1152; task += G * NTHREADS) {
        const int seq = task / 1152, q4 = task % 1152, d0 = (q4 % 12) * 4;
        const float* dsp = (const float*)(wsp + MXW_DS) + (size_t)seq * 64 * 4608 + q4 * 4;
        const float* dcp = (const float*)(wsp + MXW_DEC) + (size_t)seq * 64 * 48 + d0;
        bf16_t* spp = (bf16_t*)(wsp + MXW_SP) + (size_t)seq * 64 * 4608 + q4 * 4;
        f32x4 st = {0.f, 0.f, 0.f, 0.f};
#pragma unroll 16
        for (int n = 0; n < 64; ++n) { const f32x4 ds = *(const f32x4*)(dsp + (size_t)n * 4608), dc = *(const f32x4*)(dcp + n * 48);
            u32x2 pk; pk.x = pk2(st[0], st[1]); pk.y = pk2(st[2], st[3]); *(u32x2*)(spp + (size_t)n * 4608) = pk;
            st = dc * st + ds; }
    }
}
__device__ __forceinline__ void mixer_phase_c(const Params& P, LAS unsigned char* lds, int l, int item) {
    unsigned char* const wsp = opaque_ptr(P.ws);
    const int tid = opaque_tid(), w = __builtin_amdgcn_readfirstlane(tid >> 6), lane = tid & 63, r = lane & 31, hh = lane >> 5;
    LAS float* const Lw = (LAS float*)(lds + w * 12800);
    const int n = item & 63, h = (item >> 6) & 3, b = (item >> 8) & 7, type = item >> 11;
    const size_t tok0 = (size_t)b * SEQ + n * 64;
    const unsigned* oig = (const unsigned*)(wsp + MXW_OI) + (size_t)item * 3072;
    const bf16_t* qdg = (const bf16_t*)(wsp + MXW_QD) + (size_t)item * 3072 + 8 * hh;
    const bf16_t* spg = (const bf16_t*)(wsp + MXW_SP) + (size_t)item * 4608 + 8 * hh;
    const int rq = lane >> 2, q4 = lane & 3;
    const bf16_t* gp = (const bf16_t*)(wsp + WS_PROJ) + tok0 * NPROJP + (type ? C_RG : C_GG) + h * 96 + 24 * q4;
    bf16_t* mp = (bf16_t*)(wsp + WS_MIXED) + tok0 * 1024 + type * 384 + h * 96 + 24 * q4;
    const float* nw = (type ? P.ret_norm_w : P.gla_norm_w) + l * 384 + h * 96 + 24 * q4;
    f32x16 acc[2][3];
#pragma unroll
    for (int it = 0; it < 2; ++it)
#pragma unroll
        for (int vt = 0; vt < 3; ++vt)
#pragma unroll
            for (int q = 0; q < 8; ++q) { const unsigned u = oig[((it * 3 + vt) * 8 + q) * 64 + lane]; acc[it][vt][2 * q] = bflo(u); acc[it][vt][2 * q + 1] = bfhi(u); }
#pragma unroll
    for (int ks = 0; ks < 3; ++ks) {
        const bf16x8 a0 = *(const bf16x8*)(qdg + r * 48 + ks * 16), a1 = *(const bf16x8*)(qdg + (32 + r) * 48 + ks * 16);
#pragma unroll
        for (int vt = 0; vt < 3; ++vt) { const bf16x8 bb = *(const bf16x8*)(spg + (32 * vt + r) * 48 + ks * 16);
            acc[0][vt] = __builtin_amdgcn_mfma_f32_32x32x16_bf16(a0, bb, acc[0][vt], 0, 0, 0);
            acc[1][vt] = __builtin_amdgcn_mfma_f32_32x32x16_bf16(a1, bb, acc[1][vt], 0, 0, 0); } }
    f32x4 nwv[6];
#pragma unroll
    for (int q = 0; q < 6; ++q) nwv[q] = *(const f32x4*)(nw + 4 * q);
    u32x4 gall[4][3];
#pragma unroll
    for (int p4 = 0; p4 < 4; ++p4)
#pragma unroll
        for (int q = 0; q < 3; ++q) gall[p4][q] = *(const u32x4*)(gp + (size_t)(16 * p4 + rq) * NPROJP + 8 * q);
#pragma unroll
    for (int it = 0; it < 2; ++it) {
#pragma unroll
        for (int vt = 0; vt < 3; ++vt)
#pragma unroll
            for (int reg = 0; reg < 16; ++reg) Lw[crow(reg, lane) * 100 + 32 * vt + r] = acc[it][vt][reg];
        LDS_WAIT(); asm volatile("" ::: "memory");
#pragma unroll
        for (int ps = 0; ps < 2; ++ps) { const int rl = 16 * ps + rq, i = 32 * it + rl;
            f32x4 x[6]; u32x4 gw[3];
#pragma unroll
            for (int q = 0; q < 6; ++q) x[q] = *(const LAS f32x4*)(Lw + rl * 100 + 24 * q4 + 4 * q);
#pragma unroll
            for (int q = 0; q < 3; ++q) gw[q] = gall[it * 2 + ps][q];
            if (type == 1) { float sm = 0.f;
#pragma unroll
                for (int q = 0; q < 6; ++q) sm += (x[q][0] + x[q][1]) + (x[q][2] + x[q][3]);
                sm += lx_f(sm, lane, 1); sm += lx_f(sm, lane, 2);
                const float mean = sm * (1.0f / 96.0f);
#pragma unroll
                for (int q = 0; q < 6; ++q) x[q] = x[q] - mean; }
            float ss = 0.f;
#pragma unroll
            for (int q = 0; q < 6; ++q) ss += (x[q][0] * x[q][0] + x[q][1] * x[q][1]) + (x[q][2] * x[q][2] + x[q][3] * x[q][3]);
            ss += lx_f(ss, lane, 1); ss += lx_f(ss, lane, 2);
            const float rstd = 1.0f / sqrtf(ss * (1.0f / 96.0f) + NORM_EPS);
#pragma unroll
            for (int q = 0; q < 3; ++q) { const f32x4 xa = x[2 * q] * nwv[2 * q] * rstd, xb = x[2 * q + 1] * nwv[2 * q + 1] * rstd; const u32x4 g = gw[q];
                u32x4 o;
                o.x = pk2(xa[0] * siluf(bflo(g.x)), xa[1] * siluf(bfhi(g.x))); o.y = pk2(xa[2] * siluf(bflo(g.y)), xa[3] * siluf(bfhi(g.y)));
                o.z = pk2(xb[0] * siluf(bflo(g.z)), xb[1] * siluf(bfhi(g.z))); o.w = pk2(xb[2] * siluf(bflo(g.w)), xb[3] * siluf(bfhi(g.w)));
                *(u32x4*)(mp + (size_t)i * 1024 + 8 * q) = o; } }
        LDS_WAIT(); asm volatile("" ::: "memory");
    }
}

constexpr int S5_KT = 0, S5_EB = 33280, S5_CY = 66048;
__device__ __forceinline__ float gelu_tanh(float x) { const float u = 0.7978845608028654f * (x + 0.044715f * x * x * x); const float e = __expf(2.0f * u); const float th = 1.0f - 2.0f / (e + 1.0f); return 0.5f * x * (1.0f + th); }
__device__ __forceinline__ void s5_item(const Params& P, LAS unsigned char* lds, int l, int item) {
    unsigned char* const wsp = opaque_ptr(P.ws);
    const int tid = opaque_tid(), w = __builtin_amdgcn_readfirstlane(tid >> 6), lane = tid & 63, r = lane & 31, hh = lane >> 5;
    const int half = item & 1, b = item >> 5, g = (item >> 1) & 15, lg = l * 16 + g;
    const bf16_t* ub = (const bf16_t*)(wsp + WS_PROJ) + (size_t)b * SEQ * NPROJP + C_SU + g * 16 + 8 * hh;
    const bf16_t* ktg = (const bf16_t*)(wsp + WS_KTAB) + (size_t)lg * 65 * 256;
    const bf16_t* bpw = (const bf16_t*)(wsp + WS_BPOW) + (size_t)lg * 128 * 1024 + (size_t)((w & 3) * 32 + r) * 1024 + 8 * hh;
    const bf16_t* cpw = (const bf16_t*)(wsp + WS_CPOW) + (size_t)lg * 1024 * 128;
    for (int p = tid; p < 2080; p += NTHREADS) *(LAS u32x4*)(lds + S5_KT + p * 16) = *(const u32x4*)(ktg + p * 8);
    __syncthreads();
    f32x16 acc[2][2], eacc;
    const int nt0 = half ? (w + 8) : w, nt1 = half ? (w + 16) : (w + 24);
#pragma unroll
    for (int j = 0; j < 2; ++j)
#pragma unroll
        for (int mt = 0; mt < 2; ++mt)
#pragma unroll
            for (int i = 0; i < 16; ++i) acc[j][mt][i] = 0.f;
#pragma unroll
    for (int i = 0; i < 16; ++i) eacc[i] = 0.f;
    const int emt = w >> 2;
    const size_t arow0 = (size_t)(r * 64) * NPROJP, arow1 = (size_t)((32 + r) * 64) * NPROJP;
#define S5_LOAD(A0, A1, BP, s) do { A0 = *(const bf16x8*)(ub + arow0 + (size_t)(s) * NPROJP); A1 = *(const bf16x8*)(ub + arow1 + (size_t)(s) * NPROJP); BP = *(const bf16x8*)(bpw + (s) * 16); } while (0)
#define S5_STEP(A0, A1, BP, s) do { \
        _Pragma("unroll") for (int j = 0; j < 2; ++j) { const int t0 = 2 * (j ? nt1 : nt0); \
            if (t0 + 1 >= (s)) { const int tt = t0 + (r >> 4); const int tau = tt - (s); const int slot = tau < 0 ? 64 : tau; \
                const bf16x8 kb = *(const LAS bf16x8*)(lds + S5_KT + slot * 512 + (lane & 15) * 32 + hh * 16); \
                acc[j][0] = __builtin_amdgcn_mfma_f32_32x32x16_bf16(A0, kb, acc[j][0], 0, 0, 0); \
                acc[j][1] = __builtin_amdgcn_mfma_f32_32x32x16_bf16(A1, kb, acc[j][1], 0, 0, 0); } } \
        eacc = __builtin_amdgcn_mfma_f32_32x32x16_bf16(emt ? A1 : A0, BP, eacc, 0, 0, 0); } while (0)
    bf16x8 ra0[8], ra1[8], rbp[8];
#pragma unroll
    for (int u = 0; u < 8; ++u) S5_LOAD(ra0[u], ra1[u], rbp[u], u);
#pragma unroll 1
    for (int s0 = 0; s0 < 64; s0 += 8) {
#pragma unroll
        for (int u = 0; u < 8; ++u) {
            S5_STEP(ra0[u], ra1[u], rbp[u], s0 + u);
            if (s0 + 8 < 64) S5_LOAD(ra0[u], ra1[u], rbp[u], s0 + u + 8);
        }
    }
#undef S5_LOAD
#undef S5_STEP
#pragma unroll
    for (int reg = 0; reg < 16; ++reg) ((LAS float*)(lds + S5_EB))[(emt * 32 + crow(reg, lane)) * 128 + (w & 3) * 32 + r] = eacc[reg];
    __syncthreads();
    if (tid < 64) { const int p = tid; const float* l64 = (const float*)(wsp + WS_LAM64) + (size_t)(lg * 64 + p) * 2; const float ar = l64[0], ai = l64[1];
        float cr = 0.f, ci = 0.f;
#pragma unroll 1
        for (int n = 0; n < 64; ++n) {
            *(LAS bf16_t*)(lds + S5_CY + n * 272 + p * 2) = (bf16_t)f2bf(cr); *(LAS bf16_t*)(lds + S5_CY + n * 272 + (64 + p) * 2) = (bf16_t)f2bf(ci);
            const float er = ((const LAS float*)(lds + S5_EB))[n * 128 + p], ei = ((const LAS float*)(lds + S5_EB))[n * 128 + 64 + p];
            const float nr = ar * cr - ai * ci + er, ni = ar * ci + ai * cr + ei; cr = nr; ci = ni; } }
    __syncthreads();
#pragma unroll
    for (int j = 0; j < 2; ++j) { const bf16_t* cpr = cpw + (size_t)((j ? nt1 : nt0) * 32 + r) * 128 + 8 * hh;
#pragma unroll
        for (int ks = 0; ks < 8; ++ks) { const bf16x8 cb = *(const bf16x8*)(cpr + ks * 16);
            const bf16x8 c0 = *(const LAS bf16x8*)(lds + S5_CY + r * 272 + ks * 32 + hh * 16), c1 = *(const LAS bf16x8*)(lds + S5_CY + (32 + r) * 272 + ks * 32 + hh * 16);
            acc[j][0] = __builtin_amdgcn_mfma_f32_32x32x16_bf16(c0, cb, acc[j][0], 0, 0, 0);
            acc[j][1] = __builtin_amdgcn_mfma_f32_32x32x16_bf16(c1, cb, acc[j][1], 0, 0, 0); } }
    bf16_t* yb = (bf16_t*)(wsp + WS_YBUF) + (size_t)b * SEQ * 256 + g * 16 + (lane & 15);
#pragma unroll
    for (int j = 0; j < 2; ++j) { const int tt = 2 * (j ? nt1 : nt0) + (r >> 4);
#pragma unroll
        for (int mt = 0; mt < 2; ++mt)
#pragma unroll
            for (int reg = 0; reg < 16; ++reg) { const int n = mt * 32 + crow(reg, lane);
                yb[(size_t)(n * 64 + tt) * 256] = (bf16_t)f2bf(gelu_tanh(acc[j][mt][reg])); } }
    __syncthreads();
}

constexpr int RT_SC = 0, RT_SH = 4096, RT_RS = 8192, RT_PART = 8704, RT_CNT = 8704 + 2 * 128 * 33 * 4, RT_BASE = RT_CNT + 128, RT_TE = RT_BASE + 128, RT_TG = RT_TE + 2048, RT_TR = RT_TG + 2048;
__device__ __forceinline__ void router_phase(const Params& P, LAS unsigned char* lds, int l, int blk) {
    unsigned char* const wsp = opaque_ptr(P.ws);
    const int tid = opaque_tid(), w = __builtin_amdgcn_readfirstlane(tid >> 6), lane = tid & 63, r = lane & 31, hh = lane >> 5;
    const float* x = (const float*)(wsp + WS_X);
    bf16_t* hdn = (bf16_t*)(wsp + WS_HDN);
    const int tok0 = blk * 128, b = tok0 >> 12;
    const float* mrow = (const float*)(wsp + WS_MOD) + (size_t)(l * 8 + b) * 6144;
    int* gcount = (int*)(wsp + WS_CTL) + l * 32;
    int* stok = (int*)(wsp + WS_STOK); float* sgate = (float*)(wsp + WS_SGATE);
    LAS float* scL = (LAS float*)(lds + RT_SC); LAS float* shL = (LAS float*)(lds + RT_SH); LAS float* rsL = (LAS float*)(lds + RT_RS);
    for (int i = tid; i < 1024; i += NTHREADS) { scL[i] = P.norm2_w[l * 1024 + i] * (1.0f + mrow[4096 + i]); shL[i] = mrow[3072 + i]; }
    if (tid < 32) ((LAS int*)(lds + RT_CNT))[tid] = 0;
    __syncthreads();
    {
        f32x4 sc[4], sh[4];
#pragma unroll
        for (int j = 0; j < 4; ++j) { sc[j] = *(const LAS f32x4*)(scL + 4 * lane + 256 * j); sh[j] = *(const LAS f32x4*)(shL + 4 * lane + 256 * j); }
#pragma unroll 1
        for (int t4 = 0; t4 < 16; t4 += 4) {
            f32x4 v[4][4]; float ss[4];
#pragma unroll
            for (int u = 0; u < 4; ++u) { const size_t tok = (size_t)(tok0 + w * 16 + t4 + u);
#pragma unroll
                for (int j = 0; j < 4; ++j) v[u][j] = *(const f32x4*)(x + tok * 1024 + 4 * lane + 256 * j); }
#pragma unroll
            for (int u = 0; u < 4; ++u) { float a_ = 0.f;
#pragma unroll
                for (int j = 0; j < 4; ++j) a_ += (v[u][j][0] * v[u][j][0] + v[u][j][1] * v[u][j][1]) + (v[u][j][2] * v[u][j][2] + v[u][j][3] * v[u][j][3]);
                ss[u] = a_; }
#pragma unroll
            for (int o = 1; o < 64; o <<= 1) {
#pragma unroll
                for (int u = 0; u < 4; ++u) ss[u] += lx_f(ss[u], lane, o); }
#pragma unroll
            for (int u = 0; u < 4; ++u) { const int tl = w * 16 + t4 + u; const size_t tok = (size_t)(tok0 + tl);
                const float rstd = 1.0f / sqrtf(ss[u] * (1.0f / 1024.0f) + NORM_EPS);
                if (lane == 0) rsL[tl] = rstd;
#pragma unroll
                for (int j = 0; j < 4; ++j) { const f32x4 hv = v[u][j] * rstd * sc[j] + sh[j]; u32x2 pk; pk.x = pk2(hv[0], hv[1]); pk.y = pk2(hv[2], hv[3]);
                    *(u32x2*)(hdn + tok * 1024 + 4 * lane + 256 * j) = pk; } } }
    }
    __syncthreads();
    {
        const int mt = w & 3, kh = w >> 2;
        const float* xr = x + (size_t)(tok0 + 32 * mt + r) * 1024 + 512 * kh + 8 * hh;
        const bf16_t* wt = (const bf16_t*)(wsp + WS_RWT) + (size_t)l * 2 * 32 * 1024 + (size_t)r * 1024 + 512 * kh + 8 * hh;
        const float rs = rsL[32 * mt + r];
        f32x16 acc;
#pragma unroll
        for (int i = 0; i < 16; ++i) acc[i] = 0.f;
#pragma unroll 8
        for (int ks = 0; ks < 32; ++ks) {
            const f32x4 x0 = *(const f32x4*)(xr + 16 * ks), x1 = *(const f32x4*)(xr + 16 * ks + 4);
            const int kk = 512 * kh + 16 * ks + 8 * hh;
            const f32x4 c0 = *(const LAS f32x4*)(scL + kk), c1 = *(const LAS f32x4*)(scL + kk + 4), s0 = *(const LAS f32x4*)(shL + kk), s1 = *(const LAS f32x4*)(shL + kk + 4);
            const f32x4 h0 = x0 * rs * c0 + s0, h1 = x1 * rs * c1 + s1;
            unsigned ah[4], al[4];
            ah[0] = pk2(h0[0], h0[1]); ah[1] = pk2(h0[2], h0[3]); ah[2] = pk2(h1[0], h1[1]); ah[3] = pk2(h1[2], h1[3]);
            al[0] = pk2(h0[0] - bflo(ah[0]), h0[1] - bfhi(ah[0])); al[1] = pk2(h0[2] - bflo(ah[1]), h0[3] - bfhi(ah[1]));
            al[2] = pk2(h1[0] - bflo(ah[2]), h1[1] - bfhi(ah[2])); al[3] = pk2(h1[2] - bflo(ah[3]), h1[3] - bfhi(ah[3]));
            const bf16x8 bh = *(const bf16x8*)(wt + 16 * ks), bl = *(const bf16x8*)(wt + 32 * 1024 + 16 * ks);
            const bf16x8 fah = frag_from(ah[0], ah[1], ah[2], ah[3]), fal = frag_from(al[0], al[1], al[2], al[3]);
            acc = __builtin_amdgcn_mfma_f32_32x32x16_bf16(fah, bh, acc, 0, 0, 0);
            acc = __builtin_amdgcn_mfma_f32_32x32x16_bf16(fah, bl, acc, 0, 0, 0);
            acc = __builtin_amdgcn_mfma_f32_32x32x16_bf16(fal, bh, acc, 0, 0, 0);
        }
        LAS float* part = (LAS float*)(lds + RT_PART) + kh * 128 * 33;
#pragma unroll
        for (int reg = 0; reg < 16; ++reg) part[(32 * mt + crow(reg, lane)) * 33 + r] = acc[reg];
    }
    __syncthreads();
    if (tid < 128) {
        const LAS float* p0 = (const LAS float*)(lds + RT_PART) + tid * 33; const LAS float* p1 = p0 + 128 * 33;
        float v0 = -3.0e38f, v1 = -3.0e38f, v2 = -3.0e38f, v3 = -3.0e38f; int e0 = 0, e1 = 0, e2 = 0, e3 = 0;
#pragma unroll
        for (int e = 0; e < 32; ++e) { const float lg = p0[e] + p1[e] + P.router_b[l * 32 + e];
            if (lg > v3) { if (lg > v2) { v3 = v2; e3 = e2; if (lg > v1) { v2 = v1; e2 = e1; if (lg > v0) { v1 = v0; e1 = e0; v0 = lg; e0 = e; } else { v1 = lg; e1 = e; } } else { v2 = lg; e2 = e; } } else { v3 = lg; e3 = e; } } }
        const float x1 = __expf(v1 - v0), x2 = __expf(v2 - v0), x3 = __expf(v3 - v0), inv = 1.0f / (1.0f + x1 + x2 + x3);
        LAS int* cnt = (LAS int*)(lds + RT_CNT);
        LAS int* te = (LAS int*)(lds + RT_TE) + tid * 4; LAS float* tg = (LAS float*)(lds + RT_TG) + tid * 4; LAS int* tr = (LAS int*)(lds + RT_TR) + tid * 4;
        te[0] = e0; te[1] = e1; te[2] = e2; te[3] = e3; tg[0] = inv; tg[1] = x1 * inv; tg[2] = x2 * inv; tg[3] = x3 * inv;
        tr[0] = __hip_atomic_fetch_add(cnt + e0, 1, __ATOMIC_RELAXED, __HIP_MEMORY_SCOPE_WORKGROUP); tr[1] = __hip_atomic_fetch_add(cnt + e1, 1, __ATOMIC_RELAXED, __HIP_MEMORY_SCOPE_WORKGROUP);
        tr[2] = __hip_atomic_fetch_add(cnt + e2, 1, __ATOMIC_RELAXED, __HIP_MEMORY_SCOPE_WORKGROUP); tr[3] = __hip_atomic_fetch_add(cnt + e3, 1, __ATOMIC_RELAXED, __HIP_MEMORY_SCOPE_WORKGROUP);
    }
    __syncthreads();
    if (tid < 32) ((LAS int*)(lds + RT_BASE))[tid] = atomicAdd(gcount + tid, ((LAS int*)(lds + RT_CNT))[tid]);
    __syncthreads();
    { const int e = ((LAS int*)(lds + RT_TE))[tid]; const int pos = ((LAS int*)(lds + RT_BASE))[e] + ((LAS int*)(lds + RT_TR))[tid];
      stok[e * CAP + pos] = (tok0 + (tid >> 2)) * 4 + (tid & 3); sgate[e * CAP + pos] = ((LAS float*)(lds + RT_TG))[tid]; }
    __syncthreads();
}

__device__ __forceinline__ void combine_phase(const Params& P, int l, int gw, int ngw, int lane_in) {
    unsigned char* const wsp = opaque_ptr(P.ws);
    int lane = lane_in; asm volatile("" : "+v"(lane));
    float* x = (float*)(wsp + WS_X);
    const bf16_t* outr = (const bf16_t*)(wsp + WS_OUTR);
    bf16_t* hdn = (bf16_t*)(wsp + WS_HDN);
    for (int tokp = gw; tokp < T_TOK / 2; tokp += ngw) {
        u32x4 rr[2][2][4]; f32x4 xv[2][4];
#pragma unroll
        for (int u = 0; u < 2; ++u) { const size_t tok = (size_t)(2 * tokp + u);
#pragma unroll
            for (int hf = 0; hf < 2; ++hf) { const int col = hf * 512 + 8 * lane;
#pragma unroll
                for (int k = 0; k < 4; ++k) rr[u][hf][k] = *(const u32x4*)(outr + (tok * 4 + k) * 1024 + col);
                xv[u][hf * 2] = *(const f32x4*)(x + tok * 1024 + col); xv[u][hf * 2 + 1] = *(const f32x4*)(x + tok * 1024 + col + 4); } }
#pragma unroll
        for (int u = 0; u < 2; ++u) { const int tok = 2 * tokp + u; const int b = tok >> 12;
            const float* mrow = (const float*)(wsp + WS_MOD) + (size_t)(l * 8 + b) * 6144;
            f32x4 v[4];
#pragma unroll
            for (int hf = 0; hf < 2; ++hf) { const int col = hf * 512 + 8 * lane;
                float s[8];
#pragma unroll
                for (int e = 0; e < 8; ++e) s[e] = 0.f;
#pragma unroll
                for (int k = 0; k < 4; ++k) { const u32x4 r4 = rr[u][hf][k];
                    s[0] += bflo(r4.x); s[1] += bfhi(r4.x); s[2] += bflo(r4.y); s[3] += bfhi(r4.y); s[4] += bflo(r4.z); s[5] += bfhi(r4.z); s[6] += bflo(r4.w); s[7] += bfhi(r4.w); }
#pragma unroll
                for (int q = 0; q < 2; ++q) { const f32x4 x4 = xv[u][hf * 2 + q], g2 = *(const f32x4*)(mrow + 5120 + col + 4 * q);
                    f32x4 o; o[0] = x4[0] + g2[0] * s[4 * q]; o[1] = x4[1] + g2[1] * s[4 * q + 1]; o[2] = x4[2] + g2[2] * s[4 * q + 2]; o[3] = x4[3] + g2[3] * s[4 * q + 3];
                    v[hf * 2 + q] = o; if (l + 1 < NLAYER) *(f32x4*)(x + (size_t)tok * 1024 + col + 4 * q) = o; } }
            if (l + 1 < NLAYER) {
                const float* mnext = (const float*)(wsp + WS_MOD) + (size_t)((l + 1) * 8 + b) * 6144;
                norm_row_store(v, P.norm1_w + (l + 1) * 1024, mnext, mnext + 1024, hdn + (size_t)tok * 1024, lane);
            } else {
                float ss = 0.f;
#pragma unroll
                for (int j = 0; j < 4; ++j) ss += (v[j][0] * v[j][0] + v[j][1] * v[j][1]) + (v[j][2] * v[j][2] + v[j][3] * v[j][3]);
                const float rstd = 1.0f / sqrtf(wave_sum(ss, lane) * (1.0f / 1024.0f) + NORM_EPS);
#pragma unroll
                for (int hf = 0; hf < 2; ++hf)
#pragma unroll
                    for (int q = 0; q < 2; ++q) { const int col = hf * 512 + 8 * lane + 4 * q; const f32x4 fw = *(const f32x4*)(P.final_norm_w + col);
                        f32x4 o; o[0] = v[hf * 2 + q][0] * rstd * fw[0]; o[1] = v[hf * 2 + q][1] * rstd * fw[1]; o[2] = v[hf * 2 + q][2] * rstd * fw[2]; o[3] = v[hf * 2 + q][3] * rstd * fw[3];
                        *(f32x4*)(P.out + (size_t)tok * 1024 + col) = o; }
            }
        }
    }
}

#define XB_TMO      128
#define XB_XCNT(j)  (256  + 64 * (j))
#define XB_XSUB(j)  (1280 + 64 * (j))
#define XB_XGEN(j)  (2304 + 64 * (j))
#define XB_TOP      3328
#define XB_TOPGEN   3392
#define XCD_BAR_WORDS 3456
#define XB_SPIN_CAP (1u << 22)
__device__ __forceinline__ unsigned xb_ld(unsigned* p)              { return __hip_atomic_load(p, __ATOMIC_RELAXED, __HIP_MEMORY_SCOPE_AGENT); }
__device__ __forceinline__ unsigned xb_add(unsigned* p, unsigned v) { return __hip_atomic_fetch_add(p, v, __ATOMIC_RELAXED, __HIP_MEMORY_SCOPE_AGENT); }
__device__ __forceinline__ unsigned xb_xcc_id() { return (unsigned)__builtin_amdgcn_s_getreg((3 << 11) | 20) & 0xFu; }
#define XB_SPIN(cond, bar) do { unsigned _sp = 0; while (cond) { __builtin_amdgcn_s_sleep(1); \
    if ((++_sp & 255u) == 0u) { if (xb_ld(&(bar)[XB_TMO])) break; if (_sp > XB_SPIN_CAP) { atomicAdd(&(bar)[XB_TMO], 1u); break; } } } } while (0)
struct XcdBarrier { unsigned* bar; unsigned x; volatile LAS unsigned* st; };
__device__ __forceinline__ XcdBarrier xcd_barrier_post(unsigned* bar, volatile LAS unsigned* st) {
    XcdBarrier b; b.bar = bar; b.x = xb_xcc_id(); b.st = st;
    if (threadIdx.x == 0) (void)xb_add(&bar[XB_XCNT(b.x)], 1u);
    return b;
}
__device__ __forceinline__ void xcd_barrier_complete(unsigned* bar, unsigned x, unsigned& nloc, unsigned& nx) {
    const unsigned G = gridDim.x * gridDim.y * gridDim.z;
    unsigned sum, cnt, mine, sp = 0u;
    for (;;) {
        sum = 0u; cnt = 0u; mine = 0u;
#pragma unroll
        for (unsigned j = 0; j < 16; ++j) { const unsigned c = xb_ld(&bar[XB_XCNT(j)]); sum += c; cnt += (c > 0u) ? 1u : 0u; mine = (j == x) ? c : mine; }
        if (sum == G) break;
        __builtin_amdgcn_s_sleep(1);
        if ((++sp & 255u) == 0u) { if (xb_ld(&bar[XB_TMO])) break; if (sp > XB_SPIN_CAP) { atomicAdd(&bar[XB_TMO], 1u); break; } }
    }
    nloc = mine > 0u ? mine : 1u; nx = cnt > 0u ? cnt : 1u;
}
__device__ __forceinline__ void xcd_barrier(const XcdBarrier& b) {
    asm volatile("s_waitcnt vmcnt(0)" ::: "memory");
    __syncthreads();
    if (threadIdx.x == 0) {
        unsigned* bar = b.bar;
        __builtin_amdgcn_s_waitcnt(0);
        unsigned nloc = b.st[0], nx = b.st[1];
        if (nloc == 0u) { xcd_barrier_complete(bar, b.x, nloc, nx); b.st[0] = nloc; b.st[1] = nx; }
        const unsigned old = xb_add(&bar[XB_XSUB(b.x)], 1u);
        const unsigned gen = old / nloc;
        if (old + 1u == (gen + 1u) * nloc) {
            __builtin_amdgcn_fence(__ATOMIC_RELEASE, "agent");
            asm volatile("s_waitcnt vmcnt(0)" ::: "memory");
            const unsigned og = xb_add(&bar[XB_TOP], 1u);
            const unsigned tg = og / nx;
            if (og + 1u == (tg + 1u) * nx) xb_add(&bar[XB_TOPGEN], 1u);
            else XB_SPIN(xb_ld(&bar[XB_TOPGEN]) == tg, bar);
            __builtin_amdgcn_fence(__ATOMIC_ACQUIRE, "agent");
            xb_add(&bar[XB_XGEN(b.x)], 1u);
            asm volatile("s_waitcnt vmcnt(0)" ::: "memory");
        } else {
            XB_SPIN(xb_ld(&bar[XB_XGEN(b.x)]) == gen, bar);
            __builtin_amdgcn_fence(__ATOMIC_ACQUIRE, "agent");
            asm volatile("s_waitcnt vmcnt(0)" ::: "memory");
        }
    }
    __syncthreads();
}

#ifndef PH
#define PH 0xFFFF
#endif
#define PHON(b) ((((PH) >> (b)) & 1) != 0)
#ifndef TIME_PHASE
#define TIME_PHASE -1
#endif
#ifndef EXPERIMENT
#define EXPERIMENT 0
#endif
#define TIME_MULT 4
#if TIME_PHASE >= 0
#define PH_T0(k) do { if ((k) == TIME_PHASE && bid == 0) t_ph = __builtin_amdgcn_s_memrealtime(); } while (0)
#define PH_T1(k) do { if ((k) == TIME_PHASE && bid == 0) { const unsigned long long t1_ = __builtin_amdgcn_s_memrealtime(), d_ = t1_ - t_ph; while (__builtin_amdgcn_s_memrealtime() - t1_ < (unsigned long long)TIME_MULT * d_) __builtin_amdgcn_s_sleep(8); } } while (0)
#else
#define PH_T0(k) do { } while (0)
#define PH_T1(k) do { } while (0)
#endif
__global__ void __launch_bounds__(NTHREADS, 2) fwd_megakernel(Params P) {
    extern __shared__ __attribute__((aligned(16))) unsigned char lds_raw[];
    LAS unsigned char* const lds0 = (LAS unsigned char*)lds_raw;
    cg::grid_group grid = cg::this_grid();
    const int G = gridDim.x, bid = blockIdx.x;
    const int vcu = (G % 8 == 0) ? (bid % 8) * (G / 8) + bid / 8 : bid;
    const int ngw = G * NWAVES;
    unsigned long long t_ph = 0; (void)t_ph;
    const unsigned long long t_entry = (TIME_PHASE == 99) ? __builtin_amdgcn_s_memrealtime() : 0ull; (void)t_entry;
    if (threadIdx.x < 4) ((LAS unsigned*)(lds0 + LDS_BYTES - 16))[threadIdx.x] = 0u;
    __syncthreads();
    (void)xcd_barrier_post((unsigned*)(P.ws + WS_BAR), (volatile LAS unsigned*)(lds0 + LDS_BYTES - 16));
#define GSYNC() do { XcdBarrier xb_; xb_.bar = (unsigned*)(opaque_ptr(P.ws) + WS_BAR); xb_.x = xb_xcc_id(); xb_.st = (volatile LAS unsigned*)(opaque_lds(lds0) + LDS_BYTES - 16); xcd_barrier(xb_); } while (0)
#define KTID() const int tid = opaque_tid(), wave = __builtin_amdgcn_readfirstlane(tid >> 6), lane = tid & 63, gw = bid * NWAVES + wave; (void)lane; (void)gw

    PH_T0(0);
    { KTID(); unsigned char* const ws = opaque_ptr(P.ws); LAS unsigned char* const lds = opaque_lds(lds0); (void)lds;
    if (bid == 0 && tid < 64) ((int*)(ws + WS_CTL))[tid] = 0;
    if (PHON(0)) for (int it = bid; it < 128 + 192; it += G) { if (it < 128) s5_tables_item(P, lds, it); else mod_item(P, lds, it - 128); }
    rope_table(P, bid * NTHREADS + tid, G * NTHREADS);
    for (int i = bid * NTHREADS + tid; i < 2 * 32 * 1024; i += G * NTHREADS) { const int k_ = i & 1023, e_ = (i >> 10) & 31, l_ = i >> 15; const float wv_ = P.router_w[(size_t)l_ * 1024 * 32 + k_ * 32 + e_];
        const unsigned hw_ = f2bf(wv_); bf16_t* rt_ = (bf16_t*)(ws + WS_RWT) + (size_t)l_ * 2 * 32 * 1024 + e_ * 1024 + k_; rt_[0] = (bf16_t)hw_; rt_[32 * 1024] = (bf16_t)f2bf(wv_ - __builtin_bit_cast(float, hw_ << 16)); }
    for (int i = bid * NTHREADS + tid; i < 2 * 4 * 64 * 16; i += G * NTHREADS) { const int rr = i & 15, dd = (i >> 4) & 63, hh_ = (i >> 10) & 3, ll = i >> 12;
        ((bf16_t*)(ws + WS_WA2T))[i] = (dd < 48) ? (bf16_t)f2bf(P.gla_w_a2[(size_t)ll * 16 * 192 + rr * 192 + hh_ * 48 + dd]) : (bf16_t)0; }
    __syncthreads();
    if (PHON(1)) transpose_small(P, lds, gw, ngw, wave, lane); }
    if (P.ws == nullptr) grid.sync();
    GSYNC(); PH_T1(0); PH_T0(1);
    { KTID(); unsigned char* const ws = opaque_ptr(P.ws); LAS unsigned char* const lds = opaque_lds(lds0); (void)lds;
    for (int tokp = gw; tokp < T_TOK / 2; tokp += ngw) {
        f32x4 v[2][4];
#pragma unroll
        for (int u = 0; u < 2; ++u)
#pragma unroll
            for (int hf = 0; hf < 2; ++hf)
#pragma unroll
                for (int q = 0; q < 2; ++q) v[u][hf * 2 + q] = *(const f32x4*)(P.x + (size_t)(2 * tokp + u) * 1024 + hf * 512 + 8 * lane + 4 * q);
#pragma unroll
        for (int u = 0; u < 2; ++u) { const int tok = 2 * tokp + u; const float* mrow = (const float*)(ws + WS_MOD) + (size_t)(tok >> 12) * 6144;
            norm_row_store(v[u], P.norm1_w, mrow, mrow + 1024, (bf16_t*)(ws + WS_HDN) + (size_t)tok * 1024, lane); }
    } }
    GSYNC(); PH_T1(1);
#pragma unroll 1
    for (int l = 0; l < NLAYER; ++l) {
        PH_T0(2);
        constexpr int G_IN = 240;
        if (bid >= G_IN) { LAS unsigned char* const lds = opaque_lds(lds0); transpose_moe_pool(P, lds, l, (l == 0 ? 0 : TM_Q_DN) + TM_Q_IN); }
        else if (PHON(2)) { unsigned char* const ws = opaque_ptr(P.ws); LAS unsigned char* const lds = opaque_lds(lds0); (void)lds; DenseOrder S; S.init(T_TOK, NPROJP, 1024, G_IN, bid, ws + WS_HDN, (const bf16_t*)(ws + WS_WIN) + (size_t)l * NPROJP * 1024);
          EpiProj E{(bf16_t*)(ws + WS_PROJ), NPROJP};
          gm::gemm_phase<EpiProj, DenseOrder, false>(lds, 1024, S, E); }
        GSYNC(); PH_T1(2); PH_T0(3);
        { LAS unsigned char* const lds = opaque_lds(lds0);
#define SUBT0(k, b) do { if (TIME_PHASE == (k) && bid == (b)) t_ph = __builtin_amdgcn_s_memrealtime(); } while (0)
#define SUBT1(k, b) do { if (TIME_PHASE == (k) && bid == (b)) { const unsigned long long t1_ = __builtin_amdgcn_s_memrealtime(), d_ = t1_ - t_ph; while (__builtin_amdgcn_s_memrealtime() - t1_ < (unsigned long long)TIME_MULT * d_) __builtin_amdgcn_s_sleep(8); } } while (0)
          SUBT0(20, 0);
          if (PHON(3)) for (int rd = bid; rd < 2048; rd += G) mixer_phase_a(P, lds, l, rd);
          SUBT1(20, 0); SUBT0(21, 0);
          if (PHON(4)) for (int it = bid; it < 256; it += G) s5_item(P, lds, l, it);
          SUBT1(21, 0); SUBT0(22, 0);
          { KTID(); transpose_moe_rest(P, lds, l, gw, ngw); }
          SUBT1(22, 0); }
        GSYNC(); PH_T1(3); PH_T0(4);
        if (PHON(5) && bid >= 144) { unsigned char* const ws = opaque_ptr(P.ws); LAS unsigned char* const lds = opaque_lds(lds0); (void)lds; DenseOrder S; S.init(T_TOK, 256, 256, G - 144, bid - 144, ws + WS_YBUF, (const bf16_t*)(ws + WS_WGLU) + (size_t)l * 256 * 256);
          EpiGlu E{(const bf16_t*)(ws + WS_YBUF), (bf16_t*)(ws + WS_MIXED), P.s5_b_glu + l * 256};
          gm::gemm_phase<EpiGlu, DenseOrder, false>(lds, 256, S, E); }
        if (PHON(3)) mixer_phase_b(P, bid, G);
        GSYNC(); PH_T1(4); PH_T0(5);
        if (PHON(3)) { KTID(); LAS unsigned char* const lds = opaque_lds(lds0); for (int it = gw; it < 4096; it += ngw) mixer_phase_c(P, lds, l, it); }
        GSYNC(); PH_T1(5); PH_T0(6);
        if (PHON(6)) { unsigned char* const ws = opaque_ptr(P.ws); LAS unsigned char* const lds = opaque_lds(lds0); (void)lds; const float* modl = (const float*)(ws + WS_MOD) + (size_t)l * 8 * 6144; DenseOrder S; S.init(T_TOK, 1024, 1024, G, bid, ws + WS_MIXED, (const bf16_t*)(ws + WS_WOUT) + (size_t)l * 1024 * 1024);
          EpiOut E{l == 0 ? P.x : (const float*)(ws + WS_X), (float*)(ws + WS_X), modl + 2048};
          gm::gemm_phase<EpiOut, DenseOrder, false>(lds, 1024, S, E); }
        GSYNC(); PH_T1(6); PH_T0(7);
        if (PHON(7)) { LAS unsigned char* const lds = opaque_lds(lds0); for (int blk = bid; blk < T_TOK / 128; blk += G) router_phase(P, lds, l, blk); }
        GSYNC(); PH_T1(7); PH_T0(8);
        if (PHON(8)) { unsigned char* const ws = opaque_ptr(P.ws); LAS unsigned char* const lds = opaque_lds(lds0); (void)lds; moe_tables(lds, (const int*)(ws + WS_CTL) + l * 32, 8);
          MoeOrder<true> S; S.tab = (LAS const int*)(lds + MISC_OFF); S.nN = 8; S.G = G; S.vc = vcu; S.Wt = (const char*)(ws + WS_WUP) + (size_t)l * 32 * 2048 * 1024 * 2; S.wstride = (size_t)2048 * 1024 * 2; S.stok = (const int*)(ws + WS_STOK); S.A = (const char*)(ws + WS_HDN); S.gtab = (LAS const unsigned*)(lds + GT_OFF);
          S.fill_gather((LAS unsigned*)(lds + GT_OFF));
          EpiUp E{(bf16_t*)(ws + WS_ACT), P.b_up + (size_t)l * 32 * 2048, (LAS const int*)(lds + MISC_OFF)};
          gm::gemm_phase<EpiUp, MoeOrder<true>, true>(lds, 1024, S, E); }
        GSYNC(); PH_T1(8); PH_T0(9);
#if EXPERIMENT >= 1
        if (l == 0) { unsigned char* const ws = opaque_ptr(P.ws); LAS unsigned char* const lds = opaque_lds(lds0); (void)lds; moe_tables(lds, (const int*)(ws + WS_CTL) + l * 32, 8);
          MoeOrder<(EXPERIMENT != 2)> S; S.tab = (LAS const int*)(lds + MISC_OFF); S.nN = 8; S.G = G; S.vc = vcu; S.Wt = (const char*)(ws + WS_WUP) + (size_t)l * 32 * 2048 * 1024 * 2; S.wstride = (EXPERIMENT == 4) ? 0 : (size_t)2048 * 1024 * 2; S.stok = (const int*)(ws + WS_STOK); S.A = (const char*)(ws + WS_HDN); S.gtab = (LAS const unsigned*)(lds + GT_OFF);
          if (EXPERIMENT != 2) S.fill_gather((LAS unsigned*)(lds + GT_OFF));
          if (EXPERIMENT == 3) { EpiProj E{(bf16_t*)(ws + WS_OUTR), 2048}; gm::gemm_phase<EpiProj, MoeOrder<(EXPERIMENT != 2)>, (EXPERIMENT != 2)>(lds, 1024, S, E); }
          else { EpiUp E{(bf16_t*)(ws + WS_OUTR), P.b_up + (size_t)l * 32 * 2048, (LAS const int*)(lds + MISC_OFF)}; gm::gemm_phase<EpiUp, MoeOrder<(EXPERIMENT != 2)>, (EXPERIMENT != 2)>(lds, 1024, S, E); }
          GSYNC(); }
#endif
        if (PHON(9)) { unsigned char* const ws = opaque_ptr(P.ws); LAS unsigned char* const lds = opaque_lds(lds0); (void)lds; moe_tables(lds, (const int*)(ws + WS_CTL) + l * 32, 4);
          const int nunits = ((LAS const int*)(lds + MISC_OFF))[32], nrounds = (nunits + G - 1) / G, gneed0 = nrounds > 0 ? (nunits + nrounds - 1) / nrounds : G, gneed = (gneed0 + 7) & ~7;
          if (bid >= gneed) { if (l + 1 < NLAYER) transpose_moe_pool(P, lds, l + 1, TM_Q_DN); }
          else {
          MoeOrder<false> S; S.tab = (LAS const int*)(lds + MISC_OFF); S.nN = 4; S.G = gneed; S.vc = xcd_vc(bid, gneed); S.Wt = (const char*)(ws + WS_WDN) + (size_t)l * 32 * 1024 * 1024 * 2; S.wstride = (size_t)1024 * 1024 * 2; S.stok = nullptr; S.A = (const char*)(ws + WS_ACT); S.gtab = nullptr;
          EpiDown E{(bf16_t*)(ws + WS_OUTR), P.b_down + (size_t)l * 32 * 1024, (const int*)(ws + WS_STOK), (const float*)(ws + WS_SGATE)};
          gm::gemm_phase<EpiDown, MoeOrder<false>, false>(lds, 1024, S, E); } }
        GSYNC(); PH_T1(9); PH_T0(10);
        if (PHON(10)) { KTID(); combine_phase(P, l, gw, ngw, lane); }
        GSYNC(); PH_T1(10);
    }
    if (TIME_PHASE == 99 && bid == 0) { const unsigned long long t1_ = __builtin_amdgcn_s_memrealtime(), d_ = t1_ - t_entry; while (__builtin_amdgcn_s_memrealtime() - t1_ < d_) __builtin_amdgcn_s_sleep(8); }
}

extern "C" void kernel_launch(void* const* d_in, const int* in_sizes, int n_in, void* d_out, int out_size, void* d_ws, size_t ws_size, hipStream_t stream) {
    static int grid_blocks = 0;
    if (grid_blocks == 0) {
        if (n_in != 29 || ws_size < WS_END) { fprintf(stderr, "kernel_launch: unexpected n_in %d or ws_size %zu (need %zu)\n", n_in, ws_size, (size_t)WS_END); grid_blocks = -1; return; }
        int dev = 0, cus = 0, per_cu = 0;
        (void)hipGetDevice(&dev);
        (void)hipDeviceGetAttribute(&cus, hipDeviceAttributeMultiprocessorCount, dev);
        (void)hipFuncSetAttribute((const void*)fwd_megakernel, hipFuncAttributeMaxDynamicSharedMemorySize, LDS_BYTES);
        (void)hipOccupancyMaxActiveBlocksPerMultiprocessor(&per_cu, (const void*)fwd_megakernel, NTHREADS, LDS_BYTES);
        if (per_cu < 1) { fprintf(stderr, "kernel_launch: occupancy query returned %d\n", per_cu); per_cu = 1; }
        grid_blocks = cus;
        fprintf(stderr, "kernel_launch: cus %d per_cu %d grid %d ws_need %zu\n", cus, per_cu, grid_blocks, (size_t)WS_END);
    }
    if (grid_blocks < 0) return;
    Params p{};
    const float** pp = (const float**)&p;
    for (int i = 0; i < 29; ++i) pp[i] = (const float*)d_in[i];
    p.out = (float*)d_out; p.ws = (unsigned char*)d_ws;
    for (int i = 0; i < 24; ++i) p.inv_freq_rev[i] = pow(10000.0, -(double)(2 * i) / 48.0) / 6.283185307179586476925;
    for (int h = 0; h < 4; ++h) p.log_gamma[h] = (float)log1p(-exp2(-5.0 - (double)h));
    (void)hipMemsetAsync((char*)d_ws + WS_CTL, 0, WS_CTL_BYTES, stream);
    void* args[] = {&p};
    hipError_t e = hipLaunchCooperativeKernel((const void*)fwd_megakernel, dim3(grid_blocks), dim3(NTHREADS), args, LDS_BYTES, stream);
    if (e != hipSuccess) fprintf(stderr, "cooperative launch failed: %s (grid %d)\n", hipGetErrorString(e), grid_blocks);
}
```

```cpp
#include <hip/hip_runtime.h>
#include <hip/hip_cooperative_groups.h>
#include <cstdio>
#include <cstdint>
#include <cmath>
namespace cg = cooperative_groups;
#ifndef TIME_PHASE
#define TIME_PHASE -1
#endif
#ifndef EXPERIMENT
#define EXPERIMENT 0
#endif
#ifndef GEMM_4PH
#define GEMM_4PH 0
#endif

#define LAS __attribute__((address_space(3)))
typedef unsigned short bf16_t;
typedef short bf16x8 __attribute__((ext_vector_type(8)));
typedef float f32x4 __attribute__((ext_vector_type(4)));
typedef float f32x16 __attribute__((ext_vector_type(16)));
typedef unsigned u32x4 __attribute__((ext_vector_type(4)));
typedef unsigned u32x2 __attribute__((ext_vector_type(2)));

constexpr int T_TOK = 32768, DM = 1024, NBATCH = 8, SEQ = 4096, NLAYER = 2;
constexpr int NPROJ = 2576, NPROJP = 2816;
constexpr int NE = 32, CAP = 32768, NSLOT = T_TOK * 4;
constexpr int C_GQ = 0, C_GK = 192, C_GV = 384, C_GG = 768, C_GA = 1152, C_RQ = 1168, C_RK = 1360, C_RV = 1552, C_RG = 1936, C_SU = 2320;
constexpr float NORM_EPS = 1e-5f;
constexpr int NTHREADS = 512, NWAVES = 8;
constexpr int LDS_BYTES = 160 * 1024;
constexpr int MISC_OFF = 148 * 1024;

constexpr size_t al256(size_t x) { return (x + 255) & ~(size_t)255; }
constexpr size_t WS_CTL   = 0;
constexpr size_t WS_BAR   = 4096;
constexpr size_t WS_CTL_BYTES = 32768;
constexpr size_t WS_MOD   = 32768;
constexpr size_t WS_WIN   = al256(WS_MOD + (size_t)2 * 8 * 6144 * 4);
constexpr size_t WS_WOUT  = al256(WS_WIN + (size_t)2 * NPROJP * 1024 * 2);
constexpr size_t WS_WUP   = al256(WS_WOUT + (size_t)2 * 1024 * 1024 * 2);
constexpr size_t WS_WDN   = al256(WS_WUP + (size_t)2 * 32 * 2048 * 1024 * 2);
constexpr size_t WS_WGLU  = al256(WS_WDN + (size_t)2 * 32 * 1024 * 1024 * 2);
constexpr size_t WS_KTAB  = al256(WS_WGLU + (size_t)2 * 256 * 256 * 2);
constexpr size_t WS_BPOW  = al256(WS_KTAB + (size_t)2 * 16 * 65 * 256 * 2);
constexpr size_t WS_CPOW  = al256(WS_BPOW + (size_t)2 * 16 * 128 * 1024 * 2);
constexpr size_t WS_LAM64 = al256(WS_CPOW + (size_t)2 * 16 * 1024 * 128 * 2);
constexpr size_t WS_ROPE  = al256(WS_LAM64 + (size_t)2 * 16 * 64 * 2 * 4);
constexpr size_t WS_WA2T  = al256(WS_ROPE + (size_t)4096 * 24 * 2 * 4);
constexpr size_t WS_RWT   = al256(WS_WA2T + (size_t)2 * 4 * 64 * 16 * 2);
constexpr size_t WS_X     = al256(WS_RWT + (size_t)2 * 2 * 32 * 1024 * 2);
constexpr size_t WS_HDN   = al256(WS_X + (size_t)T_TOK * 1024 * 4);
constexpr size_t WS_PROJ  = al256(WS_HDN + (size_t)T_TOK * 1024 * 2);
constexpr size_t WS_MIXED = al256(WS_PROJ + (size_t)T_TOK * NPROJP * 2);
constexpr size_t WS_YBUF  = al256(WS_MIXED + (size_t)T_TOK * 1024 * 2);
constexpr size_t WS_SU2   = al256(WS_YBUF + (size_t)T_TOK * 256 * 2);
constexpr size_t WS_ACT   = al256(WS_SU2 + (size_t)T_TOK * 256 * 2);
constexpr size_t WS_OUTR  = al256(WS_ACT + (size_t)(NSLOT + 256) * 1024 * 2);
constexpr size_t WS_STOK  = al256(WS_OUTR + (size_t)NSLOT * 1024 * 2);
constexpr size_t WS_SGATE = al256(WS_STOK + (size_t)NE * CAP * 4);
constexpr size_t MXW_QD = WS_ACT, MXW_OI = WS_ACT + ((size_t)32 << 20), MXW_DS = WS_ACT + ((size_t)96 << 20), MXW_DEC = WS_ACT + ((size_t)176 << 20), MXW_SP = WS_ACT + ((size_t)180 << 20);
constexpr size_t WS_END   = al256(WS_SGATE + (size_t)NE * CAP * 4);

struct Params {
    const float* x; const float* c; const float* norm1_w; const float* norm2_w; const float* w_mod; const float* b_mod;
    const float* w_in; const float* gla_w_a2; const float* gla_b_a; const float* gla_norm_w; const float* ret_norm_w;
    const float* s5_a_re; const float* s5_a_im; const float* s5_log_dt; const float* s5_b_re; const float* s5_b_im;
    const float* s5_c_re; const float* s5_c_im; const float* s5_d; const float* s5_w_glu; const float* s5_b_glu;
    const float* w_out; const float* router_w; const float* router_b; const float* w_up; const float* b_up;
    const float* w_down; const float* b_down; const float* final_norm_w;
    float* out; unsigned char* ws;
    double inv_freq_rev[24];
    float log_gamma[4]; float pad0[4];
};

__device__ __forceinline__ unsigned f2bf(float f) { unsigned u = __builtin_bit_cast(unsigned, f); return (u + 0x7fffu + ((u >> 16) & 1u)) >> 16; }
typedef float f32x2_t __attribute__((ext_vector_type(2)));
typedef __bf16 bf16x2_t __attribute__((ext_vector_type(2)));
__device__ __forceinline__ unsigned pk2(float lo, float hi) { const f32x2_t v = {lo, hi}; const bf16x2_t b = __builtin_convertvector(v, bf16x2_t); return __builtin_bit_cast(unsigned, b); }
__device__ __forceinline__ float bflo(unsigned w) { return __builtin_bit_cast(float, w << 16); }
__device__ __forceinline__ float bfhi(unsigned w) { return __builtin_bit_cast(float, w & 0xffff0000u); }
__device__ __forceinline__ float bf2f(bf16_t b) { return __builtin_bit_cast(float, (unsigned)b << 16); }
__device__ __forceinline__ float lx_f(float v, int lane, int o) { return __builtin_bit_cast(float, __builtin_amdgcn_ds_bpermute((lane ^ o) << 2, __builtin_bit_cast(int, v))); }
__device__ __forceinline__ int lx_i(int v, int lane, int o) { return __builtin_amdgcn_ds_bpermute((lane ^ o) << 2, v); }
__device__ __forceinline__ float lidx_f(float v, int src) { return __builtin_bit_cast(float, __builtin_amdgcn_ds_bpermute(src << 2, __builtin_bit_cast(int, v))); }
__device__ __forceinline__ float wave_sum(float v, int lane) {
#pragma unroll
    for (int o = 1; o < 64; o <<= 1) v += lx_f(v, lane, o);
    return v;
}
__device__ __forceinline__ float sigmoidf_(float x) { return __builtin_amdgcn_rcpf(1.0f + __builtin_amdgcn_exp2f(-1.4426950408889634f * x)); }
__device__ __forceinline__ float siluf(float x) { return x * sigmoidf_(x); }
#define LDS_WAIT() asm volatile("s_waitcnt lgkmcnt(0)" ::: "memory")
__device__ __forceinline__ unsigned char* opaque_ptr(unsigned char* p) { const unsigned long long v = (unsigned long long)p; unsigned lo = __builtin_amdgcn_readfirstlane((unsigned)v), hi = __builtin_amdgcn_readfirstlane((unsigned)(v >> 32));
    asm volatile("" : "+s"(lo), "+s"(hi)); return (unsigned char*)(__attribute__((address_space(1))) unsigned char*)(((unsigned long long)hi << 32) | lo); }
__device__ __forceinline__ LAS unsigned char* opaque_lds(LAS unsigned char* p) { unsigned v = __builtin_amdgcn_readfirstlane((unsigned)(size_t)p); asm volatile("" : "+s"(v)); return (LAS unsigned char*)(size_t)v; }
__device__ __forceinline__ int opaque_tid() { int t = threadIdx.x; asm volatile("" : "+v"(t)); return t; }

namespace gm {
constexpr int BM = 256, BK = 64, HALF = 128, HTB = HALF * BK * 2, STAGE_BYTES = 8 * HTB, NXCD = 8, WGM = 8;
__device__ __forceinline__ int lds_byte(int r, int c) { const int st = (r >> 4) * 2 + (c >> 5), rr = r & 15, cc = c & 31, ob = rr * 64 + cc * 2; return st * 1024 + (ob ^ (((ob >> 9) & 1) << 5)); }
__device__ __forceinline__ void stage_rc(int b, int& R, int& C) { const int st = b / 1024, sb = b % 1024, swz = sb ^ (((sb >> 9) & 1) << 5); R = (st >> 1) * 16 + swz / 64; C = (st & 1) * 32 + (swz % 64) / 2; }
__device__ __forceinline__ int perm32(int rho) { const int n = rho >> 4, i = rho & 15; return 8 * (i >> 2) + 4 * n + (i & 3); }

struct Unit { const char* B; int pm, pn, e, rows; };

template <class Epi, class Sched, bool GATHER>
__device__ __forceinline__ void gemm_phase(LAS unsigned char* lds, const int K_in, const Sched& S, const Epi& E) {
    int K = K_in; asm volatile("" : "+s"(K));
    const int tid = opaque_tid(), wid = __builtin_amdgcn_readfirstlane(tid >> 6), lane = tid & 63, wr = wid >> 2, wc = wid & 3, fr = lane & 15, fq = lane >> 4;
    const int nt = K / BK;
    int R0, C0; unsigned voffB;
    { stage_rc(tid * 16, R0, C0);
      const int Rb0 = Epi::PERM ? ((R0 & ~31) + perm32(R0 & 31)) : R0;
      voffB = (unsigned)(Rb0 * K + C0) * 2u; }
    const size_t kstep = (size_t)(BK * 2);
    const size_t hstep = (size_t)HALF * K * 2;
    const size_t qstep = (size_t)64 * K * 2;
    const unsigned ldsw = (unsigned)wid * 1024u;
    const int aoff = lds_byte(wr * 64 + fr, fq * 8), boff = lds_byte(wc * 32 + fr, fq * 8);
#define G_SA(b, h) (((b) * 2 + (h)) * gm::HTB)
#define G_SB(b, h) ((4 + (b) * 2 + (h)) * gm::HTB)
#define G_GLDS(gptr, ldsoff) __builtin_amdgcn_global_load_lds((const unsigned*)(gptr), (LAS unsigned*)(lds + (ldsoff)), 16, 0, 0)
#define G_STAGEB(bufoff, gbase) do { G_GLDS((const char*)(gbase) + voffB, (bufoff) + ldsw); G_GLDS((const char*)(gbase) + qstep + voffB, (bufoff) + ldsw + 8192); } while (0)
#define G_STAGEA(bufoff, ubase, h, o0, o1) do { if (GATHER) { G_GLDS((const char*)(ubase) + (o0), (bufoff) + ldsw); G_GLDS((const char*)(ubase) + (o1), (bufoff) + ldsw + 8192); } \
        else { G_GLDS((const char*)(ubase) + (h) * hstep + (o0), (bufoff) + ldsw); G_GLDS((const char*)(ubase) + (h) * hstep + qstep + (o0), (bufoff) + ldsw + 8192); } } while (0)
#define G_LDA(dst, b, h) do { _Pragma("unroll") for (int m = 0; m < 4; ++m) _Pragma("unroll") for (int k = 0; k < 2; ++k) dst[m][k] = *(const LAS bf16x8*)(lds + G_SA(b, h) + aoff + m * 2048 + k * 1024); } while (0)
#define G_LDB(dst, b, h) do { _Pragma("unroll") for (int n = 0; n < 2; ++n) _Pragma("unroll") for (int k = 0; k < 2; ++k) dst[n][k] = *(const LAS bf16x8*)(lds + G_SB(b, h) + boff + n * 2048 + k * 1024); } while (0)
#define G_MMA(ai, bj, At, Bt) do { __builtin_amdgcn_s_setprio(1); _Pragma("unroll") for (int m = 0; m < 4; ++m) _Pragma("unroll") for (int n = 0; n < 2; ++n) _Pragma("unroll") for (int k = 0; k < 2; ++k) \
        acc[ai][bj][m][n] = __builtin_amdgcn_mfma_f32_16x16x32_bf16(Bt[n][k], At[m][k], acc[ai][bj][m][n], 0, 0, 0); __builtin_amdgcn_s_setprio(0); } while (0)
#define G_WAIT_V(n) asm volatile("s_waitcnt vmcnt(" #n ")" ::: "memory")
#define G_WAIT_L(n) asm volatile("s_waitcnt lgkmcnt(" #n ")" ::: "memory")
#define G_BAR __builtin_amdgcn_s_barrier()
#define G_SCHED __builtin_amdgcn_sched_barrier(0)
    Unit cur, nxt; int ui = 0;
    if (!S.next(0, cur)) return;
    f32x4 acc[2][2][4][2];
#pragma unroll
    for (int a = 0; a < 2; ++a)
#pragma unroll
        for (int b = 0; b < 2; ++b)
#pragma unroll
            for (int m = 0; m < 4; ++m)
#pragma unroll
                for (int n = 0; n < 2; ++n) acc[a][b][m][n] = (f32x4){0.f, 0.f, 0.f, 0.f};
    bf16x8 At[4][2], B0[2][2], B1[2][2];
    unsigned c00, c01 = 0, c10 = 0, c11 = 0;
    c00 = S.a_off(0, R0, C0);
    if (GATHER) { c01 = S.a_off(0, R0 + 64, C0); c10 = S.a_off(0, R0 + 128, C0); c11 = S.a_off(0, R0 + 192, C0); }
    const char* cA = S.a_base(cur); const char* cB = cur.B;
#if GEMM_4PH
    G_STAGEB(G_SB(0, 0), cB); G_STAGEA(G_SA(0, 0), cA, 0, c00, c01); G_STAGEB(G_SB(0, 1), cB + hstep); G_STAGEA(G_SA(0, 1), cA, 1, c10 + (GATHER ? 0u : c00), c11);
    if (wr == 1) G_BAR;
    G_WAIT_V(4); G_BAR;
#else
    G_STAGEB(G_SB(0, 0), cB); G_STAGEB(G_SB(0, 1), cB + hstep); G_STAGEA(G_SA(0, 0), cA, 0, c00, c01); G_STAGEA(G_SA(0, 1), cA, 1, c10 + (GATHER ? 0u : c00), c11);
    if (wr == 1) G_BAR;
    G_WAIT_V(2); G_BAR;
#endif
    G_STAGEB(G_SB(1, 0), cB + kstep); G_STAGEA(G_SA(1, 0), cA + kstep, 0, c00, c01); G_STAGEB(G_SB(1, 1), cB + hstep + kstep);
    G_WAIT_V(6); G_BAR;
    for (;;) {
        const bool has_next = S.next(ui + 1, nxt);
        const char* nB = cB; const char* nA = cA;
        if (has_next) { nB = nxt.B; nA = S.a_base(nxt); }
        for (int t = 0; t < nt; t += 2) {
            const bool last = (t == nt - 2);
            const char* a1 = cA + (size_t)(t + 1) * kstep;
            const char* a2 = last ? nA : cA + (size_t)(t + 2) * kstep;
            const char* b2 = last ? nB : cB + (size_t)(t + 2) * kstep;
#if GEMM_4PH
            G_LDB(B0, 0, 0); G_SCHED; G_LDA(At, 0, 0); G_STAGEA(G_SA(1, 1), a1, 1, c10 + (GATHER ? 0u : c00), c11);
            G_WAIT_L(8); G_BAR; G_WAIT_L(0); G_MMA(0, 0, At, B0); G_BAR; G_SCHED;
            if (GATHER) { if (last && has_next) { c00 = S.a_off(ui + 1, R0, C0); c01 = S.a_off(ui + 1, R0 + 64, C0); c10 = S.a_off(ui + 1, R0 + 128, C0); c11 = S.a_off(ui + 1, R0 + 192, C0); } }
            G_LDB(B1, 0, 1); G_STAGEB(G_SB(0, 0), b2);
            G_BAR; G_WAIT_L(0); G_MMA(0, 1, At, B1); G_BAR;
            G_LDA(At, 0, 1); G_STAGEA(G_SA(0, 0), a2, 0, c00, c01);
            G_BAR; G_WAIT_L(0); G_MMA(1, 0, At, B0); G_BAR; G_SCHED;
            G_STAGEB(G_SB(0, 1), b2 + hstep);
            G_WAIT_V(6); G_BAR; G_MMA(1, 1, At, B1); G_BAR;
            G_LDB(B0, 1, 0); G_SCHED; G_LDA(At, 1, 0); G_STAGEA(G_SA(0, 1), a2, 1, c10 + (GATHER ? 0u : c00), c11);
            G_WAIT_L(8); G_BAR; G_WAIT_L(0); G_MMA(0, 0, At, B0); G_BAR; G_SCHED;
            G_LDB(B1, 1, 1); G_STAGEB(G_SB(1, 0), b2 + kstep);
            G_BAR; G_WAIT_L(0); G_MMA(0, 1, At, B1); G_BAR;
            G_LDA(At, 1, 1); G_STAGEA(G_SA(1, 0), a2 + kstep, 0, c00, c01);
            G_BAR; G_WAIT_L(0); G_MMA(1, 0, At, B0); G_BAR; G_SCHED;
            G_STAGEB(G_SB(1, 1), b2 + kstep + hstep);
            G_WAIT_V(6); G_BAR; G_MMA(1, 1, At, B1); G_BAR;
        }
#else
            G_LDB(B0, 0, 0); G_LDB(B1, 0, 1); G_SCHED; G_LDA(At, 0, 0); G_STAGEA(G_SA(1, 1), a1, 1, c10 + (GATHER ? 0u : c00), c11);
            G_WAIT_V(8); G_WAIT_L(0); G_BAR; G_MMA(0, 0, At, B0); G_MMA(0, 1, At, B1); G_BAR; G_SCHED;
            if (GATHER) { if (last && has_next) { c00 = S.a_off(ui + 1, R0, C0); c01 = S.a_off(ui + 1, R0 + 64, C0); c10 = S.a_off(ui + 1, R0 + 128, C0); c11 = S.a_off(ui + 1, R0 + 192, C0); } }
            G_LDA(At, 0, 1); G_STAGEB(G_SB(0, 0), b2); G_STAGEB(G_SB(0, 1), b2 + hstep); G_STAGEA(G_SA(0, 0), a2, 0, c00, c01);
            G_WAIT_V(8); G_WAIT_L(0); G_BAR; G_MMA(1, 0, At, B0); G_MMA(1, 1, At, B1); G_BAR; G_SCHED;
            G_LDB(B0, 1, 0); G_LDB(B1, 1, 1); G_SCHED; G_LDA(At, 1, 0); G_STAGEA(G_SA(0, 1), a2, 1, c10 + (GATHER ? 0u : c00), c11);
            G_WAIT_V(8); G_WAIT_L(0); G_BAR; G_MMA(0, 0, At, B0); G_MMA(0, 1, At, B1); G_BAR; G_SCHED;
            G_LDA(At, 1, 1); G_STAGEB(G_SB(1, 0), b2 + kstep); G_STAGEB(G_SB(1, 1), b2 + kstep + hstep); G_STAGEA(G_SA(1, 0), a2 + kstep, 0, c00, c01);
            G_WAIT_V(8); G_WAIT_L(0); G_BAR; G_MMA(1, 0, At, B0); G_MMA(1, 1, At, B1); G_BAR; G_SCHED;
        }
#endif
        if (wr == 0) G_BAR;
        E(acc, cur, wr, wc, fr, fq);
        if (!has_next) break;
#pragma unroll
        for (int a = 0; a < 2; ++a)
#pragma unroll
            for (int b = 0; b < 2; ++b)
#pragma unroll
                for (int m = 0; m < 4; ++m)
#pragma unroll
                    for (int n = 0; n < 2; ++n) acc[a][b][m][n] = (f32x4){0.f, 0.f, 0.f, 0.f};
        cur = nxt; cB = nB; cA = nA; ++ui;
        if (wr == 1) G_BAR;
    }
    G_WAIT_V(0);
    G_BAR;
}
}

struct DenseOrder {
    int nM, nN, nwg, G, c, K; const char* Bt;
    __device__ __forceinline__ void init(int M, int N, int K_, int G_, int c_, const void* A_, const void* Bt_) { nM = M / 256; nN = N / 256; nwg = nM * nN; G = G_; c = c_; K = K_; A = (const char*)A_; Bt = (const char*)Bt_; }
    __device__ __forceinline__ bool next(int i, gm::Unit& u) const {
        const long L = (long)i * G + c; if (L >= nwg) return false;
        int wgid = (int)L; { const int q = nwg / gm::NXCD, r = nwg % gm::NXCD, xcd = wgid % gm::NXCD, off = wgid / gm::NXCD; wgid = (xcd < r ? xcd * (q + 1) : r * (q + 1) + (xcd - r) * q) + off; }
        const int nig = gm::WGM * nN, gid = wgid / nig, fm = gid * gm::WGM, gsz = (nM - fm) < gm::WGM ? (nM - fm) : gm::WGM;
        u.pm = fm + ((wgid % nig) % gsz); u.pn = (wgid % nig) / gsz; u.e = 0; u.rows = 256;
        u.B = Bt + (size_t)u.pn * 256 * K * 2; return true;
    }
    const char* A;
    __device__ __forceinline__ const char* a_base(const gm::Unit& u) const { return A + (size_t)u.pm * 256 * K * 2; }
    __device__ __forceinline__ unsigned a_off(int, int r, int c) const { return (unsigned)(r * K + c) * 2u; }
};
constexpr int GT_MAX = 19, GT_OFF = 128 * 1024;
template <bool GATHER> struct MoeOrder {
    LAS const int* tab; int nN, G, vc; const char* Wt; size_t wstride; const int* stok;
    __device__ __forceinline__ bool next(int i, gm::Unit& u) const {
        const int L = i * G + vc; if (L >= tab[32]) return false;
        int e = 0;
#pragma unroll 1
        for (int k = 1; k < 32; ++k) e += (tab[k] <= L) ? 1 : 0;
        const int r = L - tab[e]; u.e = e; u.pm = r / nN; u.pn = r % nN;
        const int cnt = tab[128 + e]; u.rows = (cnt - u.pm * 256) < 256 ? (cnt - u.pm * 256) : 256;
        u.B = Wt + (size_t)e * wstride + (size_t)u.pn * 256 * 1024 * 2; return true;
    }
    const char* A;
    __device__ __forceinline__ const char* a_base(const gm::Unit& u) const { return GATHER ? A : A + (size_t)(tab[64 + u.e] + u.pm * 256) * 2048; }
    LAS const unsigned* gtab;
    __device__ __forceinline__ unsigned a_off(int ui, int r, int c) const {
        if (GATHER) return gtab[ui * 256 + r] + (unsigned)c * 2u;
        else return (unsigned)(r * 1024 + c) * 2u;
    }
    __device__ __forceinline__ void fill_gather(LAS unsigned* gt) const {
        const int tid = opaque_tid();
        if (tid < 256) { gm::Unit u;
            for (int i = 0; i < GT_MAX && next(i, u); ++i) { int tk = 0; if (tid < u.rows) tk = stok[u.e * CAP + u.pm * 256 + tid] >> 2; gt[i * 256 + tid] = (unsigned)tk * 2048u; } }
        __syncthreads();
    }
};
__device__ __forceinline__ void moe_tables(LAS unsigned char* lds, const int* gcount, int nN) {
    LAS int* tab = (LAS int*)(lds + MISC_OFF);
    if (opaque_tid() == 0) { int cu = 0, ro = 0;
#pragma unroll 1
        for (int e = 0; e < 32; ++e) { const int c = gcount[e]; tab[e] = cu; tab[64 + e] = ro; tab[128 + e] = c; cu += ((c + 255) >> 8) * nN; ro += c; }
        tab[32] = cu; tab[64 + 32] = ro; }
    __syncthreads();
}

struct EpiProj {
    static constexpr bool PERM = true;
    bf16_t* O; int ldc; bf16_t* su2;
    __device__ __forceinline__ void operator()(const f32x4 (&acc)[2][2][4][2], const gm::Unit& u, int wr, int wc, int fr_, int fq_) const {
        int fr = fr_, fq = fq_; asm volatile("" : "+v"(fr), "+v"(fq));
        const int row0 = u.pm * 256 + wr * 64 + fr, col0 = u.pn * 256 + wc * 32 + 8 * fq;
#pragma unroll
        for (int ai = 0; ai < 2; ++ai)
#pragma unroll
            for (int m = 0; m < 4; ++m) { bf16_t* rowp = O + (size_t)(row0 + ai * 128 + m * 16) * ldc + col0;
#pragma unroll
                for (int bj = 0; bj < 2; ++bj) { const f32x4 v0 = acc[ai][bj][m][0], v1 = acc[ai][bj][m][1];
                    u32x4 w; w.x = pk2(v0[0], v0[1]); w.y = pk2(v0[2], v0[3]); w.z = pk2(v1[0], v1[1]); w.w = pk2(v1[2], v1[3]);
                    const int col = col0 + bj * 128;
                    if (su2 != nullptr && col >= C_SU && col < NPROJ) { const int row = row0 + ai * 128 + m * 16, cs = col - C_SU;
                        *(u32x4*)(su2 + ((size_t)((row >> 12) * 16 + (cs >> 4)) * 4096 + (row & 4095)) * 16 + (cs & 15)) = w; }
                    else *(u32x4*)(rowp + bj * 128) = w; } }
    }
};
struct EpiOut {
    static constexpr bool PERM = false;
    const float* xin; float* xout; const float* gate;
    __device__ __forceinline__ void operator()(const f32x4 (&acc)[2][2][4][2], const gm::Unit& u, int wr, int wc, int fr_, int fq_) const {
        int fr = fr_, fq = fq_; asm volatile("" : "+v"(fr), "+v"(fq));
        const int row0 = u.pm * 256 + wr * 64 + fr, col0 = u.pn * 256 + wc * 32 + 4 * fq;
        const float* gp = gate + (size_t)(u.pm >> 4) * 6144 + col0;
        f32x4 gv[2][2];
#pragma unroll
        for (int bj = 0; bj < 2; ++bj)
#pragma unroll
            for (int n = 0; n < 2; ++n) gv[bj][n] = *(const f32x4*)(gp + bj * 128 + n * 16);
#pragma unroll
        for (int ai = 0; ai < 2; ++ai)
#pragma unroll
            for (int m = 0; m < 4; ++m) { const size_t ro = (size_t)(row0 + ai * 128 + m * 16) * 1024 + col0;
#pragma unroll
                for (int bj = 0; bj < 2; ++bj)
#pragma unroll
                    for (int n = 0; n < 2; ++n) { const f32x4 xi = *(const f32x4*)(xin + ro + bj * 128 + n * 16);
                        *(f32x4*)(xout + ro + bj * 128 + n * 16) = xi + gv[bj][n] * acc[ai][bj][m][n]; } }
    }
};
struct EpiGlu {
    static constexpr bool PERM = true;
    const bf16_t* y; bf16_t* mixed; const float* bias;
    __device__ __forceinline__ void operator()(const f32x4 (&acc)[2][2][4][2], const gm::Unit& u, int wr, int wc, int fr_, int fq_) const {
        int fr = fr_, fq = fq_; asm volatile("" : "+v"(fr), "+v"(fq));
        const int row0 = u.pm * 256 + wr * 64 + fr, col0 = wc * 32 + 8 * fq;
#pragma unroll
        for (int ai = 0; ai < 2; ++ai)
#pragma unroll
            for (int m = 0; m < 4; ++m) { const int row = row0 + ai * 128 + m * 16;
#pragma unroll
                for (int bj = 0; bj < 2; ++bj) { const int col = col0 + bj * 128;
                    const f32x4 b0 = *(const f32x4*)(bias + col), b1 = *(const f32x4*)(bias + col + 4);
                    const u32x4 yw = *(const u32x4*)(y + (size_t)row * 256 + col);
                    const f32x4 z0 = acc[ai][bj][m][0] + b0, z1 = acc[ai][bj][m][1] + b1;
                    u32x4 w;
                    w.x = pk2(bflo(yw.x) * sigmoidf_(z0[0]), bfhi(yw.x) * sigmoidf_(z0[1]));
                    w.y = pk2(bflo(yw.y) * sigmoidf_(z0[2]), bfhi(yw.y) * sigmoidf_(z0[3]));
                    w.z = pk2(bflo(yw.z) * sigmoidf_(z1[0]), bfhi(yw.z) * sigmoidf_(z1[1]));
                    w.w = pk2(bflo(yw.w) * sigmoidf_(z1[2]), bfhi(yw.w) * sigmoidf_(z1[3]));
                    *(u32x4*)(mixed + (size_t)row * 1024 + 768 + col) = w; }
                __builtin_amdgcn_sched_barrier(0); }
    }
};
__device__ __forceinline__ float swiglu1(float g, float l) {
    g = fminf(g, 7.0f); l = fminf(fmaxf(l, -7.0f), 7.0f);
    return g * __builtin_amdgcn_rcpf(1.0f + __builtin_amdgcn_exp2f(-2.4554669595930157f * g)) * (l + 1.0f);
}
struct EpiUp {
    static constexpr bool PERM = true;
    bf16_t* act; const float* bias; LAS const int* tab;
    __device__ __forceinline__ void operator()(const f32x4 (&acc)[2][2][4][2], const gm::Unit& u, int wr, int wc, int fr_, int fq_) const {
        int fr = fr_, fq = fq_; asm volatile("" : "+v"(fr), "+v"(fq));
        const int rl0 = wr * 64 + fr, col0 = u.pn * 128 + wc * 32 + 8 * fq;
        const float* bp = bias + (size_t)u.e * 2048 + col0;
        unsigned bgp[4], blp[4];
        { const f32x4 bg0 = *(const f32x4*)(bp), bg1 = *(const f32x4*)(bp + 4), bl0 = *(const f32x4*)(bp + 1024), bl1 = *(const f32x4*)(bp + 1028);
          bgp[0] = pk2(bg0[0], bg0[1]); bgp[1] = pk2(bg0[2], bg0[3]); bgp[2] = pk2(bg1[0], bg1[1]); bgp[3] = pk2(bg1[2], bg1[3]);
          blp[0] = pk2(bl0[0], bl0[1]); blp[1] = pk2(bl0[2], bl0[3]); blp[2] = pk2(bl1[0], bl1[1]); blp[3] = pk2(bl1[2], bl1[3]); }
        const size_t arow = (size_t)(tab[64 + u.e] + u.pm * 256);
#pragma unroll
        for (int ai = 0; ai < 2; ++ai)
#pragma unroll
            for (int m = 0; m < 4; ++m) { const int rl = rl0 + ai * 128 + m * 16;
                if (rl < u.rows) {
                    const f32x4 bg0 = {bflo(bgp[0]), bfhi(bgp[0]), bflo(bgp[1]), bfhi(bgp[1])}, bg1 = {bflo(bgp[2]), bfhi(bgp[2]), bflo(bgp[3]), bfhi(bgp[3])};
                    const f32x4 bl0 = {bflo(blp[0]), bfhi(blp[0]), bflo(blp[1]), bfhi(blp[1])}, bl1 = {bflo(blp[2]), bfhi(blp[2]), bflo(blp[3]), bfhi(blp[3])};
                    const f32x4 g0 = acc[ai][0][m][0] + bg0, g1 = acc[ai][0][m][1] + bg1, l0 = acc[ai][1][m][0] + bl0, l1 = acc[ai][1][m][1] + bl1;
                    u32x4 w;
                    w.x = pk2(swiglu1(g0[0], l0[0]), swiglu1(g0[1], l0[1])); w.y = pk2(swiglu1(g0[2], l0[2]), swiglu1(g0[3], l0[3]));
                    w.z = pk2(swiglu1(g1[0], l1[0]), swiglu1(g1[1], l1[1])); w.w = pk2(swiglu1(g1[2], l1[2]), swiglu1(g1[3], l1[3]));
                    *(u32x4*)(act + (arow + rl) * 1024 + col0) = w; } }
    }
};
struct EpiDown {
    static constexpr bool PERM = true;
    bf16_t* outr; const float* bias; const int* stok; const float* sgate;
    __device__ __forceinline__ void operator()(const f32x4 (&acc)[2][2][4][2], const gm::Unit& u, int wr, int wc, int fr_, int fq_) const {
        int fr = fr_, fq = fq_; asm volatile("" : "+v"(fr), "+v"(fq));
        const int rl0 = wr * 64 + fr, col0 = u.pn * 256 + wc * 32 + 8 * fq;
        const float* bp = bias + (size_t)u.e * 1024 + col0;
        f32x4 bv[2][2];
#pragma unroll
        for (int bj = 0; bj < 2; ++bj) { bv[bj][0] = *(const f32x4*)(bp + bj * 128); bv[bj][1] = *(const f32x4*)(bp + bj * 128 + 4); }
        int sts[8]; float gts[8];
#pragma unroll
        for (int q = 0; q < 8; ++q) { const int rl = rl0 + (q >> 2) * 128 + (q & 3) * 16; const int si = u.e * CAP + u.pm * 256 + (rl < u.rows ? rl : 0); sts[q] = stok[si]; gts[q] = sgate[si]; }
#pragma unroll
        for (int ai = 0; ai < 2; ++ai)
#pragma unroll
            for (int m = 0; m < 4; ++m) { const int rl = rl0 + ai * 128 + m * 16;
                if (rl < u.rows) {
                    const int st = sts[ai * 4 + m]; const float gt = gts[ai * 4 + m];
                    bf16_t* rowp = outr + (size_t)st * 1024 + col0;
#pragma unroll
                    for (int bj = 0; bj < 2; ++bj) { const f32x4 v0 = (acc[ai][bj][m][0] + bv[bj][0]) * gt, v1 = (acc[ai][bj][m][1] + bv[bj][1]) * gt;
                        u32x4 w; w.x = pk2(v0[0], v0[1]); w.y = pk2(v0[2], v0[3]); w.z = pk2(v1[0], v1[1]); w.w = pk2(v1[2], v1[3]);
                        *(u32x4*)(rowp + bj * 128) = w; } } }
    }
};

__device__ __forceinline__ void transpose_item(const float* W, int K, int Nsrc, bf16_t* WT, int mode, LAS float* scr, int kb, int nb, int lane) {
    const int k0 = 64 * kb, n0 = 32 * nb;
    const int ncol = n0 + (lane & 31);
#pragma unroll 8
    for (int i = 0; i < 32; ++i) { const int kk = 2 * i + (lane >> 5); scr[kk * 33 + (lane & 31)] = (ncol < Nsrc) ? W[(size_t)(k0 + kk) * Nsrc + ncol] : 0.f; }
    LDS_WAIT(); asm volatile("" ::: "memory");
    const int c = lane & 7;
#pragma unroll
    for (int j = 0; j < 4; ++j) { const int n = (lane >> 3) + 8 * j; const LAS float* s = scr + (8 * c) * 33 + n;
        u32x4 o; o.x = pk2(s[0 * 33], s[1 * 33]); o.y = pk2(s[2 * 33], s[3 * 33]); o.z = pk2(s[4 * 33], s[5 * 33]); o.w = pk2(s[6 * 33], s[7 * 33]);
        int drow = n0 + n;
        if (mode == 1) { const int jj = drow & 1023, lin = drow >> 10; drow = (jj >> 7) * 256 + lin * 128 + (jj & 127); }
        *(u32x4*)(WT + (size_t)drow * K + k0 + 8 * c) = o; }
    LDS_WAIT(); asm volatile("" ::: "memory");
}
constexpr int TI_IN = 16 * 88, TI_OUT = 16 * 32, TI_UP = 16 * 64, TI_DN = 16 * 32, TI_GLU = 4 * 8;
constexpr int TS_R0 = 2 * TI_IN, TS_R1 = TS_R0 + 2 * TI_OUT, TS_R2 = TS_R1 + 2 * TI_GLU;
__device__ __forceinline__ void transpose_small(const Params& P, LAS unsigned char* lds, int gw, int ngw, int wave, int lane) {
    unsigned char* const wsp = opaque_ptr(P.ws);
    LAS float* scr = (LAS float*)(lds + wave * 8704);
    for (int it = gw; it < TS_R2; it += ngw) {
        if (it < TS_R0) { const int l = it / TI_IN, r = it % TI_IN;
            transpose_item(P.w_in + (size_t)l * 1024 * NPROJ, 1024, NPROJ, (bf16_t*)(wsp + WS_WIN) + (size_t)l * NPROJP * 1024, 0, scr, r / 88, r % 88, lane); }
        else if (it < TS_R1) { const int q = it - TS_R0, l = q / TI_OUT, r = q % TI_OUT;
            transpose_item(P.w_out + (size_t)l * 1024 * 1024, 1024, 1024, (bf16_t*)(wsp + WS_WOUT) + (size_t)l * 1024 * 1024, 0, scr, r / 32, r % 32, lane); }
        else { const int q = it - TS_R1, l = q / TI_GLU, r = q % TI_GLU;
            transpose_item(P.s5_w_glu + (size_t)l * 256 * 256, 256, 256, (bf16_t*)(wsp + WS_WGLU) + (size_t)l * 256 * 256, 0, scr, r / 8, r % 8, lane); }
    }
}
__device__ __forceinline__ void transpose_item64(const float* W, int K, int Nsrc, bf16_t* WT, int mode, LAS float* scr, int kb, int nb, int lane) {
    const int k0 = 64 * kb, n0 = 64 * nb, kq = lane >> 4, nn = 4 * (lane & 15);
    const float* src = W + (size_t)(k0 + kq) * Nsrc + n0 + nn;
    f32x4 v[16];
#pragma unroll
    for (int i = 0; i < 16; ++i) v[i] = __builtin_nontemporal_load((const f32x4*)(src + (size_t)(4 * i) * Nsrc));
#pragma unroll
    for (int i = 0; i < 16; ++i) { LAS float* d = scr + (4 * i + kq) * 65 + nn; d[0] = v[i][0]; d[1] = v[i][1]; d[2] = v[i][2]; d[3] = v[i][3]; }
    LDS_WAIT(); asm volatile("" ::: "memory");
    const int c = lane & 7;
#pragma unroll
    for (int j = 0; j < 8; ++j) { const int n = (lane >> 3) + 8 * j; const LAS float* s = scr + (8 * c) * 65 + n;
        u32x4 o; o.x = pk2(s[0 * 65], s[1 * 65]); o.y = pk2(s[2 * 65], s[3 * 65]); o.z = pk2(s[4 * 65], s[5 * 65]); o.w = pk2(s[6 * 65], s[7 * 65]);
        int drow = n0 + n;
        if (mode == 1) { const int jj = drow & 1023, lin = drow >> 10; drow = (jj >> 7) * 256 + lin * 128 + (jj & 127); }
        *(u32x4*)(WT + (size_t)drow * K + k0 + 8 * c) = o; }
    LDS_WAIT(); asm volatile("" ::: "memory");
}
constexpr int TM_UP = 16 * 32, TM_DN = 16 * 16;
constexpr int TM_TOTAL = 32 * (TM_UP + TM_DN), TM_Q_IN = 2560, TM_Q_DN = 5120, TM_Q_P0 = 8192;
__device__ __forceinline__ void transpose_moe_item(const Params& P, unsigned char* wsp, LAS float* scr, int l, int it, int lane) {
    if (it < 32 * TM_UP) { const int le = l * 32 + it / TM_UP, r = it % TM_UP;
        transpose_item64(P.w_up + (size_t)le * 1024 * 2048, 1024, 2048, (bf16_t*)(wsp + WS_WUP) + (size_t)le * 2048 * 1024, 1, scr, r / 32, r % 32, lane); }
    else { const int q = it - 32 * TM_UP, le = l * 32 + q / TM_DN, r = q % TM_DN;
        transpose_item64(P.w_down + (size_t)le * 1024 * 1024, 1024, 1024, (bf16_t*)(wsp + WS_WDN) + (size_t)le * 1024 * 1024, 0, scr, r / 16, r % 16, lane); }
}
__device__ __forceinline__ int tm_pool_size(int l) { return l == 0 ? TM_Q_P0 + TM_Q_IN : TM_Q_DN + TM_Q_IN; }
__device__ __forceinline__ void transpose_moe_pool(const Params& P, LAS unsigned char* lds, int l, int limit) {
    unsigned char* const wsp = opaque_ptr(P.ws);
    const int tid = opaque_tid(), wave = __builtin_amdgcn_readfirstlane(tid >> 6), lane = tid & 63;
    LAS float* scr = (LAS float*)(lds + wave * 16640);
    int* ctr = (int*)(wsp + WS_CTL) + 128 + l;
    const int qa = tm_pool_size(l);
    for (;;) {
        if (8 * __builtin_amdgcn_readfirstlane(__hip_atomic_load(ctr, __ATOMIC_RELAXED, __HIP_MEMORY_SCOPE_AGENT)) >= limit) break;
        int bt = 0; if (lane == 0) bt = __hip_atomic_fetch_add(ctr, 1, __ATOMIC_RELAXED, __HIP_MEMORY_SCOPE_AGENT);
        bt = __builtin_amdgcn_readfirstlane(bt);
        if (8 * bt >= qa) break;
#pragma unroll 1
        for (int k = 0; k < 8; ++k) transpose_moe_item(P, wsp, scr, l, 8 * bt + k, lane);
    }
}
__device__ __forceinline__ void transpose_moe_rest(const Params& P, LAS unsigned char* lds, int l, int gw, int ngw) {
    transpose_moe_pool(P, lds, l, TM_TOTAL);
    unsigned char* const wsp = opaque_ptr(P.ws);
    const int tid = opaque_tid(), wave = __builtin_amdgcn_readfirstlane(tid >> 6), lane = tid & 63;
    LAS float* scr = (LAS float*)(lds + wave * 16640);
    for (int it = tm_pool_size(l) + gw; it < TM_TOTAL; it += ngw) transpose_moe_item(P, wsp, scr, l, it, lane);
}
__device__ __forceinline__ int xcd_vc(int c, int Gp) { const int q = Gp / 8, r = Gp % 8, xcd = c % 8, off = c / 8; return (xcd < r ? xcd * (q + 1) : r * (q + 1) + (xcd - r) * q) + off; }
__device__ __forceinline__ void mod_item(const Params& P, LAS unsigned char* lds, int item) {
    unsigned char* const wsp = opaque_ptr(P.ws);
    const int tid = opaque_tid(), wave = tid >> 6, lane = tid & 63;
    LAS float* sc = (LAS float*)lds;
    LAS float* red = (LAS float*)(lds + 32768);
    const int l = item / 96, cb = item % 96;
    for (int i = tid; i < 8192; i += NTHREADS) sc[i] = siluf(P.c[i]);
    __syncthreads();
    const float* W = P.w_mod + (size_t)l * 1024 * 6144 + cb * 64 + lane;
    float a[8];
#pragma unroll
    for (int b = 0; b < 8; ++b) a[b] = 0.f;
#pragma unroll 1
    for (int k0 = wave; k0 < 1024; k0 += 128) { float wv[16];
#pragma unroll
        for (int u = 0; u < 16; ++u) wv[u] = __builtin_nontemporal_load(W + (size_t)(k0 + 8 * u) * 6144);
#pragma unroll
        for (int u = 0; u < 16; ++u) {
#pragma unroll
            for (int b = 0; b < 8; ++b) a[b] += sc[b * 1024 + k0 + 8 * u] * wv[u]; } }
#pragma unroll
    for (int b = 0; b < 8; ++b) red[(wave * 8 + b) * 64 + lane] = a[b];
    __syncthreads();
    { const int b = tid >> 6; float s = 0.f;
#pragma unroll
      for (int w = 0; w < 8; ++w) s += red[(w * 8 + b) * 64 + lane];
      ((float*)(wsp + WS_MOD))[(size_t)(l * 8 + b) * 6144 + cb * 64 + lane] = s + P.b_mod[l * 6144 + cb * 64 + lane]; }
    __syncthreads();
}
__device__ __forceinline__ void dsincos(double x, double& s, double& c) {
    const double x2 = x * x; double ts = x, tc = 1.0; s = x; c = 1.0;
#pragma unroll 1
    for (int k = 1; k <= 14; ++k) { tc = -tc * x2 / (double)((2 * k - 1) * (2 * k)); ts = -ts * x2 / (double)((2 * k) * (2 * k + 1)); c += tc; s += ts; }
}
__device__ __forceinline__ double dexp_small(double z) {
    double t = 1.0, r = 1.0;
#pragma unroll 1
    for (int k = 1; k <= 18; ++k) { t = t * z / (double)k; r += t; }
    return r;
}
__device__ __forceinline__ void s5_tables_item(const Params& P, LAS unsigned char* lds, int item4) {
    unsigned char* const wsp = opaque_ptr(P.ws);
    const int tid = opaque_tid(); const int item = item4 >> 2, qtr = item4 & 3; const int l = item >> 4, g = item & 15, lg = l * 16 + g;
    LAS float* pwr = (LAS float*)lds;
    LAS float* pwi = pwr + 64 * 65;
    LAS float* bbr = pwi + 64 * 65;
    LAS float* bbi = bbr + 1024;
    LAS float* ccr = bbi + 1024;
    LAS float* cci = ccr + 1024;
    if (tid < 64) { const int p = tid;
        const double are = (double)P.s5_a_re[lg * 64 + p], aim = (double)P.s5_a_im[lg * 64 + p];
        const double dt = (double)expf(P.s5_log_dt[lg]);
        const double mag = dexp_small(are * dt);
        double ang = aim * dt; const double TWO_PI = 6.283185307179586476925;
        ang -= TWO_PI * rint(ang / TWO_PI);
        double sn, cs; dsincos(ang, sn, cs);
        const double lbr = mag * cs, lbi = mag * sn;
        const double nr = lbr - 1.0, ni = lbi, den = are * are + aim * aim;
        const double cfr = (nr * are + ni * aim) / den, cfi = (ni * are - nr * aim) / den;
        double pr = 1.0, pi_ = 0.0;
        for (int t = 0; t <= 64; ++t) { pwr[p * 65 + t] = (float)pr; pwi[p * 65 + t] = (float)pi_; const double nr2 = pr * lbr - pi_ * lbi, ni2 = pr * lbi + pi_ * lbr; pr = nr2; pi_ = ni2; }
        for (int h = 0; h < 16; ++h) { const double br = (double)P.s5_b_re[(lg * 64 + p) * 16 + h], bi = (double)P.s5_b_im[(lg * 64 + p) * 16 + h];
            bbr[p * 16 + h] = (float)(cfr * br - cfi * bi); bbi[p * 16 + h] = (float)(cfr * bi + cfi * br); }
        float* l64 = (float*)(wsp + WS_LAM64) + (size_t)(lg * 64 + p) * 2;
        if (qtr == 0) { l64[0] = pwr[p * 65 + 64]; l64[1] = pwi[p * 65 + 64]; }
    }
    for (int i = tid; i < 1024; i += NTHREADS) { ccr[i] = P.s5_c_re[lg * 1024 + i]; cci[i] = P.s5_c_im[lg * 1024 + i]; }
    __syncthreads();
    bf16_t* kt = (bf16_t*)(wsp + WS_KTAB) + (size_t)lg * 65 * 256;
    for (int i = qtr * 16 * 256 + tid; i < (qtr == 3 ? 65 : 16 * (qtr + 1)) * 256; i += NTHREADS) { const int tau = i >> 8, h = (i >> 4) & 15, h2 = i & 15; float s = 0.f;
        if (tau < 64) {
            for (int p = 0; p < 64; ++p) { const float pr = pwr[p * 65 + tau], pi_ = pwi[p * 65 + tau], br = bbr[p * 16 + h2], bi = bbi[p * 16 + h2];
                const float wr_ = pr * br - pi_ * bi, wi_ = pr * bi + pi_ * br; s += ccr[h * 64 + p] * wr_ - cci[h * 64 + p] * wi_; }
            if (tau == 0 && h == h2) s += P.s5_d[l * 256 + g * 16 + h]; }
        kt[i] = (bf16_t)f2bf(s); }
    bf16_t* bp = (bf16_t*)(wsp + WS_BPOW) + (size_t)lg * 128 * 1024;
    for (int i = qtr * 32768 + tid; i < (qtr + 1) * 32768; i += NTHREADS) { const int q = i >> 10, s = (i >> 4) & 63, h2 = i & 15, p = q & 63;
        const float pr = pwr[p * 65 + 63 - s], pi_ = pwi[p * 65 + 63 - s], br = bbr[p * 16 + h2], bi = bbi[p * 16 + h2];
        const float v = (q < 64) ? (pr * br - pi_ * bi) : (pr * bi + pi_ * br);
        bp[i] = (bf16_t)f2bf(v); }
    bf16_t* cp = (bf16_t*)(wsp + WS_CPOW) + (size_t)lg * 1024 * 128;
    for (int i = qtr * 32768 + tid; i < (qtr + 1) * 32768; i += NTHREADS) { const int q = i & 127, th = i >> 7, t = th >> 4, h = th & 15, p = q & 63;
        const float pr = pwr[p * 65 + t + 1], pi_ = pwi[p * 65 + t + 1], cr = ccr[h * 64 + p], ci = cci[h * 64 + p];
        const float v = (q < 64) ? (cr * pr - ci * pi_) : -(cr * pi_ + ci * pr);
        cp[i] = (bf16_t)f2bf(v); }
    __syncthreads();
}
__device__ __forceinline__ void rope_table(const Params& P, int gtid, int gthreads) {
    unsigned char* const wsp = opaque_ptr(P.ws);
    float* rp = (float*)(wsp + WS_ROPE);
    for (int i = gtid; i < 4096 * 24; i += gthreads) { const int pos = i / 24, f = i % 24;
        double rev = (double)pos * P.inv_freq_rev[f]; rev -= rint(rev);
        double sn, cs; dsincos(rev * 6.283185307179586476925, sn, cs);
        rp[2 * i] = (float)cs; rp[2 * i + 1] = (float)sn; }
}
__device__ __forceinline__ void norm_row_store(const f32x4 (&v)[4], const float* nw, const float* modrow_sh, const float* modrow_sc, bf16_t* orow, int lane) {
    float ss = 0.f;
#pragma unroll
    for (int j = 0; j < 4; ++j) ss += (v[j][0] * v[j][0] + v[j][1] * v[j][1]) + (v[j][2] * v[j][2] + v[j][3] * v[j][3]);
    const float rstd = 1.0f / sqrtf(wave_sum(ss, lane) * (1.0f / 1024.0f) + NORM_EPS);
#pragma unroll
    for (int hf = 0; hf < 2; ++hf) { const int col = hf * 512 + 8 * lane; float o[8];
#pragma unroll
        for (int q = 0; q < 2; ++q) { const f32x4 w = *(const f32x4*)(nw + col + 4 * q), sc = *(const f32x4*)(modrow_sc + col + 4 * q), sh = *(const f32x4*)(modrow_sh + col + 4 * q);
#pragma unroll
            for (int e = 0; e < 4; ++e) o[4 * q + e] = v[hf * 2 + q][e] * rstd * w[e] * (1.0f + sc[e]) + sh[e]; }
        u32x4 w4; w4.x = pk2(o[0], o[1]); w4.y = pk2(o[2], o[3]); w4.z = pk2(o[4], o[5]); w4.w = pk2(o[6], o[7]);
        *(u32x4*)(orow + col) = w4; }
}

template <int KS>
__device__ __forceinline__ f32x16 mma32(LAS const unsigned char* A, int lda, LAS const unsigned char* B, int ldb, f32x16 acc, int lane) {
    const int r = lane & 31, h = lane >> 5;
#pragma unroll
    for (int ks = 0; ks < KS; ++ks) {
        const bf16x8 a = *(const LAS bf16x8*)(A + r * lda + ks * 32 + h * 16);
        const bf16x8 b = *(const LAS bf16x8*)(B + r * ldb + ks * 32 + h * 16);
        acc = __builtin_amdgcn_mfma_f32_32x32x16_bf16(a, b, acc, 0, 0, 0);
    }
    return acc;
}
__device__ __forceinline__ int crow(int reg, int lane) { return (reg & 3) + 8 * (reg >> 2) + 4 * (lane >> 5); }

constexpr int MA_QD = 0, MA_KI = 7168, MA_KET = 14336, MA_VT = 23552, MA_SLOT = 37376;
__device__ __forceinline__ bf16x8 frag_from(unsigned a, unsigned b, unsigned c, unsigned d) { const u32x4 v = {a, b, c, d}; return __builtin_bit_cast(bf16x8, v); }
__device__ __forceinline__ void mixer_phase_a(const Params& P, LAS unsigned char* lds, int l, int round) {
    unsigned char* const wsp = opaque_ptr(P.ws);
    const int tid = opaque_tid(), w = __builtin_amdgcn_readfirstlane(tid >> 6), lane = tid & 63, r = lane & 31, hh = lane >> 5;
    const int slot = w >> 2, wv = w & 3, nt = wv & 1, mt = wv >> 1;
    const int item = 2 * round + slot, n = item & 63, h = (item >> 6) & 3, b = (item >> 8) & 7, type = item >> 11;
    LAS unsigned char* const L = lds + slot * MA_SLOT;
    const bf16_t* prow = (const bf16_t*)(wsp + WS_PROJ) + (size_t)(b * SEQ + n * 64) * NPROJP;
    const int cq = (type ? C_RQ : C_GQ) + h * 48, ck = (type ? C_RK : C_GK) + h * 48, cv = (type ? C_RV : C_GV) + h * 96;
    const int d = 32 * nt + r; const bool dvalid = d < 48;
    { const int t4 = wv * 64 + lane;
#pragma unroll
      for (int jj = 0; jj < 3; ++jj) { const int p = t4 + 256 * jj, j = p / 12, c = p % 12;
          const u32x4 vv = *(const u32x4*)(prow + (size_t)j * NPROJP + cv + 8 * c);
          LAS bf16_t* dst = (LAS bf16_t*)(L + MA_VT + (8 * c) * 144 + j * 2);
          dst[0 * 72] = (bf16_t)(vv.x & 0xffff); dst[1 * 72] = (bf16_t)(vv.x >> 16); dst[2 * 72] = (bf16_t)(vv.y & 0xffff); dst[3 * 72] = (bf16_t)(vv.y >> 16);
          dst[4 * 72] = (bf16_t)(vv.z & 0xffff); dst[5 * 72] = (bf16_t)(vv.z >> 16); dst[6 * 72] = (bf16_t)(vv.w & 0xffff); dst[7 * 72] = (bf16_t)(vv.w >> 16); } }
    float qv[16], kv[16], cum[16], tot;
    if (type == 0) {
#pragma unroll
        for (int reg = 0; reg < 16; ++reg) { const int t = 32 * mt + crow(reg, lane); const bf16_t* pr = prow + (size_t)t * NPROJP;
            qv[reg] = dvalid ? bf2f(pr[cq + d]) * 0.14433756729740643f : 0.f; kv[reg] = dvalid ? bf2f(pr[ck + d]) : 0.f; }
        const bf16_t* wat = (const bf16_t*)(wsp + WS_WA2T) + (size_t)((l * 4 + h) * 64 + d) * 16 + 8 * hh;
        const bf16x8 waf = *(const bf16x8*)wat;
        const float bias = dvalid ? P.gla_b_a[l * 192 + h * 48 + d] : 0.f;
        unsigned xh[2][2][4];
#pragma unroll
        for (int m2 = 0; m2 < 2; ++m2) {
            const bf16x8 gaf = *(const bf16x8*)(prow + (size_t)(32 * m2 + r) * NPROJP + C_GA + 8 * hh);
            f32x16 pre;
#pragma unroll
            for (int i = 0; i < 16; ++i) pre[i] = 0.f;
            pre = __builtin_amdgcn_mfma_f32_32x32x16_bf16(gaf, waf, pre, 0, 0, 0);
            float la[16];
#pragma unroll
            for (int reg = 0; reg < 16; ++reg) { const float x = pre[reg] + bias;
                const float ls2 = fminf(x, 0.f) * 1.4426950408889634f - __builtin_amdgcn_logf(1.0f + __builtin_amdgcn_exp2f(-1.4426950408889634f * fabsf(x)));
                la[reg] = dvalid ? ls2 * (1.0f / 16.0f) : 0.f; }
#pragma unroll
            for (int s2 = 0; s2 < 2; ++s2)
#pragma unroll
                for (int q = 0; q < 4; ++q) xh[m2][s2][q] = pk2(la[8 * s2 + 2 * q], la[8 * s2 + 2 * q + 1]);
        }
        f32x16 cacc, tacc;
#pragma unroll
        for (int i = 0; i < 16; ++i) { cacc[i] = 0.f; tacc[i] = 0.f; }
        const bf16x8 ones = frag_from(0x3F803F80u, 0x3F803F80u, 0x3F803F80u, 0x3F803F80u);
#pragma unroll
        for (int m2 = 0; m2 < 2; ++m2)
#pragma unroll
            for (int s2 = 0; s2 < 2; ++s2) {
                const bf16x8 fh = frag_from(xh[m2][s2][0], xh[m2][s2][1], xh[m2][s2][2], xh[m2][s2][3]);
                tacc = __builtin_amdgcn_mfma_f32_32x32x16_bf16(ones, fh, tacc, 0, 0, 0);
                if (m2 < mt) { cacc = __builtin_amdgcn_mfma_f32_32x32x16_bf16(ones, fh, cacc, 0, 0, 0); }
                else if (m2 == mt) { unsigned tw[4];
#pragma unroll
                    for (int q = 0; q < 4; ++q) { const int k0 = 16 * s2 + 8 * ((2 * q) >> 2) + 4 * hh + ((2 * q) & 3), k1 = 16 * s2 + 8 * ((2 * q + 1) >> 2) + 4 * hh + ((2 * q + 1) & 3);
                        tw[q] = (k0 <= r ? 0x3F80u : 0u) | (k1 <= r ? 0x3F800000u : 0u); }
                    const bf16x8 tri = frag_from(tw[0], tw[1], tw[2], tw[3]);
                    cacc = __builtin_amdgcn_mfma_f32_32x32x16_bf16(tri, fh, cacc, 0, 0, 0); }
            }
#pragma unroll
        for (int reg = 0; reg < 16; ++reg) cum[reg] = cacc[reg];
        tot = tacc[0];
    } else {
        const float lgam = P.log_gamma[h];
        const float* rope = (const float*)(wsp + WS_ROPE) + (size_t)(n * 64) * 48;
        const int dp = (d < 24) ? d + 24 : d - 24, f = (d < 24) ? d : d - 24;
#pragma unroll
        for (int reg = 0; reg < 16; ++reg) { const int t = 32 * mt + crow(reg, lane); const bf16_t* pr = prow + (size_t)t * NPROJP;
            float q0 = 0.f, q1 = 0.f, k0 = 0.f, k1 = 0.f, cs = 1.f, sn = 0.f;
            if (dvalid) { q0 = bf2f(pr[cq + d]); q1 = bf2f(pr[cq + dp]); k0 = bf2f(pr[ck + d]); k1 = bf2f(pr[ck + dp]); cs = rope[t * 48 + 2 * f]; sn = rope[t * 48 + 2 * f + 1]; }
            qv[reg] = (d < 24) ? (q0 * cs - q1 * sn) : (q1 * sn + q0 * cs);
            kv[reg] = ((d < 24) ? (k0 * cs - k1 * sn) : (k1 * sn + k0 * cs)) * 0.14433756729740643f;
            cum[reg] = (float)(t + 1) * lgam * 1.4426950408889634f; }
        tot = 64.0f * lgam * 1.4426950408889634f;
    }
    {
        bf16_t* qdg = (bf16_t*)(wsp + MXW_QD) + (size_t)item * 3072;
        float ke[16];
#pragma unroll
        for (int reg = 0; reg < 16; ++reg) { const int t = 32 * mt + crow(reg, lane);
            const float e1 = __builtin_amdgcn_exp2f(cum[reg]), e2 = __builtin_amdgcn_exp2f(-cum[reg]), e3 = __builtin_amdgcn_exp2f(tot - cum[reg]);
            const bf16_t qd = (bf16_t)f2bf(qv[reg] * e1), ki = (bf16_t)f2bf(kv[reg] * e2); ke[reg] = kv[reg] * e3;
            if (dvalid) { *(LAS bf16_t*)(L + MA_QD + t * 112 + d * 2) = qd; *(LAS bf16_t*)(L + MA_KI + t * 112 + d * 2) = ki; qdg[t * 48 + d] = qd; } }
#pragma unroll
        for (int g4 = 0; g4 < 4; ++g4) { const int t0 = 32 * mt + 8 * g4 + 4 * hh; u32x2 pk; pk.x = pk2(ke[4 * g4], ke[4 * g4 + 1]); pk.y = pk2(ke[4 * g4 + 2], ke[4 * g4 + 3]);
            *(LAS u32x2*)(L + MA_KET + d * 144 + t0 * 2) = pk; }
        if (mt == 0 && hh == 0 && dvalid) ((float*)(wsp + MXW_DEC))[(size_t)item * 48 + d] = __builtin_amdgcn_exp2f(tot);
    }
    __syncthreads();
    {
        unsigned* oig = (unsigned*)(wsp + MXW_OI) + (size_t)item * 3072;
        bf16_t* dsg = (bf16_t*)(wsp + MXW_DS) + (size_t)item * 4608;
        f32x16 zero16;
#pragma unroll
        for (int i = 0; i < 16; ++i) zero16[i] = 0.f;
        const int it = (wv == 0) ? 0 : 1;
        f32x16 sd = mma32<3>(L + MA_KI + it * 32 * 112, 112, L + MA_QD + it * 32 * 112, 112, zero16, lane);
        unsigned xd[2][4];
#pragma unroll
        for (int s2 = 0; s2 < 2; ++s2)
#pragma unroll
            for (int q = 0; q < 4; ++q) { const int r0 = 8 * s2 + 2 * q; const float a0 = (crow(r0, lane) <= r) ? sd[r0] : 0.f, a1 = (crow(r0 + 1, lane) <= r) ? sd[r0 + 1] : 0.f; xd[s2][q] = pk2(a0, a1); }
        unsigned xo[2][4];
        if (it == 1) { const f32x16 so = mma32<3>(L + MA_KI, 112, L + MA_QD + 32 * 112, 112, zero16, lane);
#pragma unroll
            for (int s2 = 0; s2 < 2; ++s2)
#pragma unroll
                for (int q = 0; q < 4; ++q) xo[s2][q] = pk2(so[8 * s2 + 2 * q], so[8 * s2 + 2 * q + 1]); }
        const int nvt = (wv == 0) ? 3 : 1, vt0 = (wv == 0) ? 0 : wv - 1;
#pragma unroll 1
        for (int vi = 0; vi < nvt; ++vi) { const int vt = vt0 + vi;
            f32x16 oacc = zero16;
            LAS const unsigned char* vb = L + MA_VT + (32 * vt + r) * 144 + 8 * hh;
            if (it == 1) {
#pragma unroll
                for (int s2 = 0; s2 < 2; ++s2) { const u32x2 lo = *(const LAS u32x2*)(vb + 32 * s2), hi = *(const LAS u32x2*)(vb + 32 * s2 + 16);
                    oacc = __builtin_amdgcn_mfma_f32_32x32x16_bf16(frag_from(xo[s2][0], xo[s2][1], xo[s2][2], xo[s2][3]), frag_from(lo.x, lo.y, hi.x, hi.y), oacc, 0, 0, 0); } }
#pragma unroll
            for (int s2 = 0; s2 < 2; ++s2) { const u32x2 lo = *(const LAS u32x2*)(vb + 64 * it + 32 * s2), hi = *(const LAS u32x2*)(vb + 64 * it + 32 * s2 + 16);
                oacc = __builtin_amdgcn_mfma_f32_32x32x16_bf16(frag_from(xd[s2][0], xd[s2][1], xd[s2][2], xd[s2][3]), frag_from(lo.x, lo.y, hi.x, hi.y), oacc, 0, 0, 0); }
#pragma unroll
            for (int q = 0; q < 8; ++q) oig[((it * 3 + vt) * 8 + q) * 64 + lane] = pk2(oacc[2 * q], oacc[2 * q + 1]);
            const int dt = (wv == 0) ? 1 : 0;
            const f32x16 ds = mma32<4>(L + MA_KET + dt * 32 * 144, 144, L + MA_VT + vt * 32 * 144, 144, zero16, lane);
#pragma unroll
            for (int g4 = 0; g4 < 4; ++g4) { const int d0 = 32 * dt + 8 * g4 + 4 * hh;
                if (d0 < 48) { u32x2 o; o.x = pk2(ds[4 * g4], ds[4 * g4 + 1]); o.y = pk2(ds[4 * g4 + 2], ds[4 * g4 + 3]); *(u32x2*)(dsg + (32 * vt + r) * 48 + d0) = o; } }
        }
    }
    __syncthreads();
}
__device__ __forceinline__ void mixer_phase_b(const Params& P, int bid, int G) {
    unsigned char* const wsp = opaque_ptr(P.ws);
    const int tid = opaque_tid();
    for (int task = bid * NTHREADS + tid; task < 64 * 1152; task += G * NTHREADS) {
        const int seq = task / 1152, q4 = task % 1152, d0 = (q4 % 12) * 4;
        const bf16_t* dsp = (const bf16_t*)(wsp + MXW_DS) + (size_t)seq * 64 * 4608 + q4 * 4;
        const float* dcp = (const float*)(wsp + MXW_DEC) + (size_t)seq * 64 * 48 + d0;
        bf16_t* spp = (bf16_t*)(wsp + MXW_SP) + (size_t)seq * 64 * 4608 + q4 * 4;
        u32x2 dsv[64];
#pragma unroll
        for (int n = 0; n < 64; ++n) dsv[n] = *(const u32x2*)(dsp + (size_t)n * 4608);
        f32x4 st = {0.f, 0.f, 0.f, 0.f};
#pragma unroll
        for (int n = 0; n < 64; ++n) { const f32x4 dc = *(const f32x4*)(dcp + n * 48);
            u32x2 pk; pk.x = pk2(st[0], st[1]); pk.y = pk2(st[2], st[3]); *(u32x2*)(spp + (size_t)n * 4608) = pk;
            st[0] = dc[0] * st[0] + bflo(dsv[n].x); st[1] = dc[1] * st[1] + bfhi(dsv[n].x); st[2] = dc[2] * st[2] + bflo(dsv[n].y); st[3] = dc[3] * st[3] + bfhi(dsv[n].y); }
    }
}
__device__ __forceinline__ void mixer_phase_c(const Params& P, LAS unsigned char* lds, int l, int item) {
    unsigned char* const wsp = opaque_ptr(P.ws);
    const int tid = opaque_tid(), w = __builtin_amdgcn_readfirstlane(tid >> 6), lane = tid & 63, r = lane & 31, hh = lane >> 5;
    LAS float* const Lw = (LAS float*)(lds + w * 12800);
    const int n = item & 63, h = (item >> 6) & 3, b = (item >> 8) & 7, type = item >> 11;
    const size_t tok0 = (size_t)b * SEQ + n * 64;
    const unsigned* oig = (const unsigned*)(wsp + MXW_OI) + (size_t)item * 3072;
    const bf16_t* qdg = (const bf16_t*)(wsp + MXW_QD) + (size_t)item * 3072 + 8 * hh;
    const bf16_t* spg = (const bf16_t*)(wsp + MXW_SP) + (size_t)item * 4608 + 8 * hh;
    const int rq = lane >> 2, q4 = lane & 3;
    const bf16_t* gp = (const bf16_t*)(wsp + WS_PROJ) + tok0 * NPROJP + (type ? C_RG : C_GG) + h * 96 + 24 * q4;
    bf16_t* mp = (bf16_t*)(wsp + WS_MIXED) + tok0 * 1024 + type * 384 + h * 96 + 24 * q4;
    const float* nw = (type ? P.ret_norm_w : P.gla_norm_w) + l * 384 + h * 96 + 24 * q4;
    f32x16 acc[2][3];
#pragma unroll
    for (int it = 0; it < 2; ++it)
#pragma unroll
        for (int vt = 0; vt < 3; ++vt)
#pragma unroll
            for (int q = 0; q < 8; ++q) { const unsigned u = oig[((it * 3 + vt) * 8 + q) * 64 + lane]; acc[it][vt][2 * q] = bflo(u); acc[it][vt][2 * q + 1] = bfhi(u); }
#pragma unroll
    for (int ks = 0; ks < 3; ++ks) {
        const bf16x8 a0 = *(const bf16x8*)(qdg + r * 48 + ks * 16), a1 = *(const bf16x8*)(qdg + (32 + r) * 48 + ks * 16);
#pragma unroll
        for (int vt = 0; vt < 3; ++vt) { const bf16x8 bb = *(const bf16x8*)(spg + (32 * vt + r) * 48 + ks * 16);
            acc[0][vt] = __builtin_amdgcn_mfma_f32_32x32x16_bf16(a0, bb, acc[0][vt], 0, 0, 0);
            acc[1][vt] = __builtin_amdgcn_mfma_f32_32x32x16_bf16(a1, bb, acc[1][vt], 0, 0, 0); } }
    f32x4 nwv[6];
#pragma unroll
    for (int q = 0; q < 6; ++q) nwv[q] = *(const f32x4*)(nw + 4 * q);
    u32x4 gall[4][3];
#pragma unroll
    for (int p4 = 0; p4 < 4; ++p4)
#pragma unroll
        for (int q = 0; q < 3; ++q) gall[p4][q] = *(const u32x4*)(gp + (size_t)(16 * p4 + rq) * NPROJP + 8 * q);
#pragma unroll
    for (int it = 0; it < 2; ++it) {
#pragma unroll
        for (int vt = 0; vt < 3; ++vt)
#pragma unroll
            for (int reg = 0; reg < 16; ++reg) Lw[crow(reg, lane) * 100 + 32 * vt + r] = acc[it][vt][reg];
        LDS_WAIT(); asm volatile("" ::: "memory");
#pragma unroll
        for (int ps = 0; ps < 2; ++ps) { const int rl = 16 * ps + rq, i = 32 * it + rl;
            f32x4 x[6]; u32x4 gw[3];
#pragma unroll
            for (int q = 0; q < 6; ++q) x[q] = *(const LAS f32x4*)(Lw + rl * 100 + 24 * q4 + 4 * q);
#pragma unroll
            for (int q = 0; q < 3; ++q) gw[q] = gall[it * 2 + ps][q];
            if (type == 1) { float sm = 0.f;
#pragma unroll
                for (int q = 0; q < 6; ++q) sm += (x[q][0] + x[q][1]) + (x[q][2] + x[q][3]);
                sm += lx_f(sm, lane, 1); sm += lx_f(sm, lane, 2);
                const float mean = sm * (1.0f / 96.0f);
#pragma unroll
                for (int q = 0; q < 6; ++q) x[q] = x[q] - mean; }
            float ss = 0.f;
#pragma unroll
            for (int q = 0; q < 6; ++q) ss += (x[q][0] * x[q][0] + x[q][1] * x[q][1]) + (x[q][2] * x[q][2] + x[q][3] * x[q][3]);
            ss += lx_f(ss, lane, 1); ss += lx_f(ss, lane, 2);
            const float rstd = 1.0f / sqrtf(ss * (1.0f / 96.0f) + NORM_EPS);
#pragma unroll
            for (int q = 0; q < 3; ++q) { const f32x4 xa = x[2 * q] * nwv[2 * q] * rstd, xb = x[2 * q + 1] * nwv[2 * q + 1] * rstd; const u32x4 g = gw[q];
                u32x4 o;
                o.x = pk2(xa[0] * siluf(bflo(g.x)), xa[1] * siluf(bfhi(g.x))); o.y = pk2(xa[2] * siluf(bflo(g.y)), xa[3] * siluf(bfhi(g.y)));
                o.z = pk2(xb[0] * siluf(bflo(g.z)), xb[1] * siluf(bfhi(g.z))); o.w = pk2(xb[2] * siluf(bflo(g.w)), xb[3] * siluf(bfhi(g.w)));
                *(u32x4*)(mp + (size_t)i * 1024 + 8 * q) = o; } }
        LDS_WAIT(); asm volatile("" ::: "memory");
    }
}

constexpr int S5_KT = 0, S5_U0 = 33280, S5_UB = 64 * 528, S5_EB = S5_U0 + 2 * S5_UB, S5_CY = S5_EB + 32768;
__device__ __forceinline__ float gelu_tanh(float x) { const float u = 0.7978845608028654f * (x + 0.044715f * x * x * x); const float e = __expf(2.0f * u); const float th = 1.0f - 2.0f / (e + 1.0f); return 0.5f * x * (1.0f + th); }
__device__ __forceinline__ void s5_item(const Params& P, LAS unsigned char* lds, int l, int item) {
    unsigned char* const wsp = opaque_ptr(P.ws);
    const int tid = opaque_tid(), w = __builtin_amdgcn_readfirstlane(tid >> 6), lane = tid & 63, r = lane & 31, hh = lane >> 5;
    const int half = item & 1, b = item >> 5, g = (item >> 1) & 15, lg = l * 16 + g;
    const bf16_t* ub = (const bf16_t*)(wsp + WS_SU2) + (size_t)(b * 16 + g) * 4096 * 16 + 8 * hh;
    const bf16_t* ktg = (const bf16_t*)(wsp + WS_KTAB) + (size_t)lg * 65 * 256;
    const bf16_t* bpw = (const bf16_t*)(wsp + WS_BPOW) + (size_t)lg * 128 * 1024 + (size_t)((w & 3) * 32 + r) * 1024 + 8 * hh;
    const bf16_t* cpw = (const bf16_t*)(wsp + WS_CPOW) + (size_t)lg * 1024 * 128;
    { int rp = (TIME_PHASE == 44) ? 3 : 1; asm volatile("" : "+s"(rp));
#pragma unroll 1
      for (int q_ = 0; q_ < rp; ++q_) { for (int p = tid; p < 2080; p += NTHREADS) *(LAS u32x4*)(lds + S5_KT + p * 16) = *(const u32x4*)(ktg + p * 8);
    __syncthreads(); } }
    f32x16 acc[2][2], eacc;
    const int nt0 = half ? (w + 8) : w, nt1 = half ? (w + 16) : (w + 24);
#pragma unroll
    for (int j = 0; j < 2; ++j)
#pragma unroll
        for (int mt = 0; mt < 2; ++mt)
#pragma unroll
            for (int i = 0; i < 16; ++i) acc[j][mt][i] = 0.f;
#pragma unroll
    for (int i = 0; i < 16; ++i) eacc[i] = 0.f;
    const int emt = w >> 2;
    const bf16_t* ug = (const bf16_t*)(wsp + WS_SU2) + (size_t)(b * 16 + g) * 4096 * 16;
    u32x4 pfu[4];
#define S5_GLOAD(gi) do { _Pragma("unroll") for (int j_ = 0; j_ < 4; ++j_) { const int p_ = tid + NTHREADS * j_; pfu[j_] = *(const u32x4*)(ug + (size_t)((p_ >> 5) * 64 + 16 * (gi)) * 16 + (p_ & 31) * 8); } } while (0)
#define S5_GWRITE(bufoff) do { _Pragma("unroll") for (int j_ = 0; j_ < 4; ++j_) { const int p_ = tid + NTHREADS * j_; *(LAS u32x4*)(lds + (bufoff) + (p_ >> 5) * 528 + (p_ & 31) * 16) = pfu[j_]; } } while (0)
#define S5_STEP(A0, A1, BP, s) do { \
        _Pragma("unroll") for (int j = 0; j < 2; ++j) { const int t0 = 2 * (j ? nt1 : nt0); \
            if (t0 + 1 >= (s)) { const int tt = t0 + (r >> 4); const int tau = tt - (s); const int slot = tau < 0 ? 64 : tau; \
                const bf16x8 kb = *(const LAS bf16x8*)(lds + S5_KT + slot * 512 + (lane & 15) * 32 + hh * 16); \
                acc[j][0] = __builtin_amdgcn_mfma_f32_32x32x16_bf16(A0, kb, acc[j][0], 0, 0, 0); \
                acc[j][1] = __builtin_amdgcn_mfma_f32_32x32x16_bf16(A1, kb, acc[j][1], 0, 0, 0); } } \
        eacc = __builtin_amdgcn_mfma_f32_32x32x16_bf16(emt ? A1 : A0, BP, eacc, 0, 0, 0); } while (0)
    S5_GLOAD(0); S5_GWRITE(S5_U0);
    __syncthreads();
#pragma unroll 1
    for (int gi = 0; gi < 4; ++gi) {
        if (gi < 3) S5_GLOAD(gi + 1);
        LAS const unsigned char* ubuf = lds + S5_U0 + (gi & 1) * S5_UB + r * 528 + hh * 16;
        bf16x8 rbp[4];
#pragma unroll
        for (int u = 0; u < 4; ++u) rbp[u] = *(const bf16x8*)(bpw + (16 * gi + u) * 16);
#pragma unroll
        for (int q4 = 0; q4 < 4; ++q4) {
#pragma unroll
            for (int u = 0; u < 4; ++u) { const int sl = 4 * q4 + u, s = 16 * gi + sl;
                const bf16x8 a0 = *(const LAS bf16x8*)(ubuf + sl * 32), a1 = *(const LAS bf16x8*)(ubuf + 32 * 528 + sl * 32);
                S5_STEP(a0, a1, rbp[u], s);
                if (q4 < 3) rbp[u] = *(const bf16x8*)(bpw + (s + 4) * 16); }
        }
        if (gi < 3) { S5_GWRITE(S5_U0 + ((gi + 1) & 1) * S5_UB); __syncthreads(); }
    }
#undef S5_GLOAD
#undef S5_GWRITE
#undef S5_STEP
#pragma unroll
    for (int reg = 0; reg < 16; ++reg) ((LAS float*)(lds + S5_EB))[(emt * 32 + crow(reg, lane)) * 128 + (w & 3) * 32 + r] = eacc[reg];
    __syncthreads();
    { int rp = (TIME_PHASE == 42) ? 3 : 1; asm volatile("" : "+s"(rp));
#pragma unroll 1
    for (int q_ = 0; q_ < rp; ++q_)
    if (tid < 64) { const int p = tid; const float* l64 = (const float*)(wsp + WS_LAM64) + (size_t)(lg * 64 + p) * 2; const float ar = l64[0], ai = l64[1];
        float cr = 0.f, ci = 0.f;
#pragma unroll 1
        for (int n = 0; n < 64; ++n) {
            *(LAS bf16_t*)(lds + S5_CY + n * 272 + p * 2) = (bf16_t)f2bf(cr); *(LAS bf16_t*)(lds + S5_CY + n * 272 + (64 + p) * 2) = (bf16_t)f2bf(ci);
            const float er = ((const LAS float*)(lds + S5_EB))[n * 128 + p], ei = ((const LAS float*)(lds + S5_EB))[n * 128 + 64 + p];
            const float nr = ar * cr - ai * ci + er, ni = ar * ci + ai * cr + ei; cr = nr; ci = ni; } } }
    __syncthreads();
#pragma unroll
    for (int j = 0; j < 2; ++j) { const bf16_t* cpr = cpw + (size_t)((j ? nt1 : nt0) * 32 + r) * 128 + 8 * hh;
#pragma unroll
        for (int ks = 0; ks < 8; ++ks) { const bf16x8 cb = *(const bf16x8*)(cpr + ks * 16);
            const bf16x8 c0 = *(const LAS bf16x8*)(lds + S5_CY + r * 272 + ks * 32 + hh * 16), c1 = *(const LAS bf16x8*)(lds + S5_CY + (32 + r) * 272 + ks * 32 + hh * 16);
            acc[j][0] = __builtin_amdgcn_mfma_f32_32x32x16_bf16(c0, cb, acc[j][0], 0, 0, 0);
            acc[j][1] = __builtin_amdgcn_mfma_f32_32x32x16_bf16(c1, cb, acc[j][1], 0, 0, 0); } }
    bf16_t* yb = (bf16_t*)(wsp + WS_YBUF) + (size_t)b * SEQ * 256 + g * 16 + (lane & 15);
    int rpe = (TIME_PHASE == 43) ? 3 : 1; asm volatile("" : "+s"(rpe));
#pragma unroll 1
    for (int q_ = 0; q_ < rpe; ++q_)
#pragma unroll
    for (int j = 0; j < 2; ++j) { const int tt = 2 * (j ? nt1 : nt0) + (r >> 4);
#pragma unroll
        for (int mt = 0; mt < 2; ++mt)
#pragma unroll
            for (int reg = 0; reg < 16; ++reg) { const int n = mt * 32 + crow(reg, lane);
                yb[(size_t)(n * 64 + tt) * 256] = (bf16_t)f2bf(gelu_tanh(acc[j][mt][reg])); } }
    __syncthreads();
}

constexpr int RT_SC = 0, RT_SH = 4096, RT_RS = 8192, RT_PART = 8704, RT_CNT = 8704 + 2 * 128 * 33 * 4, RT_BASE = RT_CNT + 128, RT_TE = RT_BASE + 128, RT_TG = RT_TE + 2048, RT_TR = RT_TG + 2048;
__device__ __forceinline__ void router_phase(const Params& P, LAS unsigned char* lds, int l, int blk) {
    unsigned char* const wsp = opaque_ptr(P.ws);
    const int tid = opaque_tid(), w = __builtin_amdgcn_readfirstlane(tid >> 6), lane = tid & 63, r = lane & 31, hh = lane >> 5;
    const float* x = (const float*)(wsp + WS_X);
    bf16_t* hdn = (bf16_t*)(wsp + WS_HDN);
    const int tok0 = blk * 128, b = tok0 >> 12;
    const float* mrow = (const float*)(wsp + WS_MOD) + (size_t)(l * 8 + b) * 6144;
    int* gcount = (int*)(wsp + WS_CTL) + l * 32;
    int* stok = (int*)(wsp + WS_STOK); float* sgate = (float*)(wsp + WS_SGATE);
    LAS float* scL = (LAS float*)(lds + RT_SC); LAS float* shL = (LAS float*)(lds + RT_SH); LAS float* rsL = (LAS float*)(lds + RT_RS);
    for (int i = tid; i < 1024; i += NTHREADS) { scL[i] = P.norm2_w[l * 1024 + i] * (1.0f + mrow[4096 + i]); shL[i] = mrow[3072 + i]; }
    if (tid < 32) ((LAS int*)(lds + RT_CNT))[tid] = 0;
    __syncthreads();
    {
        f32x4 sc[4], sh[4];
#pragma unroll
        for (int j = 0; j < 4; ++j) { sc[j] = *(const LAS f32x4*)(scL + 4 * lane + 256 * j); sh[j] = *(const LAS f32x4*)(shL + 4 * lane + 256 * j); }
#pragma unroll 1
        for (int t4 = 0; t4 < 16; t4 += 4) {
            f32x4 v[4][4]; float ss[4];
#pragma unroll
            for (int u = 0; u < 4; ++u) { const size_t tok = (size_t)(tok0 + w * 16 + t4 + u);
#pragma unroll
                for (int j = 0; j < 4; ++j) v[u][j] = *(const f32x4*)(x + tok * 1024 + 4 * lane + 256 * j); }
#pragma unroll
            for (int u = 0; u < 4; ++u) { float a_ = 0.f;
#pragma unroll
                for (int j = 0; j < 4; ++j) a_ += (v[u][j][0] * v[u][j][0] + v[u][j][1] * v[u][j][1]) + (v[u][j][2] * v[u][j][2] + v[u][j][3] * v[u][j][3]);
                ss[u] = a_; }
#pragma unroll
            for (int o = 1; o < 64; o <<= 1) {
#pragma unroll
                for (int u = 0; u < 4; ++u) ss[u] += lx_f(ss[u], lane, o); }
#pragma unroll
            for (int u = 0; u < 4; ++u) { const int tl = w * 16 + t4 + u; const size_t tok = (size_t)(tok0 + tl);
                const float rstd = 1.0f / sqrtf(ss[u] * (1.0f / 1024.0f) + NORM_EPS);
                if (lane == 0) rsL[tl] = rstd;
#pragma unroll
                for (int j = 0; j < 4; ++j) { const f32x4 hv = v[u][j] * rstd * sc[j] + sh[j]; u32x2 pk; pk.x = pk2(hv[0], hv[1]); pk.y = pk2(hv[2], hv[3]);
                    *(u32x2*)(hdn + tok * 1024 + 4 * lane + 256 * j) = pk; } } }
    }
    __syncthreads();
    {
        const int mt = w & 3, kh = w >> 2;
        const float* xr = x + (size_t)(tok0 + 32 * mt + r) * 1024 + 512 * kh + 8 * hh;
        const bf16_t* wt = (const bf16_t*)(wsp + WS_RWT) + (size_t)l * 2 * 32 * 1024 + (size_t)r * 1024 + 512 * kh + 8 * hh;
        const float rs = rsL[32 * mt + r];
        f32x16 acc;
#pragma unroll
        for (int i = 0; i < 16; ++i) acc[i] = 0.f;
#pragma unroll 8
        for (int ks = 0; ks < 32; ++ks) {
            const f32x4 x0 = *(const f32x4*)(xr + 16 * ks), x1 = *(const f32x4*)(xr + 16 * ks + 4);
            const int kk = 512 * kh + 16 * ks + 8 * hh;
            const f32x4 c0 = *(const LAS f32x4*)(scL + kk), c1 = *(const LAS f32x4*)(scL + kk + 4), s0 = *(const LAS f32x4*)(shL + kk), s1 = *(const LAS f32x4*)(shL + kk + 4);
            const f32x4 h0 = x0 * rs * c0 + s0, h1 = x1 * rs * c1 + s1;
            unsigned ah[4], al[4];
            ah[0] = pk2(h0[0], h0[1]); ah[1] = pk2(h0[2], h0[3]); ah[2] = pk2(h1[0], h1[1]); ah[3] = pk2(h1[2], h1[3]);
            al[0] = pk2(h0[0] - bflo(ah[0]), h0[1] - bfhi(ah[0])); al[1] = pk2(h0[2] - bflo(ah[1]), h0[3] - bfhi(ah[1]));
            al[2] = pk2(h1[0] - bflo(ah[2]), h1[1] - bfhi(ah[2])); al[3] = pk2(h1[2] - bflo(ah[3]), h1[3] - bfhi(ah[3]));
            const bf16x8 bh = *(const bf16x8*)(wt + 16 * ks), bl = *(const bf16x8*)(wt + 32 * 1024 + 16 * ks);
            const bf16x8 fah = frag_from(ah[0], ah[1], ah[2], ah[3]), fal = frag_from(al[0], al[1], al[2], al[3]);
            acc = __builtin_amdgcn_mfma_f32_32x32x16_bf16(fah, bh, acc, 0, 0, 0);
            acc = __builtin_amdgcn_mfma_f32_32x32x16_bf16(fah, bl, acc, 0, 0, 0);
            acc = __builtin_amdgcn_mfma_f32_32x32x16_bf16(fal, bh, acc, 0, 0, 0);
        }
        LAS float* part = (LAS float*)(lds + RT_PART) + kh * 128 * 33;
#pragma unroll
        for (int reg = 0; reg < 16; ++reg) part[(32 * mt + crow(reg, lane)) * 33 + r] = acc[reg];
    }
    __syncthreads();
    if (tid < 128) {
        const LAS float* p0 = (const LAS float*)(lds + RT_PART) + tid * 33; const LAS float* p1 = p0 + 128 * 33;
        float v0 = -3.0e38f, v1 = -3.0e38f, v2 = -3.0e38f, v3 = -3.0e38f; int e0 = 0, e1 = 0, e2 = 0, e3 = 0;
#pragma unroll
        for (int e = 0; e < 32; ++e) { const float lg = p0[e] + p1[e] + P.router_b[l * 32 + e];
            if (lg > v3) { if (lg > v2) { v3 = v2; e3 = e2; if (lg > v1) { v2 = v1; e2 = e1; if (lg > v0) { v1 = v0; e1 = e0; v0 = lg; e0 = e; } else { v1 = lg; e1 = e; } } else { v2 = lg; e2 = e; } } else { v3 = lg; e3 = e; } } }
        const float x1 = __expf(v1 - v0), x2 = __expf(v2 - v0), x3 = __expf(v3 - v0), inv = 1.0f / (1.0f + x1 + x2 + x3);
        LAS int* cnt = (LAS int*)(lds + RT_CNT);
        LAS int* te = (LAS int*)(lds + RT_TE) + tid * 4; LAS float* tg = (LAS float*)(lds + RT_TG) + tid * 4; LAS int* tr = (LAS int*)(lds + RT_TR) + tid * 4;
        te[0] = e0; te[1] = e1; te[2] = e2; te[3] = e3; tg[0] = inv; tg[1] = x1 * inv; tg[2] = x2 * inv; tg[3] = x3 * inv;
        tr[0] = __hip_atomic_fetch_add(cnt + e0, 1, __ATOMIC_RELAXED, __HIP_MEMORY_SCOPE_WORKGROUP); tr[1] = __hip_atomic_fetch_add(cnt + e1, 1, __ATOMIC_RELAXED, __HIP_MEMORY_SCOPE_WORKGROUP);
        tr[2] = __hip_atomic_fetch_add(cnt + e2, 1, __ATOMIC_RELAXED, __HIP_MEMORY_SCOPE_WORKGROUP); tr[3] = __hip_atomic_fetch_add(cnt + e3, 1, __ATOMIC_RELAXED, __HIP_MEMORY_SCOPE_WORKGROUP);
    }
    __syncthreads();
    if (tid < 32) ((LAS int*)(lds + RT_BASE))[tid] = atomicAdd(gcount + tid, ((LAS int*)(lds + RT_CNT))[tid]);
    __syncthreads();
    { const int e = ((LAS int*)(lds + RT_TE))[tid]; const int pos = ((LAS int*)(lds + RT_BASE))[e] + ((LAS int*)(lds + RT_TR))[tid];
      stok[e * CAP + pos] = (tok0 + (tid >> 2)) * 4 + (tid & 3); sgate[e * CAP + pos] = ((LAS float*)(lds + RT_TG))[tid]; }
    __syncthreads();
}

__device__ __forceinline__ void combine_phase(const Params& P, int l, int gw, int ngw, int lane_in) {
    unsigned char* const wsp = opaque_ptr(P.ws);
    int lane = lane_in; asm volatile("" : "+v"(lane));
    float* x = (float*)(wsp + WS_X);
    const bf16_t* outr = (const bf16_t*)(wsp + WS_OUTR);
    bf16_t* hdn = (bf16_t*)(wsp + WS_HDN);
    for (int tokp = gw; tokp < T_TOK / 2; tokp += ngw) {
        u32x4 rr[2][2][4]; f32x4 xv[2][4];
#pragma unroll
        for (int u = 0; u < 2; ++u) { const size_t tok = (size_t)(2 * tokp + u);
#pragma unroll
            for (int hf = 0; hf < 2; ++hf) { const int col = hf * 512 + 8 * lane;
#pragma unroll
                for (int k = 0; k < 4; ++k) rr[u][hf][k] = *(const u32x4*)(outr + (tok * 4 + k) * 1024 + col);
                xv[u][hf * 2] = *(const f32x4*)(x + tok * 1024 + col); xv[u][hf * 2 + 1] = *(const f32x4*)(x + tok * 1024 + col + 4); } }
#pragma unroll
        for (int u = 0; u < 2; ++u) { const int tok = 2 * tokp + u; const int b = tok >> 12;
            const float* mrow = (const float*)(wsp + WS_MOD) + (size_t)(l * 8 + b) * 6144;
            f32x4 v[4];
#pragma unroll
            for (int hf = 0; hf < 2; ++hf) { const int col = hf * 512 + 8 * lane;
                float s[8];
#pragma unroll
                for (int e = 0; e < 8; ++e) s[e] = 0.f;
#pragma unroll
                for (int k = 0; k < 4; ++k) { const u32x4 r4 = rr[u][hf][k];
                    s[0] += bflo(r4.x); s[1] += bfhi(r4.x); s[2] += bflo(r4.y); s[3] += bfhi(r4.y); s[4] += bflo(r4.z); s[5] += bfhi(r4.z); s[6] += bflo(r4.w); s[7] += bfhi(r4.w); }
#pragma unroll
                for (int q = 0; q < 2; ++q) { const f32x4 x4 = xv[u][hf * 2 + q], g2 = *(const f32x4*)(mrow + 5120 + col + 4 * q);
                    f32x4 o; o[0] = x4[0] + g2[0] * s[4 * q]; o[1] = x4[1] + g2[1] * s[4 * q + 1]; o[2] = x4[2] + g2[2] * s[4 * q + 2]; o[3] = x4[3] + g2[3] * s[4 * q + 3];
                    v[hf * 2 + q] = o; if (l + 1 < NLAYER) *(f32x4*)(x + (size_t)tok * 1024 + col + 4 * q) = o; } }
            if (l + 1 < NLAYER) {
                const float* mnext = (const float*)(wsp + WS_MOD) + (size_t)((l + 1) * 8 + b) * 6144;
                norm_row_store(v, P.norm1_w + (l + 1) * 1024, mnext, mnext + 1024, hdn + (size_t)tok * 1024, lane);
            } else {
                float ss = 0.f;
#pragma unroll
                for (int j = 0; j < 4; ++j) ss += (v[j][0] * v[j][0] + v[j][1] * v[j][1]) + (v[j][2] * v[j][2] + v[j][3] * v[j][3]);
                const float rstd = 1.0f / sqrtf(wave_sum(ss, lane) * (1.0f / 1024.0f) + NORM_EPS);
#pragma unroll
                for (int hf = 0; hf < 2; ++hf)
#pragma unroll
                    for (int q = 0; q < 2; ++q) { const int col = hf * 512 + 8 * lane + 4 * q; const f32x4 fw = *(const f32x4*)(P.final_norm_w + col);
                        f32x4 o; o[0] = v[hf * 2 + q][0] * rstd * fw[0]; o[1] = v[hf * 2 + q][1] * rstd * fw[1]; o[2] = v[hf * 2 + q][2] * rstd * fw[2]; o[3] = v[hf * 2 + q][3] * rstd * fw[3];
                        *(f32x4*)(P.out + (size_t)tok * 1024 + col) = o; }
            }
        }
    }
}

#define XB_TMO      128
#define XB_XCNT(j)  (256  + 64 * (j))
#define XB_XSUB(j)  (1280 + 64 * (j))
#define XB_XGEN(j)  (2304 + 64 * (j))
#define XB_TOP      3328
#define XB_TOPGEN   3392
#define XCD_BAR_WORDS 3456
#define XB_SPIN_CAP (1u << 22)
__device__ __forceinline__ unsigned xb_ld(unsigned* p)              { return __hip_atomic_load(p, __ATOMIC_RELAXED, __HIP_MEMORY_SCOPE_AGENT); }
__device__ __forceinline__ unsigned xb_add(unsigned* p, unsigned v) { return __hip_atomic_fetch_add(p, v, __ATOMIC_RELAXED, __HIP_MEMORY_SCOPE_AGENT); }
__device__ __forceinline__ unsigned xb_xcc_id() { return (unsigned)__builtin_amdgcn_s_getreg((3 << 11) | 20) & 0xFu; }
#define XB_SPIN(cond, bar) do { unsigned _sp = 0; while (cond) { __builtin_amdgcn_s_sleep(1); \
    if ((++_sp & 255u) == 0u) { if (xb_ld(&(bar)[XB_TMO])) break; if (_sp > XB_SPIN_CAP) { atomicAdd(&(bar)[XB_TMO], 1u); break; } } } } while (0)
struct XcdBarrier { unsigned* bar; unsigned x; volatile LAS unsigned* st; };
__device__ __forceinline__ XcdBarrier xcd_barrier_post(unsigned* bar, volatile LAS unsigned* st) {
    XcdBarrier b; b.bar = bar; b.x = xb_xcc_id(); b.st = st;
    if (threadIdx.x == 0) (void)xb_add(&bar[XB_XCNT(b.x)], 1u);
    return b;
}
__device__ __forceinline__ void xcd_barrier_complete(unsigned* bar, unsigned x, unsigned& nloc, unsigned& nx) {
    const unsigned G = gridDim.x * gridDim.y * gridDim.z;
    unsigned sum, cnt, mine, sp = 0u;
    for (;;) {
        sum = 0u; cnt = 0u; mine = 0u;
#pragma unroll
        for (unsigned j = 0; j < 16; ++j) { const unsigned c = xb_ld(&bar[XB_XCNT(j)]); sum += c; cnt += (c > 0u) ? 1u : 0u; mine = (j == x) ? c : mine; }
        if (sum == G) break;
        __builtin_amdgcn_s_sleep(1);
        if ((++sp & 255u) == 0u) { if (xb_ld(&bar[XB_TMO])) break; if (sp > XB_SPIN_CAP) { atomicAdd(&bar[XB_TMO], 1u); break; } }
    }
    nloc = mine > 0u ? mine : 1u; nx = cnt > 0u ? cnt : 1u;
}
__device__ __forceinline__ void xcd_barrier(const XcdBarrier& b) {
    asm volatile("s_waitcnt vmcnt(0)" ::: "memory");
    __syncthreads();
    if (threadIdx.x == 0) {
        unsigned* bar = b.bar;
        __builtin_amdgcn_s_waitcnt(0);
        unsigned nloc = b.st[0], nx = b.st[1];
        if (nloc == 0u) { xcd_barrier_complete(bar, b.x, nloc, nx); b.st[0] = nloc; b.st[1] = nx; }
        const unsigned old = xb_add(&bar[XB_XSUB(b.x)], 1u);
        const unsigned gen = old / nloc;
        if (old + 1u == (gen + 1u) * nloc) {
            __builtin_amdgcn_fence(__ATOMIC_RELEASE, "agent");
            asm volatile("s_waitcnt vmcnt(0)" ::: "memory");
            const unsigned og = xb_add(&bar[XB_TOP], 1u);
            const unsigned tg = og / nx;
            if (og + 1u == (tg + 1u) * nx) xb_add(&bar[XB_TOPGEN], 1u);
            else XB_SPIN(xb_ld(&bar[XB_TOPGEN]) == tg, bar);
            __builtin_amdgcn_fence(__ATOMIC_ACQUIRE, "agent");
            xb_add(&bar[XB_XGEN(b.x)], 1u);
            asm volatile("s_waitcnt vmcnt(0)" ::: "memory");
        } else {
            XB_SPIN(xb_ld(&bar[XB_XGEN(b.x)]) == gen, bar);
            __builtin_amdgcn_fence(__ATOMIC_ACQUIRE, "agent");
            asm volatile("s_waitcnt vmcnt(0)" ::: "memory");
        }
    }
    __syncthreads();
}

#ifndef PH
#define PH 0xFFFF
#endif
#define PHON(b) ((((PH) >> (b)) & 1) != 0)
#define TIME_MULT 4
#if TIME_PHASE >= 0
#define PH_T0(k) do { if ((k) == TIME_PHASE && bid == 0) t_ph = __builtin_amdgcn_s_memrealtime(); } while (0)
#define PH_T1(k) do { if ((k) == TIME_PHASE && bid == 0) { const unsigned long long t1_ = __builtin_amdgcn_s_memrealtime(), d_ = t1_ - t_ph; while (__builtin_amdgcn_s_memrealtime() - t1_ < (unsigned long long)TIME_MULT * d_) __builtin_amdgcn_s_sleep(8); } } while (0)
#else
#define PH_T0(k) do { } while (0)
#define PH_T1(k) do { } while (0)
#endif
__global__ void __launch_bounds__(NTHREADS, 2) fwd_megakernel(Params P) {
    extern __shared__ __attribute__((aligned(16))) unsigned char lds_raw[];
    LAS unsigned char* const lds0 = (LAS unsigned char*)lds_raw;
    cg::grid_group grid = cg::this_grid();
    const int G = gridDim.x, bid = blockIdx.x;
    const int vcu = (G % 8 == 0) ? (bid % 8) * (G / 8) + bid / 8 : bid;
    const int ngw = G * NWAVES;
    unsigned long long t_ph = 0; (void)t_ph;
    const unsigned long long t_entry = (TIME_PHASE == 99) ? __builtin_amdgcn_s_memrealtime() : 0ull; (void)t_entry;
    if (threadIdx.x < 4) ((LAS unsigned*)(lds0 + LDS_BYTES - 16))[threadIdx.x] = 0u;
    __syncthreads();
    (void)xcd_barrier_post((unsigned*)(P.ws + WS_BAR), (volatile LAS unsigned*)(lds0 + LDS_BYTES - 16));
#define GSYNC() do { XcdBarrier xb_; xb_.bar = (unsigned*)(opaque_ptr(P.ws) + WS_BAR); xb_.x = xb_xcc_id(); xb_.st = (volatile LAS unsigned*)(opaque_lds(lds0) + LDS_BYTES - 16); xcd_barrier(xb_); } while (0)
#define KTID() const int tid = opaque_tid(), wave = __builtin_amdgcn_readfirstlane(tid >> 6), lane = tid & 63, gw = bid * NWAVES + wave; (void)lane; (void)gw

    PH_T0(0);
    { KTID(); unsigned char* const ws = opaque_ptr(P.ws); LAS unsigned char* const lds = opaque_lds(lds0); (void)lds;
    if (bid == 0 && tid < 64) ((int*)(ws + WS_CTL))[tid] = 0;
    if (PHON(0)) for (int it = bid; it < 128 + 192; it += G) { if (it < 128) s5_tables_item(P, lds, it); else mod_item(P, lds, it - 128); }
    rope_table(P, bid * NTHREADS + tid, G * NTHREADS);
    for (int i = bid * NTHREADS + tid; i < 2 * 32 * 1024; i += G * NTHREADS) { const int k_ = i & 1023, e_ = (i >> 10) & 31, l_ = i >> 15; const float wv_ = P.router_w[(size_t)l_ * 1024 * 32 + k_ * 32 + e_];
        const unsigned hw_ = f2bf(wv_); bf16_t* rt_ = (bf16_t*)(ws + WS_RWT) + (size_t)l_ * 2 * 32 * 1024 + e_ * 1024 + k_; rt_[0] = (bf16_t)hw_; rt_[32 * 1024] = (bf16_t)f2bf(wv_ - __builtin_bit_cast(float, hw_ << 16)); }
    for (int i = bid * NTHREADS + tid; i < 2 * 4 * 64 * 16; i += G * NTHREADS) { const int rr = i & 15, dd = (i >> 4) & 63, hh_ = (i >> 10) & 3, ll = i >> 12;
        ((bf16_t*)(ws + WS_WA2T))[i] = (dd < 48) ? (bf16_t)f2bf(P.gla_w_a2[(size_t)ll * 16 * 192 + rr * 192 + hh_ * 48 + dd]) : (bf16_t)0; }
    __syncthreads();
    if (PHON(1)) transpose_small(P, lds, gw, ngw, wave, lane);
    if (bid >= 64) { __syncthreads(); transpose_moe_pool(P, lds, 0, TM_Q_P0); } }
    if (P.ws == nullptr) grid.sync();
    GSYNC(); PH_T1(0); PH_T0(1);
    { KTID(); unsigned char* const ws = opaque_ptr(P.ws); LAS unsigned char* const lds = opaque_lds(lds0); (void)lds;
    for (int tokp = gw; tokp < T_TOK / 2; tokp += ngw) {
        f32x4 v[2][4];
#pragma unroll
        for (int u = 0; u < 2; ++u)
#pragma unroll
            for (int hf = 0; hf < 2; ++hf)
#pragma unroll
                for (int q = 0; q < 2; ++q) v[u][hf * 2 + q] = *(const f32x4*)(P.x + (size_t)(2 * tokp + u) * 1024 + hf * 512 + 8 * lane + 4 * q);
#pragma unroll
        for (int u = 0; u < 2; ++u) { const int tok = 2 * tokp + u; const float* mrow = (const float*)(ws + WS_MOD) + (size_t)(tok >> 12) * 6144;
            norm_row_store(v[u], P.norm1_w, mrow, mrow + 1024, (bf16_t*)(ws + WS_HDN) + (size_t)tok * 1024, lane); }
    } }
    GSYNC(); PH_T1(1);
#pragma unroll 1
    for (int l = 0; l < NLAYER; ++l) {
        PH_T0(2);
        constexpr int G_IN = 240;
        if (bid >= G_IN) { LAS unsigned char* const lds = opaque_lds(lds0); transpose_moe_pool(P, lds, l, (l == 0 ? TM_Q_P0 : TM_Q_DN) + TM_Q_IN); }
        else if (PHON(2)) { unsigned char* const ws = opaque_ptr(P.ws); LAS unsigned char* const lds = opaque_lds(lds0); (void)lds; DenseOrder S; S.init(T_TOK, NPROJP, 1024, G_IN, bid, ws + WS_HDN, (const bf16_t*)(ws + WS_WIN) + (size_t)l * NPROJP * 1024);
          EpiProj E{(bf16_t*)(ws + WS_PROJ), NPROJP, (bf16_t*)(ws + WS_SU2)};
          gm::gemm_phase<EpiProj, DenseOrder, false>(lds, 1024, S, E); }
        GSYNC(); PH_T1(2); PH_T0(3);
        { LAS unsigned char* const lds = opaque_lds(lds0);
#define SUBT0(k, b) do { if (TIME_PHASE == (k) && bid == (b)) t_ph = __builtin_amdgcn_s_memrealtime(); } while (0)
#define SUBT1(k, b) do { if (TIME_PHASE == (k) && bid == (b)) { const unsigned long long t1_ = __builtin_amdgcn_s_memrealtime(), d_ = t1_ - t_ph; while (__builtin_amdgcn_s_memrealtime() - t1_ < (unsigned long long)TIME_MULT * d_) __builtin_amdgcn_s_sleep(8); } } while (0)
          SUBT0(20, 0);
          { int rpa = (TIME_PHASE == 46) ? 2 : 1; asm volatile("" : "+s"(rpa));
#pragma unroll 1
            for (int q_ = 0; q_ < rpa; ++q_)
          if (PHON(3)) for (int rd = bid; rd < 2048; rd += G) mixer_phase_a(P, lds, l, rd); }
          SUBT1(20, 0); SUBT0(21, 0);
          { int rps = (TIME_PHASE == 45) ? 2 : 1; asm volatile("" : "+s"(rps));
#pragma unroll 1
            for (int q_ = 0; q_ < rps; ++q_)
          if (PHON(4)) for (int it = bid; it < 256; it += G) s5_item(P, lds, l, it); }
          SUBT1(21, 0); SUBT0(22, 0);
          { KTID(); transpose_moe_rest(P, lds, l, gw, ngw); }
          SUBT1(22, 0); SUBT0(47, 0); SUBT0(48, 101); SUBT0(49, 202); }
        GSYNC(); PH_T1(3); SUBT1(47, 0); SUBT1(48, 101); SUBT1(49, 202); PH_T0(4);
        if (PHON(5) && bid >= 128) { unsigned char* const ws = opaque_ptr(P.ws); LAS unsigned char* const lds = opaque_lds(lds0); (void)lds; DenseOrder S; S.init(T_TOK, 256, 256, G - 128, bid - 128, ws + WS_YBUF, (const bf16_t*)(ws + WS_WGLU) + (size_t)l * 256 * 256);
          EpiGlu E{(const bf16_t*)(ws + WS_YBUF), (bf16_t*)(ws + WS_MIXED), P.s5_b_glu + l * 256};
          gm::gemm_phase<EpiGlu, DenseOrder, false>(lds, 256, S, E); }
        if (PHON(3)) mixer_phase_b(P, bid, G);
        GSYNC(); PH_T1(4); PH_T0(5);
        if (PHON(3)) { KTID(); LAS unsigned char* const lds = opaque_lds(lds0); for (int it = gw; it < 4096; it += ngw) mixer_phase_c(P, lds, l, it); }
        GSYNC(); PH_T1(5); PH_T0(6);
        if (PHON(6)) { unsigned char* const ws = opaque_ptr(P.ws); LAS unsigned char* const lds = opaque_lds(lds0); (void)lds; const float* modl = (const float*)(ws + WS_MOD) + (size_t)l * 8 * 6144; DenseOrder S; S.init(T_TOK, 1024, 1024, G, bid, ws + WS_MIXED, (const bf16_t*)(ws + WS_WOUT) + (size_t)l * 1024 * 1024);
          EpiOut E{l == 0 ? P.x : (const float*)(ws + WS_X), (float*)(ws + WS_X), modl + 2048};
          gm::gemm_phase<EpiOut, DenseOrder, false>(lds, 1024, S, E); }
        GSYNC(); PH_T1(6); PH_T0(7);
        if (PHON(7)) { LAS unsigned char* const lds = opaque_lds(lds0); for (int blk = bid; blk < T_TOK / 128; blk += G) router_phase(P, lds, l, blk); }
        GSYNC(); PH_T1(7); PH_T0(8);
        if (PHON(8)) { unsigned char* const ws = opaque_ptr(P.ws); LAS unsigned char* const lds = opaque_lds(lds0); (void)lds; moe_tables(lds, (const int*)(ws + WS_CTL) + l * 32, 8);
          MoeOrder<true> S; S.tab = (LAS const int*)(lds + MISC_OFF); S.nN = 8; S.G = G; S.vc = vcu; S.Wt = (const char*)(ws + WS_WUP) + (size_t)l * 32 * 2048 * 1024 * 2; S.wstride = (size_t)2048 * 1024 * 2; S.stok = (const int*)(ws + WS_STOK); S.A = (const char*)(ws + WS_HDN); S.gtab = (LAS const unsigned*)(lds + GT_OFF);
          S.fill_gather((LAS unsigned*)(lds + GT_OFF));
          EpiUp E{(bf16_t*)(ws + WS_ACT), P.b_up + (size_t)l * 32 * 2048, (LAS const int*)(lds + MISC_OFF)};
          gm::gemm_phase<EpiUp, MoeOrder<true>, true>(lds, 1024, S, E); }
        GSYNC(); PH_T1(8); PH_T0(9);
#if EXPERIMENT >= 1
        if (l == 0) { unsigned char* const ws = opaque_ptr(P.ws); LAS unsigned char* const lds = opaque_lds(lds0); (void)lds; moe_tables(lds, (const int*)(ws + WS_CTL) + l * 32, 8);
          MoeOrder<(EXPERIMENT != 2)> S; S.tab = (LAS const int*)(lds + MISC_OFF); S.nN = 8; S.G = G; S.vc = vcu; S.Wt = (const char*)(ws + WS_WUP) + (size_t)l * 32 * 2048 * 1024 * 2; S.wstride = (EXPERIMENT == 4) ? 0 : (size_t)2048 * 1024 * 2; S.stok = (const int*)(ws + WS_STOK); S.A = (const char*)(ws + WS_HDN); S.gtab = (LAS const unsigned*)(lds + GT_OFF);
          if (EXPERIMENT != 2) S.fill_gather((LAS unsigned*)(lds + GT_OFF));
          if (EXPERIMENT == 3) { EpiProj E{(bf16_t*)(ws + WS_OUTR), 2048, nullptr}; gm::gemm_phase<EpiProj, MoeOrder<(EXPERIMENT != 2)>, (EXPERIMENT != 2)>(lds, 1024, S, E); }
          else { EpiUp E{(bf16_t*)(ws + WS_OUTR), P.b_up + (size_t)l * 32 * 2048, (LAS const int*)(lds + MISC_OFF)}; gm::gemm_phase<EpiUp, MoeOrder<(EXPERIMENT != 2)>, (EXPERIMENT != 2)>(lds, 1024, S, E); }
          GSYNC(); }
#endif
        if (PHON(9)) { unsigned char* const ws = opaque_ptr(P.ws); LAS unsigned char* const lds = opaque_lds(lds0); (void)lds; moe_tables(lds, (const int*)(ws + WS_CTL) + l * 32, 4);
          const int nunits = ((LAS const int*)(lds + MISC_OFF))[32], nrounds = (nunits + G - 1) / G, gneed0 = nrounds > 0 ? (nunits + nrounds - 1) / nrounds : G, gneed = (gneed0 + 7) & ~7;
          if (bid >= gneed) { if (l + 1 < NLAYER) transpose_moe_pool(P, lds, l + 1, TM_Q_DN); }
          else {
          MoeOrder<false> S; S.tab = (LAS const int*)(lds + MISC_OFF); S.nN = 4; S.G = gneed; S.vc = xcd_vc(bid, gneed); S.Wt = (const char*)(ws + WS_WDN) + (size_t)l * 32 * 1024 * 1024 * 2; S.wstride = (size_t)1024 * 1024 * 2; S.stok = nullptr; S.A = (const char*)(ws + WS_ACT); S.gtab = nullptr;
          EpiDown E{(bf16_t*)(ws + WS_OUTR), P.b_down + (size_t)l * 32 * 1024, (const int*)(ws + WS_STOK), (const float*)(ws + WS_SGATE)};
          gm::gemm_phase<EpiDown, MoeOrder<false>, false>(lds, 1024, S, E); } }
        GSYNC(); PH_T1(9); PH_T0(10);
        if (PHON(10)) { KTID(); combine_phase(P, l, gw, ngw, lane); }
        GSYNC(); PH_T1(10);
    }
    if (TIME_PHASE == 99 && bid == 0) { const unsigned long long t1_ = __builtin_amdgcn_s_memrealtime(), d_ = t1_ - t_entry; while (__builtin_amdgcn_s_memrealtime() - t1_ < d_) __builtin_amdgcn_s_sleep(8); }
}

extern "C" void kernel_launch(void* const* d_in, const int* in_sizes, int n_in, void* d_out, int out_size, void* d_ws, size_t ws_size, hipStream_t stream) {
    static int grid_blocks = 0;
    if (grid_blocks == 0) {
        if (n_in != 29 || ws_size < WS_END) { fprintf(stderr, "kernel_launch: unexpected n_in %d or ws_size %zu (need %zu)\n", n_in, ws_size, (size_t)WS_END); grid_blocks = -1; return; }
        int dev = 0, cus = 0, per_cu = 0;
        (void)hipGetDevice(&dev);
        (void)hipDeviceGetAttribute(&cus, hipDeviceAttributeMultiprocessorCount, dev);
        (void)hipFuncSetAttribute((const void*)fwd_megakernel, hipFuncAttributeMaxDynamicSharedMemorySize, LDS_BYTES);
        (void)hipOccupancyMaxActiveBlocksPerMultiprocessor(&per_cu, (const void*)fwd_megakernel, NTHREADS, LDS_BYTES);
        if (per_cu < 1) { fprintf(stderr, "kernel_launch: occupancy query returned %d\n", per_cu); per_cu = 1; }
        grid_blocks = cus;
        fprintf(stderr, "kernel_launch: cus %d per_cu %d grid %d ws_need %zu\n", cus, per_cu, grid_blocks, (size_t)WS_END);
    }
    if (grid_blocks < 0) return;
    Params p{};
    const float** pp = (const float**)&p;
    for (int i = 0; i < 29; ++i) pp[i] = (const float*)d_in[i];
    p.out = (float*)d_out; p.ws = (unsigned char*)d_ws;
    for (int i = 0; i < 24; ++i) p.inv_freq_rev[i] = pow(10000.0, -(double)(2 * i) / 48.0) / 6.283185307179586476925;
    for (int h = 0; h < 4; ++h) p.log_gamma[h] = (float)log1p(-exp2(-5.0 - (double)h));
    (void)hipMemsetAsync((char*)d_ws + WS_CTL, 0, WS_CTL_BYTES, stream);
    void* args[] = {&p};
    hipError_t e = hipLaunchCooperativeKernel((const void*)fwd_megakernel, dim3(grid_blocks), dim3(NTHREADS), args, LDS_BYTES, stream);
    if (e != hipSuccess) fprintf(stderr, "cooperative launch failed: %s (grid %d)\n", hipGetErrorString(e), grid_blocks);
}
```

```cpp
#include <hip/hip_runtime.h>
#include <hip/hip_cooperative_groups.h>
#include <cstdio>
#include <cstdint>
#include <cmath>
namespace cg = cooperative_groups;
#ifndef TIME_PHASE
#define TIME_PHASE -1
#endif
#ifndef EXPERIMENT
#define EXPERIMENT 0
#endif
#ifndef GEMM_4PH
#define GEMM_4PH 0
#endif

#define LAS __attribute__((address_space(3)))
typedef unsigned short bf16_t;
typedef short bf16x8 __attribute__((ext_vector_type(8)));
typedef float f32x4 __attribute__((ext_vector_type(4)));
typedef float f32x16 __attribute__((ext_vector_type(16)));
typedef unsigned u32x4 __attribute__((ext_vector_type(4)));
typedef unsigned u32x2 __attribute__((ext_vector_type(2)));

constexpr int T_TOK = 32768, DM = 1024, NBATCH = 8, SEQ = 4096, NLAYER = 2;
constexpr int NPROJ = 2576, NPROJP = 2816;
constexpr int NE = 32, CAP = 32768, NSLOT = T_TOK * 4;
constexpr int C_GQ = 0, C_GK = 192, C_GV = 384, C_GG = 768, C_GA = 1152, C_RQ = 1168, C_RK = 1360, C_RV = 1552, C_RG = 1936, C_SU = 2320;
constexpr float NORM_EPS = 1e-5f;
constexpr int NTHREADS = 512, NWAVES = 8;
constexpr int LDS_BYTES = 160 * 1024;
constexpr int MISC_OFF = 148 * 1024;

constexpr size_t al256(size_t x) { return (x + 255) & ~(size_t)255; }
constexpr size_t WS_CTL   = 0;
constexpr size_t WS_BAR   = 4096;
constexpr size_t WS_CTL_BYTES = 32768;
constexpr size_t WS_MOD   = 32768;
constexpr size_t WS_WIN   = al256(WS_MOD + (size_t)2 * 8 * 6144 * 4);
constexpr size_t WS_WOUT  = al256(WS_WIN + (size_t)2 * NPROJP * 1024 * 2);
constexpr size_t WS_WUP   = al256(WS_WOUT + (size_t)2 * 1024 * 1024 * 2);
constexpr size_t WS_WDN   = al256(WS_WUP + (size_t)2 * 32 * 2048 * 1024 * 2);
constexpr size_t WS_WGLU  = al256(WS_WDN + (size_t)2 * 32 * 1024 * 1024 * 2);
constexpr size_t WS_KTAB  = al256(WS_WGLU + (size_t)2 * 256 * 256 * 2);
constexpr size_t WS_BPOW  = al256(WS_KTAB + (size_t)2 * 16 * 65 * 256 * 2);
constexpr size_t WS_CPOW  = al256(WS_BPOW + (size_t)2 * 16 * 128 * 1024 * 2);
constexpr size_t WS_LAM64 = al256(WS_CPOW + (size_t)2 * 16 * 1024 * 128 * 2);
constexpr size_t WS_ROPE  = al256(WS_LAM64 + (size_t)2 * 16 * 64 * 2 * 4);
constexpr size_t WS_WA2T  = al256(WS_ROPE + (size_t)4096 * 24 * 2 * 4);
constexpr size_t WS_RWT   = al256(WS_WA2T + (size_t)2 * 4 * 64 * 16 * 2);
constexpr size_t WS_X     = al256(WS_RWT + (size_t)2 * 2 * 32 * 1024 * 2);
constexpr size_t WS_HDN   = al256(WS_X + (size_t)T_TOK * 1024 * 4);
constexpr size_t WS_PROJ  = al256(WS_HDN + (size_t)T_TOK * 1024 * 2);
constexpr size_t WS_MIXED = al256(WS_PROJ + (size_t)T_TOK * NPROJP * 2);
constexpr size_t WS_YBUF  = al256(WS_MIXED + (size_t)T_TOK * 1024 * 2);
constexpr size_t WS_SU2   = al256(WS_YBUF + (size_t)T_TOK * 256 * 2);
constexpr size_t WS_ACT   = al256(WS_SU2 + (size_t)T_TOK * 256 * 2);
constexpr size_t WS_OUTR  = al256(WS_ACT + (size_t)(NSLOT + 256) * 1024 * 2);
constexpr size_t WS_STOK  = al256(WS_OUTR + (size_t)NSLOT * 1024 * 2);
constexpr size_t WS_SGATE = al256(WS_STOK + (size_t)NE * CAP * 4);
constexpr size_t MXW_QD = WS_ACT, MXW_OI = WS_ACT + ((size_t)32 << 20), MXW_DS = WS_ACT + ((size_t)96 << 20), MXW_DEC = WS_ACT + ((size_t)176 << 20), MXW_SP = WS_ACT + ((size_t)180 << 20);
constexpr size_t WS_END   = al256(WS_SGATE + (size_t)NE * CAP * 4);

struct Params {
    const float* x; const float* c; const float* norm1_w; const float* norm2_w; const float* w_mod; const float* b_mod;
    const float* w_in; const float* gla_w_a2; const float* gla_b_a; const float* gla_norm_w; const float* ret_norm_w;
    const float* s5_a_re; const float* s5_a_im; const float* s5_log_dt; const float* s5_b_re; const float* s5_b_im;
    const float* s5_c_re; const float* s5_c_im; const float* s5_d; const float* s5_w_glu; const float* s5_b_glu;
    const float* w_out; const float* router_w; const float* router_b; const float* w_up; const float* b_up;
    const float* w_down; const float* b_down; const float* final_norm_w;
    float* out; unsigned char* ws;
    double inv_freq_rev[24];
    float log_gamma[4]; float pad0[4];
};

__device__ __forceinline__ unsigned f2bf(float f) { unsigned u = __builtin_bit_cast(unsigned, f); return (u + 0x7fffu + ((u >> 16) & 1u)) >> 16; }
typedef float f32x2_t __attribute__((ext_vector_type(2)));
typedef __bf16 bf16x2_t __attribute__((ext_vector_type(2)));
__device__ __forceinline__ unsigned pk2(float lo, float hi) { const f32x2_t v = {lo, hi}; const bf16x2_t b = __builtin_convertvector(v, bf16x2_t); return __builtin_bit_cast(unsigned, b); }
__device__ __forceinline__ float bflo(unsigned w) { return __builtin_bit_cast(float, w << 16); }
__device__ __forceinline__ float bfhi(unsigned w) { return __builtin_bit_cast(float, w & 0xffff0000u); }
__device__ __forceinline__ float bf2f(bf16_t b) { return __builtin_bit_cast(float, (unsigned)b << 16); }
__device__ __forceinline__ float lx_f(float v, int lane, int o) { return __builtin_bit_cast(float, __builtin_amdgcn_ds_bpermute((lane ^ o) << 2, __builtin_bit_cast(int, v))); }
__device__ __forceinline__ int lx_i(int v, int lane, int o) { return __builtin_amdgcn_ds_bpermute((lane ^ o) << 2, v); }
__device__ __forceinline__ float lidx_f(float v, int src) { return __builtin_bit_cast(float, __builtin_amdgcn_ds_bpermute(src << 2, __builtin_bit_cast(int, v))); }
__device__ __forceinline__ float wave_sum(float v, int lane) {
#pragma unroll
    for (int o = 1; o < 64; o <<= 1) v += lx_f(v, lane, o);
    return v;
}
__device__ __forceinline__ float sigmoidf_(float x) { return __builtin_amdgcn_rcpf(1.0f + __builtin_amdgcn_exp2f(-1.4426950408889634f * x)); }
__device__ __forceinline__ float siluf(float x) { return x * sigmoidf_(x); }
#define LDS_WAIT() asm volatile("s_waitcnt lgkmcnt(0)" ::: "memory")
__device__ __forceinline__ unsigned char* opaque_ptr(unsigned char* p) { const unsigned long long v = (unsigned long long)p; unsigned lo = __builtin_amdgcn_readfirstlane((unsigned)v), hi = __builtin_amdgcn_readfirstlane((unsigned)(v >> 32));
    asm volatile("" : "+s"(lo), "+s"(hi)); return (unsigned char*)(__attribute__((address_space(1))) unsigned char*)(((unsigned long long)hi << 32) | lo); }
__device__ __forceinline__ LAS unsigned char* opaque_lds(LAS unsigned char* p) { unsigned v = __builtin_amdgcn_readfirstlane((unsigned)(size_t)p); asm volatile("" : "+s"(v)); return (LAS unsigned char*)(size_t)v; }
__device__ __forceinline__ int opaque_tid() { int t = threadIdx.x; asm volatile("" : "+v"(t)); return t; }

namespace gm {
constexpr int BM = 256, BK = 64, HALF = 128, HTB = HALF * BK * 2, STAGE_BYTES = 8 * HTB, NXCD = 8, WGM = 8;
__device__ __forceinline__ int lds_byte(int r, int c) { const int st = (r >> 4) * 2 + (c >> 5), rr = r & 15, cc = c & 31, ob = rr * 64 + cc * 2; return st * 1024 + (ob ^ (((ob >> 9) & 1) << 5)); }
__device__ __forceinline__ void stage_rc(int b, int& R, int& C) { const int st = b / 1024, sb = b % 1024, swz = sb ^ (((sb >> 9) & 1) << 5); R = (st >> 1) * 16 + swz / 64; C = (st & 1) * 32 + (swz % 64) / 2; }
__device__ __forceinline__ int perm32(int rho) { const int n = rho >> 4, i = rho & 15; return 8 * (i >> 2) + 4 * n + (i & 3); }

struct Unit { const char* B; int pm, pn, e, rows; };

template <class Epi, class Sched, bool GATHER>
__device__ __forceinline__ void gemm_phase(LAS unsigned char* lds, const int K_in, const Sched& S, const Epi& E) {
    int K = K_in; asm volatile("" : "+s"(K));
    const int tid = opaque_tid(), wid = __builtin_amdgcn_readfirstlane(tid >> 6), lane = tid & 63, wr = wid >> 2, wc = wid & 3, fr = lane & 15, fq = lane >> 4;
    const int nt = K / BK;
    int R0, C0; unsigned voffB;
    { stage_rc(tid * 16, R0, C0);
      const int Rb0 = Epi::PERM ? ((R0 & ~31) + perm32(R0 & 31)) : R0;
      voffB = (unsigned)(Rb0 * K + C0) * 2u; }
    const size_t kstep = (size_t)(BK * 2);
    const size_t hstep = (size_t)HALF * K * 2;
    const size_t qstep = (size_t)64 * K * 2;
    const unsigned ldsw = (unsigned)wid * 1024u;
    const int aoff = lds_byte(wr * 64 + fr, fq * 8), boff = lds_byte(wc * 32 + fr, fq * 8);
#define G_SA(b, h) (((b) * 2 + (h)) * gm::HTB)
#define G_SB(b, h) ((4 + (b) * 2 + (h)) * gm::HTB)
#define G_GLDS(gptr, ldsoff) __builtin_amdgcn_global_load_lds((const unsigned*)(gptr), (LAS unsigned*)(lds + (ldsoff)), 16, 0, 0)
#define G_STAGEB(bufoff, gbase) do { G_GLDS((const char*)(gbase) + voffB, (bufoff) + ldsw); G_GLDS((const char*)(gbase) + qstep + voffB, (bufoff) + ldsw + 8192); } while (0)
#define G_STAGEA(bufoff, ubase, h, o0, o1) do { if (GATHER) { G_GLDS((const char*)(ubase) + (o0), (bufoff) + ldsw); G_GLDS((const char*)(ubase) + (o1), (bufoff) + ldsw + 8192); } \
        else { G_GLDS((const char*)(ubase) + (h) * hstep + (o0), (bufoff) + ldsw); G_GLDS((const char*)(ubase) + (h) * hstep + qstep + (o0), (bufoff) + ldsw + 8192); } } while (0)
#define G_LDA(dst, b, h) do { _Pragma("unroll") for (int m = 0; m < 4; ++m) _Pragma("unroll") for (int k = 0; k < 2; ++k) dst[m][k] = *(const LAS bf16x8*)(lds + G_SA(b, h) + aoff + m * 2048 + k * 1024); } while (0)
#define G_LDB(dst, b, h) do { _Pragma("unroll") for (int n = 0; n < 2; ++n) _Pragma("unroll") for (int k = 0; k < 2; ++k) dst[n][k] = *(const LAS bf16x8*)(lds + G_SB(b, h) + boff + n * 2048 + k * 1024); } while (0)
#define G_MMA(ai, bj, At, Bt) do { __builtin_amdgcn_s_setprio(1); _Pragma("unroll") for (int m = 0; m < 4; ++m) _Pragma("unroll") for (int n = 0; n < 2; ++n) _Pragma("unroll") for (int k = 0; k < 2; ++k) \
        acc[ai][bj][m][n] = __builtin_amdgcn_mfma_f32_16x16x32_bf16(Bt[n][k], At[m][k], acc[ai][bj][m][n], 0, 0, 0); __builtin_amdgcn_s_setprio(0); } while (0)
#define G_WAIT_V(n) asm volatile("s_waitcnt vmcnt(" #n ")" ::: "memory")
#define G_WAIT_L(n) asm volatile("s_waitcnt lgkmcnt(" #n ")" ::: "memory")
#define G_BAR __builtin_amdgcn_s_barrier()
#define G_SCHED __builtin_amdgcn_sched_barrier(0)
    Unit cur, nxt; int ui = 0;
    if (!S.next(0, cur)) return;
    f32x4 acc[2][2][4][2];
#pragma unroll
    for (int a = 0; a < 2; ++a)
#pragma unroll
        for (int b = 0; b < 2; ++b)
#pragma unroll
            for (int m = 0; m < 4; ++m)
#pragma unroll
                for (int n = 0; n < 2; ++n) acc[a][b][m][n] = (f32x4){0.f, 0.f, 0.f, 0.f};
    bf16x8 At[4][2], B0[2][2], B1[2][2];
    unsigned c00, c01 = 0, c10 = 0, c11 = 0;
    c00 = S.a_off(0, R0, C0);
    if (GATHER) { c01 = S.a_off(0, R0 + 64, C0); c10 = S.a_off(0, R0 + 128, C0); c11 = S.a_off(0, R0 + 192, C0); }
    const char* cA = S.a_base(cur); const char* cB = cur.B;
#if GEMM_4PH
    G_STAGEB(G_SB(0, 0), cB); G_STAGEA(G_SA(0, 0), cA, 0, c00, c01); G_STAGEB(G_SB(0, 1), cB + hstep); G_STAGEA(G_SA(0, 1), cA, 1, c10 + (GATHER ? 0u : c00), c11);
    if (wr == 1) G_BAR;
    G_WAIT_V(4); G_BAR;
#else
    G_STAGEB(G_SB(0, 0), cB); G_STAGEB(G_SB(0, 1), cB + hstep); G_STAGEA(G_SA(0, 0), cA, 0, c00, c01); G_STAGEA(G_SA(0, 1), cA, 1, c10 + (GATHER ? 0u : c00), c11);
    if (wr == 1) G_BAR;
    G_WAIT_V(2); G_BAR;
#endif
    G_STAGEB(G_SB(1, 0), cB + kstep); G_STAGEA(G_SA(1, 0), cA + kstep, 0, c00, c01); G_STAGEB(G_SB(1, 1), cB + hstep + kstep);
    G_WAIT_V(6); G_BAR;
    for (;;) {
        const bool has_next = S.next(ui + 1, nxt);
        const char* nB = cB; const char* nA = cA;
        if (has_next) { nB = nxt.B; nA = S.a_base(nxt); }
        for (int t = 0; t < nt; t += 2) {
            const bool last = (t == nt - 2);
            const char* a1 = cA + (size_t)(t + 1) * kstep;
            const char* a2 = last ? nA : cA + (size_t)(t + 2) * kstep;
            const char* b2 = last ? nB : cB + (size_t)(t + 2) * kstep;
#if GEMM_4PH
            G_LDB(B0, 0, 0); G_SCHED; G_LDA(At, 0, 0); G_STAGEA(G_SA(1, 1), a1, 1, c10 + (GATHER ? 0u : c00), c11);
            G_WAIT_L(8); G_BAR; G_WAIT_L(0); G_MMA(0, 0, At, B0); G_BAR; G_SCHED;
            if (GATHER) { if (last && has_next) { c00 = S.a_off(ui + 1, R0, C0); c01 = S.a_off(ui + 1, R0 + 64, C0); c10 = S.a_off(ui + 1, R0 + 128, C0); c11 = S.a_off(ui + 1, R0 + 192, C0); } }
            G_LDB(B1, 0, 1); G_STAGEB(G_SB(0, 0), b2);
            G_BAR; G_WAIT_L(0); G_MMA(0, 1, At, B1); G_BAR;
            G_LDA(At, 0, 1); G_STAGEA(G_SA(0, 0), a2, 0, c00, c01);
            G_BAR; G_WAIT_L(0); G_MMA(1, 0, At, B0); G_BAR; G_SCHED;
            G_STAGEB(G_SB(0, 1), b2 + hstep);
            G_WAIT_V(6); G_BAR; G_MMA(1, 1, At, B1); G_BAR;
            G_LDB(B0, 1, 0); G_SCHED; G_LDA(At, 1, 0); G_STAGEA(G_SA(0, 1), a2, 1, c10 + (GATHER ? 0u : c00), c11);
            G_WAIT_L(8); G_BAR; G_WAIT_L(0); G_MMA(0, 0, At, B0); G_BAR; G_SCHED;
            G_LDB(B1, 1, 1); G_STAGEB(G_SB(1, 0), b2 + kstep);
            G_BAR; G_WAIT_L(0); G_MMA(0, 1, At, B1); G_BAR;
            G_LDA(At, 1, 1); G_STAGEA(G_SA(1, 0), a2 + kstep, 0, c00, c01);
            G_BAR; G_WAIT_L(0); G_MMA(1, 0, At, B0); G_BAR; G_SCHED;
            G_STAGEB(G_SB(1, 1), b2 + kstep + hstep);
            G_WAIT_V(6); G_BAR; G_MMA(1, 1, At, B1); G_BAR;
        }
#else
            G_LDB(B0, 0, 0); G_LDB(B1, 0, 1); G_SCHED; G_LDA(At, 0, 0); G_STAGEA(G_SA(1, 1), a1, 1, c10 + (GATHER ? 0u : c00), c11);
            G_WAIT_V(8); G_WAIT_L(0); G_BAR; G_MMA(0, 0, At, B0); G_MMA(0, 1, At, B1); G_BAR; G_SCHED;
            if (GATHER) { if (last && has_next) { c00 = S.a_off(ui + 1, R0, C0); c01 = S.a_off(ui + 1, R0 + 64, C0); c10 = S.a_off(ui + 1, R0 + 128, C0); c11 = S.a_off(ui + 1, R0 + 192, C0); } }
            G_LDA(At, 0, 1); G_STAGEB(G_SB(0, 0), b2); G_STAGEB(G_SB(0, 1), b2 + hstep); G_STAGEA(G_SA(0, 0), a2, 0, c00, c01);
            G_WAIT_V(8); G_WAIT_L(0); G_BAR; G_MMA(1, 0, At, B0); G_MMA(1, 1, At, B1); G_BAR; G_SCHED;
            G_LDB(B0, 1, 0); G_LDB(B1, 1, 1); G_SCHED; G_LDA(At, 1, 0); G_STAGEA(G_SA(0, 1), a2, 1, c10 + (GATHER ? 0u : c00), c11);
            G_WAIT_V(8); G_WAIT_L(0); G_BAR; G_MMA(0, 0, At, B0); G_MMA(0, 1, At, B1); G_BAR; G_SCHED;
            G_LDA(At, 1, 1); G_STAGEB(G_SB(1, 0), b2 + kstep); G_STAGEB(G_SB(1, 1), b2 + kstep + hstep); G_STAGEA(G_SA(1, 0), a2 + kstep, 0, c00, c01);
            G_WAIT_V(8); G_WAIT_L(0); G_BAR; G_MMA(1, 0, At, B0); G_MMA(1, 1, At, B1); G_BAR; G_SCHED;
        }
#endif
        if (wr == 0) G_BAR;
        E(acc, cur, wr, wc, fr, fq);
        if (!has_next) break;
#pragma unroll
        for (int a = 0; a < 2; ++a)
#pragma unroll
            for (int b = 0; b < 2; ++b)
#pragma unroll
                for (int m = 0; m < 4; ++m)
#pragma unroll
                    for (int n = 0; n < 2; ++n) acc[a][b][m][n] = (f32x4){0.f, 0.f, 0.f, 0.f};
        cur = nxt; cB = nB; cA = nA; ++ui;
        if (wr == 1) G_BAR;
    }
    G_WAIT_V(0);
    G_BAR;
}
}

struct DenseOrder {
    int nM, nN, nwg, G, c, K; const char* Bt;
    __device__ __forceinline__ void init(int M, int N, int K_, int G_, int c_, const void* A_, const void* Bt_) { nM = M / 256; nN = N / 256; nwg = nM * nN; G = G_; c = c_; K = K_; A = (const char*)A_; Bt = (const char*)Bt_; }
    __device__ __forceinline__ bool next(int i, gm::Unit& u) const {
        const long L = (long)i * G + c; if (L >= nwg) return false;
        int wgid = (int)L; { const int q = nwg / gm::NXCD, r = nwg % gm::NXCD, xcd = wgid % gm::NXCD, off = wgid / gm::NXCD; wgid = (xcd < r ? xcd * (q + 1) : r * (q + 1) + (xcd - r) * q) + off; }
        const int nig = gm::WGM * nN, gid = wgid / nig, fm = gid * gm::WGM, gsz = (nM - fm) < gm::WGM ? (nM - fm) : gm::WGM;
        u.pm = fm + ((wgid % nig) % gsz); u.pn = (wgid % nig) / gsz; u.e = 0; u.rows = 256;
        u.B = Bt + (size_t)u.pn * 256 * K * 2; return true;
    }
    const char* A;
    __device__ __forceinline__ const char* a_base(const gm::Unit& u) const { return A + (size_t)u.pm * 256 * K * 2; }
    __device__ __forceinline__ unsigned a_off(int, int r, int c) const { return (unsigned)(r * K + c) * 2u; }
};
constexpr int GT_MAX = 19, GT_OFF = 128 * 1024;
template <bool GATHER> struct MoeOrder {
    LAS const int* tab; int nN, G, vc; const char* Wt; size_t wstride; const int* stok;
    __device__ __forceinline__ bool next(int i, gm::Unit& u) const {
        const int L = i * G + vc; if (L >= tab[32]) return false;
        int e = 0;
#pragma unroll 1
        for (int k = 1; k < 32; ++k) e += (tab[k] <= L) ? 1 : 0;
        const int r = L - tab[e]; u.e = e; u.pm = r / nN; u.pn = r % nN;
        const int cnt = tab[128 + e]; u.rows = (cnt - u.pm * 256) < 256 ? (cnt - u.pm * 256) : 256;
        u.B = Wt + (size_t)e * wstride + (size_t)u.pn * 256 * 1024 * 2; return true;
    }
    const char* A;
    __device__ __forceinline__ const char* a_base(const gm::Unit& u) const { return GATHER ? A : A + (size_t)(tab[64 + u.e] + u.pm * 256) * 2048; }
    LAS const unsigned* gtab;
    __device__ __forceinline__ unsigned a_off(int ui, int r, int c) const {
        if (GATHER) return gtab[ui * 256 + r] + (unsigned)c * 2u;
        else return (unsigned)(r * 1024 + c) * 2u;
    }
    __device__ __forceinline__ void fill_gather(LAS unsigned* gt) const {
        const int tid = opaque_tid();
        if (tid < 256) { gm::Unit u;
            for (int i = 0; i < GT_MAX && next(i, u); ++i) { int tk = 0; if (tid < u.rows) tk = stok[u.e * CAP + u.pm * 256 + tid] >> 2; gt[i * 256 + tid] = (unsigned)tk * 2048u; } }
        __syncthreads();
    }
};
__device__ __forceinline__ void moe_tables(LAS unsigned char* lds, const int* gcount, int nN) {
    LAS int* tab = (LAS int*)(lds + MISC_OFF);
    if (opaque_tid() == 0) { int cu = 0, ro = 0;
#pragma unroll 1
        for (int e = 0; e < 32; ++e) { const int c = gcount[e]; tab[e] = cu; tab[64 + e] = ro; tab[128 + e] = c; cu += ((c + 255) >> 8) * nN; ro += c; }
        tab[32] = cu; tab[64 + 32] = ro; }
    __syncthreads();
}

struct EpiProj {
    static constexpr bool PERM = true;
    bf16_t* O; int ldc; bf16_t* su2;
    __device__ __forceinline__ void operator()(const f32x4 (&acc)[2][2][4][2], const gm::Unit& u, int wr, int wc, int fr_, int fq_) const {
        int fr = fr_, fq = fq_; asm volatile("" : "+v"(fr), "+v"(fq));
        const int row0 = u.pm * 256 + wr * 64 + fr, col0 = u.pn * 256 + wc * 32 + 8 * fq;
#pragma unroll
        for (int ai = 0; ai < 2; ++ai)
#pragma unroll
            for (int m = 0; m < 4; ++m) { bf16_t* rowp = O + (size_t)(row0 + ai * 128 + m * 16) * ldc + col0;
#pragma unroll
                for (int bj = 0; bj < 2; ++bj) { const f32x4 v0 = acc[ai][bj][m][0], v1 = acc[ai][bj][m][1];
                    u32x4 w; w.x = pk2(v0[0], v0[1]); w.y = pk2(v0[2], v0[3]); w.z = pk2(v1[0], v1[1]); w.w = pk2(v1[2], v1[3]);
                    const int col = col0 + bj * 128;
                    if (su2 != nullptr && col >= C_SU && col < NPROJ) { const int row = row0 + ai * 128 + m * 16, cs = col - C_SU;
                        *(u32x4*)(su2 + ((size_t)((row >> 12) * 16 + (cs >> 4)) * 4096 + (row & 4095)) * 16 + (cs & 15)) = w; }
                    else *(u32x4*)(rowp + bj * 128) = w; } }
    }
};
struct EpiOut {
    static constexpr bool PERM = false;
    const float* xin; float* xout; const float* gate;
    __device__ __forceinline__ void operator()(const f32x4 (&acc)[2][2][4][2], const gm::Unit& u, int wr, int wc, int fr_, int fq_) const {
        int fr = fr_, fq = fq_; asm volatile("" : "+v"(fr), "+v"(fq));
        const int row0 = u.pm * 256 + wr * 64 + fr, col0 = u.pn * 256 + wc * 32 + 4 * fq;
        const float* gp = gate + (size_t)(u.pm >> 4) * 6144 + col0;
        f32x4 gv[2][2];
#pragma unroll
        for (int bj = 0; bj < 2; ++bj)
#pragma unroll
            for (int n = 0; n < 2; ++n) gv[bj][n] = *(const f32x4*)(gp + bj * 128 + n * 16);
#pragma unroll
        for (int ai = 0; ai < 2; ++ai)
#pragma unroll
            for (int m = 0; m < 4; ++m) { const size_t ro = (size_t)(row0 + ai * 128 + m * 16) * 1024 + col0;
#pragma unroll
                for (int bj = 0; bj < 2; ++bj)
#pragma unroll
                    for (int n = 0; n < 2; ++n) { const f32x4 xi = *(const f32x4*)(xin + ro + bj * 128 + n * 16);
                        *(f32x4*)(xout + ro + bj * 128 + n * 16) = xi + gv[bj][n] * acc[ai][bj][m][n]; } }
    }
};
struct EpiGlu {
    static constexpr bool PERM = true;
    const bf16_t* y; bf16_t* mixed; const float* bias;
    __device__ __forceinline__ void operator()(const f32x4 (&acc)[2][2][4][2], const gm::Unit& u, int wr, int wc, int fr_, int fq_) const {
        int fr = fr_, fq = fq_; asm volatile("" : "+v"(fr), "+v"(fq));
        const int row0 = u.pm * 256 + wr * 64 + fr, col0 = wc * 32 + 8 * fq;
#pragma unroll
        for (int ai = 0; ai < 2; ++ai)
#pragma unroll
            for (int m = 0; m < 4; ++m) { const int row = row0 + ai * 128 + m * 16;
#pragma unroll
                for (int bj = 0; bj < 2; ++bj) { const int col = col0 + bj * 128;
                    const f32x4 b0 = *(const f32x4*)(bias + col), b1 = *(const f32x4*)(bias + col + 4);
                    const u32x4 yw = *(const u32x4*)(y + (size_t)row * 256 + col);
                    const f32x4 z0 = acc[ai][bj][m][0] + b0, z1 = acc[ai][bj][m][1] + b1;
                    u32x4 w;
                    w.x = pk2(bflo(yw.x) * sigmoidf_(z0[0]), bfhi(yw.x) * sigmoidf_(z0[1]));
                    w.y = pk2(bflo(yw.y) * sigmoidf_(z0[2]), bfhi(yw.y) * sigmoidf_(z0[3]));
                    w.z = pk2(bflo(yw.z) * sigmoidf_(z1[0]), bfhi(yw.z) * sigmoidf_(z1[1]));
                    w.w = pk2(bflo(yw.w) * sigmoidf_(z1[2]), bfhi(yw.w) * sigmoidf_(z1[3]));
                    *(u32x4*)(mixed + (size_t)row * 1024 + 768 + col) = w; }
                __builtin_amdgcn_sched_barrier(0); }
    }
};
__device__ __forceinline__ float swiglu1(float g, float l) {
    g = fminf(g, 7.0f); l = fminf(fmaxf(l, -7.0f), 7.0f);
    return g * __builtin_amdgcn_rcpf(1.0f + __builtin_amdgcn_exp2f(-2.4554669595930157f * g)) * (l + 1.0f);
}
struct EpiUp {
    static constexpr bool PERM = true;
    bf16_t* act; const float* bias; LAS const int* tab;
    __device__ __forceinline__ void operator()(const f32x4 (&acc)[2][2][4][2], const gm::Unit& u, int wr, int wc, int fr_, int fq_) const {
        int fr = fr_, fq = fq_; asm volatile("" : "+v"(fr), "+v"(fq));
        const int rl0 = wr * 64 + fr, col0 = u.pn * 128 + wc * 32 + 8 * fq;
        const float* bp = bias + (size_t)u.e * 2048 + col0;
        unsigned bgp[4], blp[4];
        { const f32x4 bg0 = *(const f32x4*)(bp), bg1 = *(const f32x4*)(bp + 4), bl0 = *(const f32x4*)(bp + 1024), bl1 = *(const f32x4*)(bp + 1028);
          bgp[0] = pk2(bg0[0], bg0[1]); bgp[1] = pk2(bg0[2], bg0[3]); bgp[2] = pk2(bg1[0], bg1[1]); bgp[3] = pk2(bg1[2], bg1[3]);
          blp[0] = pk2(bl0[0], bl0[1]); blp[1] = pk2(bl0[2], bl0[3]); blp[2] = pk2(bl1[0], bl1[1]); blp[3] = pk2(bl1[2], bl1[3]); }
        const size_t arow = (size_t)(tab[64 + u.e] + u.pm * 256);
#pragma unroll
        for (int ai = 0; ai < 2; ++ai)
#pragma unroll
            for (int m = 0; m < 4; ++m) { const int rl = rl0 + ai * 128 + m * 16;
                if (rl < u.rows) {
                    const f32x4 bg0 = {bflo(bgp[0]), bfhi(bgp[0]), bflo(bgp[1]), bfhi(bgp[1])}, bg1 = {bflo(bgp[2]), bfhi(bgp[2]), bflo(bgp[3]), bfhi(bgp[3])};
                    const f32x4 bl0 = {bflo(blp[0]), bfhi(blp[0]), bflo(blp[1]), bfhi(blp[1])}, bl1 = {bflo(blp[2]), bfhi(blp[2]), bflo(blp[3]), bfhi(blp[3])};
                    const f32x4 g0 = acc[ai][0][m][0] + bg0, g1 = acc[ai][0][m][1] + bg1, l0 = acc[ai][1][m][0] + bl0, l1 = acc[ai][1][m][1] + bl1;
                    u32x4 w;
                    w.x = pk2(swiglu1(g0[0], l0[0]), swiglu1(g0[1], l0[1])); w.y = pk2(swiglu1(g0[2], l0[2]), swiglu1(g0[3], l0[3]));
                    w.z = pk2(swiglu1(g1[0], l1[0]), swiglu1(g1[1], l1[1])); w.w = pk2(swiglu1(g1[2], l1[2]), swiglu1(g1[3], l1[3]));
                    *(u32x4*)(act + (arow + rl) * 1024 + col0) = w; } }
    }
};
struct EpiDown {
    static constexpr bool PERM = true;
    bf16_t* outr; const float* bias; const int* stok; const float* sgate;
    __device__ __forceinline__ void operator()(const f32x4 (&acc)[2][2][4][2], const gm::Unit& u, int wr, int wc, int fr_, int fq_) const {
        int fr = fr_, fq = fq_; asm volatile("" : "+v"(fr), "+v"(fq));
        const int rl0 = wr * 64 + fr, col0 = u.pn * 256 + wc * 32 + 8 * fq;
        const float* bp = bias + (size_t)u.e * 1024 + col0;
        f32x4 bv[2][2];
#pragma unroll
        for (int bj = 0; bj < 2; ++bj) { bv[bj][0] = *(const f32x4*)(bp + bj * 128); bv[bj][1] = *(const f32x4*)(bp + bj * 128 + 4); }
        int sts[8]; float gts[8];
#pragma unroll
        for (int q = 0; q < 8; ++q) { const int rl = rl0 + (q >> 2) * 128 + (q & 3) * 16; const int si = u.e * CAP + u.pm * 256 + (rl < u.rows ? rl : 0); sts[q] = stok[si]; gts[q] = sgate[si]; }
#pragma unroll
        for (int ai = 0; ai < 2; ++ai)
#pragma unroll
            for (int m = 0; m < 4; ++m) { const int rl = rl0 + ai * 128 + m * 16;
                if (rl < u.rows) {
                    const int st = sts[ai * 4 + m]; const float gt = gts[ai * 4 + m];
                    bf16_t* rowp = outr + (size_t)st * 1024 + col0;
#pragma unroll
                    for (int bj = 0; bj < 2; ++bj) { const f32x4 v0 = (acc[ai][bj][m][0] + bv[bj][0]) * gt, v1 = (acc[ai][bj][m][1] + bv[bj][1]) * gt;
                        u32x4 w; w.x = pk2(v0[0], v0[1]); w.y = pk2(v0[2], v0[3]); w.z = pk2(v1[0], v1[1]); w.w = pk2(v1[2], v1[3]);
                        *(u32x4*)(rowp + bj * 128) = w; } } }
    }
};

__device__ __forceinline__ void transpose_item(const float* W, int K, int Nsrc, bf16_t* WT, int mode, LAS float* scr, int kb, int nb, int lane) {
    const int k0 = 64 * kb, n0 = 32 * nb;
    const int ncol = n0 + (lane & 31);
#pragma unroll 8
    for (int i = 0; i < 32; ++i) { const int kk = 2 * i + (lane >> 5); scr[kk * 33 + (lane & 31)] = (ncol < Nsrc) ? W[(size_t)(k0 + kk) * Nsrc + ncol] : 0.f; }
    LDS_WAIT(); asm volatile("" ::: "memory");
    const int c = lane & 7;
#pragma unroll
    for (int j = 0; j < 4; ++j) { const int n = (lane >> 3) + 8 * j; const LAS float* s = scr + (8 * c) * 33 + n;
        u32x4 o; o.x = pk2(s[0 * 33], s[1 * 33]); o.y = pk2(s[2 * 33], s[3 * 33]); o.z = pk2(s[4 * 33], s[5 * 33]); o.w = pk2(s[6 * 33], s[7 * 33]);
        int drow = n0 + n;
        if (mode == 1) { const int jj = drow & 1023, lin = drow >> 10; drow = (jj >> 7) * 256 + lin * 128 + (jj & 127); }
        *(u32x4*)(WT + (size_t)drow * K + k0 + 8 * c) = o; }
    LDS_WAIT(); asm volatile("" ::: "memory");
}
constexpr int TI_IN = 16 * 88, TI_OUT = 16 * 32, TI_UP = 16 * 64, TI_DN = 16 * 32, TI_GLU = 4 * 8;
constexpr int TS_R0 = 2 * TI_IN, TS_R1 = TS_R0 + 2 * TI_OUT, TS_R2 = TS_R1 + 2 * TI_GLU;
__device__ __forceinline__ void transpose_small(const Params& P, LAS unsigned char* lds, int gw, int ngw, int wave, int lane) {
    unsigned char* const wsp = opaque_ptr(P.ws);
    LAS float* scr = (LAS float*)(lds + wave * 8704);
    for (int it = gw; it < TS_R2; it += ngw) {
        if (it < TS_R0) { const int l = it / TI_IN, r = it % TI_IN;
            transpose_item(P.w_in + (size_t)l * 1024 * NPROJ, 1024, NPROJ, (bf16_t*)(wsp + WS_WIN) + (size_t)l * NPROJP * 1024, 0, scr, r / 88, r % 88, lane); }
        else if (it < TS_R1) { const int q = it - TS_R0, l = q / TI_OUT, r = q % TI_OUT;
            transpose_item(P.w_out + (size_t)l * 1024 * 1024, 1024, 1024, (bf16_t*)(wsp + WS_WOUT) + (size_t)l * 1024 * 1024, 0, scr, r / 32, r % 32, lane); }
        else { const int q = it - TS_R1, l = q / TI_GLU, r = q % TI_GLU;
            transpose_item(P.s5_w_glu + (size_t)l * 256 * 256, 256, 256, (bf16_t*)(wsp + WS_WGLU) + (size_t)l * 256 * 256, 0, scr, r / 8, r % 8, lane); }
    }
}
__device__ __forceinline__ void transpose_item64(const float* W, int K, int Nsrc, bf16_t* WT, int mode, LAS float* scr, int kb, int nb, int lane) {
    const int k0 = 64 * kb, n0 = 64 * nb, kq = lane >> 4, nn = 4 * (lane & 15);
    const float* src = W + (size_t)(k0 + kq) * Nsrc + n0 + nn;
    f32x4 v[16];
#pragma unroll
    for (int i = 0; i < 16; ++i) v[i] = __builtin_nontemporal_load((const f32x4*)(src + (size_t)(4 * i) * Nsrc));
#pragma unroll
    for (int i = 0; i < 16; ++i) { LAS float* d = scr + (4 * i + kq) * 65 + nn; d[0] = v[i][0]; d[1] = v[i][1]; d[2] = v[i][2]; d[3] = v[i][3]; }
    LDS_WAIT(); asm volatile("" ::: "memory");
    const int c = lane & 7;
#pragma unroll
    for (int j = 0; j < 8; ++j) { const int n = (lane >> 3) + 8 * j; const LAS float* s = scr + (8 * c) * 65 + n;
        u32x4 o; o.x = pk2(s[0 * 65], s[1 * 65]); o.y = pk2(s[2 * 65], s[3 * 65]); o.z = pk2(s[4 * 65], s[5 * 65]); o.w = pk2(s[6 * 65], s[7 * 65]);
        int drow = n0 + n;
        if (mode == 1) { const int jj = drow & 1023, lin = drow >> 10; drow = (jj >> 7) * 256 + lin * 128 + (jj & 127); }
        *(u32x4*)(WT + (size_t)drow * K + k0 + 8 * c) = o; }
    LDS_WAIT(); asm volatile("" ::: "memory");
}
constexpr int TM_UP = 16 * 32, TM_DN = 16 * 16;
constexpr int TM_TOTAL = 32 * (TM_UP + TM_DN), TM_Q_IN = 2560, TM_Q_DN = 5120, TM_Q_P0 = 8192;
__device__ __forceinline__ void transpose_moe_item(const Params& P, unsigned char* wsp, LAS float* scr, int l, int it, int lane) {
    if (it < 32 * TM_UP) { const int le = l * 32 + it / TM_UP, r = it % TM_UP;
        transpose_item64(P.w_up + (size_t)le * 1024 * 2048, 1024, 2048, (bf16_t*)(wsp + WS_WUP) + (size_t)le * 2048 * 1024, 1, scr, r / 32, r % 32, lane); }
    else { const int q = it - 32 * TM_UP, le = l * 32 + q / TM_DN, r = q % TM_DN;
        transpose_item64(P.w_down + (size_t)le * 1024 * 1024, 1024, 1024, (bf16_t*)(wsp + WS_WDN) + (size_t)le * 1024 * 1024, 0, scr, r / 16, r % 16, lane); }
}
__device__ __forceinline__ int tm_pool_size(int l) { return l == 0 ? TM_Q_P0 + TM_Q_IN : TM_Q_DN + TM_Q_IN; }
__device__ __forceinline__ void transpose_moe_pool(const Params& P, LAS unsigned char* lds, int l, int limit) {
    unsigned char* const wsp = opaque_ptr(P.ws);
    const int tid = opaque_tid(), wave = __builtin_amdgcn_readfirstlane(tid >> 6), lane = tid & 63;
    LAS float* scr = (LAS float*)(lds + wave * 16640);
    int* ctr = (int*)(wsp + WS_CTL) + 128 + l;
    const int qa = tm_pool_size(l);
    for (;;) {
        if (8 * __builtin_amdgcn_readfirstlane(__hip_atomic_load(ctr, __ATOMIC_RELAXED, __HIP_MEMORY_SCOPE_AGENT)) >= limit) break;
        int bt = 0; if (lane == 0) bt = __hip_atomic_fetch_add(ctr, 1, __ATOMIC_RELAXED, __HIP_MEMORY_SCOPE_AGENT);
        bt = __builtin_amdgcn_readfirstlane(bt);
        if (8 * bt >= qa) break;
#pragma unroll 1
        for (int k = 0; k < 8; ++k) transpose_moe_item(P, wsp, scr, l, 8 * bt + k, lane);
    }
}
__device__ __forceinline__ void transpose_moe_rest(const Params& P, LAS unsigned char* lds, int l, int gw, int ngw) {
    transpose_moe_pool(P, lds, l, TM_TOTAL);
    unsigned char* const wsp = opaque_ptr(P.ws);
    const int tid = opaque_tid(), wave = __builtin_amdgcn_readfirstlane(tid >> 6), lane = tid & 63;
    LAS float* scr = (LAS float*)(lds + wave * 16640);
    for (int it = tm_pool_size(l) + gw; it < TM_TOTAL; it += ngw) transpose_moe_item(P, wsp, scr, l, it, lane);
}
__device__ __forceinline__ int xcd_vc(int c, int Gp) { const int q = Gp / 8, r = Gp % 8, xcd = c % 8, off = c / 8; return (xcd < r ? xcd * (q + 1) : r * (q + 1) + (xcd - r) * q) + off; }
__device__ __forceinline__ void mod_item(const Params& P, LAS unsigned char* lds, int item) {
    unsigned char* const wsp = opaque_ptr(P.ws);
    const int tid = opaque_tid(), wave = tid >> 6, lane = tid & 63;
    LAS float* sc = (LAS float*)lds;
    LAS float* red = (LAS float*)(lds + 32768);
    const int l = item / 96, cb = item % 96;
    for (int i = tid; i < 8192; i += NTHREADS) sc[i] = siluf(P.c[i]);
    __syncthreads();
    const float* W = P.w_mod + (size_t)l * 1024 * 6144 + cb * 64 + lane;
    float a[8];
#pragma unroll
    for (int b = 0; b < 8; ++b) a[b] = 0.f;
#pragma unroll 1
    for (int k0 = wave; k0 < 1024; k0 += 128) { float wv[16];
#pragma unroll
        for (int u = 0; u < 16; ++u) wv[u] = __builtin_nontemporal_load(W + (size_t)(k0 + 8 * u) * 6144);
#pragma unroll
        for (int u = 0; u < 16; ++u) {
#pragma unroll
            for (int b = 0; b < 8; ++b) a[b] += sc[b * 1024 + k0 + 8 * u] * wv[u]; } }
#pragma unroll
    for (int b = 0; b < 8; ++b) red[(wave * 8 + b) * 64 + lane] = a[b];
    __syncthreads();
    { const int b = tid >> 6; float s = 0.f;
#pragma unroll
      for (int w = 0; w < 8; ++w) s += red[(w * 8 + b) * 64 + lane];
      ((float*)(wsp + WS_MOD))[(size_t)(l * 8 + b) * 6144 + cb * 64 + lane] = s + P.b_mod[l * 6144 + cb * 64 + lane]; }
    __syncthreads();
}
__device__ __forceinline__ void dsincos(double x, double& s, double& c) {
    const double x2 = x * x; double ts = x, tc = 1.0; s = x; c = 1.0;
#pragma unroll 1
    for (int k = 1; k <= 14; ++k) { tc = -tc * x2 / (double)((2 * k - 1) * (2 * k)); ts = -ts * x2 / (double)((2 * k) * (2 * k + 1)); c += tc; s += ts; }
}
__device__ __forceinline__ double dexp_small(double z) {
    double t = 1.0, r = 1.0;
#pragma unroll 1
    for (int k = 1; k <= 18; ++k) { t = t * z / (double)k; r += t; }
    return r;
}
__device__ __forceinline__ void s5_tables_item(const Params& P, LAS unsigned char* lds, int item4) {
    unsigned char* const wsp = opaque_ptr(P.ws);
    const int tid = opaque_tid(); const int item = item4 >> 2, qtr = item4 & 3; const int l = item >> 4, g = item & 15, lg = l * 16 + g;
    LAS float* pwr = (LAS float*)lds;
    LAS float* pwi = pwr + 64 * 65;
    LAS float* bbr = pwi + 64 * 65;
    LAS float* bbi = bbr + 1024;
    LAS float* ccr = bbi + 1024;
    LAS float* cci = ccr + 1024;
    if (tid < 64) { const int p = tid;
        const double are = (double)P.s5_a_re[lg * 64 + p], aim = (double)P.s5_a_im[lg * 64 + p];
        const double dt = (double)expf(P.s5_log_dt[lg]);
        const double mag = dexp_small(are * dt);
        double ang = aim * dt; const double TWO_PI = 6.283185307179586476925;
        ang -= TWO_PI * rint(ang / TWO_PI);
        double sn, cs; dsincos(ang, sn, cs);
        const double lbr = mag * cs, lbi = mag * sn;
        const double nr = lbr - 1.0, ni = lbi, den = are * are + aim * aim;
        const double cfr = (nr * are + ni * aim) / den, cfi = (ni * are - nr * aim) / den;
        double pr = 1.0, pi_ = 0.0;
        for (int t = 0; t <= 64; ++t) { pwr[p * 65 + t] = (float)pr; pwi[p * 65 + t] = (float)pi_; const double nr2 = pr * lbr - pi_ * lbi, ni2 = pr * lbi + pi_ * lbr; pr = nr2; pi_ = ni2; }
        for (int h = 0; h < 16; ++h) { const double br = (double)P.s5_b_re[(lg * 64 + p) * 16 + h], bi = (double)P.s5_b_im[(lg * 64 + p) * 16 + h];
            bbr[p * 16 + h] = (float)(cfr * br - cfi * bi); bbi[p * 16 + h] = (float)(cfr * bi + cfi * br); }
        float* l64 = (float*)(wsp + WS_LAM64) + (size_t)(lg * 64 + p) * 2;
        if (qtr == 0) { l64[0] = pwr[p * 65 + 64]; l64[1] = pwi[p * 65 + 64]; }
    }
    for (int i = tid; i < 1024; i += NTHREADS) { ccr[i] = P.s5_c_re[lg * 1024 + i]; cci[i] = P.s5_c_im[lg * 1024 + i]; }
    __syncthreads();
    bf16_t* kt = (bf16_t*)(wsp + WS_KTAB) + (size_t)lg * 65 * 256;
    for (int i = qtr * 16 * 256 + tid; i < (qtr == 3 ? 65 : 16 * (qtr + 1)) * 256; i += NTHREADS) { const int tau = i >> 8, h = (i >> 4) & 15, h2 = i & 15; float s = 0.f;
        if (tau < 64) {
            for (int p = 0; p < 64; ++p) { const float pr = pwr[p * 65 + tau], pi_ = pwi[p * 65 + tau], br = bbr[p * 16 + h2], bi = bbi[p * 16 + h2];
                const float wr_ = pr * br - pi_ * bi, wi_ = pr * bi + pi_ * br; s += ccr[h * 64 + p] * wr_ - cci[h * 64 + p] * wi_; }
            if (tau == 0 && h == h2) s += P.s5_d[l * 256 + g * 16 + h]; }
        kt[i] = (bf16_t)f2bf(s); }
    bf16_t* bp = (bf16_t*)(wsp + WS_BPOW) + (size_t)lg * 128 * 1024;
    for (int i = qtr * 32768 + tid; i < (qtr + 1) * 32768; i += NTHREADS) { const int q = i >> 10, s = (i >> 4) & 63, h2 = i & 15, p = q & 63;
        const float pr = pwr[p * 65 + 63 - s], pi_ = pwi[p * 65 + 63 - s], br = bbr[p * 16 + h2], bi = bbi[p * 16 + h2];
        const float v = (q < 64) ? (pr * br - pi_ * bi) : (pr * bi + pi_ * br);
        bp[(s * 128 + q) * 16 + h2] = (bf16_t)f2bf(v); }
    bf16_t* cp = (bf16_t*)(wsp + WS_CPOW) + (size_t)lg * 1024 * 128;
    for (int i = qtr * 32768 + tid; i < (qtr + 1) * 32768; i += NTHREADS) { const int q = i & 127, th = i >> 7, t = th >> 4, h = th & 15, p = q & 63;
        const float pr = pwr[p * 65 + t + 1], pi_ = pwi[p * 65 + t + 1], cr = ccr[h * 64 + p], ci = cci[h * 64 + p];
        const float v = (q < 64) ? (cr * pr - ci * pi_) : -(cr * pi_ + ci * pr);
        cp[((q >> 4) * 1024 + th) * 16 + (q & 15)] = (bf16_t)f2bf(v); }
    __syncthreads();
}
__device__ __forceinline__ void rope_table(const Params& P, int gtid, int gthreads) {
    unsigned char* const wsp = opaque_ptr(P.ws);
    float* rp = (float*)(wsp + WS_ROPE);
    for (int i = gtid; i < 4096 * 24; i += gthreads) { const int pos = i / 24, f = i % 24;
        double rev = (double)pos * P.inv_freq_rev[f]; rev -= rint(rev);
        double sn, cs; dsincos(rev * 6.283185307179586476925, sn, cs);
        rp[2 * i] = (float)cs; rp[2 * i + 1] = (float)sn; }
}
__device__ __forceinline__ void norm_row_store(const f32x4 (&v)[4], const float* nw, const float* modrow_sh, const float* modrow_sc, bf16_t* orow, int lane) {
    float ss = 0.f;
#pragma unroll
    for (int j = 0; j < 4; ++j) ss += (v[j][0] * v[j][0] + v[j][1] * v[j][1]) + (v[j][2] * v[j][2] + v[j][3] * v[j][3]);
    const float rstd = 1.0f / sqrtf(wave_sum(ss, lane) * (1.0f / 1024.0f) + NORM_EPS);
#pragma unroll
    for (int hf = 0; hf < 2; ++hf) { const int col = hf * 512 + 8 * lane; float o[8];
#pragma unroll
        for (int q = 0; q < 2; ++q) { const f32x4 w = *(const f32x4*)(nw + col + 4 * q), sc = *(const f32x4*)(modrow_sc + col + 4 * q), sh = *(const f32x4*)(modrow_sh + col + 4 * q);
#pragma unroll
            for (int e = 0; e < 4; ++e) o[4 * q + e] = v[hf * 2 + q][e] * rstd * w[e] * (1.0f + sc[e]) + sh[e]; }
        u32x4 w4; w4.x = pk2(o[0], o[1]); w4.y = pk2(o[2], o[3]); w4.z = pk2(o[4], o[5]); w4.w = pk2(o[6], o[7]);
        *(u32x4*)(orow + col) = w4; }
}

template <int KS>
__device__ __forceinline__ f32x16 mma32(LAS const unsigned char* A, int lda, LAS const unsigned char* B, int ldb, f32x16 acc, int lane) {
    const int r = lane & 31, h = lane >> 5;
#pragma unroll
    for (int ks = 0; ks < KS; ++ks) {
        const bf16x8 a = *(const LAS bf16x8*)(A + r * lda + ks * 32 + h * 16);
        const bf16x8 b = *(const LAS bf16x8*)(B + r * ldb + ks * 32 + h * 16);
        acc = __builtin_amdgcn_mfma_f32_32x32x16_bf16(a, b, acc, 0, 0, 0);
    }
    return acc;
}
__device__ __forceinline__ int crow(int reg, int lane) { return (reg & 3) + 8 * (reg >> 2) + 4 * (lane >> 5); }

constexpr int MA_QD = 0, MA_KI = 7168, MA_KET = 14336, MA_VT = 23552, MA_SLOT = 37376;
__device__ __forceinline__ bf16x8 frag_from(unsigned a, unsigned b, unsigned c, unsigned d) { const u32x4 v = {a, b, c, d}; return __builtin_bit_cast(bf16x8, v); }
struct MixPf { u32x4 v[3]; bf16x8 ga[2]; };
__device__ __forceinline__ void mixer_pf_load(const Params& P, int round, MixPf& pf) {
    unsigned char* const wsp = opaque_ptr(P.ws);
    const int tid = opaque_tid(), w = __builtin_amdgcn_readfirstlane(tid >> 6), lane = tid & 63, r = lane & 31, hh = lane >> 5;
    const int slot = w >> 2, wv = w & 3;
    const int item = 2 * round + slot, n = item & 63, h = (item >> 6) & 3, b = (item >> 8) & 7, type = item >> 11;
    const bf16_t* prow = (const bf16_t*)(wsp + WS_PROJ) + (size_t)(b * SEQ + n * 64) * NPROJP;
    const int cv = (type ? C_RV : C_GV) + h * 96, t4 = wv * 64 + lane;
#pragma unroll
    for (int jj = 0; jj < 3; ++jj) { const int p = t4 + 256 * jj, j = p / 12, c = p % 12; pf.v[jj] = *(const u32x4*)(prow + (size_t)j * NPROJP + cv + 8 * c); }
    if (type == 0) {
#pragma unroll
        for (int m2 = 0; m2 < 2; ++m2) pf.ga[m2] = *(const bf16x8*)(prow + (size_t)(32 * m2 + r) * NPROJP + C_GA + 8 * hh); }
}
__device__ __forceinline__ void mixer_phase_a(const Params& P, LAS unsigned char* lds, int l, int round, int next_round, MixPf& pf) {
    unsigned char* const wsp = opaque_ptr(P.ws);
    const int tid = opaque_tid(), w = __builtin_amdgcn_readfirstlane(tid >> 6), lane = tid & 63, r = lane & 31, hh = lane >> 5;
    const int slot = w >> 2, wv = w & 3, nt = wv & 1, mt = wv >> 1;
    const int item = 2 * round + slot, n = item & 63, h = (item >> 6) & 3, b = (item >> 8) & 7, type = item >> 11;
    LAS unsigned char* const L = lds + slot * MA_SLOT;
    const bf16_t* prow = (const bf16_t*)(wsp + WS_PROJ) + (size_t)(b * SEQ + n * 64) * NPROJP;
    const int cq = (type ? C_RQ : C_GQ) + h * 48, ck = (type ? C_RK : C_GK) + h * 48, cv = (type ? C_RV : C_GV) + h * 96;
    const int d = 32 * nt + r; const bool dvalid = d < 48;
    { const int t4 = wv * 64 + lane;
#pragma unroll
      for (int jj = 0; jj < 3; ++jj) { const int p = t4 + 256 * jj, j = p / 12, c = p % 12;
          const u32x4 vv = pf.v[jj];
          LAS bf16_t* dst = (LAS bf16_t*)(L + MA_VT + (8 * c) * 144 + j * 2);
          dst[0 * 72] = (bf16_t)(vv.x & 0xffff); dst[1 * 72] = (bf16_t)(vv.x >> 16); dst[2 * 72] = (bf16_t)(vv.y & 0xffff); dst[3 * 72] = (bf16_t)(vv.y >> 16);
          dst[4 * 72] = (bf16_t)(vv.z & 0xffff); dst[5 * 72] = (bf16_t)(vv.z >> 16); dst[6 * 72] = (bf16_t)(vv.w & 0xffff); dst[7 * 72] = (bf16_t)(vv.w >> 16); } }
    float qv[16], kv[16], cum[16], tot;
    if (type == 0) {
#pragma unroll
        for (int reg = 0; reg < 16; ++reg) { const int t = 32 * mt + crow(reg, lane); const bf16_t* pr = prow + (size_t)t * NPROJP;
            qv[reg] = dvalid ? bf2f(pr[cq + d]) * 0.14433756729740643f : 0.f; kv[reg] = dvalid ? bf2f(pr[ck + d]) : 0.f; }
        const bf16_t* wat = (const bf16_t*)(wsp + WS_WA2T) + (size_t)((l * 4 + h) * 64 + d) * 16 + 8 * hh;
        const bf16x8 waf = *(const bf16x8*)wat;
        const float bias = dvalid ? P.gla_b_a[l * 192 + h * 48 + d] : 0.f;
        unsigned xh[2][2][4];
#pragma unroll
        for (int m2 = 0; m2 < 2; ++m2) {
            const bf16x8 gaf = pf.ga[m2];
            f32x16 pre;
#pragma unroll
            for (int i = 0; i < 16; ++i) pre[i] = 0.f;
            pre = __builtin_amdgcn_mfma_f32_32x32x16_bf16(gaf, waf, pre, 0, 0, 0);
            float la[16];
#pragma unroll
            for (int reg = 0; reg < 16; ++reg) { const float x = pre[reg] + bias;
                const float ls2 = fminf(x, 0.f) * 1.4426950408889634f - __builtin_amdgcn_logf(1.0f + __builtin_amdgcn_exp2f(-1.4426950408889634f * fabsf(x)));
                la[reg] = dvalid ? ls2 * (1.0f / 16.0f) : 0.f; }
#pragma unroll
            for (int s2 = 0; s2 < 2; ++s2)
#pragma unroll
                for (int q = 0; q < 4; ++q) xh[m2][s2][q] = pk2(la[8 * s2 + 2 * q], la[8 * s2 + 2 * q + 1]);
        }
        f32x16 cacc, tacc;
#pragma unroll
        for (int i = 0; i < 16; ++i) { cacc[i] = 0.f; tacc[i] = 0.f; }
        const bf16x8 ones = frag_from(0x3F803F80u, 0x3F803F80u, 0x3F803F80u, 0x3F803F80u);
#pragma unroll
        for (int m2 = 0; m2 < 2; ++m2)
#pragma unroll
            for (int s2 = 0; s2 < 2; ++s2) {
                const bf16x8 fh = frag_from(xh[m2][s2][0], xh[m2][s2][1], xh[m2][s2][2], xh[m2][s2][3]);
                tacc = __builtin_amdgcn_mfma_f32_32x32x16_bf16(ones, fh, tacc, 0, 0, 0);
                if (m2 < mt) { cacc = __builtin_amdgcn_mfma_f32_32x32x16_bf16(ones, fh, cacc, 0, 0, 0); }
                else if (m2 == mt) { unsigned tw[4];
#pragma unroll
                    for (int q = 0; q < 4; ++q) { const int k0 = 16 * s2 + 8 * ((2 * q) >> 2) + 4 * hh + ((2 * q) & 3), k1 = 16 * s2 + 8 * ((2 * q + 1) >> 2) + 4 * hh + ((2 * q + 1) & 3);
                        tw[q] = (k0 <= r ? 0x3F80u : 0u) | (k1 <= r ? 0x3F800000u : 0u); }
                    const bf16x8 tri = frag_from(tw[0], tw[1], tw[2], tw[3]);
                    cacc = __builtin_amdgcn_mfma_f32_32x32x16_bf16(tri, fh, cacc, 0, 0, 0); }
            }
#pragma unroll
        for (int reg = 0; reg < 16; ++reg) cum[reg] = cacc[reg];
        tot = tacc[0];
    } else {
        const float lgam = P.log_gamma[h];
        const float* rope = (const float*)(wsp + WS_ROPE) + (size_t)(n * 64) * 48;
        const int dp = (d < 24) ? d + 24 : d - 24, f = (d < 24) ? d : d - 24;
#pragma unroll
        for (int reg = 0; reg < 16; ++reg) { const int t = 32 * mt + crow(reg, lane); const bf16_t* pr = prow + (size_t)t * NPROJP;
            float q0 = 0.f, q1 = 0.f, k0 = 0.f, k1 = 0.f, cs = 1.f, sn = 0.f;
            if (dvalid) { q0 = bf2f(pr[cq + d]); q1 = bf2f(pr[cq + dp]); k0 = bf2f(pr[ck + d]); k1 = bf2f(pr[ck + dp]); cs = rope[t * 48 + 2 * f]; sn = rope[t * 48 + 2 * f + 1]; }
            qv[reg] = (d < 24) ? (q0 * cs - q1 * sn) : (q1 * sn + q0 * cs);
            kv[reg] = ((d < 24) ? (k0 * cs - k1 * sn) : (k1 * sn + k0 * cs)) * 0.14433756729740643f;
            cum[reg] = (float)(t + 1) * lgam * 1.4426950408889634f; }
        tot = 64.0f * lgam * 1.4426950408889634f;
    }
    {
        bf16_t* qdg = (bf16_t*)(wsp + MXW_QD) + (size_t)item * 3072;
        float ke[16];
#pragma unroll
        for (int reg = 0; reg < 16; ++reg) { const int t = 32 * mt + crow(reg, lane);
            const float e1 = __builtin_amdgcn_exp2f(cum[reg]), e2 = __builtin_amdgcn_exp2f(-cum[reg]), e3 = __builtin_amdgcn_exp2f(tot - cum[reg]);
            const bf16_t qd = (bf16_t)f2bf(qv[reg] * e1), ki = (bf16_t)f2bf(kv[reg] * e2); ke[reg] = kv[reg] * e3;
            if (dvalid) { *(LAS bf16_t*)(L + MA_QD + t * 112 + d * 2) = qd; *(LAS bf16_t*)(L + MA_KI + t * 112 + d * 2) = ki; qdg[t * 48 + d] = qd; } }
#pragma unroll
        for (int g4 = 0; g4 < 4; ++g4) { const int t0 = 32 * mt + 8 * g4 + 4 * hh; u32x2 pk; pk.x = pk2(ke[4 * g4], ke[4 * g4 + 1]); pk.y = pk2(ke[4 * g4 + 2], ke[4 * g4 + 3]);
            *(LAS u32x2*)(L + MA_KET + d * 144 + t0 * 2) = pk; }
        if (mt == 0 && hh == 0 && dvalid) ((float*)(wsp + MXW_DEC))[(size_t)item * 48 + d] = __builtin_amdgcn_exp2f(tot);
    }
    if (next_round < 2048) mixer_pf_load(P, next_round, pf);
    __syncthreads();
    int rep3 = (TIME_PHASE == 41) ? 2 : 1; asm volatile("" : "+s"(rep3));
#pragma unroll 1
    for (int rq_ = 0; rq_ < rep3; ++rq_)
    {
        unsigned* oig = (unsigned*)(wsp + MXW_OI) + (size_t)item * 3072;
        bf16_t* dsg = (bf16_t*)(wsp + MXW_DS) + (size_t)item * 4608;
        f32x16 zero16;
#pragma unroll
        for (int i = 0; i < 16; ++i) zero16[i] = 0.f;
        const int it = (wv == 0) ? 0 : 1;
        f32x16 sd = mma32<3>(L + MA_KI + it * 32 * 112, 112, L + MA_QD + it * 32 * 112, 112, zero16, lane);
        unsigned xd[2][4];
#pragma unroll
        for (int s2 = 0; s2 < 2; ++s2)
#pragma unroll
            for (int q = 0; q < 4; ++q) { const int r0 = 8 * s2 + 2 * q; const float a0 = (crow(r0, lane) <= r) ? sd[r0] : 0.f, a1 = (crow(r0 + 1, lane) <= r) ? sd[r0 + 1] : 0.f; xd[s2][q] = pk2(a0, a1); }
        unsigned xo[2][4];
        if (it == 1) { const f32x16 so = mma32<3>(L + MA_KI, 112, L + MA_QD + 32 * 112, 112, zero16, lane);
#pragma unroll
            for (int s2 = 0; s2 < 2; ++s2)
#pragma unroll
                for (int q = 0; q < 4; ++q) xo[s2][q] = pk2(so[8 * s2 + 2 * q], so[8 * s2 + 2 * q + 1]); }
        const int nvt = (wv == 0) ? 3 : 1, vt0 = (wv == 0) ? 0 : wv - 1;
#pragma unroll 1
        for (int vi = 0; vi < nvt; ++vi) { const int vt = vt0 + vi;
            f32x16 oacc = zero16;
            LAS const unsigned char* vb = L + MA_VT + (32 * vt + r) * 144 + 8 * hh;
            if (it == 1) {
#pragma unroll
                for (int s2 = 0; s2 < 2; ++s2) { const u32x2 lo = *(const LAS u32x2*)(vb + 32 * s2), hi = *(const LAS u32x2*)(vb + 32 * s2 + 16);
                    oacc = __builtin_amdgcn_mfma_f32_32x32x16_bf16(frag_from(xo[s2][0], xo[s2][1], xo[s2][2], xo[s2][3]), frag_from(lo.x, lo.y, hi.x, hi.y), oacc, 0, 0, 0); } }
#pragma unroll
            for (int s2 = 0; s2 < 2; ++s2) { const u32x2 lo = *(const LAS u32x2*)(vb + 64 * it + 32 * s2), hi = *(const LAS u32x2*)(vb + 64 * it + 32 * s2 + 16);
                oacc = __builtin_amdgcn_mfma_f32_32x32x16_bf16(frag_from(xd[s2][0], xd[s2][1], xd[s2][2], xd[s2][3]), frag_from(lo.x, lo.y, hi.x, hi.y), oacc, 0, 0, 0); }
#pragma unroll
            for (int q = 0; q < 8; ++q) oig[((it * 3 + vt) * 8 + q) * 64 + lane] = pk2(oacc[2 * q], oacc[2 * q + 1]);
            const int dt = (wv == 0) ? 1 : 0;
            const f32x16 ds = mma32<4>(L + MA_KET + dt * 32 * 144, 144, L + MA_VT + vt * 32 * 144, 144, zero16, lane);
#pragma unroll
            for (int g4 = 0; g4 < 4; ++g4) { const int d0 = 32 * dt + 8 * g4 + 4 * hh;
                if (d0 < 48) { u32x2 o; o.x = pk2(ds[4 * g4], ds[4 * g4 + 1]); o.y = pk2(ds[4 * g4 + 2], ds[4 * g4 + 3]); *(u32x2*)(dsg + (32 * vt + r) * 48 + d0) = o; } }
        }
    }
    __syncthreads();
}
__device__ __forceinline__ void mixer_phase_b(const Params& P, int bid, int G) {
    unsigned char* const wsp = opaque_ptr(P.ws);
    const int tid = opaque_tid();
    for (int task = bid * NTHREADS + tid; task < 64 * 1152; task += G * NTHREADS) {
        const int seq = task / 1152, q4 = task % 1152, d0 = (q4 % 12) * 4;
        const bf16_t* dsp = (const bf16_t*)(wsp + MXW_DS) + (size_t)seq * 64 * 4608 + q4 * 4;
        const float* dcp = (const float*)(wsp + MXW_DEC) + (size_t)seq * 64 * 48 + d0;
        bf16_t* spp = (bf16_t*)(wsp + MXW_SP) + (size_t)seq * 64 * 4608 + q4 * 4;
        u32x2 dsv[64];
#pragma unroll
        for (int n = 0; n < 64; ++n) dsv[n] = *(const u32x2*)(dsp + (size_t)n * 4608);
        f32x4 st = {0.f, 0.f, 0.f, 0.f};
#pragma unroll
        for (int n = 0; n < 64; ++n) { const f32x4 dc = *(const f32x4*)(dcp + n * 48);
            u32x2 pk; pk.x = pk2(st[0], st[1]); pk.y = pk2(st[2], st[3]); *(u32x2*)(spp + (size_t)n * 4608) = pk;
            st[0] = dc[0] * st[0] + bflo(dsv[n].x); st[1] = dc[1] * st[1] + bfhi(dsv[n].x); st[2] = dc[2] * st[2] + bflo(dsv[n].y); st[3] = dc[3] * st[3] + bfhi(dsv[n].y); }
    }
}
__device__ __forceinline__ void mixer_phase_c(const Params& P, LAS unsigned char* lds, int l, int item) {
    unsigned char* const wsp = opaque_ptr(P.ws);
    const int tid = opaque_tid(), w = __builtin_amdgcn_readfirstlane(tid >> 6), lane = tid & 63, r = lane & 31, hh = lane >> 5;
    LAS float* const Lw = (LAS float*)(lds + w * 12800);
    const int n = item & 63, h = (item >> 6) & 3, b = (item >> 8) & 7, type = item >> 11;
    const size_t tok0 = (size_t)b * SEQ + n * 64;
    const unsigned* oig = (const unsigned*)(wsp + MXW_OI) + (size_t)item * 3072;
    const bf16_t* qdg = (const bf16_t*)(wsp + MXW_QD) + (size_t)item * 3072 + 8 * hh;
    const bf16_t* spg = (const bf16_t*)(wsp + MXW_SP) + (size_t)item * 4608 + 8 * hh;
    const int rq = lane >> 2, q4 = lane & 3;
    const bf16_t* gp = (const bf16_t*)(wsp + WS_PROJ) + tok0 * NPROJP + (type ? C_RG : C_GG) + h * 96 + 24 * q4;
    bf16_t* mp = (bf16_t*)(wsp + WS_MIXED) + tok0 * 1024 + type * 384 + h * 96 + 24 * q4;
    const float* nw = (type ? P.ret_norm_w : P.gla_norm_w) + l * 384 + h * 96 + 24 * q4;
    f32x16 acc[2][3];
#pragma unroll
    for (int it = 0; it < 2; ++it)
#pragma unroll
        for (int vt = 0; vt < 3; ++vt)
#pragma unroll
            for (int q = 0; q < 8; ++q) { const unsigned u = oig[((it * 3 + vt) * 8 + q) * 64 + lane]; acc[it][vt][2 * q] = bflo(u); acc[it][vt][2 * q + 1] = bfhi(u); }
#pragma unroll
    for (int ks = 0; ks < 3; ++ks) {
        const bf16x8 a0 = *(const bf16x8*)(qdg + r * 48 + ks * 16), a1 = *(const bf16x8*)(qdg + (32 + r) * 48 + ks * 16);
#pragma unroll
        for (int vt = 0; vt < 3; ++vt) { const bf16x8 bb = *(const bf16x8*)(spg + (32 * vt + r) * 48 + ks * 16);
            acc[0][vt] = __builtin_amdgcn_mfma_f32_32x32x16_bf16(a0, bb, acc[0][vt], 0, 0, 0);
            acc[1][vt] = __builtin_amdgcn_mfma_f32_32x32x16_bf16(a1, bb, acc[1][vt], 0, 0, 0); } }
    f32x4 nwv[6];
#pragma unroll
    for (int q = 0; q < 6; ++q) nwv[q] = *(const f32x4*)(nw + 4 * q);
    u32x4 gall[4][3];
#pragma unroll
    for (int p4 = 0; p4 < 4; ++p4)
#pragma unroll
        for (int q = 0; q < 3; ++q) gall[p4][q] = *(const u32x4*)(gp + (size_t)(16 * p4 + rq) * NPROJP + 8 * q);
#pragma unroll
    for (int it = 0; it < 2; ++it) {
#pragma unroll
        for (int vt = 0; vt < 3; ++vt)
#pragma unroll
            for (int reg = 0; reg < 16; ++reg) Lw[crow(reg, lane) * 100 + 32 * vt + r] = acc[it][vt][reg];
        LDS_WAIT(); asm volatile("" ::: "memory");
#pragma unroll
        for (int ps = 0; ps < 2; ++ps) { const int rl = 16 * ps + rq, i = 32 * it + rl;
            f32x4 x[6]; u32x4 gw[3];
#pragma unroll
            for (int q = 0; q < 6; ++q) x[q] = *(const LAS f32x4*)(Lw + rl * 100 + 24 * q4 + 4 * q);
#pragma unroll
            for (int q = 0; q < 3; ++q) gw[q] = gall[it * 2 + ps][q];
            if (type == 1) { float sm = 0.f;
#pragma unroll
                for (int q = 0; q < 6; ++q) sm += (x[q][0] + x[q][1]) + (x[q][2] + x[q][3]);
                sm += lx_f(sm, lane, 1); sm += lx_f(sm, lane, 2);
                const float mean = sm * (1.0f / 96.0f);
#pragma unroll
                for (int q = 0; q < 6; ++q) x[q] = x[q] - mean; }
            float ss = 0.f;
#pragma unroll
            for (int q = 0; q < 6; ++q) ss += (x[q][0] * x[q][0] + x[q][1] * x[q][1]) + (x[q][2] * x[q][2] + x[q][3] * x[q][3]);
            ss += lx_f(ss, lane, 1); ss += lx_f(ss, lane, 2);
            const float rstd = 1.0f / sqrtf(ss * (1.0f / 96.0f) + NORM_EPS);
#pragma unroll
            for (int q = 0; q < 3; ++q) { const f32x4 xa = x[2 * q] * nwv[2 * q] * rstd, xb = x[2 * q + 1] * nwv[2 * q + 1] * rstd; const u32x4 g = gw[q];
                u32x4 o;
                o.x = pk2(xa[0] * siluf(bflo(g.x)), xa[1] * siluf(bfhi(g.x))); o.y = pk2(xa[2] * siluf(bflo(g.y)), xa[3] * siluf(bfhi(g.y)));
                o.z = pk2(xb[0] * siluf(bflo(g.z)), xb[1] * siluf(bfhi(g.z))); o.w = pk2(xb[2] * siluf(bflo(g.w)), xb[3] * siluf(bfhi(g.w)));
                *(u32x4*)(mp + (size_t)i * 1024 + 8 * q) = o; } }
        LDS_WAIT(); asm volatile("" ::: "memory");
    }
}

constexpr int S5_KT = 0, S5_U0 = 33280, S5_UB = 64 * 528, S5_EB = S5_U0 + 2 * S5_UB, S5_CY = S5_EB + 32768;
__device__ __forceinline__ float gelu_tanh(float x) { const float u = 0.7978845608028654f * (x + 0.044715f * x * x * x); const float e = __expf(2.0f * u); const float th = 1.0f - 2.0f / (e + 1.0f); return 0.5f * x * (1.0f + th); }
__device__ __forceinline__ void s5_item(const Params& P, LAS unsigned char* lds, int l, int item) {
    unsigned char* const wsp = opaque_ptr(P.ws);
    const int tid = opaque_tid(), w = __builtin_amdgcn_readfirstlane(tid >> 6), lane = tid & 63, r = lane & 31, hh = lane >> 5;
    const int half = item & 1, b = item >> 5, g = (item >> 1) & 15, lg = l * 16 + g;
    const bf16_t* ub = (const bf16_t*)(wsp + WS_SU2) + (size_t)(b * 16 + g) * 4096 * 16 + 8 * hh;
    const bf16_t* ktg = (const bf16_t*)(wsp + WS_KTAB) + (size_t)lg * 65 * 256;
    const bf16_t* bpw = (const bf16_t*)(wsp + WS_BPOW) + (size_t)lg * 128 * 1024 + (size_t)((w & 3) * 32 + r) * 16 + 8 * hh;
    const bf16_t* cpw = (const bf16_t*)(wsp + WS_CPOW) + (size_t)lg * 1024 * 128;
    { int rp = (TIME_PHASE == 44) ? 3 : 1; asm volatile("" : "+s"(rp));
#pragma unroll 1
      for (int q_ = 0; q_ < rp; ++q_) { for (int p = tid; p < 2080; p += NTHREADS) *(LAS u32x4*)(lds + S5_KT + p * 16) = *(const u32x4*)(ktg + p * 8);
    __syncthreads(); } }
    f32x16 acc[2][2], eacc;
    const int nt0 = half ? (w + 8) : w, nt1 = half ? (w + 16) : (w + 24);
#pragma unroll
    for (int j = 0; j < 2; ++j)
#pragma unroll
        for (int mt = 0; mt < 2; ++mt)
#pragma unroll
            for (int i = 0; i < 16; ++i) acc[j][mt][i] = 0.f;
#pragma unroll
    for (int i = 0; i < 16; ++i) eacc[i] = 0.f;
    const int emt = w >> 2;
    const bf16_t* ug = (const bf16_t*)(wsp + WS_SU2) + (size_t)(b * 16 + g) * 4096 * 16;
    u32x4 pfu[4];
#define S5_GLOAD(gi) do { _Pragma("unroll") for (int j_ = 0; j_ < 4; ++j_) { const int p_ = tid + NTHREADS * j_; pfu[j_] = *(const u32x4*)(ug + (size_t)((p_ >> 5) * 64 + 16 * (gi)) * 16 + (p_ & 31) * 8); } } while (0)
#define S5_GWRITE(bufoff) do { _Pragma("unroll") for (int j_ = 0; j_ < 4; ++j_) { const int p_ = tid + NTHREADS * j_; *(LAS u32x4*)(lds + (bufoff) + (p_ >> 5) * 528 + (p_ & 31) * 16) = pfu[j_]; } } while (0)
#define S5_STEP(A0, A1, BP, s) do { \
        _Pragma("unroll") for (int j = 0; j < 2; ++j) { const int t0 = 2 * (j ? nt1 : nt0); \
            if (t0 + 1 >= (s)) { const int tt = t0 + (r >> 4); const int tau = tt - (s); const int slot = tau < 0 ? 64 : tau; \
                const bf16x8 kb = *(const LAS bf16x8*)(lds + S5_KT + slot * 512 + (lane & 15) * 32 + hh * 16); \
                acc[j][0] = __builtin_amdgcn_mfma_f32_32x32x16_bf16(A0, kb, acc[j][0], 0, 0, 0); \
                acc[j][1] = __builtin_amdgcn_mfma_f32_32x32x16_bf16(A1, kb, acc[j][1], 0, 0, 0); } } \
        eacc = __builtin_amdgcn_mfma_f32_32x32x16_bf16(emt ? A1 : A0, BP, eacc, 0, 0, 0); } while (0)
    S5_GLOAD(0); S5_GWRITE(S5_U0);
    __syncthreads();
#pragma unroll 1
    for (int gi = 0; gi < 4; ++gi) {
        if (gi < 3) S5_GLOAD(gi + 1);
        LAS const unsigned char* ubuf = lds + S5_U0 + (gi & 1) * S5_UB + r * 528 + hh * 16;
        bf16x8 rbp[4];
#pragma unroll
        for (int u = 0; u < 4; ++u) rbp[u] = *(const bf16x8*)(bpw + (16 * gi + u) * 2048);
#pragma unroll
        for (int q4 = 0; q4 < 4; ++q4) {
#pragma unroll
            for (int u = 0; u < 4; ++u) { const int sl = 4 * q4 + u, s = 16 * gi + sl;
                const bf16x8 a0 = *(const LAS bf16x8*)(ubuf + sl * 32), a1 = *(const LAS bf16x8*)(ubuf + 32 * 528 + sl * 32);
                S5_STEP(a0, a1, rbp[u], s);
                if (q4 < 3) rbp[u] = *(const bf16x8*)(bpw + (s + 4) * 2048); }
        }
        if (gi < 3) { S5_GWRITE(S5_U0 + ((gi + 1) & 1) * S5_UB); __syncthreads(); }
    }
#undef S5_GLOAD
#undef S5_GWRITE
#undef S5_STEP
#pragma unroll
    for (int reg = 0; reg < 16; ++reg) ((LAS float*)(lds + S5_EB))[(emt * 32 + crow(reg, lane)) * 128 + (w & 3) * 32 + r] = eacc[reg];
    __syncthreads();
    { int rp = (TIME_PHASE == 42) ? 3 : 1; asm volatile("" : "+s"(rp));
#pragma unroll 1
    for (int q_ = 0; q_ < rp; ++q_)
    if (tid < 64) { const int p = tid; const float* l64 = (const float*)(wsp + WS_LAM64) + (size_t)(lg * 64 + p) * 2; const float ar = l64[0], ai = l64[1];
        float cr = 0.f, ci = 0.f;
#pragma unroll 1
        for (int n = 0; n < 64; ++n) {
            *(LAS bf16_t*)(lds + S5_CY + n * 272 + p * 2) = (bf16_t)f2bf(cr); *(LAS bf16_t*)(lds + S5_CY + n * 272 + (64 + p) * 2) = (bf16_t)f2bf(ci);
            const float er = ((const LAS float*)(lds + S5_EB))[n * 128 + p], ei = ((const LAS float*)(lds + S5_EB))[n * 128 + 64 + p];
            const float nr = ar * cr - ai * ci + er, ni = ar * ci + ai * cr + ei; cr = nr; ci = ni; } } }
    __syncthreads();
#pragma unroll
    for (int j = 0; j < 2; ++j) { const bf16_t* cpr = cpw + (size_t)((j ? nt1 : nt0) * 32 + r) * 16 + 8 * hh;
#pragma unroll
        for (int ks = 0; ks < 8; ++ks) { const bf16x8 cb = *(const bf16x8*)(cpr + ks * 16384);
            const bf16x8 c0 = *(const LAS bf16x8*)(lds + S5_CY + r * 272 + ks * 32 + hh * 16), c1 = *(const LAS bf16x8*)(lds + S5_CY + (32 + r) * 272 + ks * 32 + hh * 16);
            acc[j][0] = __builtin_amdgcn_mfma_f32_32x32x16_bf16(c0, cb, acc[j][0], 0, 0, 0);
            acc[j][1] = __builtin_amdgcn_mfma_f32_32x32x16_bf16(c1, cb, acc[j][1], 0, 0, 0); } }
    bf16_t* yb = (bf16_t*)(wsp + WS_YBUF) + (size_t)b * SEQ * 256 + g * 16 + (lane & 15);
    int rpe = (TIME_PHASE == 43) ? 3 : 1; asm volatile("" : "+s"(rpe));
#pragma unroll 1
    for (int q_ = 0; q_ < rpe; ++q_)
#pragma unroll
    for (int j = 0; j < 2; ++j) { const int tt = 2 * (j ? nt1 : nt0) + (r >> 4);
#pragma unroll
        for (int mt = 0; mt < 2; ++mt)
#pragma unroll
            for (int reg = 0; reg < 16; ++reg) { const int n = mt * 32 + crow(reg, lane);
                yb[(size_t)(n * 64 + tt) * 256] = (bf16_t)f2bf(gelu_tanh(acc[j][mt][reg])); } }
    __syncthreads();
}

constexpr int RT_SC = 0, RT_SH = 4096, RT_RS = 8192, RT_PART = 8704, RT_CNT = 8704 + 2 * 128 * 33 * 4, RT_BASE = RT_CNT + 128, RT_TE = RT_BASE + 128, RT_TG = RT_TE + 2048, RT_TR = RT_TG + 2048;
__device__ __forceinline__ void router_phase(const Params& P, LAS unsigned char* lds, int l, int blk) {
    unsigned char* const wsp = opaque_ptr(P.ws);
    const int tid = opaque_tid(), w = __builtin_amdgcn_readfirstlane(tid >> 6), lane = tid & 63, r = lane & 31, hh = lane >> 5;
    const float* x = (const float*)(wsp + WS_X);
    bf16_t* hdn = (bf16_t*)(wsp + WS_HDN);
    const int tok0 = blk * 128, b = tok0 >> 12;
    const float* mrow = (const float*)(wsp + WS_MOD) + (size_t)(l * 8 + b) * 6144;
    int* gcount = (int*)(wsp + WS_CTL) + l * 32;
    int* stok = (int*)(wsp + WS_STOK); float* sgate = (float*)(wsp + WS_SGATE);
    LAS float* scL = (LAS float*)(lds + RT_SC); LAS float* shL = (LAS float*)(lds + RT_SH); LAS float* rsL = (LAS float*)(lds + RT_RS);
    for (int i = tid; i < 1024; i += NTHREADS) { scL[i] = P.norm2_w[l * 1024 + i] * (1.0f + mrow[4096 + i]); shL[i] = mrow[3072 + i]; }
    if (tid < 32) ((LAS int*)(lds + RT_CNT))[tid] = 0;
    __syncthreads();
    {
        f32x4 sc[4], sh[4];
#pragma unroll
        for (int j = 0; j < 4; ++j) { sc[j] = *(const LAS f32x4*)(scL + 4 * lane + 256 * j); sh[j] = *(const LAS f32x4*)(shL + 4 * lane + 256 * j); }
#pragma unroll 1
        for (int t4 = 0; t4 < 16; t4 += 4) {
            f32x4 v[4][4]; float ss[4];
#pragma unroll
            for (int u = 0; u < 4; ++u) { const size_t tok = (size_t)(tok0 + w * 16 + t4 + u);
#pragma unroll
                for (int j = 0; j < 4; ++j) v[u][j] = *(const f32x4*)(x + tok * 1024 + 4 * lane + 256 * j); }
#pragma unroll
            for (int u = 0; u < 4; ++u) { float a_ = 0.f;
#pragma unroll
                for (int j = 0; j < 4; ++j) a_ += (v[u][j][0] * v[u][j][0] + v[u][j][1] * v[u][j][1]) + (v[u][j][2] * v[u][j][2] + v[u][j][3] * v[u][j][3]);
                ss[u] = a_; }
#pragma unroll
            for (int o = 1; o < 64; o <<= 1) {
#pragma unroll
                for (int u = 0; u < 4; ++u) ss[u] += lx_f(ss[u], lane, o); }
#pragma unroll
            for (int u = 0; u < 4; ++u) { const int tl = w * 16 + t4 + u; const size_t tok = (size_t)(tok0 + tl);
                const float rstd = 1.0f / sqrtf(ss[u] * (1.0f / 1024.0f) + NORM_EPS);
                if (lane == 0) rsL[tl] = rstd;
#pragma unroll
                for (int j = 0; j < 4; ++j) { const f32x4 hv = v[u][j] * rstd * sc[j] + sh[j]; u32x2 pk; pk.x = pk2(hv[0], hv[1]); pk.y = pk2(hv[2], hv[3]);
                    *(u32x2*)(hdn + tok * 1024 + 4 * lane + 256 * j) = pk; } } }
    }
    __syncthreads();
    {
        const int mt = w & 3, kh = w >> 2;
        const float* xr = x + (size_t)(tok0 + 32 * mt + r) * 1024 + 512 * kh + 8 * hh;
        const bf16_t* wt = (const bf16_t*)(wsp + WS_RWT) + (size_t)l * 2 * 32 * 1024 + (size_t)(32 * kh) * 512 + r * 16 + 8 * hh;
        const float rs = rsL[32 * mt + r];
        f32x16 acc;
#pragma unroll
        for (int i = 0; i < 16; ++i) acc[i] = 0.f;
#pragma unroll 8
        for (int ks = 0; ks < 32; ++ks) {
            const f32x4 x0 = *(const f32x4*)(xr + 16 * ks), x1 = *(const f32x4*)(xr + 16 * ks + 4);
            const int kk = 512 * kh + 16 * ks + 8 * hh;
            const f32x4 c0 = *(const LAS f32x4*)(scL + kk), c1 = *(const LAS f32x4*)(scL + kk + 4), s0 = *(const LAS f32x4*)(shL + kk), s1 = *(const LAS f32x4*)(shL + kk + 4);
            const f32x4 h0 = x0 * rs * c0 + s0, h1 = x1 * rs * c1 + s1;
            unsigned ah[4], al[4];
            ah[0] = pk2(h0[0], h0[1]); ah[1] = pk2(h0[2], h0[3]); ah[2] = pk2(h1[0], h1[1]); ah[3] = pk2(h1[2], h1[3]);
            al[0] = pk2(h0[0] - bflo(ah[0]), h0[1] - bfhi(ah[0])); al[1] = pk2(h0[2] - bflo(ah[1]), h0[3] - bfhi(ah[1]));
            al[2] = pk2(h1[0] - bflo(ah[2]), h1[1] - bfhi(ah[2])); al[3] = pk2(h1[2] - bflo(ah[3]), h1[3] - bfhi(ah[3]));
            const bf16x8 bh = *(const bf16x8*)(wt + 512 * ks), bl = *(const bf16x8*)(wt + 32 * 1024 + 512 * ks);
            const bf16x8 fah = frag_from(ah[0], ah[1], ah[2], ah[3]), fal = frag_from(al[0], al[1], al[2], al[3]);
            acc = __builtin_amdgcn_mfma_f32_32x32x16_bf16(fah, bh, acc, 0, 0, 0);
            acc = __builtin_amdgcn_mfma_f32_32x32x16_bf16(fah, bl, acc, 0, 0, 0);
            acc = __builtin_amdgcn_mfma_f32_32x32x16_bf16(fal, bh, acc, 0, 0, 0);
        }
        LAS float* part = (LAS float*)(lds + RT_PART) + kh * 128 * 33;
#pragma unroll
        for (int reg = 0; reg < 16; ++reg) part[(32 * mt + crow(reg, lane)) * 33 + r] = acc[reg];
    }
    __syncthreads();
    if (tid < 128) {
        const LAS float* p0 = (const LAS float*)(lds + RT_PART) + tid * 33; const LAS float* p1 = p0 + 128 * 33;
        float v0 = -3.0e38f, v1 = -3.0e38f, v2 = -3.0e38f, v3 = -3.0e38f; int e0 = 0, e1 = 0, e2 = 0, e3 = 0;
#pragma unroll
        for (int e = 0; e < 32; ++e) { const float lg = p0[e] + p1[e] + P.router_b[l * 32 + e];
            if (lg > v3) { if (lg > v2) { v3 = v2; e3 = e2; if (lg > v1) { v2 = v1; e2 = e1; if (lg > v0) { v1 = v0; e1 = e0; v0 = lg; e0 = e; } else { v1 = lg; e1 = e; } } else { v2 = lg; e2 = e; } } else { v3 = lg; e3 = e; } } }
        const float x1 = __expf(v1 - v0), x2 = __expf(v2 - v0), x3 = __expf(v3 - v0), inv = 1.0f / (1.0f + x1 + x2 + x3);
        LAS int* cnt = (LAS int*)(lds + RT_CNT);
        LAS int* te = (LAS int*)(lds + RT_TE) + tid * 4; LAS float* tg = (LAS float*)(lds + RT_TG) + tid * 4; LAS int* tr = (LAS int*)(lds + RT_TR) + tid * 4;
        te[0] = e0; te[1] = e1; te[2] = e2; te[3] = e3; tg[0] = inv; tg[1] = x1 * inv; tg[2] = x2 * inv; tg[3] = x3 * inv;
        tr[0] = __hip_atomic_fetch_add(cnt + e0, 1, __ATOMIC_RELAXED, __HIP_MEMORY_SCOPE_WORKGROUP); tr[1] = __hip_atomic_fetch_add(cnt + e1, 1, __ATOMIC_RELAXED, __HIP_MEMORY_SCOPE_WORKGROUP);
        tr[2] = __hip_atomic_fetch_add(cnt + e2, 1, __ATOMIC_RELAXED, __HIP_MEMORY_SCOPE_WORKGROUP); tr[3] = __hip_atomic_fetch_add(cnt + e3, 1, __ATOMIC_RELAXED, __HIP_MEMORY_SCOPE_WORKGROUP);
    }
    __syncthreads();
    if (tid < 32) ((LAS int*)(lds + RT_BASE))[tid] = atomicAdd(gcount + tid, ((LAS int*)(lds + RT_CNT))[tid]);
    __syncthreads();
    { const int e = ((LAS int*)(lds + RT_TE))[tid]; const int pos = ((LAS int*)(lds + RT_BASE))[e] + ((LAS int*)(lds + RT_TR))[tid];
      stok[e * CAP + pos] = (tok0 + (tid >> 2)) * 4 + (tid & 3); sgate[e * CAP + pos] = ((LAS float*)(lds + RT_TG))[tid]; }
    __syncthreads();
}

__device__ __forceinline__ void combine_phase(const Params& P, int l, int gw, int ngw, int lane_in) {
    unsigned char* const wsp = opaque_ptr(P.ws);
    int lane = lane_in; asm volatile("" : "+v"(lane));
    float* x = (float*)(wsp + WS_X);
    const bf16_t* outr = (const bf16_t*)(wsp + WS_OUTR);
    bf16_t* hdn = (bf16_t*)(wsp + WS_HDN);
    for (int tokp = gw; tokp < T_TOK / 2; tokp += ngw) {
        u32x4 rr[2][2][4]; f32x4 xv[2][4];
#pragma unroll
        for (int u = 0; u < 2; ++u) { const size_t tok = (size_t)(2 * tokp + u);
#pragma unroll
            for (int hf = 0; hf < 2; ++hf) { const int col = hf * 512 + 8 * lane;
#pragma unroll
                for (int k = 0; k < 4; ++k) rr[u][hf][k] = *(const u32x4*)(outr + (tok * 4 + k) * 1024 + col);
                xv[u][hf * 2] = *(const f32x4*)(x + tok * 1024 + col); xv[u][hf * 2 + 1] = *(const f32x4*)(x + tok * 1024 + col + 4); } }
#pragma unroll
        for (int u = 0; u < 2; ++u) { const int tok = 2 * tokp + u; const int b = tok >> 12;
            const float* mrow = (const float*)(wsp + WS_MOD) + (size_t)(l * 8 + b) * 6144;
            f32x4 v[4];
#pragma unroll
            for (int hf = 0; hf < 2; ++hf) { const int col = hf * 512 + 8 * lane;
                float s[8];
#pragma unroll
                for (int e = 0; e < 8; ++e) s[e] = 0.f;
#pragma unroll
                for (int k = 0; k < 4; ++k) { const u32x4 r4 = rr[u][hf][k];
                    s[0] += bflo(r4.x); s[1] += bfhi(r4.x); s[2] += bflo(r4.y); s[3] += bfhi(r4.y); s[4] += bflo(r4.z); s[5] += bfhi(r4.z); s[6] += bflo(r4.w); s[7] += bfhi(r4.w); }
#pragma unroll
                for (int q = 0; q < 2; ++q) { const f32x4 x4 = xv[u][hf * 2 + q], g2 = *(const f32x4*)(mrow + 5120 + col + 4 * q);
                    f32x4 o; o[0] = x4[0] + g2[0] * s[4 * q]; o[1] = x4[1] + g2[1] * s[4 * q + 1]; o[2] = x4[2] + g2[2] * s[4 * q + 2]; o[3] = x4[3] + g2[3] * s[4 * q + 3];
                    v[hf * 2 + q] = o; if (l + 1 < NLAYER) *(f32x4*)(x + (size_t)tok * 1024 + col + 4 * q) = o; } }
            if (l + 1 < NLAYER) {
                const float* mnext = (const float*)(wsp + WS_MOD) + (size_t)((l + 1) * 8 + b) * 6144;
                norm_row_store(v, P.norm1_w + (l + 1) * 1024, mnext, mnext + 1024, hdn + (size_t)tok * 1024, lane);
            } else {
                float ss = 0.f;
#pragma unroll
                for (int j = 0; j < 4; ++j) ss += (v[j][0] * v[j][0] + v[j][1] * v[j][1]) + (v[j][2] * v[j][2] + v[j][3] * v[j][3]);
                const float rstd = 1.0f / sqrtf(wave_sum(ss, lane) * (1.0f / 1024.0f) + NORM_EPS);
#pragma unroll
                for (int hf = 0; hf < 2; ++hf)
#pragma unroll
                    for (int q = 0; q < 2; ++q) { const int col = hf * 512 + 8 * lane + 4 * q; const f32x4 fw = *(const f32x4*)(P.final_norm_w + col);
                        f32x4 o; o[0] = v[hf * 2 + q][0] * rstd * fw[0]; o[1] = v[hf * 2 + q][1] * rstd * fw[1]; o[2] = v[hf * 2 + q][2] * rstd * fw[2]; o[3] = v[hf * 2 + q][3] * rstd * fw[3];
                        *(f32x4*)(P.out + (size_t)tok * 1024 + col) = o; }
            }
        }
    }
}

#define XB_TMO      128
#define XB_XCNT(j)  (256  + 64 * (j))
#define XB_XSUB(j)  (1280 + 64 * (j))
#define XB_XGEN(j)  (2304 + 64 * (j))
#define XB_TOP      3328
#define XB_TOPGEN   3392
#define XCD_BAR_WORDS 3456
#define XB_SPIN_CAP (1u << 22)
__device__ __forceinline__ unsigned xb_ld(unsigned* p)              { return __hip_atomic_load(p, __ATOMIC_RELAXED, __HIP_MEMORY_SCOPE_AGENT); }
__device__ __forceinline__ unsigned xb_add(unsigned* p, unsigned v) { return __hip_atomic_fetch_add(p, v, __ATOMIC_RELAXED, __HIP_MEMORY_SCOPE_AGENT); }
__device__ __forceinline__ unsigned xb_xcc_id() { return (unsigned)__builtin_amdgcn_s_getreg((3 << 11) | 20) & 0xFu; }
#define XB_SPIN(cond, bar) do { unsigned _sp = 0; while (cond) { __builtin_amdgcn_s_sleep(1); \
    if ((++_sp & 255u) == 0u) { if (xb_ld(&(bar)[XB_TMO])) break; if (_sp > XB_SPIN_CAP) { atomicAdd(&(bar)[XB_TMO], 1u); break; } } } } while (0)
struct XcdBarrier { unsigned* bar; unsigned x; volatile LAS unsigned* st; };
__device__ __forceinline__ XcdBarrier xcd_barrier_post(unsigned* bar, volatile LAS unsigned* st) {
    XcdBarrier b; b.bar = bar; b.x = xb_xcc_id(); b.st = st;
    if (threadIdx.x == 0) (void)xb_add(&bar[XB_XCNT(b.x)], 1u);
    return b;
}
__device__ __forceinline__ void xcd_barrier_complete(unsigned* bar, unsigned x, unsigned& nloc, unsigned& nx) {
    const unsigned G = gridDim.x * gridDim.y * gridDim.z;
    unsigned sum, cnt, mine, sp = 0u;
    for (;;) {
        sum = 0u; cnt = 0u; mine = 0u;
#pragma unroll
        for (unsigned j = 0; j < 16; ++j) { const unsigned c = xb_ld(&bar[XB_XCNT(j)]); sum += c; cnt += (c > 0u) ? 1u : 0u; mine = (j == x) ? c : mine; }
        if (sum == G) break;
        __builtin_amdgcn_s_sleep(1);
        if ((++sp & 255u) == 0u) { if (xb_ld(&bar[XB_TMO])) break; if (sp > XB_SPIN_CAP) { atomicAdd(&bar[XB_TMO], 1u); break; } }
    }
    nloc = mine > 0u ? mine : 1u; nx = cnt > 0u ? cnt : 1u;
}
__device__ __forceinline__ void xcd_barrier(const XcdBarrier& b) {
    asm volatile("s_waitcnt vmcnt(0)" ::: "memory");
    __syncthreads();
    if (threadIdx.x == 0) {
        unsigned* bar = b.bar;
        __builtin_amdgcn_s_waitcnt(0);
        unsigned nloc = b.st[0], nx = b.st[1];
        if (nloc == 0u) { xcd_barrier_complete(bar, b.x, nloc, nx); b.st[0] = nloc; b.st[1] = nx; }
        const unsigned old = xb_add(&bar[XB_XSUB(b.x)], 1u);
        const unsigned gen = old / nloc;
        if (old + 1u == (gen + 1u) * nloc) {
            __builtin_amdgcn_fence(__ATOMIC_RELEASE, "agent");
            asm volatile("s_waitcnt vmcnt(0)" ::: "memory");
            const unsigned og = xb_add(&bar[XB_TOP], 1u);
            const unsigned tg = og / nx;
            if (og + 1u == (tg + 1u) * nx) xb_add(&bar[XB_TOPGEN], 1u);
            else XB_SPIN(xb_ld(&bar[XB_TOPGEN]) == tg, bar);
            __builtin_amdgcn_fence(__ATOMIC_ACQUIRE, "agent");
            xb_add(&bar[XB_XGEN(b.x)], 1u);
            asm volatile("s_waitcnt vmcnt(0)" ::: "memory");
        } else {
            XB_SPIN(xb_ld(&bar[XB_XGEN(b.x)]) == gen, bar);
            __builtin_amdgcn_fence(__ATOMIC_ACQUIRE, "agent");
            asm volatile("s_waitcnt vmcnt(0)" ::: "memory");
        }
    }
    __syncthreads();
}

#ifndef PH
#define PH 0xFFFF
#endif
#define PHON(b) ((((PH) >> (b)) & 1) != 0)
#define TIME_MULT 4
#if TIME_PHASE >= 0
#define PH_T0(k) do { if ((k) == TIME_PHASE && bid == 0) t_ph = __builtin_amdgcn_s_memrealtime(); } while (0)
#define PH_T1(k) do { if ((k) == TIME_PHASE && bid == 0) { const unsigned long long t1_ = __builtin_amdgcn_s_memrealtime(), d_ = t1_ - t_ph; while (__builtin_amdgcn_s_memrealtime() - t1_ < (unsigned long long)TIME_MULT * d_) __builtin_amdgcn_s_sleep(8); } } while (0)
#else
#define PH_T0(k) do { } while (0)
#define PH_T1(k) do { } while (0)
#endif
__global__ void __launch_bounds__(NTHREADS, 2) fwd_megakernel(Params P) {
    extern __shared__ __attribute__((aligned(16))) unsigned char lds_raw[];
    LAS unsigned char* const lds0 = (LAS unsigned char*)lds_raw;
    cg::grid_group grid = cg::this_grid();
    const int G = gridDim.x, bid = blockIdx.x;
    const int vcu = (G % 8 == 0) ? (bid % 8) * (G / 8) + bid / 8 : bid;
    const int ngw = G * NWAVES;
    unsigned long long t_ph = 0; (void)t_ph;
    const unsigned long long t_entry = (TIME_PHASE == 99) ? __builtin_amdgcn_s_memrealtime() : 0ull; (void)t_entry;
    if (threadIdx.x < 4) ((LAS unsigned*)(lds0 + LDS_BYTES - 16))[threadIdx.x] = 0u;
    __syncthreads();
    (void)xcd_barrier_post((unsigned*)(P.ws + WS_BAR), (volatile LAS unsigned*)(lds0 + LDS_BYTES - 16));
#define GSYNC() do { XcdBarrier xb_; xb_.bar = (unsigned*)(opaque_ptr(P.ws) + WS_BAR); xb_.x = xb_xcc_id(); xb_.st = (volatile LAS unsigned*)(opaque_lds(lds0) + LDS_BYTES - 16); xcd_barrier(xb_); } while (0)
#define KTID() const int tid = opaque_tid(), wave = __builtin_amdgcn_readfirstlane(tid >> 6), lane = tid & 63, gw = bid * NWAVES + wave; (void)lane; (void)gw

    PH_T0(0);
    { KTID(); unsigned char* const ws = opaque_ptr(P.ws); LAS unsigned char* const lds = opaque_lds(lds0); (void)lds;
    if (bid == 0 && tid < 64) ((int*)(ws + WS_CTL))[tid] = 0;
    if (PHON(0)) for (int it = bid; it < 128 + 192; it += G) { if (it < 128) s5_tables_item(P, lds, it); else mod_item(P, lds, it - 128); }
    rope_table(P, bid * NTHREADS + tid, G * NTHREADS);
    for (int i = bid * NTHREADS + tid; i < 2 * 32 * 1024; i += G * NTHREADS) { const int k_ = i & 1023, e_ = (i >> 10) & 31, l_ = i >> 15; const float wv_ = P.router_w[(size_t)l_ * 1024 * 32 + k_ * 32 + e_];
        const unsigned hw_ = f2bf(wv_); bf16_t* rt_ = (bf16_t*)(ws + WS_RWT) + (size_t)l_ * 2 * 32 * 1024 + (k_ >> 4) * 512 + e_ * 16 + (k_ & 15); rt_[0] = (bf16_t)hw_; rt_[32 * 1024] = (bf16_t)f2bf(wv_ - __builtin_bit_cast(float, hw_ << 16)); }
    for (int i = bid * NTHREADS + tid; i < 2 * 4 * 64 * 16; i += G * NTHREADS) { const int rr = i & 15, dd = (i >> 4) & 63, hh_ = (i >> 10) & 3, ll = i >> 12;
        ((bf16_t*)(ws + WS_WA2T))[i] = (dd < 48) ? (bf16_t)f2bf(P.gla_w_a2[(size_t)ll * 16 * 192 + rr * 192 + hh_ * 48 + dd]) : (bf16_t)0; }
    __syncthreads();
    if (PHON(1)) transpose_small(P, lds, gw, ngw, wave, lane);
    if (bid >= 64) { __syncthreads(); transpose_moe_pool(P, lds, 0, TM_Q_P0); } }
    if (P.ws == nullptr) grid.sync();
    GSYNC(); PH_T1(0); PH_T0(1);
    { KTID(); unsigned char* const ws = opaque_ptr(P.ws); LAS unsigned char* const lds = opaque_lds(lds0); (void)lds;
    for (int tokp = gw; tokp < T_TOK / 2; tokp += ngw) {
        f32x4 v[2][4];
#pragma unroll
        for (int u = 0; u < 2; ++u)
#pragma unroll
            for (int hf = 0; hf < 2; ++hf)
#pragma unroll
                for (int q = 0; q < 2; ++q) v[u][hf * 2 + q] = *(const f32x4*)(P.x + (size_t)(2 * tokp + u) * 1024 + hf * 512 + 8 * lane + 4 * q);
#pragma unroll
        for (int u = 0; u < 2; ++u) { const int tok = 2 * tokp + u; const float* mrow = (const float*)(ws + WS_MOD) + (size_t)(tok >> 12) * 6144;
            norm_row_store(v[u], P.norm1_w, mrow, mrow + 1024, (bf16_t*)(ws + WS_HDN) + (size_t)tok * 1024, lane); }
    } }
    GSYNC(); PH_T1(1);
#pragma unroll 1
    for (int l = 0; l < NLAYER; ++l) {
        PH_T0(2);
        constexpr int G_IN = 240;
        if (bid >= G_IN) { LAS unsigned char* const lds = opaque_lds(lds0); transpose_moe_pool(P, lds, l, (l == 0 ? TM_Q_P0 : TM_Q_DN) + TM_Q_IN); }
        else if (PHON(2)) { unsigned char* const ws = opaque_ptr(P.ws); LAS unsigned char* const lds = opaque_lds(lds0); (void)lds; DenseOrder S; S.init(T_TOK, NPROJP, 1024, G_IN, bid, ws + WS_HDN, (const bf16_t*)(ws + WS_WIN) + (size_t)l * NPROJP * 1024);
          EpiProj E{(bf16_t*)(ws + WS_PROJ), NPROJP, (bf16_t*)(ws + WS_SU2)};
          gm::gemm_phase<EpiProj, DenseOrder, false>(lds, 1024, S, E); }
        GSYNC(); PH_T1(2); PH_T0(3);
        { LAS unsigned char* const lds = opaque_lds(lds0);
#define SUBT0(k, b) do { if (TIME_PHASE == (k) && bid == (b)) t_ph = __builtin_amdgcn_s_memrealtime(); } while (0)
#define SUBT1(k, b) do { if (TIME_PHASE == (k) && bid == (b)) { const unsigned long long t1_ = __builtin_amdgcn_s_memrealtime(), d_ = t1_ - t_ph; while (__builtin_amdgcn_s_memrealtime() - t1_ < (unsigned long long)TIME_MULT * d_) __builtin_amdgcn_s_sleep(8); } } while (0)
          SUBT0(20, 0);
          { int rpa = (TIME_PHASE == 46) ? 2 : 1; asm volatile("" : "+s"(rpa));
#pragma unroll 1
            for (int q_ = 0; q_ < rpa; ++q_)
          if (PHON(3) && bid < 2048) { MixPf pf; mixer_pf_load(P, bid, pf); for (int rd = bid; rd < 2048; rd += G) mixer_phase_a(P, lds, l, rd, rd + G, pf); } }
          SUBT1(20, 0); SUBT0(21, 0);
          { int rps = (TIME_PHASE == 45) ? 2 : 1; asm volatile("" : "+s"(rps));
#pragma unroll 1
            for (int q_ = 0; q_ < rps; ++q_)
          if (PHON(4)) for (int it = bid; it < 256; it += G) s5_item(P, lds, l, it); }
          SUBT1(21, 0); SUBT0(22, 0);
          { KTID(); transpose_moe_rest(P, lds, l, gw, ngw); }
          SUBT1(22, 0); SUBT0(47, 0); SUBT0(48, 101); SUBT0(49, 202); }
        GSYNC(); PH_T1(3); SUBT1(47, 0); SUBT1(48, 101); SUBT1(49, 202); PH_T0(4);
        if (PHON(5) && bid >= 128) { unsigned char* const ws = opaque_ptr(P.ws); LAS unsigned char* const lds = opaque_lds(lds0); (void)lds; DenseOrder S; S.init(T_TOK, 256, 256, G - 128, bid - 128, ws + WS_YBUF, (const bf16_t*)(ws + WS_WGLU) + (size_t)l * 256 * 256);
          EpiGlu E{(const bf16_t*)(ws + WS_YBUF), (bf16_t*)(ws + WS_MIXED), P.s5_b_glu + l * 256};
          gm::gemm_phase<EpiGlu, DenseOrder, false>(lds, 256, S, E); }
        if (PHON(3)) mixer_phase_b(P, bid, G);
        GSYNC(); PH_T1(4); PH_T0(5);
        if (PHON(3)) { KTID(); LAS unsigned char* const lds = opaque_lds(lds0); for (int it = gw; it < 4096; it += ngw) mixer_phase_c(P, lds, l, it); }
        GSYNC(); PH_T1(5); PH_T0(6);
        if (PHON(6)) { unsigned char* const ws = opaque_ptr(P.ws); LAS unsigned char* const lds = opaque_lds(lds0); (void)lds; const float* modl = (const float*)(ws + WS_MOD) + (size_t)l * 8 * 6144; DenseOrder S; S.init(T_TOK, 1024, 1024, G, bid, ws + WS_MIXED, (const bf16_t*)(ws + WS_WOUT) + (size_t)l * 1024 * 1024);
          EpiOut E{l == 0 ? P.x : (const float*)(ws + WS_X), (float*)(ws + WS_X), modl + 2048};
          gm::gemm_phase<EpiOut, DenseOrder, false>(lds, 1024, S, E); }
        GSYNC(); PH_T1(6); PH_T0(7);
        if (PHON(7)) { LAS unsigned char* const lds = opaque_lds(lds0); for (int blk = bid; blk < T_TOK / 128; blk += G) router_phase(P, lds, l, blk); }
        GSYNC(); PH_T1(7); PH_T0(8);
        if (PHON(8)) { unsigned char* const ws = opaque_ptr(P.ws); LAS unsigned char* const lds = opaque_lds(lds0); (void)lds; moe_tables(lds, (const int*)(ws + WS_CTL) + l * 32, 8);
          MoeOrder<true> S; S.tab = (LAS const int*)(lds + MISC_OFF); S.nN = 8; S.G = G; S.vc = vcu; S.Wt = (const char*)(ws + WS_WUP) + (size_t)l * 32 * 2048 * 1024 * 2; S.wstride = (size_t)2048 * 1024 * 2; S.stok = (const int*)(ws + WS_STOK); S.A = (const char*)(ws + WS_HDN); S.gtab = (LAS const unsigned*)(lds + GT_OFF);
          S.fill_gather((LAS unsigned*)(lds + GT_OFF));
          EpiUp E{(bf16_t*)(ws + WS_ACT), P.b_up + (size_t)l * 32 * 2048, (LAS const int*)(lds + MISC_OFF)};
          gm::gemm_phase<EpiUp, MoeOrder<true>, true>(lds, 1024, S, E); }
        GSYNC(); PH_T1(8); PH_T0(9);
#if EXPERIMENT >= 1
        if (l == 0) { unsigned char* const ws = opaque_ptr(P.ws); LAS unsigned char* const lds = opaque_lds(lds0); (void)lds; moe_tables(lds, (const int*)(ws + WS_CTL) + l * 32, 8);
          MoeOrder<(EXPERIMENT != 2)> S; S.tab = (LAS const int*)(lds + MISC_OFF); S.nN = 8; S.G = G; S.vc = vcu; S.Wt = (const char*)(ws + WS_WUP) + (size_t)l * 32 * 2048 * 1024 * 2; S.wstride = (EXPERIMENT == 4) ? 0 : (size_t)2048 * 1024 * 2; S.stok = (const int*)(ws + WS_STOK); S.A = (const char*)(ws + WS_HDN); S.gtab = (LAS const unsigned*)(lds + GT_OFF);
          if (EXPERIMENT != 2) S.fill_gather((LAS unsigned*)(lds + GT_OFF));
          if (EXPERIMENT == 3) { EpiProj E{(bf16_t*)(ws + WS_OUTR), 2048, nullptr}; gm::gemm_phase<EpiProj, MoeOrder<(EXPERIMENT != 2)>, (EXPERIMENT != 2)>(lds, 1024, S, E); }
          else { EpiUp E{(bf16_t*)(ws + WS_OUTR), P.b_up + (size_t)l * 32 * 2048, (LAS const int*)(lds + MISC_OFF)}; gm::gemm_phase<EpiUp, MoeOrder<(EXPERIMENT != 2)>, (EXPERIMENT != 2)>(lds, 1024, S, E); }
          GSYNC(); }
#endif
        if (PHON(9)) { unsigned char* const ws = opaque_ptr(P.ws); LAS unsigned char* const lds = opaque_lds(lds0); (void)lds; moe_tables(lds, (const int*)(ws + WS_CTL) + l * 32, 4);
          const int nunits = ((LAS const int*)(lds + MISC_OFF))[32], nrounds = (nunits + G - 1) / G, gneed0 = nrounds > 0 ? (nunits + nrounds - 1) / nrounds : G, gneed = (gneed0 + 7) & ~7;
          if (bid >= gneed) { if (l + 1 < NLAYER) transpose_moe_pool(P, lds, l + 1, TM_Q_DN); }
          else {
          MoeOrder<false> S; S.tab = (LAS const int*)(lds + MISC_OFF); S.nN = 4; S.G = gneed; S.vc = xcd_vc(bid, gneed); S.Wt = (const char*)(ws + WS_WDN) + (size_t)l * 32 * 1024 * 1024 * 2; S.wstride = (size_t)1024 * 1024 * 2; S.stok = nullptr; S.A = (const char*)(ws + WS_ACT); S.gtab = nullptr;
          EpiDown E{(bf16_t*)(ws + WS_OUTR), P.b_down + (size_t)l * 32 * 1024, (const int*)(ws + WS_STOK), (const float*)(ws + WS_SGATE)};
          gm::gemm_phase<EpiDown, MoeOrder<false>, false>(lds, 1024, S, E); } }
        GSYNC(); PH_T1(9); PH_T0(10);
        if (PHON(10)) { KTID(); combine_phase(P, l, gw, ngw, lane); }
        GSYNC(); PH_T1(10);
    }
    if (TIME_PHASE == 99 && bid == 0) { const unsigned long long t1_ = __builtin_amdgcn_s_memrealtime(), d_ = t1_ - t_entry; while (__builtin_amdgcn_s_memrealtime() - t1_ < d_) __builtin_amdgcn_s_sleep(8); }
}

extern "C" void kernel_launch(void* const* d_in, const int* in_sizes, int n_in, void* d_out, int out_size, void* d_ws, size_t ws_size, hipStream_t stream) {
    static int grid_blocks = 0;
    if (grid_blocks == 0) {
        if (n_in != 29 || ws_size < WS_END) { fprintf(stderr, "kernel_launch: unexpected n_in %d or ws_size %zu (need %zu)\n", n_in, ws_size, (size_t)WS_END); grid_blocks = -1; return; }
        int dev = 0, cus = 0, per_cu = 0;
        (void)hipGetDevice(&dev);
        (void)hipDeviceGetAttribute(&cus, hipDeviceAttributeMultiprocessorCount, dev);
        (void)hipFuncSetAttribute((const void*)fwd_megakernel, hipFuncAttributeMaxDynamicSharedMemorySize, LDS_BYTES);
        (void)hipOccupancyMaxActiveBlocksPerMultiprocessor(&per_cu, (const void*)fwd_megakernel, NTHREADS, LDS_BYTES);
        if (per_cu < 1) { fprintf(stderr, "kernel_launch: occupancy query returned %d\n", per_cu); per_cu = 1; }
        grid_blocks = cus;
        fprintf(stderr, "kernel_launch: cus %d per_cu %d grid %d ws_need %zu\n", cus, per_cu, grid_blocks, (size_t)WS_END);
    }
    if (grid_blocks < 0) return;
    Params p{};
    const float** pp = (const float**)&p;
    for (int i = 0; i < 29; ++i) pp[i] = (const float*)d_in[i];
    p.out = (float*)d_out; p.ws = (unsigned char*)d_ws;
    for (int i = 0; i < 24; ++i) p.inv_freq_rev[i] = pow(10000.0, -(double)(2 * i) / 48.0) / 6.283185307179586476925;
    for (int h = 0; h < 4; ++h) p.log_gamma[h] = (float)log1p(-exp2(-5.0 - (double)h));
    (void)hipMemsetAsync((char*)d_ws + WS_CTL, 0, WS_CTL_BYTES, stream);
    void* args[] = {&p};
    hipError_t e = hipLaunchCooperativeKernel((const void*)fwd_megakernel, dim3(grid_blocks), dim3(NTHREADS), args, LDS_BYTES, stream);
    if (e != hipSuccess) fprintf(stderr, "cooperative launch failed: %s (grid %d)\n", hipGetErrorString(e), grid_blocks);
}
```

```cpp
#include <hip/hip_runtime.h>
#include <hip/hip_cooperative_groups.h>
#include <cstdio>
#include <cstdint>
#include <cmath>
namespace cg = cooperative_groups;
#ifndef TIME_PHASE
#define TIME_PHASE -1
#endif
#ifndef EXPERIMENT
#define EXPERIMENT 0
#endif
#ifndef GEMM_4PH
#define GEMM_4PH 0
#endif

#define LAS __attribute__((address_space(3)))
typedef unsigned short bf16_t;
typedef short bf16x8 __attribute__((ext_vector_type(8)));
typedef float f32x4 __attribute__((ext_vector_type(4)));
typedef float f32x16 __attribute__((ext_vector_type(16)));
typedef unsigned u32x4 __attribute__((ext_vector_type(4)));
typedef unsigned u32x2 __attribute__((ext_vector_type(2)));

constexpr int T_TOK = 32768, DM = 1024, NBATCH = 8, SEQ = 4096, NLAYER = 2;
constexpr int NPROJ = 2576, NPROJP = 2816;
constexpr int NE = 32, CAP = 32768, NSLOT = T_TOK * 4;
constexpr int C_GQ = 0, C_GK = 192, C_GV = 384, C_GG = 768, C_GA = 1152, C_RQ = 1168, C_RK = 1360, C_RV = 1552, C_RG = 1936, C_SU = 2320;
constexpr float NORM_EPS = 1e-5f;
constexpr int NTHREADS = 512, NWAVES = 8;
constexpr int LDS_BYTES = 160 * 1024;
constexpr int MISC_OFF = 148 * 1024;

constexpr size_t al256(size_t x) { return (x + 255) & ~(size_t)255; }
constexpr size_t WS_CTL   = 0;
constexpr size_t WS_BAR   = 4096;
constexpr size_t WS_CTL_BYTES = 32768;
constexpr size_t WS_MOD   = 32768;
constexpr size_t WS_WIN   = al256(WS_MOD + (size_t)2 * 8 * 6144 * 4);
constexpr size_t WS_WOUT  = al256(WS_WIN + (size_t)2 * NPROJP * 1024 * 2);
constexpr size_t WS_WUP   = al256(WS_WOUT + (size_t)2 * 1024 * 1024 * 2);
constexpr size_t WS_WDN   = al256(WS_WUP + (size_t)2 * 32 * 2048 * 1024 * 2);
constexpr size_t WS_WGLU  = al256(WS_WDN + (size_t)2 * 32 * 1024 * 1024 * 2);
constexpr size_t WS_KTAB  = al256(WS_WGLU + (size_t)2 * 256 * 256 * 2);
constexpr size_t WS_BPOW  = al256(WS_KTAB + (size_t)2 * 16 * 65 * 256 * 2);
constexpr size_t WS_CPOW  = al256(WS_BPOW + (size_t)2 * 16 * 128 * 1024 * 2);
constexpr size_t WS_LAM64 = al256(WS_CPOW + (size_t)2 * 16 * 1024 * 128 * 2);
constexpr size_t WS_ROPE  = al256(WS_LAM64 + (size_t)2 * 16 * 64 * 2 * 4);
constexpr size_t WS_WA2T  = al256(WS_ROPE + (size_t)4096 * 24 * 2 * 4);
constexpr size_t WS_RWT   = al256(WS_WA2T + (size_t)2 * 4 * 64 * 16 * 2);
constexpr size_t WS_X     = al256(WS_RWT + (size_t)2 * 2 * 32 * 1024 * 2);
constexpr size_t WS_HDN   = al256(WS_X + (size_t)T_TOK * 1024 * 4);
constexpr size_t WS_PROJ  = al256(WS_HDN + (size_t)T_TOK * 1024 * 2);
constexpr size_t WS_MIXED = al256(WS_PROJ + (size_t)T_TOK * NPROJP * 2);
constexpr size_t WS_YBUF  = al256(WS_MIXED + (size_t)T_TOK * 1024 * 2);
constexpr size_t WS_SU2   = al256(WS_YBUF + (size_t)T_TOK * 256 * 2);
constexpr size_t WS_ACT   = al256(WS_SU2 + (size_t)T_TOK * 256 * 2);
constexpr size_t WS_OUTR  = al256(WS_ACT + (size_t)(NSLOT + 256) * 1024 * 2);
constexpr size_t WS_STOK  = al256(WS_OUTR + (size_t)NSLOT * 1024 * 2);
constexpr size_t WS_SGATE = al256(WS_STOK + (size_t)NE * CAP * 4);
constexpr size_t MXW_QD = WS_ACT, MXW_OI = WS_ACT + ((size_t)32 << 20), MXW_DS = WS_ACT + ((size_t)96 << 20), MXW_DEC = WS_ACT + ((size_t)176 << 20), MXW_SP = WS_ACT + ((size_t)180 << 20);
constexpr size_t WS_END   = al256(WS_SGATE + (size_t)NE * CAP * 4);

struct Params {
    const float* x; const float* c; const float* norm1_w; const float* norm2_w; const float* w_mod; const float* b_mod;
    const float* w_in; const float* gla_w_a2; const float* gla_b_a; const float* gla_norm_w; const float* ret_norm_w;
    const float* s5_a_re; const float* s5_a_im; const float* s5_log_dt; const float* s5_b_re; const float* s5_b_im;
    const float* s5_c_re; const float* s5_c_im; const float* s5_d; const float* s5_w_glu; const float* s5_b_glu;
    const float* w_out; const float* router_w; const float* router_b; const float* w_up; const float* b_up;
    const float* w_down; const float* b_down; const float* final_norm_w;
    float* out; unsigned char* ws;
    double inv_freq_rev[24];
    float log_gamma[4]; float pad0[4];
};

__device__ __forceinline__ unsigned f2bf(float f) { unsigned u = __builtin_bit_cast(unsigned, f); return (u + 0x7fffu + ((u >> 16) & 1u)) >> 16; }
typedef float f32x2_t __attribute__((ext_vector_type(2)));
typedef __bf16 bf16x2_t __attribute__((ext_vector_type(2)));
__device__ __forceinline__ unsigned pk2(float lo, float hi) { const f32x2_t v = {lo, hi}; const bf16x2_t b = __builtin_convertvector(v, bf16x2_t); return __builtin_bit_cast(unsigned, b); }
__device__ __forceinline__ float bflo(unsigned w) { return __builtin_bit_cast(float, w << 16); }
__device__ __forceinline__ float bfhi(unsigned w) { return __builtin_bit_cast(float, w & 0xffff0000u); }
__device__ __forceinline__ float bf2f(bf16_t b) { return __builtin_bit_cast(float, (unsigned)b << 16); }
__device__ __forceinline__ float lx_f(float v, int lane, int o) { return __builtin_bit_cast(float, __builtin_amdgcn_ds_bpermute((lane ^ o) << 2, __builtin_bit_cast(int, v))); }
__device__ __forceinline__ int lx_i(int v, int lane, int o) { return __builtin_amdgcn_ds_bpermute((lane ^ o) << 2, v); }
__device__ __forceinline__ float lidx_f(float v, int src) { return __builtin_bit_cast(float, __builtin_amdgcn_ds_bpermute(src << 2, __builtin_bit_cast(int, v))); }
__device__ __forceinline__ float wave_sum(float v, int lane) {
#pragma unroll
    for (int o = 1; o < 64; o <<= 1) v += lx_f(v, lane, o);
    return v;
}
__device__ __forceinline__ float sigmoidf_(float x) { return __builtin_amdgcn_rcpf(1.0f + __builtin_amdgcn_exp2f(-1.4426950408889634f * x)); }
__device__ __forceinline__ float siluf(float x) { return x * sigmoidf_(x); }
#define LDS_WAIT() asm volatile("s_waitcnt lgkmcnt(0)" ::: "memory")
__device__ __forceinline__ unsigned char* opaque_ptr(unsigned char* p) { const unsigned long long v = (unsigned long long)p; unsigned lo = __builtin_amdgcn_readfirstlane((unsigned)v), hi = __builtin_amdgcn_readfirstlane((unsigned)(v >> 32));
    asm volatile("" : "+s"(lo), "+s"(hi)); return (unsigned char*)(__attribute__((address_space(1))) unsigned char*)(((unsigned long long)hi << 32) | lo); }
__device__ __forceinline__ LAS unsigned char* opaque_lds(LAS unsigned char* p) { unsigned v = __builtin_amdgcn_readfirstlane((unsigned)(size_t)p); asm volatile("" : "+s"(v)); return (LAS unsigned char*)(size_t)v; }
__device__ __forceinline__ int opaque_tid() { int t = threadIdx.x; asm volatile("" : "+v"(t)); return t; }

namespace gm {
constexpr int BM = 256, BK = 64, HALF = 128, HTB = HALF * BK * 2, STAGE_BYTES = 8 * HTB, NXCD = 8, WGM = 8;
__device__ __forceinline__ int lds_byte(int r, int c) { const int st = (r >> 4) * 2 + (c >> 5), rr = r & 15, cc = c & 31, ob = rr * 64 + cc * 2; return st * 1024 + (ob ^ (((ob >> 9) & 1) << 5)); }
__device__ __forceinline__ void stage_rc(int b, int& R, int& C) { const int st = b / 1024, sb = b % 1024, swz = sb ^ (((sb >> 9) & 1) << 5); R = (st >> 1) * 16 + swz / 64; C = (st & 1) * 32 + (swz % 64) / 2; }
__device__ __forceinline__ int perm32(int rho) { const int n = rho >> 4, i = rho & 15; return 8 * (i >> 2) + 4 * n + (i & 3); }

struct Unit { const char* B; int pm, pn, e, rows; };

template <class Epi, class Sched, bool GATHER>
__device__ __forceinline__ void gemm_phase(LAS unsigned char* lds, const int K_in, const Sched& S, const Epi& E) {
    int K = K_in; asm volatile("" : "+s"(K));
    const int tid = opaque_tid(), wid = __builtin_amdgcn_readfirstlane(tid >> 6), lane = tid & 63, wr = wid >> 2, wc = wid & 3, fr = lane & 15, fq = lane >> 4;
    const int nt = K / BK;
    int R0, C0; unsigned voffB;
    { stage_rc(tid * 16, R0, C0);
      const int Rb0 = Epi::PERM ? ((R0 & ~31) + perm32(R0 & 31)) : R0;
      voffB = (unsigned)(Rb0 * K + C0) * 2u; }
    const size_t kstep = (size_t)(BK * 2);
    const size_t hstep = (size_t)HALF * K * 2;
    const size_t qstep = (size_t)64 * K * 2;
    const unsigned ldsw = (unsigned)wid * 1024u;
    const int aoff = lds_byte(wr * 64 + fr, fq * 8), boff = lds_byte(wc * 32 + fr, fq * 8);
#define G_SA(b, h) (((b) * 2 + (h)) * gm::HTB)
#define G_SB(b, h) ((4 + (b) * 2 + (h)) * gm::HTB)
#define G_GLDS(gptr, ldsoff) __builtin_amdgcn_global_load_lds((const unsigned*)(gptr), (LAS unsigned*)(lds + (ldsoff)), 16, 0, 0)
#define G_STAGEB(bufoff, gbase) do { G_GLDS((const char*)(gbase) + voffB, (bufoff) + ldsw); G_GLDS((const char*)(gbase) + qstep + voffB, (bufoff) + ldsw + 8192); } while (0)
#define G_STAGEA(bufoff, ubase, h, o0, o1) do { if (GATHER) { G_GLDS((const char*)(ubase) + (o0), (bufoff) + ldsw); G_GLDS((const char*)(ubase) + (o1), (bufoff) + ldsw + 8192); } \
        else { G_GLDS((const char*)(ubase) + (h) * hstep + (o0), (bufoff) + ldsw); G_GLDS((const char*)(ubase) + (h) * hstep + qstep + (o0), (bufoff) + ldsw + 8192); } } while (0)
#define G_LDA(dst, b, h) do { _Pragma("unroll") for (int m = 0; m < 4; ++m) _Pragma("unroll") for (int k = 0; k < 2; ++k) dst[m][k] = *(const LAS bf16x8*)(lds + G_SA(b, h) + aoff + m * 2048 + k * 1024); } while (0)
#define G_LDB(dst, b, h) do { _Pragma("unroll") for (int n = 0; n < 2; ++n) _Pragma("unroll") for (int k = 0; k < 2; ++k) dst[n][k] = *(const LAS bf16x8*)(lds + G_SB(b, h) + boff + n * 2048 + k * 1024); } while (0)
#define G_MMA(ai, bj, At, Bt) do { __builtin_amdgcn_s_setprio(1); _Pragma("unroll") for (int m = 0; m < 4; ++m) _Pragma("unroll") for (int n = 0; n < 2; ++n) _Pragma("unroll") for (int k = 0; k < 2; ++k) \
        acc[ai][bj][m][n] = __builtin_amdgcn_mfma_f32_16x16x32_bf16(Bt[n][k], At[m][k], acc[ai][bj][m][n], 0, 0, 0); __builtin_amdgcn_s_setprio(0); } while (0)
#define G_WAIT_V(n) asm volatile("s_waitcnt vmcnt(" #n ")" ::: "memory")
#define G_WAIT_L(n) asm volatile("s_waitcnt lgkmcnt(" #n ")" ::: "memory")
#define G_BAR __builtin_amdgcn_s_barrier()
#define G_SCHED __builtin_amdgcn_sched_barrier(0)
    Unit cur, nxt; int ui = 0;
    if (!S.next(0, cur)) return;
    f32x4 acc[2][2][4][2];
#pragma unroll
    for (int a = 0; a < 2; ++a)
#pragma unroll
        for (int b = 0; b < 2; ++b)
#pragma unroll
            for (int m = 0; m < 4; ++m)
#pragma unroll
                for (int n = 0; n < 2; ++n) acc[a][b][m][n] = (f32x4){0.f, 0.f, 0.f, 0.f};
    bf16x8 At[4][2], B0[2][2], B1[2][2];
    unsigned c00, c01 = 0, c10 = 0, c11 = 0;
    c00 = S.a_off(0, R0, C0);
    if (GATHER) { c01 = S.a_off(0, R0 + 64, C0); c10 = S.a_off(0, R0 + 128, C0); c11 = S.a_off(0, R0 + 192, C0); }
    const char* cA = S.a_base(cur); const char* cB = cur.B;
#if GEMM_4PH
    G_STAGEB(G_SB(0, 0), cB); G_STAGEA(G_SA(0, 0), cA, 0, c00, c01); G_STAGEB(G_SB(0, 1), cB + hstep); G_STAGEA(G_SA(0, 1), cA, 1, c10 + (GATHER ? 0u : c00), c11);
    if (wr == 1) G_BAR;
    G_WAIT_V(4); G_BAR;
#else
    G_STAGEB(G_SB(0, 0), cB); G_STAGEB(G_SB(0, 1), cB + hstep); G_STAGEA(G_SA(0, 0), cA, 0, c00, c01); G_STAGEA(G_SA(0, 1), cA, 1, c10 + (GATHER ? 0u : c00), c11);
    if (wr == 1) G_BAR;
    G_WAIT_V(2); G_BAR;
#endif
    G_STAGEB(G_SB(1, 0), cB + kstep); G_STAGEA(G_SA(1, 0), cA + kstep, 0, c00, c01); G_STAGEB(G_SB(1, 1), cB + hstep + kstep);
    G_WAIT_V(6); G_BAR;
    for (;;) {
        const bool has_next = S.next(ui + 1, nxt);
        const char* nB = cB; const char* nA = cA;
        if (has_next) { nB = nxt.B; nA = S.a_base(nxt); }
        for (int t = 0; t < nt; t += 2) {
            const bool last = (t == nt - 2);
            const char* a1 = cA + (size_t)(t + 1) * kstep;
            const char* a2 = last ? nA : cA + (size_t)(t + 2) * kstep;
            const char* b2 = last ? nB : cB + (size_t)(t + 2) * kstep;
#if GEMM_4PH
            G_LDB(B0, 0, 0); G_SCHED; G_LDA(At, 0, 0); G_STAGEA(G_SA(1, 1), a1, 1, c10 + (GATHER ? 0u : c00), c11);
            G_WAIT_L(8); G_BAR; G_WAIT_L(0); G_MMA(0, 0, At, B0); G_BAR; G_SCHED;
            if (GATHER) { if (last && has_next) { c00 = S.a_off(ui + 1, R0, C0); c01 = S.a_off(ui + 1, R0 + 64, C0); c10 = S.a_off(ui + 1, R0 + 128, C0); c11 = S.a_off(ui + 1, R0 + 192, C0); } }
            G_LDB(B1, 0, 1); G_STAGEB(G_SB(0, 0), b2);
            G_BAR; G_WAIT_L(0); G_MMA(0, 1, At, B1); G_BAR;
            G_LDA(At, 0, 1); G_STAGEA(G_SA(0, 0), a2, 0, c00, c01);
            G_BAR; G_WAIT_L(0); G_MMA(1, 0, At, B0); G_BAR; G_SCHED;
            G_STAGEB(G_SB(0, 1), b2 + hstep);
            G_WAIT_V(6); G_BAR; G_MMA(1, 1, At, B1); G_BAR;
            G_LDB(B0, 1, 0); G_SCHED; G_LDA(At, 1, 0); G_STAGEA(G_SA(0, 1), a2, 1, c10 + (GATHER ? 0u : c00), c11);
            G_WAIT_L(8); G_BAR; G_WAIT_L(0); G_MMA(0, 0, At, B0); G_BAR; G_SCHED;
            G_LDB(B1, 1, 1); G_STAGEB(G_SB(1, 0), b2 + kstep);
            G_BAR; G_WAIT_L(0); G_MMA(0, 1, At, B1); G_BAR;
            G_LDA(At, 1, 1); G_STAGEA(G_SA(1, 0), a2 + kstep, 0, c00, c01);
            G_BAR; G_WAIT_L(0); G_MMA(1, 0, At, B0); G_BAR; G_SCHED;
            G_STAGEB(G_SB(1, 1), b2 + kstep + hstep);
            G_WAIT_V(6); G_BAR; G_MMA(1, 1, At, B1); G_BAR;
        }
#else
            G_LDB(B0, 0, 0); G_LDB(B1, 0, 1); G_SCHED; G_LDA(At, 0, 0); G_STAGEA(G_SA(1, 1), a1, 1, c10 + (GATHER ? 0u : c00), c11);
            G_WAIT_V(8); G_WAIT_L(0); G_BAR; G_MMA(0, 0, At, B0); G_MMA(0, 1, At, B1); G_BAR; G_SCHED;
            if (GATHER) { if (last && has_next) { c00 = S.a_off(ui + 1, R0, C0); c01 = S.a_off(ui + 1, R0 + 64, C0); c10 = S.a_off(ui + 1, R0 + 128, C0); c11 = S.a_off(ui + 1, R0 + 192, C0); } }
            G_LDA(At, 0, 1); G_STAGEB(G_SB(0, 0), b2); G_STAGEB(G_SB(0, 1), b2 + hstep); G_STAGEA(G_SA(0, 0), a2, 0, c00, c01);
            G_WAIT_V(8); G_WAIT_L(0); G_BAR; G_MMA(1, 0, At, B0); G_MMA(1, 1, At, B1); G_BAR; G_SCHED;
            G_LDB(B0, 1, 0); G_LDB(B1, 1, 1); G_SCHED; G_LDA(At, 1, 0); G_STAGEA(G_SA(0, 1), a2, 1, c10 + (GATHER ? 0u : c00), c11);
            G_WAIT_V(8); G_WAIT_L(0); G_BAR; G_MMA(0, 0, At, B0); G_MMA(0, 1, At, B1); G_BAR; G_SCHED;
            G_LDA(At, 1, 1); G_STAGEB(G_SB(1, 0), b2 + kstep); G_STAGEB(G_SB(1, 1), b2 + kstep + hstep); G_STAGEA(G_SA(1, 0), a2 + kstep, 0, c00, c01);
            G_WAIT_V(8); G_WAIT_L(0); G_BAR; G_MMA(1, 0, At, B0); G_MMA(1, 1, At, B1); G_BAR; G_SCHED;
        }
#endif
        if (wr == 0) G_BAR;
        E(acc, cur, wr, wc, fr, fq);
        if (!has_next) break;
#pragma unroll
        for (int a = 0; a < 2; ++a)
#pragma unroll
            for (int b = 0; b < 2; ++b)
#pragma unroll
                for (int m = 0; m < 4; ++m)
#pragma unroll
                    for (int n = 0; n < 2; ++n) acc[a][b][m][n] = (f32x4){0.f, 0.f, 0.f, 0.f};
        cur = nxt; cB = nB; cA = nA; ++ui;
        if (wr == 1) G_BAR;
    }
    G_WAIT_V(0);
    G_BAR;
}
}

struct DenseOrder {
    int nM, nN, nwg, G, c, K; const char* Bt;
    __device__ __forceinline__ void init(int M, int N, int K_, int G_, int c_, const void* A_, const void* Bt_) { nM = M / 256; nN = N / 256; nwg = nM * nN; G = G_; c = c_; K = K_; A = (const char*)A_; Bt = (const char*)Bt_; }
    __device__ __forceinline__ bool next(int i, gm::Unit& u) const {
        const long L = (long)i * G + c; if (L >= nwg) return false;
        int wgid = (int)L; { const int q = nwg / gm::NXCD, r = nwg % gm::NXCD, xcd = wgid % gm::NXCD, off = wgid / gm::NXCD; wgid = (xcd < r ? xcd * (q + 1) : r * (q + 1) + (xcd - r) * q) + off; }
        const int nig = gm::WGM * nN, gid = wgid / nig, fm = gid * gm::WGM, gsz = (nM - fm) < gm::WGM ? (nM - fm) : gm::WGM;
        u.pm = fm + ((wgid % nig) % gsz); u.pn = (wgid % nig) / gsz; u.e = 0; u.rows = 256;
        u.B = Bt + (size_t)u.pn * 256 * K * 2; return true;
    }
    const char* A;
    __device__ __forceinline__ const char* a_base(const gm::Unit& u) const { return A + (size_t)u.pm * 256 * K * 2; }
    __device__ __forceinline__ unsigned a_off(int, int r, int c) const { return (unsigned)(r * K + c) * 2u; }
};
constexpr int GT_MAX = 19, GT_OFF = 128 * 1024;
template <bool GATHER> struct MoeOrder {
    LAS const int* tab; int nN, G, vc; const char* Wt; size_t wstride; const int* stok;
    __device__ __forceinline__ bool next(int i, gm::Unit& u) const {
        const int L = i * G + vc; if (L >= tab[32]) return false;
        int e = 0;
#pragma unroll 1
        for (int k = 1; k < 32; ++k) e += (tab[k] <= L) ? 1 : 0;
        const int r = L - tab[e]; u.e = e; u.pm = r / nN; u.pn = r % nN;
        const int cnt = tab[128 + e]; u.rows = (cnt - u.pm * 256) < 256 ? (cnt - u.pm * 256) : 256;
        u.B = Wt + (size_t)e * wstride + (size_t)u.pn * 256 * 1024 * 2; return true;
    }
    const char* A;
    __device__ __forceinline__ const char* a_base(const gm::Unit& u) const { return GATHER ? A : A + (size_t)(tab[64 + u.e] + u.pm * 256) * 2048; }
    LAS const unsigned* gtab;
    __device__ __forceinline__ unsigned a_off(int ui, int r, int c) const {
        if (GATHER) return gtab[ui * 256 + r] + (unsigned)c * 2u;
        else return (unsigned)(r * 1024 + c) * 2u;
    }
    __device__ __forceinline__ void fill_gather(LAS unsigned* gt) const {
        const int tid = opaque_tid();
        if (tid < 256) { gm::Unit u;
            for (int i = 0; i < GT_MAX && next(i, u); ++i) { int tk = 0; if (tid < u.rows) tk = stok[u.e * CAP + u.pm * 256 + tid] >> 2; gt[i * 256 + tid] = (unsigned)tk * 2048u; } }
        __syncthreads();
    }
};
__device__ __forceinline__ void moe_tables(LAS unsigned char* lds, const int* gcount, int nN) {
    LAS int* tab = (LAS int*)(lds + MISC_OFF);
    if (opaque_tid() == 0) { int cu = 0, ro = 0;
#pragma unroll 1
        for (int e = 0; e < 32; ++e) { const int c = gcount[e]; tab[e] = cu; tab[64 + e] = ro; tab[128 + e] = c; cu += ((c + 255) >> 8) * nN; ro += c; }
        tab[32] = cu; tab[64 + 32] = ro; }
    __syncthreads();
}

struct EpiProj {
    static constexpr bool PERM = true;
    bf16_t* O; int ldc; bf16_t* su2;
    __device__ __forceinline__ void operator()(const f32x4 (&acc)[2][2][4][2], const gm::Unit& u, int wr, int wc, int fr_, int fq_) const {
        int fr = fr_, fq = fq_; asm volatile("" : "+v"(fr), "+v"(fq));
        const int row0 = u.pm * 256 + wr * 64 + fr, col0 = u.pn * 256 + wc * 32 + 8 * fq;
#pragma unroll
        for (int ai = 0; ai < 2; ++ai)
#pragma unroll
            for (int m = 0; m < 4; ++m) { bf16_t* rowp = O + (size_t)(row0 + ai * 128 + m * 16) * ldc + col0;
#pragma unroll
                for (int bj = 0; bj < 2; ++bj) { const f32x4 v0 = acc[ai][bj][m][0], v1 = acc[ai][bj][m][1];
                    u32x4 w; w.x = pk2(v0[0], v0[1]); w.y = pk2(v0[2], v0[3]); w.z = pk2(v1[0], v1[1]); w.w = pk2(v1[2], v1[3]);
                    const int col = col0 + bj * 128;
                    if (su2 != nullptr && col >= C_SU && col < NPROJ) { const int row = row0 + ai * 128 + m * 16, cs = col - C_SU;
                        *(u32x4*)(su2 + ((size_t)((row >> 12) * 16 + (cs >> 4)) * 4096 + (row & 4095)) * 16 + (cs & 15)) = w; }
                    else *(u32x4*)(rowp + bj * 128) = w; } }
    }
};
struct EpiOut {
    static constexpr bool PERM = false;
    const float* xin; float* xout; const float* gate;
    __device__ __forceinline__ void operator()(const f32x4 (&acc)[2][2][4][2], const gm::Unit& u, int wr, int wc, int fr_, int fq_) const {
        int fr = fr_, fq = fq_; asm volatile("" : "+v"(fr), "+v"(fq));
        const int row0 = u.pm * 256 + wr * 64 + fr, col0 = u.pn * 256 + wc * 32 + 4 * fq;
        const float* gp = gate + (size_t)(u.pm >> 4) * 6144 + col0;
        f32x4 gv[2][2];
#pragma unroll
        for (int bj = 0; bj < 2; ++bj)
#pragma unroll
            for (int n = 0; n < 2; ++n) gv[bj][n] = *(const f32x4*)(gp + bj * 128 + n * 16);
#pragma unroll
        for (int ai = 0; ai < 2; ++ai)
#pragma unroll
            for (int m = 0; m < 4; ++m) { const size_t ro = (size_t)(row0 + ai * 128 + m * 16) * 1024 + col0;
#pragma unroll
                for (int bj = 0; bj < 2; ++bj)
#pragma unroll
                    for (int n = 0; n < 2; ++n) { const f32x4 xi = *(const f32x4*)(xin + ro + bj * 128 + n * 16);
                        *(f32x4*)(xout + ro + bj * 128 + n * 16) = xi + gv[bj][n] * acc[ai][bj][m][n]; } }
    }
};
struct EpiGlu {
    static constexpr bool PERM = true;
    const bf16_t* y; bf16_t* mixed; const float* bias;
    __device__ __forceinline__ void operator()(const f32x4 (&acc)[2][2][4][2], const gm::Unit& u, int wr, int wc, int fr_, int fq_) const {
        int fr = fr_, fq = fq_; asm volatile("" : "+v"(fr), "+v"(fq));
        const int row0 = u.pm * 256 + wr * 64 + fr, col0 = wc * 32 + 8 * fq;
#pragma unroll
        for (int ai = 0; ai < 2; ++ai)
#pragma unroll
            for (int m = 0; m < 4; ++m) { const int row = row0 + ai * 128 + m * 16;
#pragma unroll
                for (int bj = 0; bj < 2; ++bj) { const int col = col0 + bj * 128;
                    const f32x4 b0 = *(const f32x4*)(bias + col), b1 = *(const f32x4*)(bias + col + 4);
                    const u32x4 yw = *(const u32x4*)(y + (size_t)row * 256 + col);
                    const f32x4 z0 = acc[ai][bj][m][0] + b0, z1 = acc[ai][bj][m][1] + b1;
                    u32x4 w;
                    w.x = pk2(bflo(yw.x) * sigmoidf_(z0[0]), bfhi(yw.x) * sigmoidf_(z0[1]));
                    w.y = pk2(bflo(yw.y) * sigmoidf_(z0[2]), bfhi(yw.y) * sigmoidf_(z0[3]));
                    w.z = pk2(bflo(yw.z) * sigmoidf_(z1[0]), bfhi(yw.z) * sigmoidf_(z1[1]));
                    w.w = pk2(bflo(yw.w) * sigmoidf_(z1[2]), bfhi(yw.w) * sigmoidf_(z1[3]));
                    *(u32x4*)(mixed + (size_t)row * 1024 + 768 + col) = w; }
                __builtin_amdgcn_sched_barrier(0); }
    }
};
__device__ __forceinline__ float swiglu1(float g, float l) {
    g = fminf(g, 7.0f); l = fminf(fmaxf(l, -7.0f), 7.0f);
    return g * __builtin_amdgcn_rcpf(1.0f + __builtin_amdgcn_exp2f(-2.4554669595930157f * g)) * (l + 1.0f);
}
struct EpiUp {
    static constexpr bool PERM = true;
    bf16_t* act; const float* bias; LAS const int* tab;
    __device__ __forceinline__ void operator()(const f32x4 (&acc)[2][2][4][2], const gm::Unit& u, int wr, int wc, int fr_, int fq_) const {
        int fr = fr_, fq = fq_; asm volatile("" : "+v"(fr), "+v"(fq));
        const int rl0 = wr * 64 + fr, col0 = u.pn * 128 + wc * 32 + 8 * fq;
        const float* bp = bias + (size_t)u.e * 2048 + col0;
        unsigned bgp[4], blp[4];
        { const f32x4 bg0 = *(const f32x4*)(bp), bg1 = *(const f32x4*)(bp + 4), bl0 = *(const f32x4*)(bp + 1024), bl1 = *(const f32x4*)(bp + 1028);
          bgp[0] = pk2(bg0[0], bg0[1]); bgp[1] = pk2(bg0[2], bg0[3]); bgp[2] = pk2(bg1[0], bg1[1]); bgp[3] = pk2(bg1[2], bg1[3]);
          blp[0] = pk2(bl0[0], bl0[1]); blp[1] = pk2(bl0[2], bl0[3]); blp[2] = pk2(bl1[0], bl1[1]); blp[3] = pk2(bl1[2], bl1[3]); }
        const size_t arow = (size_t)(tab[64 + u.e] + u.pm * 256);
#pragma unroll
        for (int ai = 0; ai < 2; ++ai)
#pragma unroll
            for (int m = 0; m < 4; ++m) { const int rl = rl0 + ai * 128 + m * 16;
                if (rl < u.rows) {
                    const f32x4 bg0 = {bflo(bgp[0]), bfhi(bgp[0]), bflo(bgp[1]), bfhi(bgp[1])}, bg1 = {bflo(bgp[2]), bfhi(bgp[2]), bflo(bgp[3]), bfhi(bgp[3])};
                    const f32x4 bl0 = {bflo(blp[0]), bfhi(blp[0]), bflo(blp[1]), bfhi(blp[1])}, bl1 = {bflo(blp[2]), bfhi(blp[2]), bflo(blp[3]), bfhi(blp[3])};
                    const f32x4 g0 = acc[ai][0][m][0] + bg0, g1 = acc[ai][0][m][1] + bg1, l0 = acc[ai][1][m][0] + bl0, l1 = acc[ai][1][m][1] + bl1;
                    u32x4 w;
                    w.x = pk2(swiglu1(g0[0], l0[0]), swiglu1(g0[1], l0[1])); w.y = pk2(swiglu1(g0[2], l0[2]), swiglu1(g0[3], l0[3]));
                    w.z = pk2(swiglu1(g1[0], l1[0]), swiglu1(g1[1], l1[1])); w.w = pk2(swiglu1(g1[2], l1[2]), swiglu1(g1[3], l1[3]));
                    *(u32x4*)(act + (arow + rl) * 1024 + col0) = w; } }
    }
};
struct EpiDown {
    static constexpr bool PERM = true;
    bf16_t* outr; const float* bias; const int* stok; const float* sgate;
    __device__ __forceinline__ void operator()(const f32x4 (&acc)[2][2][4][2], const gm::Unit& u, int wr, int wc, int fr_, int fq_) const {
        int fr = fr_, fq = fq_; asm volatile("" : "+v"(fr), "+v"(fq));
        const int rl0 = wr * 64 + fr, col0 = u.pn * 256 + wc * 32 + 8 * fq;
        const float* bp = bias + (size_t)u.e * 1024 + col0;
        f32x4 bv[2][2];
#pragma unroll
        for (int bj = 0; bj < 2; ++bj) { bv[bj][0] = *(const f32x4*)(bp + bj * 128); bv[bj][1] = *(const f32x4*)(bp + bj * 128 + 4); }
        int sts[8]; float gts[8];
#pragma unroll
        for (int q = 0; q < 8; ++q) { const int rl = rl0 + (q >> 2) * 128 + (q & 3) * 16; const int si = u.e * CAP + u.pm * 256 + (rl < u.rows ? rl : 0); sts[q] = stok[si]; gts[q] = sgate[si]; }
#pragma unroll
        for (int ai = 0; ai < 2; ++ai)
#pragma unroll
            for (int m = 0; m < 4; ++m) { const int rl = rl0 + ai * 128 + m * 16;
                if (rl < u.rows) {
                    const int st = sts[ai * 4 + m]; const float gt = gts[ai * 4 + m];
                    bf16_t* rowp = outr + (size_t)st * 1024 + col0;
#pragma unroll
                    for (int bj = 0; bj < 2; ++bj) { const f32x4 v0 = (acc[ai][bj][m][0] + bv[bj][0]) * gt, v1 = (acc[ai][bj][m][1] + bv[bj][1]) * gt;
                        u32x4 w; w.x = pk2(v0[0], v0[1]); w.y = pk2(v0[2], v0[3]); w.z = pk2(v1[0], v1[1]); w.w = pk2(v1[2], v1[3]);
                        *(u32x4*)(rowp + bj * 128) = w; } } }
    }
};

__device__ __forceinline__ void transpose_item(const float* W, int K, int Nsrc, bf16_t* WT, int mode, LAS float* scr, int kb, int nb, int lane) {
    const int k0 = 64 * kb, n0 = 32 * nb;
    const int ncol = n0 + (lane & 31);
#pragma unroll 8
    for (int i = 0; i < 32; ++i) { const int kk = 2 * i + (lane >> 5); scr[kk * 33 + (lane & 31)] = (ncol < Nsrc) ? W[(size_t)(k0 + kk) * Nsrc + ncol] : 0.f; }
    LDS_WAIT(); asm volatile("" ::: "memory");
    const int c = lane & 7;
#pragma unroll
    for (int j = 0; j < 4; ++j) { const int n = (lane >> 3) + 8 * j; const LAS float* s = scr + (8 * c) * 33 + n;
        u32x4 o; o.x = pk2(s[0 * 33], s[1 * 33]); o.y = pk2(s[2 * 33], s[3 * 33]); o.z = pk2(s[4 * 33], s[5 * 33]); o.w = pk2(s[6 * 33], s[7 * 33]);
        int drow = n0 + n;
        if (mode == 1) { const int jj = drow & 1023, lin = drow >> 10; drow = (jj >> 7) * 256 + lin * 128 + (jj & 127); }
        *(u32x4*)(WT + (size_t)drow * K + k0 + 8 * c) = o; }
    LDS_WAIT(); asm volatile("" ::: "memory");
}
constexpr int TI_IN = 16 * 88, TI_OUT = 16 * 32, TI_UP = 16 * 64, TI_DN = 16 * 32, TI_GLU = 4 * 8;
constexpr int TS_R0 = 2 * TI_IN, TS_R1 = TS_R0 + 2 * TI_OUT, TS_R2 = TS_R1 + 2 * TI_GLU;
__device__ __forceinline__ void transpose_small(const Params& P, LAS unsigned char* lds, int gw, int ngw, int wave, int lane) {
    unsigned char* const wsp = opaque_ptr(P.ws);
    LAS float* scr = (LAS float*)(lds + wave * 8704);
    for (int it = gw; it < TS_R2; it += ngw) {
        if (it < TS_R0) { const int l = it / TI_IN, r = it % TI_IN;
            transpose_item(P.w_in + (size_t)l * 1024 * NPROJ, 1024, NPROJ, (bf16_t*)(wsp + WS_WIN) + (size_t)l * NPROJP * 1024, 0, scr, r / 88, r % 88, lane); }
        else if (it < TS_R1) { const int q = it - TS_R0, l = q / TI_OUT, r = q % TI_OUT;
            transpose_item(P.w_out + (size_t)l * 1024 * 1024, 1024, 1024, (bf16_t*)(wsp + WS_WOUT) + (size_t)l * 1024 * 1024, 0, scr, r / 32, r % 32, lane); }
        else { const int q = it - TS_R1, l = q / TI_GLU, r = q % TI_GLU;
            transpose_item(P.s5_w_glu + (size_t)l * 256 * 256, 256, 256, (bf16_t*)(wsp + WS_WGLU) + (size_t)l * 256 * 256, 0, scr, r / 8, r % 8, lane); }
    }
}
__device__ __forceinline__ void transpose_item64(const float* W, int K, int Nsrc, bf16_t* WT, int mode, LAS float* scr, int kb, int nb, int lane) {
    const int k0 = 64 * kb, n0 = 64 * nb, kq = lane >> 4, nn = 4 * (lane & 15);
    const float* src = W + (size_t)(k0 + kq) * Nsrc + n0 + nn;
    f32x4 v[16];
#pragma unroll
    for (int i = 0; i < 16; ++i) v[i] = __builtin_nontemporal_load((const f32x4*)(src + (size_t)(4 * i) * Nsrc));
#pragma unroll
    for (int i = 0; i < 16; ++i) { LAS float* d = scr + (4 * i + kq) * 65 + nn; d[0] = v[i][0]; d[1] = v[i][1]; d[2] = v[i][2]; d[3] = v[i][3]; }
    LDS_WAIT(); asm volatile("" ::: "memory");
    const int c = lane & 7;
#pragma unroll
    for (int j = 0; j < 8; ++j) { const int n = (lane >> 3) + 8 * j; const LAS float* s = scr + (8 * c) * 65 + n;
        u32x4 o; o.x = pk2(s[0 * 65], s[1 * 65]); o.y = pk2(s[2 * 65], s[3 * 65]); o.z = pk2(s[4 * 65], s[5 * 65]); o.w = pk2(s[6 * 65], s[7 * 65]);
        int drow = n0 + n;
        if (mode == 1) { const int jj = drow & 1023, lin = drow >> 10; drow = (jj >> 7) * 256 + lin * 128 + (jj & 127); }
        *(u32x4*)(WT + (size_t)drow * K + k0 + 8 * c) = o; }
    LDS_WAIT(); asm volatile("" ::: "memory");
}
constexpr int TM_UP = 16 * 32, TM_DN = 16 * 16;
constexpr int TM_TOTAL = 32 * (TM_UP + TM_DN), TM_Q_IN = 2560, TM_Q_DN = 5120, TM_Q_P0 = 8192;
__device__ __forceinline__ void transpose_moe_item(const Params& P, unsigned char* wsp, LAS float* scr, int l, int it, int lane) {
    if (it < 32 * TM_UP) { const int le = l * 32 + it / TM_UP, r = it % TM_UP;
        transpose_item64(P.w_up + (size_t)le * 1024 * 2048, 1024, 2048, (bf16_t*)(wsp + WS_WUP) + (size_t)le * 2048 * 1024, 1, scr, r / 32, r % 32, lane); }
    else { const int q = it - 32 * TM_UP, le = l * 32 + q / TM_DN, r = q % TM_DN;
        transpose_item64(P.w_down + (size_t)le * 1024 * 1024, 1024, 1024, (bf16_t*)(wsp + WS_WDN) + (size_t)le * 1024 * 1024, 0, scr, r / 16, r % 16, lane); }
}
__device__ __forceinline__ int tm_pool_size(int l) { return l == 0 ? TM_Q_P0 + TM_Q_IN : TM_Q_DN + TM_Q_IN; }
__device__ __forceinline__ void transpose_moe_pool(const Params& P, LAS unsigned char* lds, int l, int limit) {
    unsigned char* const wsp = opaque_ptr(P.ws);
    const int tid = opaque_tid(), wave = __builtin_amdgcn_readfirstlane(tid >> 6), lane = tid & 63;
    LAS float* scr = (LAS float*)(lds + wave * 16640);
    int* ctr = (int*)(wsp + WS_CTL) + 128 + l;
    const int qa = tm_pool_size(l);
    for (;;) {
        if (8 * __builtin_amdgcn_readfirstlane(__hip_atomic_load(ctr, __ATOMIC_RELAXED, __HIP_MEMORY_SCOPE_AGENT)) >= limit) break;
        int bt = 0; if (lane == 0) bt = __hip_atomic_fetch_add(ctr, 1, __ATOMIC_RELAXED, __HIP_MEMORY_SCOPE_AGENT);
        bt = __builtin_amdgcn_readfirstlane(bt);
        if (8 * bt >= qa) break;
#pragma unroll 1
        for (int k = 0; k < 8; ++k) transpose_moe_item(P, wsp, scr, l, 8 * bt + k, lane);
    }
}
__device__ __forceinline__ void transpose_moe_rest(const Params& P, LAS unsigned char* lds, int l, int gw, int ngw) {
    transpose_moe_pool(P, lds, l, TM_TOTAL);
    unsigned char* const wsp = opaque_ptr(P.ws);
    const int tid = opaque_tid(), wave = __builtin_amdgcn_readfirstlane(tid >> 6), lane = tid & 63;
    LAS float* scr = (LAS float*)(lds + wave * 16640);
    for (int it = tm_pool_size(l) + gw; it < TM_TOTAL; it += ngw) transpose_moe_item(P, wsp, scr, l, it, lane);
}
__device__ __forceinline__ int xcd_vc(int c, int Gp) { const int q = Gp / 8, r = Gp % 8, xcd = c % 8, off = c / 8; return (xcd < r ? xcd * (q + 1) : r * (q + 1) + (xcd - r) * q) + off; }
__device__ __forceinline__ void mod_item(const Params& P, LAS unsigned char* lds, int item) {
    unsigned char* const wsp = opaque_ptr(P.ws);
    const int tid = opaque_tid(), wave = tid >> 6, lane = tid & 63;
    LAS float* sc = (LAS float*)lds;
    LAS float* red = (LAS float*)(lds + 32768);
    const int l = item / 96, cb = item % 96;
    for (int i = tid; i < 8192; i += NTHREADS) sc[i] = siluf(P.c[i]);
    __syncthreads();
    const float* W = P.w_mod + (size_t)l * 1024 * 6144 + cb * 64 + lane;
    float a[8];
#pragma unroll
    for (int b = 0; b < 8; ++b) a[b] = 0.f;
#pragma unroll 1
    for (int k0 = wave; k0 < 1024; k0 += 128) { float wv[16];
#pragma unroll
        for (int u = 0; u < 16; ++u) wv[u] = __builtin_nontemporal_load(W + (size_t)(k0 + 8 * u) * 6144);
#pragma unroll
        for (int u = 0; u < 16; ++u) {
#pragma unroll
            for (int b = 0; b < 8; ++b) a[b] += sc[b * 1024 + k0 + 8 * u] * wv[u]; } }
#pragma unroll
    for (int b = 0; b < 8; ++b) red[(wave * 8 + b) * 64 + lane] = a[b];
    __syncthreads();
    { const int b = tid >> 6; float s = 0.f;
#pragma unroll
      for (int w = 0; w < 8; ++w) s += red[(w * 8 + b) * 64 + lane];
      ((float*)(wsp + WS_MOD))[(size_t)(l * 8 + b) * 6144 + cb * 64 + lane] = s + P.b_mod[l * 6144 + cb * 64 + lane]; }
    __syncthreads();
}
__device__ __forceinline__ void dsincos(double x, double& s, double& c) {
    const double x2 = x * x; double ts = x, tc = 1.0; s = x; c = 1.0;
#pragma unroll 1
    for (int k = 1; k <= 14; ++k) { tc = -tc * x2 / (double)((2 * k - 1) * (2 * k)); ts = -ts * x2 / (double)((2 * k) * (2 * k + 1)); c += tc; s += ts; }
}
__device__ __forceinline__ double dexp_small(double z) {
    double t = 1.0, r = 1.0;
#pragma unroll 1
    for (int k = 1; k <= 18; ++k) { t = t * z / (double)k; r += t; }
    return r;
}
__device__ __forceinline__ void s5_tables_item(const Params& P, LAS unsigned char* lds, int item4) {
    unsigned char* const wsp = opaque_ptr(P.ws);
    const int tid = opaque_tid(); const int item = item4 >> 2, qtr = item4 & 3; const int l = item >> 4, g = item & 15, lg = l * 16 + g;
    LAS float* pwr = (LAS float*)lds;
    LAS float* pwi = pwr + 64 * 65;
    LAS float* bbr = pwi + 64 * 65;
    LAS float* bbi = bbr + 1024;
    LAS float* ccr = bbi + 1024;
    LAS float* cci = ccr + 1024;
    if (tid < 64) { const int p = tid;
        const double are = (double)P.s5_a_re[lg * 64 + p], aim = (double)P.s5_a_im[lg * 64 + p];
        const double dt = (double)expf(P.s5_log_dt[lg]);
        const double mag = dexp_small(are * dt);
        double ang = aim * dt; const double TWO_PI = 6.283185307179586476925;
        ang -= TWO_PI * rint(ang / TWO_PI);
        double sn, cs; dsincos(ang, sn, cs);
        const double lbr = mag * cs, lbi = mag * sn;
        const double nr = lbr - 1.0, ni = lbi, den = are * are + aim * aim;
        const double cfr = (nr * are + ni * aim) / den, cfi = (ni * are - nr * aim) / den;
        double pr = 1.0, pi_ = 0.0;
        for (int t = 0; t <= 64; ++t) { pwr[p * 65 + t] = (float)pr; pwi[p * 65 + t] = (float)pi_; const double nr2 = pr * lbr - pi_ * lbi, ni2 = pr * lbi + pi_ * lbr; pr = nr2; pi_ = ni2; }
        for (int h = 0; h < 16; ++h) { const double br = (double)P.s5_b_re[(lg * 64 + p) * 16 + h], bi = (double)P.s5_b_im[(lg * 64 + p) * 16 + h];
            bbr[p * 16 + h] = (float)(cfr * br - cfi * bi); bbi[p * 16 + h] = (float)(cfr * bi + cfi * br); }
        float* l64 = (float*)(wsp + WS_LAM64) + (size_t)(lg * 64 + p) * 2;
        if (qtr == 0) { l64[0] = pwr[p * 65 + 64]; l64[1] = pwi[p * 65 + 64]; }
    }
    for (int i = tid; i < 1024; i += NTHREADS) { ccr[i] = P.s5_c_re[lg * 1024 + i]; cci[i] = P.s5_c_im[lg * 1024 + i]; }
    __syncthreads();
    bf16_t* kt = (bf16_t*)(wsp + WS_KTAB) + (size_t)lg * 65 * 256;
    for (int i = qtr * 16 * 256 + tid; i < (qtr == 3 ? 65 : 16 * (qtr + 1)) * 256; i += NTHREADS) { const int tau = i >> 8, h = (i >> 4) & 15, h2 = i & 15; float s = 0.f;
        if (tau < 64) {
            for (int p = 0; p < 64; ++p) { const float pr = pwr[p * 65 + tau], pi_ = pwi[p * 65 + tau], br = bbr[p * 16 + h2], bi = bbi[p * 16 + h2];
                const float wr_ = pr * br - pi_ * bi, wi_ = pr * bi + pi_ * br; s += ccr[h * 64 + p] * wr_ - cci[h * 64 + p] * wi_; }
            if (tau == 0 && h == h2) s += P.s5_d[l * 256 + g * 16 + h]; }
        kt[i] = (bf16_t)f2bf(s); }
    bf16_t* bp = (bf16_t*)(wsp + WS_BPOW) + (size_t)lg * 128 * 1024;
    for (int i = qtr * 32768 + tid; i < (qtr + 1) * 32768; i += NTHREADS) { const int q = i >> 10, s = (i >> 4) & 63, h2 = i & 15, p = q & 63;
        const float pr = pwr[p * 65 + 63 - s], pi_ = pwi[p * 65 + 63 - s], br = bbr[p * 16 + h2], bi = bbi[p * 16 + h2];
        const float v = (q < 64) ? (pr * br - pi_ * bi) : (pr * bi + pi_ * br);
        bp[(s * 128 + q) * 16 + h2] = (bf16_t)f2bf(v); }
    bf16_t* cp = (bf16_t*)(wsp + WS_CPOW) + (size_t)lg * 1024 * 128;
    for (int i = qtr * 32768 + tid; i < (qtr + 1) * 32768; i += NTHREADS) { const int q = i & 127, th = i >> 7, t = th >> 4, h = th & 15, p = q & 63;
        const float pr = pwr[p * 65 + t + 1], pi_ = pwi[p * 65 + t + 1], cr = ccr[h * 64 + p], ci = cci[h * 64 + p];
        const float v = (q < 64) ? (cr * pr - ci * pi_) : -(cr * pi_ + ci * pr);
        cp[((q >> 4) * 1024 + th) * 16 + (q & 15)] = (bf16_t)f2bf(v); }
    __syncthreads();
}
__device__ __forceinline__ void rope_table(const Params& P, int gtid, int gthreads) {
    unsigned char* const wsp = opaque_ptr(P.ws);
    float* rp = (float*)(wsp + WS_ROPE);
    for (int i = gtid; i < 4096 * 24; i += gthreads) { const int pos = i / 24, f = i % 24;
        double rev = (double)pos * P.inv_freq_rev[f]; rev -= rint(rev);
        double sn, cs; dsincos(rev * 6.283185307179586476925, sn, cs);
        rp[2 * i] = (float)cs; rp[2 * i + 1] = (float)sn; }
}
__device__ __forceinline__ void norm_row_store(const f32x4 (&v)[4], const float* nw, const float* modrow_sh, const float* modrow_sc, bf16_t* orow, int lane) {
    float ss = 0.f;
#pragma unroll
    for (int j = 0; j < 4; ++j) ss += (v[j][0] * v[j][0] + v[j][1] * v[j][1]) + (v[j][2] * v[j][2] + v[j][3] * v[j][3]);
    const float rstd = 1.0f / sqrtf(wave_sum(ss, lane) * (1.0f / 1024.0f) + NORM_EPS);
#pragma unroll
    for (int hf = 0; hf < 2; ++hf) { const int col = hf * 512 + 8 * lane; float o[8];
#pragma unroll
        for (int q = 0; q < 2; ++q) { const f32x4 w = *(const f32x4*)(nw + col + 4 * q), sc = *(const f32x4*)(modrow_sc + col + 4 * q), sh = *(const f32x4*)(modrow_sh + col + 4 * q);
#pragma unroll
            for (int e = 0; e < 4; ++e) o[4 * q + e] = v[hf * 2 + q][e] * rstd * w[e] * (1.0f + sc[e]) + sh[e]; }
        u32x4 w4; w4.x = pk2(o[0], o[1]); w4.y = pk2(o[2], o[3]); w4.z = pk2(o[4], o[5]); w4.w = pk2(o[6], o[7]);
        *(u32x4*)(orow + col) = w4; }
}

template <int KS>
__device__ __forceinline__ f32x16 mma32(LAS const unsigned char* A, int lda, LAS const unsigned char* B, int ldb, f32x16 acc, int lane) {
    const int r = lane & 31, h = lane >> 5;
#pragma unroll
    for (int ks = 0; ks < KS; ++ks) {
        const bf16x8 a = *(const LAS bf16x8*)(A + r * lda + ks * 32 + h * 16);
        const bf16x8 b = *(const LAS bf16x8*)(B + r * ldb + ks * 32 + h * 16);
        acc = __builtin_amdgcn_mfma_f32_32x32x16_bf16(a, b, acc, 0, 0, 0);
    }
    return acc;
}
__device__ __forceinline__ int crow(int reg, int lane) { return (reg & 3) + 8 * (reg >> 2) + 4 * (lane >> 5); }

constexpr int MA_QD = 0, MA_KI = 7168, MA_KET = 14336, MA_VT = 23552, MA_RAW = 37376, MA_SLOT = 37376 + 4 * 7168;
__device__ __forceinline__ bf16x8 frag_from(unsigned a, unsigned b, unsigned c, unsigned d) { const u32x4 v = {a, b, c, d}; return __builtin_bit_cast(bf16x8, v); }
struct MixPf { u32x4 v[3]; bf16x8 ga[2]; u32x4 qk[6]; };
__device__ __forceinline__ void mixer_pf_load(const Params& P, int round, MixPf& pf) {
    unsigned char* const wsp = opaque_ptr(P.ws);
    const int tid = opaque_tid(), w = __builtin_amdgcn_readfirstlane(tid >> 6), lane = tid & 63, r = lane & 31, hh = lane >> 5;
    const int slot = w >> 2, wv = w & 3;
    const int item = 2 * round + slot, n = item & 63, h = (item >> 6) & 3, b = (item >> 8) & 7, type = item >> 11;
    const bf16_t* prow = (const bf16_t*)(wsp + WS_PROJ) + (size_t)(b * SEQ + n * 64) * NPROJP;
    const int cv = (type ? C_RV : C_GV) + h * 96, t4 = wv * 64 + lane;
#pragma unroll
    for (int jj = 0; jj < 3; ++jj) { const int p = t4 + 256 * jj, j = p / 12, c = p % 12; pf.v[jj] = *(const u32x4*)(prow + (size_t)j * NPROJP + cv + 8 * c); }
    if (type == 0) {
#pragma unroll
        for (int m2 = 0; m2 < 2; ++m2) pf.ga[m2] = *(const bf16x8*)(prow + (size_t)(32 * m2 + r) * NPROJP + C_GA + 8 * hh); }
    { const int mt = wv >> 1, cq = (type ? C_RQ : C_GQ) + h * 48, ck = (type ? C_RK : C_GK) + h * 48;
#pragma unroll
      for (int i = 0; i < 3; ++i) { const int p = lane + 64 * i, rr = p / 6, c = p % 6; const bf16_t* pr = prow + (size_t)(32 * mt + rr) * NPROJP + 8 * c;
          pf.qk[i] = *(const u32x4*)(pr + cq); pf.qk[3 + i] = *(const u32x4*)(pr + ck); } }
}
__device__ __forceinline__ void mixer_phase_a(const Params& P, LAS unsigned char* lds, int l, int round, int next_round, MixPf& pf) {
    unsigned char* const wsp = opaque_ptr(P.ws);
    const int tid = opaque_tid(), w = __builtin_amdgcn_readfirstlane(tid >> 6), lane = tid & 63, r = lane & 31, hh = lane >> 5;
    const int slot = w >> 2, wv = w & 3, nt = wv & 1, mt = wv >> 1;
    const int item = 2 * round + slot, n = item & 63, h = (item >> 6) & 3, b = (item >> 8) & 7, type = item >> 11;
    LAS unsigned char* const L = lds + slot * MA_SLOT;
    const bf16_t* prow = (const bf16_t*)(wsp + WS_PROJ) + (size_t)(b * SEQ + n * 64) * NPROJP;
    const int cq = (type ? C_RQ : C_GQ) + h * 48, ck = (type ? C_RK : C_GK) + h * 48, cv = (type ? C_RV : C_GV) + h * 96;
    const int d = 32 * nt + r; const bool dvalid = d < 48;
    { const int t4 = wv * 64 + lane;
#pragma unroll
      for (int jj = 0; jj < 3; ++jj) { const int p = t4 + 256 * jj, j = p / 12, c = p % 12;
          const u32x4 vv = pf.v[jj];
          LAS bf16_t* dst = (LAS bf16_t*)(L + MA_VT + (8 * c) * 144 + j * 2);
          dst[0 * 72] = (bf16_t)(vv.x & 0xffff); dst[1 * 72] = (bf16_t)(vv.x >> 16); dst[2 * 72] = (bf16_t)(vv.y & 0xffff); dst[3 * 72] = (bf16_t)(vv.y >> 16);
          dst[4 * 72] = (bf16_t)(vv.z & 0xffff); dst[5 * 72] = (bf16_t)(vv.z >> 16); dst[6 * 72] = (bf16_t)(vv.w & 0xffff); dst[7 * 72] = (bf16_t)(vv.w >> 16); } }
    LAS unsigned char* const RW = L + MA_RAW + wv * 7168;
#pragma unroll
    for (int i = 0; i < 3; ++i) { const int p = lane + 64 * i, rr = p / 6, c = p % 6; *(LAS u32x4*)(RW + rr * 112 + c * 16) = pf.qk[i]; *(LAS u32x4*)(RW + 3584 + rr * 112 + c * 16) = pf.qk[3 + i]; }
    LDS_WAIT(); asm volatile("" ::: "memory");
    LAS const unsigned char* const rwq = RW + hh * 448;
    float qv[16], kv[16], cum[16], tot;
    if (type == 0) {
#pragma unroll
        for (int reg = 0; reg < 16; ++reg) { const int ro = ((reg & 3) + 8 * (reg >> 2)) * 112 + d * 2;
            qv[reg] = dvalid ? bf2f(*(const LAS bf16_t*)(rwq + ro)) * 0.14433756729740643f : 0.f; kv[reg] = dvalid ? bf2f(*(const LAS bf16_t*)(rwq + 3584 + ro)) : 0.f; }
        const bf16_t* wat = (const bf16_t*)(wsp + WS_WA2T) + (size_t)((l * 4 + h) * 64 + d) * 16 + 8 * hh;
        const bf16x8 waf = *(const bf16x8*)wat;
        const float bias = dvalid ? P.gla_b_a[l * 192 + h * 48 + d] : 0.f;
        unsigned xh[2][2][4];
#pragma unroll
        for (int m2 = 0; m2 < 2; ++m2) {
            const bf16x8 gaf = pf.ga[m2];
            f32x16 pre;
#pragma unroll
            for (int i = 0; i < 16; ++i) pre[i] = 0.f;
            pre = __builtin_amdgcn_mfma_f32_32x32x16_bf16(gaf, waf, pre, 0, 0, 0);
            float la[16];
#pragma unroll
            for (int reg = 0; reg < 16; ++reg) { const float x = pre[reg] + bias;
                const float ls2 = fminf(x, 0.f) * 1.4426950408889634f - __builtin_amdgcn_logf(1.0f + __builtin_amdgcn_exp2f(-1.4426950408889634f * fabsf(x)));
                la[reg] = dvalid ? ls2 * (1.0f / 16.0f) : 0.f; }
#pragma unroll
            for (int s2 = 0; s2 < 2; ++s2)
#pragma unroll
                for (int q = 0; q < 4; ++q) xh[m2][s2][q] = pk2(la[8 * s2 + 2 * q], la[8 * s2 + 2 * q + 1]);
        }
        f32x16 cacc, tacc;
#pragma unroll
        for (int i = 0; i < 16; ++i) { cacc[i] = 0.f; tacc[i] = 0.f; }
        const bf16x8 ones = frag_from(0x3F803F80u, 0x3F803F80u, 0x3F803F80u, 0x3F803F80u);
#pragma unroll
        for (int m2 = 0; m2 < 2; ++m2)
#pragma unroll
            for (int s2 = 0; s2 < 2; ++s2) {
                const bf16x8 fh = frag_from(xh[m2][s2][0], xh[m2][s2][1], xh[m2][s2][2], xh[m2][s2][3]);
                tacc = __builtin_amdgcn_mfma_f32_32x32x16_bf16(ones, fh, tacc, 0, 0, 0);
                if (m2 < mt) { cacc = __builtin_amdgcn_mfma_f32_32x32x16_bf16(ones, fh, cacc, 0, 0, 0); }
                else if (m2 == mt) { unsigned tw[4];
#pragma unroll
                    for (int q = 0; q < 4; ++q) { const int k0 = 16 * s2 + 8 * ((2 * q) >> 2) + 4 * hh + ((2 * q) & 3), k1 = 16 * s2 + 8 * ((2 * q + 1) >> 2) + 4 * hh + ((2 * q + 1) & 3);
                        tw[q] = (k0 <= r ? 0x3F80u : 0u) | (k1 <= r ? 0x3F800000u : 0u); }
                    const bf16x8 tri = frag_from(tw[0], tw[1], tw[2], tw[3]);
                    cacc = __builtin_amdgcn_mfma_f32_32x32x16_bf16(tri, fh, cacc, 0, 0, 0); }
            }
#pragma unroll
        for (int reg = 0; reg < 16; ++reg) cum[reg] = cacc[reg];
        tot = tacc[0];
    } else {
        const float lgam = P.log_gamma[h];
        const float* rope = (const float*)(wsp + WS_ROPE) + (size_t)(n * 64) * 48;
        const int dp = (d < 24) ? d + 24 : d - 24, f = (d < 24) ? d : d - 24;
#pragma unroll
        for (int reg = 0; reg < 16; ++reg) { const int t = 32 * mt + crow(reg, lane); const int ro = ((reg & 3) + 8 * (reg >> 2)) * 112;
            float q0 = 0.f, q1 = 0.f, k0 = 0.f, k1 = 0.f, cs = 1.f, sn = 0.f;
            if (dvalid) { q0 = bf2f(*(const LAS bf16_t*)(rwq + ro + d * 2)); q1 = bf2f(*(const LAS bf16_t*)(rwq + ro + dp * 2)); k0 = bf2f(*(const LAS bf16_t*)(rwq + 3584 + ro + d * 2)); k1 = bf2f(*(const LAS bf16_t*)(rwq + 3584 + ro + dp * 2));
                cs = rope[t * 48 + 2 * f]; sn = rope[t * 48 + 2 * f + 1]; }
            qv[reg] = (d < 24) ? (q0 * cs - q1 * sn) : (q1 * sn + q0 * cs);
            kv[reg] = ((d < 24) ? (k0 * cs - k1 * sn) : (k1 * sn + k0 * cs)) * 0.14433756729740643f;
            cum[reg] = (float)(t + 1) * lgam * 1.4426950408889634f; }
        tot = 64.0f * lgam * 1.4426950408889634f;
    }
    {
        float ke[16];
#pragma unroll
        for (int reg = 0; reg < 16; ++reg) { const int t = 32 * mt + crow(reg, lane);
            const float e1 = __builtin_amdgcn_exp2f(cum[reg]), e2 = __builtin_amdgcn_exp2f(-cum[reg]), e3 = __builtin_amdgcn_exp2f(tot - cum[reg]);
            const bf16_t qd = (bf16_t)f2bf(qv[reg] * e1), ki = (bf16_t)f2bf(kv[reg] * e2); ke[reg] = kv[reg] * e3;
            if (dvalid) { *(LAS bf16_t*)(L + MA_QD + t * 112 + d * 2) = qd; *(LAS bf16_t*)(L + MA_KI + t * 112 + d * 2) = ki; } }
#pragma unroll
        for (int g4 = 0; g4 < 4; ++g4) { const int t0 = 32 * mt + 8 * g4 + 4 * hh; u32x2 pk; pk.x = pk2(ke[4 * g4], ke[4 * g4 + 1]); pk.y = pk2(ke[4 * g4 + 2], ke[4 * g4 + 3]);
            *(LAS u32x2*)(L + MA_KET + d * 144 + t0 * 2) = pk; }
        if (mt == 0 && hh == 0 && dvalid) ((float*)(wsp + MXW_DEC))[(size_t)item * 48 + d] = __builtin_amdgcn_exp2f(tot);
    }
    if (next_round < 2048) mixer_pf_load(P, next_round, pf);
    __syncthreads();
    { bf16_t* qdg = (bf16_t*)(wsp + MXW_QD) + (size_t)item * 3072; const int t4 = wv * 64 + lane;
#pragma unroll
      for (int jj = 0; jj < 2; ++jj) { const int p = t4 + 256 * jj; if (p < 384) { const int row = p / 6, c = p % 6; *(u32x4*)(qdg + row * 48 + c * 8) = *(const LAS u32x4*)(L + MA_QD + row * 112 + c * 16); } } }
    int rep3 = (TIME_PHASE == 41) ? 2 : 1; asm volatile("" : "+s"(rep3));
#pragma unroll 1
    for (int rq_ = 0; rq_ < rep3; ++rq_)
    {
        unsigned* oig = (unsigned*)(wsp + MXW_OI) + (size_t)item * 3072;
        bf16_t* dsg = (bf16_t*)(wsp + MXW_DS) + (size_t)item * 4608;
        f32x16 zero16;
#pragma unroll
        for (int i = 0; i < 16; ++i) zero16[i] = 0.f;
        const int it = (wv == 0) ? 0 : 1;
        f32x16 sd = mma32<3>(L + MA_KI + it * 32 * 112, 112, L + MA_QD + it * 32 * 112, 112, zero16, lane);
        unsigned xd[2][4];
#pragma unroll
        for (int s2 = 0; s2 < 2; ++s2)
#pragma unroll
            for (int q = 0; q < 4; ++q) { const int r0 = 8 * s2 + 2 * q; const float a0 = (crow(r0, lane) <= r) ? sd[r0] : 0.f, a1 = (crow(r0 + 1, lane) <= r) ? sd[r0 + 1] : 0.f; xd[s2][q] = pk2(a0, a1); }
        unsigned xo[2][4];
        if (it == 1) { const f32x16 so = mma32<3>(L + MA_KI, 112, L + MA_QD + 32 * 112, 112, zero16, lane);
#pragma unroll
            for (int s2 = 0; s2 < 2; ++s2)
#pragma unroll
                for (int q = 0; q < 4; ++q) xo[s2][q] = pk2(so[8 * s2 + 2 * q], so[8 * s2 + 2 * q + 1]); }
        const int nvt = (wv == 0) ? 3 : 1, vt0 = (wv == 0) ? 0 : wv - 1;
#pragma unroll 1
        for (int vi = 0; vi < nvt; ++vi) { const int vt = vt0 + vi;
            f32x16 oacc = zero16;
            LAS const unsigned char* vb = L + MA_VT + (32 * vt + r) * 144 + 8 * hh;
            if (it == 1) {
#pragma unroll
                for (int s2 = 0; s2 < 2; ++s2) { const u32x2 lo = *(const LAS u32x2*)(vb + 32 * s2), hi = *(const LAS u32x2*)(vb + 32 * s2 + 16);
                    oacc = __builtin_amdgcn_mfma_f32_32x32x16_bf16(frag_from(xo[s2][0], xo[s2][1], xo[s2][2], xo[s2][3]), frag_from(lo.x, lo.y, hi.x, hi.y), oacc, 0, 0, 0); } }
#pragma unroll
            for (int s2 = 0; s2 < 2; ++s2) { const u32x2 lo = *(const LAS u32x2*)(vb + 64 * it + 32 * s2), hi = *(const LAS u32x2*)(vb + 64 * it + 32 * s2 + 16);
                oacc = __builtin_amdgcn_mfma_f32_32x32x16_bf16(frag_from(xd[s2][0], xd[s2][1], xd[s2][2], xd[s2][3]), frag_from(lo.x, lo.y, hi.x, hi.y), oacc, 0, 0, 0); }
#pragma unroll
            for (int q = 0; q < 8; ++q) oig[((it * 3 + vt) * 8 + q) * 64 + lane] = pk2(oacc[2 * q], oacc[2 * q + 1]);
            const int dt = (wv == 0) ? 1 : 0;
            const f32x16 ds = mma32<4>(L + MA_KET + dt * 32 * 144, 144, L + MA_VT + vt * 32 * 144, 144, zero16, lane);
#pragma unroll
            for (int g4 = 0; g4 < 4; ++g4) { const int d0 = 32 * dt + 8 * g4 + 4 * hh;
                if (d0 < 48) { u32x2 o; o.x = pk2(ds[4 * g4], ds[4 * g4 + 1]); o.y = pk2(ds[4 * g4 + 2], ds[4 * g4 + 3]); *(u32x2*)(dsg + (32 * vt + r) * 48 + d0) = o; } }
        }
    }
    __syncthreads();
}
__device__ __forceinline__ void mixer_phase_b(const Params& P, int bid, int G) {
    unsigned char* const wsp = opaque_ptr(P.ws);
    const int tid = opaque_tid();
    for (int task = bid * NTHREADS + tid; task < 64 * 1152; task += G * NTHREADS) {
        const int seq = task / 1152, q4 = task % 1152, d0 = (q4 % 12) * 4;
        const bf16_t* dsp = (const bf16_t*)(wsp + MXW_DS) + (size_t)seq * 64 * 4608 + q4 * 4;
        const float* dcp = (const float*)(wsp + MXW_DEC) + (size_t)seq * 64 * 48 + d0;
        bf16_t* spp = (bf16_t*)(wsp + MXW_SP) + (size_t)seq * 64 * 4608 + q4 * 4;
        u32x2 dsv[64];
#pragma unroll
        for (int n = 0; n < 64; ++n) dsv[n] = *(const u32x2*)(dsp + (size_t)n * 4608);
        f32x4 st = {0.f, 0.f, 0.f, 0.f};
#pragma unroll
        for (int n = 0; n < 64; ++n) { const f32x4 dc = *(const f32x4*)(dcp + n * 48);
            u32x2 pk; pk.x = pk2(st[0], st[1]); pk.y = pk2(st[2], st[3]); *(u32x2*)(spp + (size_t)n * 4608) = pk;
            st[0] = dc[0] * st[0] + bflo(dsv[n].x); st[1] = dc[1] * st[1] + bfhi(dsv[n].x); st[2] = dc[2] * st[2] + bflo(dsv[n].y); st[3] = dc[3] * st[3] + bfhi(dsv[n].y); }
    }
}
__device__ __forceinline__ void mixer_phase_c(const Params& P, LAS unsigned char* lds, int l, int item) {
    unsigned char* const wsp = opaque_ptr(P.ws);
    const int tid = opaque_tid(), w = __builtin_amdgcn_readfirstlane(tid >> 6), lane = tid & 63, r = lane & 31, hh = lane >> 5;
    LAS float* const Lw = (LAS float*)(lds + w * 12800);
    const int n = item & 63, h = (item >> 6) & 3, b = (item >> 8) & 7, type = item >> 11;
    const size_t tok0 = (size_t)b * SEQ + n * 64;
    const unsigned* oig = (const unsigned*)(wsp + MXW_OI) + (size_t)item * 3072;
    const bf16_t* qdg = (const bf16_t*)(wsp + MXW_QD) + (size_t)item * 3072 + 8 * hh;
    const bf16_t* spg = (const bf16_t*)(wsp + MXW_SP) + (size_t)item * 4608 + 8 * hh;
    const int rq = lane >> 2, q4 = lane & 3;
    const bf16_t* gp = (const bf16_t*)(wsp + WS_PROJ) + tok0 * NPROJP + (type ? C_RG : C_GG) + h * 96 + 24 * q4;
    bf16_t* mp = (bf16_t*)(wsp + WS_MIXED) + tok0 * 1024 + type * 384 + h * 96 + 24 * q4;
    const float* nw = (type ? P.ret_norm_w : P.gla_norm_w) + l * 384 + h * 96 + 24 * q4;
    f32x16 acc[2][3];
#pragma unroll
    for (int it = 0; it < 2; ++it)
#pragma unroll
        for (int vt = 0; vt < 3; ++vt)
#pragma unroll
            for (int q = 0; q < 8; ++q) { const unsigned u = oig[((it * 3 + vt) * 8 + q) * 64 + lane]; acc[it][vt][2 * q] = bflo(u); acc[it][vt][2 * q + 1] = bfhi(u); }
#pragma unroll
    for (int ks = 0; ks < 3; ++ks) {
        const bf16x8 a0 = *(const bf16x8*)(qdg + r * 48 + ks * 16), a1 = *(const bf16x8*)(qdg + (32 + r) * 48 + ks * 16);
#pragma unroll
        for (int vt = 0; vt < 3; ++vt) { const bf16x8 bb = *(const bf16x8*)(spg + (32 * vt + r) * 48 + ks * 16);
            acc[0][vt] = __builtin_amdgcn_mfma_f32_32x32x16_bf16(a0, bb, acc[0][vt], 0, 0, 0);
            acc[1][vt] = __builtin_amdgcn_mfma_f32_32x32x16_bf16(a1, bb, acc[1][vt], 0, 0, 0); } }
    f32x4 nwv[6];
#pragma unroll
    for (int q = 0; q < 6; ++q) nwv[q] = *(const f32x4*)(nw + 4 * q);
    u32x4 gall[4][3];
#pragma unroll
    for (int p4 = 0; p4 < 4; ++p4)
#pragma unroll
        for (int q = 0; q < 3; ++q) gall[p4][q] = *(const u32x4*)(gp + (size_t)(16 * p4 + rq) * NPROJP + 8 * q);
#pragma unroll
    for (int it = 0; it < 2; ++it) {
#pragma unroll
        for (int vt = 0; vt < 3; ++vt)
#pragma unroll
            for (int reg = 0; reg < 16; ++reg) Lw[crow(reg, lane) * 100 + 32 * vt + r] = acc[it][vt][reg];
        LDS_WAIT(); asm volatile("" ::: "memory");
#pragma unroll
        for (int ps = 0; ps < 2; ++ps) { const int rl = 16 * ps + rq, i = 32 * it + rl;
            f32x4 x[6]; u32x4 gw[3];
#pragma unroll
            for (int q = 0; q < 6; ++q) x[q] = *(const LAS f32x4*)(Lw + rl * 100 + 24 * q4 + 4 * q);
#pragma unroll
            for (int q = 0; q < 3; ++q) gw[q] = gall[it * 2 + ps][q];
            if (type == 1) { float sm = 0.f;
#pragma unroll
                for (int q = 0; q < 6; ++q) sm += (x[q][0] + x[q][1]) + (x[q][2] + x[q][3]);
                sm += lx_f(sm, lane, 1); sm += lx_f(sm, lane, 2);
                const float mean = sm * (1.0f / 96.0f);
#pragma unroll
                for (int q = 0; q < 6; ++q) x[q] = x[q] - mean; }
            float ss = 0.f;
#pragma unroll
            for (int q = 0; q < 6; ++q) ss += (x[q][0] * x[q][0] + x[q][1] * x[q][1]) + (x[q][2] * x[q][2] + x[q][3] * x[q][3]);
            ss += lx_f(ss, lane, 1); ss += lx_f(ss, lane, 2);
            const float rstd = 1.0f / sqrtf(ss * (1.0f / 96.0f) + NORM_EPS);
#pragma unroll
            for (int q = 0; q < 3; ++q) { const f32x4 xa = x[2 * q] * nwv[2 * q] * rstd, xb = x[2 * q + 1] * nwv[2 * q + 1] * rstd; const u32x4 g = gw[q];
                u32x4 o;
                o.x = pk2(xa[0] * siluf(bflo(g.x)), xa[1] * siluf(bfhi(g.x))); o.y = pk2(xa[2] * siluf(bflo(g.y)), xa[3] * siluf(bfhi(g.y)));
                o.z = pk2(xb[0] * siluf(bflo(g.z)), xb[1] * siluf(bfhi(g.z))); o.w = pk2(xb[2] * siluf(bflo(g.w)), xb[3] * siluf(bfhi(g.w)));
                *(u32x4*)(mp + (size_t)i * 1024 + 8 * q) = o; } }
        LDS_WAIT(); asm volatile("" ::: "memory");
    }
}

constexpr int S5_KT = 0, S5_U0 = 33280, S5_UB = 64 * 528, S5_EB = S5_U0 + 2 * S5_UB, S5_CY = S5_EB + 32768;
__device__ __forceinline__ float gelu_tanh(float x) { const float u = 0.7978845608028654f * (x + 0.044715f * x * x * x); const float e = __expf(2.0f * u); const float th = 1.0f - 2.0f / (e + 1.0f); return 0.5f * x * (1.0f + th); }
__device__ __forceinline__ void s5_item(const Params& P, LAS unsigned char* lds, int l, int item) {
    unsigned char* const wsp = opaque_ptr(P.ws);
    const int tid = opaque_tid(), w = __builtin_amdgcn_readfirstlane(tid >> 6), lane = tid & 63, r = lane & 31, hh = lane >> 5;
    const int half = item & 1, b = item >> 5, g = (item >> 1) & 15, lg = l * 16 + g;
    const bf16_t* ub = (const bf16_t*)(wsp + WS_SU2) + (size_t)(b * 16 + g) * 4096 * 16 + 8 * hh;
    const bf16_t* ktg = (const bf16_t*)(wsp + WS_KTAB) + (size_t)lg * 65 * 256;
    const bf16_t* bpw = (const bf16_t*)(wsp + WS_BPOW) + (size_t)lg * 128 * 1024 + (size_t)((w & 3) * 32 + r) * 16 + 8 * hh;
    const bf16_t* cpw = (const bf16_t*)(wsp + WS_CPOW) + (size_t)lg * 1024 * 128;
    { int rp = (TIME_PHASE == 44) ? 3 : 1; asm volatile("" : "+s"(rp));
#pragma unroll 1
      for (int q_ = 0; q_ < rp; ++q_) { for (int p = tid; p < 2080; p += NTHREADS) *(LAS u32x4*)(lds + S5_KT + p * 16) = *(const u32x4*)(ktg + p * 8);
    __syncthreads(); } }
    f32x16 acc[2][2], eacc;
    const int nt0 = half ? (w + 8) : w, nt1 = half ? (w + 16) : (w + 24);
#pragma unroll
    for (int j = 0; j < 2; ++j)
#pragma unroll
        for (int mt = 0; mt < 2; ++mt)
#pragma unroll
            for (int i = 0; i < 16; ++i) acc[j][mt][i] = 0.f;
#pragma unroll
    for (int i = 0; i < 16; ++i) eacc[i] = 0.f;
    const int emt = w >> 2;
    const bf16_t* ug = (const bf16_t*)(wsp + WS_SU2) + (size_t)(b * 16 + g) * 4096 * 16;
    u32x4 pfu[4];
#define S5_GLOAD(gi) do { _Pragma("unroll") for (int j_ = 0; j_ < 4; ++j_) { const int p_ = tid + NTHREADS * j_; pfu[j_] = *(const u32x4*)(ug + (size_t)((p_ >> 5) * 64 + 16 * (gi)) * 16 + (p_ & 31) * 8); } } while (0)
#define S5_GWRITE(bufoff) do { _Pragma("unroll") for (int j_ = 0; j_ < 4; ++j_) { const int p_ = tid + NTHREADS * j_; *(LAS u32x4*)(lds + (bufoff) + (p_ >> 5) * 528 + (p_ & 31) * 16) = pfu[j_]; } } while (0)
#define S5_STEP(A0, A1, BP, s) do { \
        _Pragma("unroll") for (int j = 0; j < 2; ++j) { const int t0 = 2 * (j ? nt1 : nt0); \
            if (t0 + 1 >= (s)) { const int tt = t0 + (r >> 4); const int tau = tt - (s); const int slot = tau < 0 ? 64 : tau; \
                const bf16x8 kb = *(const LAS bf16x8*)(lds + S5_KT + slot * 512 + (lane & 15) * 32 + hh * 16); \
                acc[j][0] = __builtin_amdgcn_mfma_f32_32x32x16_bf16(A0, kb, acc[j][0], 0, 0, 0); \
                acc[j][1] = __builtin_amdgcn_mfma_f32_32x32x16_bf16(A1, kb, acc[j][1], 0, 0, 0); } } \
        eacc = __builtin_amdgcn_mfma_f32_32x32x16_bf16(emt ? A1 : A0, BP, eacc, 0, 0, 0); } while (0)
    S5_GLOAD(0); S5_GWRITE(S5_U0);
    __syncthreads();
#pragma unroll 1
    for (int gi = 0; gi < 4; ++gi) {
        if (gi < 3) S5_GLOAD(gi + 1);
        LAS const unsigned char* ubuf = lds + S5_U0 + (gi & 1) * S5_UB + r * 528 + hh * 16;
        bf16x8 rbp[4];
#pragma unroll
        for (int u = 0; u < 4; ++u) rbp[u] = *(const bf16x8*)(bpw + (16 * gi + u) * 2048);
#pragma unroll
        for (int q4 = 0; q4 < 4; ++q4) {
#pragma unroll
            for (int u = 0; u < 4; ++u) { const int sl = 4 * q4 + u, s = 16 * gi + sl;
                const bf16x8 a0 = *(const LAS bf16x8*)(ubuf + sl * 32), a1 = *(const LAS bf16x8*)(ubuf + 32 * 528 + sl * 32);
                S5_STEP(a0, a1, rbp[u], s);
                if (q4 < 3) rbp[u] = *(const bf16x8*)(bpw + (s + 4) * 2048); }
        }
        if (gi < 3) { S5_GWRITE(S5_U0 + ((gi + 1) & 1) * S5_UB); __syncthreads(); }
    }
#undef S5_GLOAD
#undef S5_GWRITE
#undef S5_STEP
#pragma unroll
    for (int reg = 0; reg < 16; ++reg) ((LAS float*)(lds + S5_EB))[(emt * 32 + crow(reg, lane)) * 128 + (w & 3) * 32 + r] = eacc[reg];
    __syncthreads();
    { int rp = (TIME_PHASE == 42) ? 3 : 1; asm volatile("" : "+s"(rp));
#pragma unroll 1
    for (int q_ = 0; q_ < rp; ++q_)
    if (tid < 64) { const int p = tid; const float* l64 = (const float*)(wsp + WS_LAM64) + (size_t)(lg * 64 + p) * 2; const float ar = l64[0], ai = l64[1];
        float cr = 0.f, ci = 0.f;
#pragma unroll 1
        for (int n = 0; n < 64; ++n) {
            *(LAS bf16_t*)(lds + S5_CY + n * 272 + p * 2) = (bf16_t)f2bf(cr); *(LAS bf16_t*)(lds + S5_CY + n * 272 + (64 + p) * 2) = (bf16_t)f2bf(ci);
            const float er = ((const LAS float*)(lds + S5_EB))[n * 128 + p], ei = ((const LAS float*)(lds + S5_EB))[n * 128 + 64 + p];
            const float nr = ar * cr - ai * ci + er, ni = ar * ci + ai * cr + ei; cr = nr; ci = ni; } } }
    __syncthreads();
#pragma unroll
    for (int j = 0; j < 2; ++j) { const bf16_t* cpr = cpw + (size_t)((j ? nt1 : nt0) * 32 + r) * 16 + 8 * hh;
#pragma unroll
        for (int ks = 0; ks < 8; ++ks) { const bf16x8 cb = *(const bf16x8*)(cpr + ks * 16384);
            const bf16x8 c0 = *(const LAS bf16x8*)(lds + S5_CY + r * 272 + ks * 32 + hh * 16), c1 = *(const LAS bf16x8*)(lds + S5_CY + (32 + r) * 272 + ks * 32 + hh * 16);
            acc[j][0] = __builtin_amdgcn_mfma_f32_32x32x16_bf16(c0, cb, acc[j][0], 0, 0, 0);
            acc[j][1] = __builtin_amdgcn_mfma_f32_32x32x16_bf16(c1, cb, acc[j][1], 0, 0, 0); } }
    bf16_t* yb = (bf16_t*)(wsp + WS_YBUF) + (size_t)b * SEQ * 256 + g * 16 + (lane & 15);
    int rpe = (TIME_PHASE == 43) ? 3 : 1; asm volatile("" : "+s"(rpe));
#pragma unroll 1
    for (int q_ = 0; q_ < rpe; ++q_)
#pragma unroll
    for (int j = 0; j < 2; ++j) { const int tt = 2 * (j ? nt1 : nt0) + (r >> 4);
#pragma unroll
        for (int mt = 0; mt < 2; ++mt)
#pragma unroll
            for (int reg = 0; reg < 16; ++reg) { const int n = mt * 32 + crow(reg, lane);
                yb[(size_t)(n * 64 + tt) * 256] = (bf16_t)f2bf(gelu_tanh(acc[j][mt][reg])); } }
    __syncthreads();
}

constexpr int RT_SC = 0, RT_SH = 4096, RT_RS = 8192, RT_PART = 8704, RT_CNT = 8704 + 2 * 128 * 33 * 4, RT_BASE = RT_CNT + 128, RT_TE = RT_BASE + 128, RT_TG = RT_TE + 2048, RT_TR = RT_TG + 2048;
__device__ __forceinline__ void router_phase(const Params& P, LAS unsigned char* lds, int l, int blk) {
    unsigned char* const wsp = opaque_ptr(P.ws);
    const int tid = opaque_tid(), w = __builtin_amdgcn_readfirstlane(tid >> 6), lane = tid & 63, r = lane & 31, hh = lane >> 5;
    const float* x = (const float*)(wsp + WS_X);
    bf16_t* hdn = (bf16_t*)(wsp + WS_HDN);
    const int tok0 = blk * 128, b = tok0 >> 12;
    const float* mrow = (const float*)(wsp + WS_MOD) + (size_t)(l * 8 + b) * 6144;
    int* gcount = (int*)(wsp + WS_CTL) + l * 32;
    int* stok = (int*)(wsp + WS_STOK); float* sgate = (float*)(wsp + WS_SGATE);
    LAS float* scL = (LAS float*)(lds + RT_SC); LAS float* shL = (LAS float*)(lds + RT_SH); LAS float* rsL = (LAS float*)(lds + RT_RS);
    for (int i = tid; i < 1024; i += NTHREADS) { scL[i] = P.norm2_w[l * 1024 + i] * (1.0f + mrow[4096 + i]); shL[i] = mrow[3072 + i]; }
    if (tid < 32) ((LAS int*)(lds + RT_CNT))[tid] = 0;
    __syncthreads();
    {
        f32x4 sc[4], sh[4];
#pragma unroll
        for (int j = 0; j < 4; ++j) { sc[j] = *(const LAS f32x4*)(scL + 4 * lane + 256 * j); sh[j] = *(const LAS f32x4*)(shL + 4 * lane + 256 * j); }
#pragma unroll 1
        for (int t4 = 0; t4 < 16; t4 += 4) {
            f32x4 v[4][4]; float ss[4];
#pragma unroll
            for (int u = 0; u < 4; ++u) { const size_t tok = (size_t)(tok0 + w * 16 + t4 + u);
#pragma unroll
                for (int j = 0; j < 4; ++j) v[u][j] = *(const f32x4*)(x + tok * 1024 + 4 * lane + 256 * j); }
#pragma unroll
            for (int u = 0; u < 4; ++u) { float a_ = 0.f;
#pragma unroll
                for (int j = 0; j < 4; ++j) a_ += (v[u][j][0] * v[u][j][0] + v[u][j][1] * v[u][j][1]) + (v[u][j][2] * v[u][j][2] + v[u][j][3] * v[u][j][3]);
                ss[u] = a_; }
#pragma unroll
            for (int o = 1; o < 64; o <<= 1) {
#pragma unroll
                for (int u = 0; u < 4; ++u) ss[u] += lx_f(ss[u], lane, o); }
#pragma unroll
            for (int u = 0; u < 4; ++u) { const int tl = w * 16 + t4 + u; const size_t tok = (size_t)(tok0 + tl);
                const float rstd = 1.0f / sqrtf(ss[u] * (1.0f / 1024.0f) + NORM_EPS);
                if (lane == 0) rsL[tl] = rstd;
#pragma unroll
                for (int j = 0; j < 4; ++j) { const f32x4 hv = v[u][j] * rstd * sc[j] + sh[j]; u32x2 pk; pk.x = pk2(hv[0], hv[1]); pk.y = pk2(hv[2], hv[3]);
                    *(u32x2*)(hdn + tok * 1024 + 4 * lane + 256 * j) = pk; } } }
    }
    __syncthreads();
    {
        const int mt = w & 3, kh = w >> 2;
        const float* xr = x + (size_t)(tok0 + 32 * mt + r) * 1024 + 512 * kh + 8 * hh;
        const bf16_t* wt = (const bf16_t*)(wsp + WS_RWT) + (size_t)l * 2 * 32 * 1024 + (size_t)(32 * kh) * 512 + r * 16 + 8 * hh;
        const float rs = rsL[32 * mt + r];
        f32x16 acc;
#pragma unroll
        for (int i = 0; i < 16; ++i) acc[i] = 0.f;
#pragma unroll 8
        for (int ks = 0; ks < 32; ++ks) {
            const f32x4 x0 = *(const f32x4*)(xr + 16 * ks), x1 = *(const f32x4*)(xr + 16 * ks + 4);
            const int kk = 512 * kh + 16 * ks + 8 * hh;
            const f32x4 c0 = *(const LAS f32x4*)(scL + kk), c1 = *(const LAS f32x4*)(scL + kk + 4), s0 = *(const LAS f32x4*)(shL + kk), s1 = *(const LAS f32x4*)(shL + kk + 4);
            const f32x4 h0 = x0 * rs * c0 + s0, h1 = x1 * rs * c1 + s1;
            unsigned ah[4], al[4];
            ah[0] = pk2(h0[0], h0[1]); ah[1] = pk2(h0[2], h0[3]); ah[2] = pk2(h1[0], h1[1]); ah[3] = pk2(h1[2], h1[3]);
            al[0] = pk2(h0[0] - bflo(ah[0]), h0[1] - bfhi(ah[0])); al[1] = pk2(h0[2] - bflo(ah[1]), h0[3] - bfhi(ah[1]));
            al[2] = pk2(h1[0] - bflo(ah[2]), h1[1] - bfhi(ah[2])); al[3] = pk2(h1[2] - bflo(ah[3]), h1[3] - bfhi(ah[3]));
            const bf16x8 bh = *(const bf16x8*)(wt + 512 * ks), bl = *(const bf16x8*)(wt + 32 * 1024 + 512 * ks);
            const bf16x8 fah = frag_from(ah[0], ah[1], ah[2], ah[3]), fal = frag_from(al[0], al[1], al[2], al[3]);
            acc = __builtin_amdgcn_mfma_f32_32x32x16_bf16(fah, bh, acc, 0, 0, 0);
            acc = __builtin_amdgcn_mfma_f32_32x32x16_bf16(fah, bl, acc, 0, 0, 0);
            acc = __builtin_amdgcn_mfma_f32_32x32x16_bf16(fal, bh, acc, 0, 0, 0);
        }
        LAS float* part = (LAS float*)(lds + RT_PART) + kh * 128 * 33;
#pragma unroll
        for (int reg = 0; reg < 16; ++reg) part[(32 * mt + crow(reg, lane)) * 33 + r] = acc[reg];
    }
    __syncthreads();
    if (tid < 128) {
        const LAS float* p0 = (const LAS float*)(lds + RT_PART) + tid * 33; const LAS float* p1 = p0 + 128 * 33;
        float v0 = -3.0e38f, v1 = -3.0e38f, v2 = -3.0e38f, v3 = -3.0e38f; int e0 = 0, e1 = 0, e2 = 0, e3 = 0;
#pragma unroll
        for (int e = 0; e < 32; ++e) { const float lg = p0[e] + p1[e] + P.router_b[l * 32 + e];
            if (lg > v3) { if (lg > v2) { v3 = v2; e3 = e2; if (lg > v1) { v2 = v1; e2 = e1; if (lg > v0) { v1 = v0; e1 = e0; v0 = lg; e0 = e; } else { v1 = lg; e1 = e; } } else { v2 = lg; e2 = e; } } else { v3 = lg; e3 = e; } } }
        const float x1 = __expf(v1 - v0), x2 = __expf(v2 - v0), x3 = __expf(v3 - v0), inv = 1.0f / (1.0f + x1 + x2 + x3);
        LAS int* cnt = (LAS int*)(lds + RT_CNT);
        LAS int* te = (LAS int*)(lds + RT_TE) + tid * 4; LAS float* tg = (LAS float*)(lds + RT_TG) + tid * 4; LAS int* tr = (LAS int*)(lds + RT_TR) + tid * 4;
        te[0] = e0; te[1] = e1; te[2] = e2; te[3] = e3; tg[0] = inv; tg[1] = x1 * inv; tg[2] = x2 * inv; tg[3] = x3 * inv;
        tr[0] = __hip_atomic_fetch_add(cnt + e0, 1, __ATOMIC_RELAXED, __HIP_MEMORY_SCOPE_WORKGROUP); tr[1] = __hip_atomic_fetch_add(cnt + e1, 1, __ATOMIC_RELAXED, __HIP_MEMORY_SCOPE_WORKGROUP);
        tr[2] = __hip_atomic_fetch_add(cnt + e2, 1, __ATOMIC_RELAXED, __HIP_MEMORY_SCOPE_WORKGROUP); tr[3] = __hip_atomic_fetch_add(cnt + e3, 1, __ATOMIC_RELAXED, __HIP_MEMORY_SCOPE_WORKGROUP);
    }
    __syncthreads();
    if (tid < 32) ((LAS int*)(lds + RT_BASE))[tid] = atomicAdd(gcount + tid, ((LAS int*)(lds + RT_CNT))[tid]);
    __syncthreads();
    { const int e = ((LAS int*)(lds + RT_TE))[tid]; const int pos = ((LAS int*)(lds + RT_BASE))[e] + ((LAS int*)(lds + RT_TR))[tid];
      stok[e * CAP + pos] = (tok0 + (tid >> 2)) * 4 + (tid & 3); sgate[e * CAP + pos] = ((LAS float*)(lds + RT_TG))[tid]; }
    __syncthreads();
}

__device__ __forceinline__ void combine_phase(const Params& P, int l, int gw, int ngw, int lane_in) {
    unsigned char* const wsp = opaque_ptr(P.ws);
    int lane = lane_in; asm volatile("" : "+v"(lane));
    float* x = (float*)(wsp + WS_X);
    const bf16_t* outr = (const bf16_t*)(wsp + WS_OUTR);
    bf16_t* hdn = (bf16_t*)(wsp + WS_HDN);
    for (int tokp = gw; tokp < T_TOK / 2; tokp += ngw) {
        u32x4 rr[2][2][4]; f32x4 xv[2][4];
#pragma unroll
        for (int u = 0; u < 2; ++u) { const size_t tok = (size_t)(2 * tokp + u);
#pragma unroll
            for (int hf = 0; hf < 2; ++hf) { const int col = hf * 512 + 8 * lane;
#pragma unroll
                for (int k = 0; k < 4; ++k) rr[u][hf][k] = *(const u32x4*)(outr + (tok * 4 + k) * 1024 + col);
                xv[u][hf * 2] = *(const f32x4*)(x + tok * 1024 + col); xv[u][hf * 2 + 1] = *(const f32x4*)(x + tok * 1024 + col + 4); } }
#pragma unroll
        for (int u = 0; u < 2; ++u) { const int tok = 2 * tokp + u; const int b = tok >> 12;
            const float* mrow = (const float*)(wsp + WS_MOD) + (size_t)(l * 8 + b) * 6144;
            f32x4 v[4];
#pragma unroll
            for (int hf = 0; hf < 2; ++hf) { const int col = hf * 512 + 8 * lane;
                float s[8];
#pragma unroll
                for (int e = 0; e < 8; ++e) s[e] = 0.f;
#pragma unroll
                for (int k = 0; k < 4; ++k) { const u32x4 r4 = rr[u][hf][k];
                    s[0] += bflo(r4.x); s[1] += bfhi(r4.x); s[2] += bflo(r4.y); s[3] += bfhi(r4.y); s[4] += bflo(r4.z); s[5] += bfhi(r4.z); s[6] += bflo(r4.w); s[7] += bfhi(r4.w); }
#pragma unroll
                for (int q = 0; q < 2; ++q) { const f32x4 x4 = xv[u][hf * 2 + q], g2 = *(const f32x4*)(mrow + 5120 + col + 4 * q);
                    f32x4 o; o[0] = x4[0] + g2[0] * s[4 * q]; o[1] = x4[1] + g2[1] * s[4 * q + 1]; o[2] = x4[2] + g2[2] * s[4 * q + 2]; o[3] = x4[3] + g2[3] * s[4 * q + 3];
                    v[hf * 2 + q] = o; if (l + 1 < NLAYER) *(f32x4*)(x + (size_t)tok * 1024 + col + 4 * q) = o; } }
            if (l + 1 < NLAYER) {
                const float* mnext = (const float*)(wsp + WS_MOD) + (size_t)((l + 1) * 8 + b) * 6144;
                norm_row_store(v, P.norm1_w + (l + 1) * 1024, mnext, mnext + 1024, hdn + (size_t)tok * 1024, lane);
            } else {
                float ss = 0.f;
#pragma unroll
                for (int j = 0; j < 4; ++j) ss += (v[j][0] * v[j][0] + v[j][1] * v[j][1]) + (v[j][2] * v[j][2] + v[j][3] * v[j][3]);
                const float rstd = 1.0f / sqrtf(wave_sum(ss, lane) * (1.0f / 1024.0f) + NORM_EPS);
#pragma unroll
                for (int hf = 0; hf < 2; ++hf)
#pragma unroll
                    for (int q = 0; q < 2; ++q) { const int col = hf * 512 + 8 * lane + 4 * q; const f32x4 fw = *(const f32x4*)(P.final_norm_w + col);
                        f32x4 o; o[0] = v[hf * 2 + q][0] * rstd * fw[0]; o[1] = v[hf * 2 + q][1] * rstd * fw[1]; o[2] = v[hf * 2 + q][2] * rstd * fw[2]; o[3] = v[hf * 2 + q][3] * rstd * fw[3];
                        *(f32x4*)(P.out + (size_t)tok * 1024 + col) = o; }
            }
        }
    }
}

#define XB_TMO      128
#define XB_XCNT(j)  (256  + 64 * (j))
#define XB_XSUB(j)  (1280 + 64 * (j))
#define XB_XGEN(j)  (2304 + 64 * (j))
#define XB_TOP      3328
#define XB_TOPGEN   3392
#define XCD_BAR_WORDS 3456
#define XB_SPIN_CAP (1u << 22)
__device__ __forceinline__ unsigned xb_ld(unsigned* p)              { return __hip_atomic_load(p, __ATOMIC_RELAXED, __HIP_MEMORY_SCOPE_AGENT); }
__device__ __forceinline__ unsigned xb_add(unsigned* p, unsigned v) { return __hip_atomic_fetch_add(p, v, __ATOMIC_RELAXED, __HIP_MEMORY_SCOPE_AGENT); }
__device__ __forceinline__ unsigned xb_xcc_id() { return (unsigned)__builtin_amdgcn_s_getreg((3 << 11) | 20) & 0xFu; }
#define XB_SPIN(cond, bar) do { unsigned _sp = 0; while (cond) { __builtin_amdgcn_s_sleep(1); \
    if ((++_sp & 255u) == 0u) { if (xb_ld(&(bar)[XB_TMO])) break; if (_sp > XB_SPIN_CAP) { atomicAdd(&(bar)[XB_TMO], 1u); break; } } } } while (0)
struct XcdBarrier { unsigned* bar; unsigned x; volatile LAS unsigned* st; };
__device__ __forceinline__ XcdBarrier xcd_barrier_post(unsigned* bar, volatile LAS unsigned* st) {
    XcdBarrier b; b.bar = bar; b.x = xb_xcc_id(); b.st = st;
    if (threadIdx.x == 0) (void)xb_add(&bar[XB_XCNT(b.x)], 1u);
    return b;
}
__device__ __forceinline__ void xcd_barrier_complete(unsigned* bar, unsigned x, unsigned& nloc, unsigned& nx) {
    const unsigned G = gridDim.x * gridDim.y * gridDim.z;
    unsigned sum, cnt, mine, sp = 0u;
    for (;;) {
        sum = 0u; cnt = 0u; mine = 0u;
#pragma unroll
        for (unsigned j = 0; j < 16; ++j) { const unsigned c = xb_ld(&bar[XB_XCNT(j)]); sum += c; cnt += (c > 0u) ? 1u : 0u; mine = (j == x) ? c : mine; }
        if (sum == G) break;
        __builtin_amdgcn_s_sleep(1);
        if ((++sp & 255u) == 0u) { if (xb_ld(&bar[XB_TMO])) break; if (sp > XB_SPIN_CAP) { atomicAdd(&bar[XB_TMO], 1u); break; } }
    }
    nloc = mine > 0u ? mine : 1u; nx = cnt > 0u ? cnt : 1u;
}
__device__ __forceinline__ void xcd_barrier(const XcdBarrier& b) {
    asm volatile("s_waitcnt vmcnt(0)" ::: "memory");
    __syncthreads();
    if (threadIdx.x == 0) {
        unsigned* bar = b.bar;
        __builtin_amdgcn_s_waitcnt(0);
        unsigned nloc = b.st[0], nx = b.st[1];
        if (nloc == 0u) { xcd_barrier_complete(bar, b.x, nloc, nx); b.st[0] = nloc; b.st[1] = nx; }
        const unsigned old = xb_add(&bar[XB_XSUB(b.x)], 1u);
        const unsigned gen = old / nloc;
        if (old + 1u == (gen + 1u) * nloc) {
            __builtin_amdgcn_fence(__ATOMIC_RELEASE, "agent");
            asm volatile("s_waitcnt vmcnt(0)" ::: "memory");
            const unsigned og = xb_add(&bar[XB_TOP], 1u);
            const unsigned tg = og / nx;
            if (og + 1u == (tg + 1u) * nx) xb_add(&bar[XB_TOPGEN], 1u);
            else XB_SPIN(xb_ld(&bar[XB_TOPGEN]) == tg, bar);
            __builtin_amdgcn_fence(__ATOMIC_ACQUIRE, "agent");
            xb_add(&bar[XB_XGEN(b.x)], 1u);
            asm volatile("s_waitcnt vmcnt(0)" ::: "memory");
        } else {
            XB_SPIN(xb_ld(&bar[XB_XGEN(b.x)]) == gen, bar);
            __builtin_amdgcn_fence(__ATOMIC_ACQUIRE, "agent");
            asm volatile("s_waitcnt vmcnt(0)" ::: "memory");
        }
    }
    __syncthreads();
}

#ifndef PH
#define PH 0xFFFF
#endif
#define PHON(b) ((((PH) >> (b)) & 1) != 0)
#define TIME_MULT 4
#if TIME_PHASE >= 0
#define PH_T0(k) do { if ((k) == TIME_PHASE && bid == 0) t_ph = __builtin_amdgcn_s_memrealtime(); } while (0)
#define PH_T1(k) do { if ((k) == TIME_PHASE && bid == 0) { const unsigned long long t1_ = __builtin_amdgcn_s_memrealtime(), d_ = t1_ - t_ph; while (__builtin_amdgcn_s_memrealtime() - t1_ < (unsigned long long)TIME_MULT * d_) __builtin_amdgcn_s_sleep(8); } } while (0)
#else
#define PH_T0(k) do { } while (0)
#define PH_T1(k) do { } while (0)
#endif
__global__ void __launch_bounds__(NTHREADS, 2) fwd_megakernel(Params P) {
    extern __shared__ __attribute__((aligned(16))) unsigned char lds_raw[];
    LAS unsigned char* const lds0 = (LAS unsigned char*)lds_raw;
    cg::grid_group grid = cg::this_grid();
    const int G = gridDim.x, bid = blockIdx.x;
    const int vcu = (G % 8 == 0) ? (bid % 8) * (G / 8) + bid / 8 : bid;
    const int ngw = G * NWAVES;
    unsigned long long t_ph = 0; (void)t_ph;
    const unsigned long long t_entry = (TIME_PHASE == 99) ? __builtin_amdgcn_s_memrealtime() : 0ull; (void)t_entry;
    if (threadIdx.x < 4) ((LAS unsigned*)(lds0 + LDS_BYTES - 16))[threadIdx.x] = 0u;
    __syncthreads();
    (void)xcd_barrier_post((unsigned*)(P.ws + WS_BAR), (volatile LAS unsigned*)(lds0 + LDS_BYTES - 16));
#define GSYNC() do { for (int rb_ = 0; rb_ < ((TIME_PHASE == 50) ? 3 : 1); ++rb_) { XcdBarrier xb_; xb_.bar = (unsigned*)(opaque_ptr(P.ws) + WS_BAR); xb_.x = xb_xcc_id(); xb_.st = (volatile LAS unsigned*)(opaque_lds(lds0) + LDS_BYTES - 16); xcd_barrier(xb_); } } while (0)
#define KTID() const int tid = opaque_tid(), wave = __builtin_amdgcn_readfirstlane(tid >> 6), lane = tid & 63, gw = bid * NWAVES + wave; (void)lane; (void)gw

    PH_T0(0);
    { KTID(); unsigned char* const ws = opaque_ptr(P.ws); LAS unsigned char* const lds = opaque_lds(lds0); (void)lds;
    if (bid == 0 && tid < 64) ((int*)(ws + WS_CTL))[tid] = 0;
    if (PHON(0)) for (int it = bid; it < 128 + 192; it += G) { if (it < 128) s5_tables_item(P, lds, it); else mod_item(P, lds, it - 128); }
    rope_table(P, bid * NTHREADS + tid, G * NTHREADS);
    for (int i = bid * NTHREADS + tid; i < 2 * 32 * 1024; i += G * NTHREADS) { const int k_ = i & 1023, e_ = (i >> 10) & 31, l_ = i >> 15; const float wv_ = P.router_w[(size_t)l_ * 1024 * 32 + k_ * 32 + e_];
        const unsigned hw_ = f2bf(wv_); bf16_t* rt_ = (bf16_t*)(ws + WS_RWT) + (size_t)l_ * 2 * 32 * 1024 + (k_ >> 4) * 512 + e_ * 16 + (k_ & 15); rt_[0] = (bf16_t)hw_; rt_[32 * 1024] = (bf16_t)f2bf(wv_ - __builtin_bit_cast(float, hw_ << 16)); }
    for (int i = bid * NTHREADS + tid; i < 2 * 4 * 64 * 16; i += G * NTHREADS) { const int rr = i & 15, dd = (i >> 4) & 63, hh_ = (i >> 10) & 3, ll = i >> 12;
        ((bf16_t*)(ws + WS_WA2T))[i] = (dd < 48) ? (bf16_t)f2bf(P.gla_w_a2[(size_t)ll * 16 * 192 + rr * 192 + hh_ * 48 + dd]) : (bf16_t)0; }
    __syncthreads();
    if (PHON(1)) transpose_small(P, lds, gw, ngw, wave, lane);
    if (bid >= 64) { __syncthreads(); transpose_moe_pool(P, lds, 0, TM_Q_P0); } }
    if (P.ws == nullptr) grid.sync();
    GSYNC(); PH_T1(0); PH_T0(1);
    { KTID(); unsigned char* const ws = opaque_ptr(P.ws); LAS unsigned char* const lds = opaque_lds(lds0); (void)lds;
    for (int tokp = gw; tokp < T_TOK / 2; tokp += ngw) {
        f32x4 v[2][4];
#pragma unroll
        for (int u = 0; u < 2; ++u)
#pragma unroll
            for (int hf = 0; hf < 2; ++hf)
#pragma unroll
                for (int q = 0; q < 2; ++q) v[u][hf * 2 + q] = *(const f32x4*)(P.x + (size_t)(2 * tokp + u) * 1024 + hf * 512 + 8 * lane + 4 * q);
#pragma unroll
        for (int u = 0; u < 2; ++u) { const int tok = 2 * tokp + u; const float* mrow = (const float*)(ws + WS_MOD) + (size_t)(tok >> 12) * 6144;
            norm_row_store(v[u], P.norm1_w, mrow, mrow + 1024, (bf16_t*)(ws + WS_HDN) + (size_t)tok * 1024, lane); }
    } }
    GSYNC(); PH_T1(1);
#pragma unroll 1
    for (int l = 0; l < NLAYER; ++l) {
        PH_T0(2);
        constexpr int G_IN = 240;
        if (bid >= G_IN) { LAS unsigned char* const lds = opaque_lds(lds0); transpose_moe_pool(P, lds, l, (l == 0 ? TM_Q_P0 : TM_Q_DN) + TM_Q_IN); }
        else if (PHON(2)) { unsigned char* const ws = opaque_ptr(P.ws); LAS unsigned char* const lds = opaque_lds(lds0); (void)lds; DenseOrder S; S.init(T_TOK, NPROJP, 1024, G_IN, bid, ws + WS_HDN, (const bf16_t*)(ws + WS_WIN) + (size_t)l * NPROJP * 1024);
          EpiProj E{(bf16_t*)(ws + WS_PROJ), NPROJP, (bf16_t*)(ws + WS_SU2)};
          gm::gemm_phase<EpiProj, DenseOrder, false>(lds, 1024, S, E); }
        GSYNC(); PH_T1(2); PH_T0(3);
        { LAS unsigned char* const lds = opaque_lds(lds0);
#define SUBT0(k, b) do { if (TIME_PHASE == (k) && bid == (b)) t_ph = __builtin_amdgcn_s_memrealtime(); } while (0)
#define SUBT1(k, b) do { if (TIME_PHASE == (k) && bid == (b)) { const unsigned long long t1_ = __builtin_amdgcn_s_memrealtime(), d_ = t1_ - t_ph; while (__builtin_amdgcn_s_memrealtime() - t1_ < (unsigned long long)TIME_MULT * d_) __builtin_amdgcn_s_sleep(8); } } while (0)
          SUBT0(20, 0);
          { int rpa = (TIME_PHASE == 46) ? 2 : 1; asm volatile("" : "+s"(rpa));
#pragma unroll 1
            for (int q_ = 0; q_ < rpa; ++q_)
          if (PHON(3) && bid < 2048) { MixPf pf; mixer_pf_load(P, bid, pf); for (int rd = bid; rd < 2048; rd += G) mixer_phase_a(P, lds, l, rd, rd + G, pf); } }
          SUBT1(20, 0); SUBT0(21, 0);
          { int rps = (TIME_PHASE == 45) ? 2 : 1; asm volatile("" : "+s"(rps));
#pragma unroll 1
            for (int q_ = 0; q_ < rps; ++q_)
          if (PHON(4)) for (int it = bid; it < 256; it += G) s5_item(P, lds, l, it); }
          SUBT1(21, 0); SUBT0(22, 0);
          { KTID(); transpose_moe_rest(P, lds, l, gw, ngw); }
          SUBT1(22, 0); SUBT0(47, 0); SUBT0(48, 101); SUBT0(49, 202); }
        GSYNC(); PH_T1(3); SUBT1(47, 0); SUBT1(48, 101); SUBT1(49, 202); PH_T0(4);
        if (PHON(5) && bid >= 128) { unsigned char* const ws = opaque_ptr(P.ws); LAS unsigned char* const lds = opaque_lds(lds0); (void)lds; DenseOrder S; S.init(T_TOK, 256, 256, G - 128, bid - 128, ws + WS_YBUF, (const bf16_t*)(ws + WS_WGLU) + (size_t)l * 256 * 256);
          EpiGlu E{(const bf16_t*)(ws + WS_YBUF), (bf16_t*)(ws + WS_MIXED), P.s5_b_glu + l * 256};
          gm::gemm_phase<EpiGlu, DenseOrder, false>(lds, 256, S, E); }
        if (PHON(3)) mixer_phase_b(P, bid, G);
        GSYNC(); PH_T1(4); PH_T0(5);
        if (PHON(3)) { KTID(); LAS unsigned char* const lds = opaque_lds(lds0); for (int it = gw; it < 4096; it += ngw) mixer_phase_c(P, lds, l, it); }
        GSYNC(); PH_T1(5); PH_T0(6);
        if (PHON(6)) { unsigned char* const ws = opaque_ptr(P.ws); LAS unsigned char* const lds = opaque_lds(lds0); (void)lds; const float* modl = (const float*)(ws + WS_MOD) + (size_t)l * 8 * 6144; DenseOrder S; S.init(T_TOK, 1024, 1024, G, bid, ws + WS_MIXED, (const bf16_t*)(ws + WS_WOUT) + (size_t)l * 1024 * 1024);
          EpiOut E{l == 0 ? P.x : (const float*)(ws + WS_X), (float*)(ws + WS_X), modl + 2048};
          gm::gemm_phase<EpiOut, DenseOrder, false>(lds, 1024, S, E); }
        GSYNC(); PH_T1(6); PH_T0(7);
        if (PHON(7)) { LAS unsigned char* const lds = opaque_lds(lds0); for (int blk = bid; blk < T_TOK / 128; blk += G) router_phase(P, lds, l, blk); }
        GSYNC(); PH_T1(7); PH_T0(8);
        if (PHON(8)) { unsigned char* const ws = opaque_ptr(P.ws); LAS unsigned char* const lds = opaque_lds(lds0); (void)lds; moe_tables(lds, (const int*)(ws + WS_CTL) + l * 32, 8);
          MoeOrder<true> S; S.tab = (LAS const int*)(lds + MISC_OFF); S.nN = 8; S.G = G; S.vc = vcu; S.Wt = (const char*)(ws + WS_WUP) + (size_t)l * 32 * 2048 * 1024 * 2; S.wstride = (size_t)2048 * 1024 * 2; S.stok = (const int*)(ws + WS_STOK); S.A = (const char*)(ws + WS_HDN); S.gtab = (LAS const unsigned*)(lds + GT_OFF);
          S.fill_gather((LAS unsigned*)(lds + GT_OFF));
          EpiUp E{(bf16_t*)(ws + WS_ACT), P.b_up + (size_t)l * 32 * 2048, (LAS const int*)(lds + MISC_OFF)};
          gm::gemm_phase<EpiUp, MoeOrder<true>, true>(lds, 1024, S, E); }
        GSYNC(); PH_T1(8); PH_T0(9);
#if EXPERIMENT >= 1
        if (l == 0) { unsigned char* const ws = opaque_ptr(P.ws); LAS unsigned char* const lds = opaque_lds(lds0); (void)lds; moe_tables(lds, (const int*)(ws + WS_CTL) + l * 32, 8);
          MoeOrder<(EXPERIMENT != 2)> S; S.tab = (LAS const int*)(lds + MISC_OFF); S.nN = 8; S.G = G; S.vc = vcu; S.Wt = (const char*)(ws + WS_WUP) + (size_t)l * 32 * 2048 * 1024 * 2; S.wstride = (EXPERIMENT == 4) ? 0 : (size_t)2048 * 1024 * 2; S.stok = (const int*)(ws + WS_STOK); S.A = (const char*)(ws + WS_HDN); S.gtab = (LAS const unsigned*)(lds + GT_OFF);
          if (EXPERIMENT != 2) S.fill_gather((LAS unsigned*)(lds + GT_OFF));
          if (EXPERIMENT == 3) { EpiProj E{(bf16_t*)(ws + WS_OUTR), 2048, nullptr}; gm::gemm_phase<EpiProj, MoeOrder<(EXPERIMENT != 2)>, (EXPERIMENT != 2)>(lds, 1024, S, E); }
          else { EpiUp E{(bf16_t*)(ws + WS_OUTR), P.b_up + (size_t)l * 32 * 2048, (LAS const int*)(lds + MISC_OFF)}; gm::gemm_phase<EpiUp, MoeOrder<(EXPERIMENT != 2)>, (EXPERIMENT != 2)>(lds, 1024, S, E); }
          GSYNC(); }
#endif
        if (PHON(9)) { unsigned char* const ws = opaque_ptr(P.ws); LAS unsigned char* const lds = opaque_lds(lds0); (void)lds; moe_tables(lds, (const int*)(ws + WS_CTL) + l * 32, 4);
          const int nunits = ((LAS const int*)(lds + MISC_OFF))[32], nrounds = (nunits + G - 1) / G, gneed0 = nrounds > 0 ? (nunits + nrounds - 1) / nrounds : G, gneed = (gneed0 + 7) & ~7;
          if (bid >= gneed) { if (l + 1 < NLAYER) transpose_moe_pool(P, lds, l + 1, TM_Q_DN); }
          else {
          MoeOrder<false> S; S.tab = (LAS const int*)(lds + MISC_OFF); S.nN = 4; S.G = gneed; S.vc = xcd_vc(bid, gneed); S.Wt = (const char*)(ws + WS_WDN) + (size_t)l * 32 * 1024 * 1024 * 2; S.wstride = (size_t)1024 * 1024 * 2; S.stok = nullptr; S.A = (const char*)(ws + WS_ACT); S.gtab = nullptr;
          EpiDown E{(bf16_t*)(ws + WS_OUTR), P.b_down + (size_t)l * 32 * 1024, (const int*)(ws + WS_STOK), (const float*)(ws + WS_SGATE)};
          gm::gemm_phase<EpiDown, MoeOrder<false>, false>(lds, 1024, S, E); } }
        GSYNC(); PH_T1(9); PH_T0(10);
        if (PHON(10)) { KTID(); combine_phase(P, l, gw, ngw, lane); }
        GSYNC(); PH_T1(10);
    }
    if (TIME_PHASE == 99 && bid == 0) { const unsigned long long t1_ = __builtin_amdgcn_s_memrealtime(), d_ = t1_ - t_entry; while (__builtin_amdgcn_s_memrealtime() - t1_ < d_) __builtin_amdgcn_s_sleep(8); }
}

extern "C" void kernel_launch(void* const* d_in, const int* in_sizes, int n_in, void* d_out, int out_size, void* d_ws, size_t ws_size, hipStream_t stream) {
    static int grid_blocks = 0;
    if (grid_blocks == 0) {
        if (n_in != 29 || ws_size < WS_END) { fprintf(stderr, "kernel_launch: unexpected n_in %d or ws_size %zu (need %zu)\n", n_in, ws_size, (size_t)WS_END); grid_blocks = -1; return; }
        int dev = 0, cus = 0, per_cu = 0;
        (void)hipGetDevice(&dev);
        (void)hipDeviceGetAttribute(&cus, hipDeviceAttributeMultiprocessorCount, dev);
        (void)hipFuncSetAttribute((const void*)fwd_megakernel, hipFuncAttributeMaxDynamicSharedMemorySize, LDS_BYTES);
        (void)hipOccupancyMaxActiveBlocksPerMultiprocessor(&per_cu, (const void*)fwd_megakernel, NTHREADS, LDS_BYTES);
        if (per_cu < 1) { fprintf(stderr, "kernel_launch: occupancy query returned %d\n", per_cu); per_cu = 1; }
        grid_blocks = cus;
        fprintf(stderr, "kernel_launch: cus %d per_cu %d grid %d ws_need %zu\n", cus, per_cu, grid_blocks, (size_t)WS_END);
    }
    if (grid_blocks < 0) return;
    Params p{};
    const float** pp = (const float**)&p;
    for (int i = 0; i < 29; ++i) pp[i] = (const float*)d_in[i];
    p.out = (float*)d_out; p.ws = (unsigned char*)d_ws;
    for (int i = 0; i < 24; ++i) p.inv_freq_rev[i] = pow(10000.0, -(double)(2 * i) / 48.0) / 6.283185307179586476925;
    for (int h = 0; h < 4; ++h) p.log_gamma[h] = (float)log1p(-exp2(-5.0 - (double)h));
    (void)hipMemsetAsync((char*)d_ws + WS_CTL, 0, WS_CTL_BYTES, stream);
    void* args[] = {&p};
    hipError_t e = hipLaunchCooperativeKernel((const void*)fwd_megakernel, dim3(grid_blocks), dim3(NTHREADS), args, LDS_BYTES, stream);
    if (e != hipSuccess) fprintf(stderr, "cooperative launch failed: %s (grid %d)\n", hipGetErrorString(e), grid_blocks);
}
```
